# Optimizing an MI355X kernel written in HIP

```python
import jax
import jax.numpy as jnp
from jax import lax
import numpy as np

D_MODEL = 2048
BATCH = 2
SEQ = 4096
DEPTH = 2

MEM_LEN = 256
BRANCH_W = 512
N_BRANCHES = 5
NORM_EPS = 1e-6

RWKV_HEAD = 64
RWKV_HEADS = BRANCH_W // RWKV_HEAD
RWKV_DECAY_LORA = 96
RWKV_A_LORA = 96
RWKV_GATE_LORA = 256
RWKV_V_LORA = 64
RWKV_GN_EPS = 64e-5

NSA_HEAD = 64
NSA_Q_HEADS = BRANCH_W // NSA_HEAD
NSA_KV_HEADS = 2
NSA_GROUP = NSA_Q_HEADS // NSA_KV_HEADS
NSA_KV_W = NSA_KV_HEADS * NSA_HEAD
COMP_L = 32
COMP_STRIDE = 16
COMP_HIDDEN = 2 * NSA_HEAD
SEL_L = 64
SEL_N = 16
WINDOW = 512
Q_BLOCK = 128

CONV_W = 3

POOL_WINDOWS = (2, 4, 8, 16)
POOL_GROUP = BRANCH_W // len(POOL_WINDOWS)
POOL_OUT = D_MODEL // len(POOL_WINDOWS)

MEM_HEADS = 4
MEM_HEAD = BRANCH_W // MEM_HEADS

D_FF = 5632
N_EXPERTS = 8
TOP_K = 2
EXPERT_FF = 2816
N_DENSE = (DEPTH + 1) // 2
N_MOE = DEPTH // 2

RWKV_COLS = 3 * BRANCH_W + RWKV_DECAY_LORA + RWKV_A_LORA + RWKV_GATE_LORA
NSA_COLS = BRANCH_W + 6 * NSA_KV_W + 3 * NSA_Q_HEADS
CONV_COLS = 3 * BRANCH_W
POOL_COLS = BRANCH_W
MEM_COLS = BRANCH_W
GATE_COLS = N_BRANCHES * D_MODEL
IN_SIZES = (RWKV_COLS, NSA_COLS, CONV_COLS, POOL_COLS, MEM_COLS, GATE_COLS)
N_IN = RWKV_COLS + NSA_COLS + CONV_COLS + POOL_COLS + MEM_COLS + GATE_COLS

kernel_name = 'hybrid_rwkv7_nsa_conv_pool_memxattn_moe'

F32 = jnp.float32


def _split(a, sizes):
    return jnp.split(a, np.cumsum(sizes)[:-1].tolist(), axis=-1)


def _rms(x, g, eps=NORM_EPS):
    xf = x.astype(F32)
    y = xf * lax.rsqrt(jnp.mean(xf * xf, axis=-1, keepdims=True) + eps)
    return (y * g.astype(F32)).astype(x.dtype)


def _masked_softmax(s, mask, scale):
    s = jnp.where(mask, s.astype(F32) * scale, -1e30)
    return jnp.where(mask, jax.nn.softmax(s, axis=-1), 0.0)


def _token_shift(u, mu):
    prev = jnp.pad(u, ((0, 0), (1, 0), (0, 0)))[:, :-1]
    return u + (prev - u) * mu


def _rwkv7_time_mix(u, mu, w0, w2, a0, a2, g2, k_k, k_a, r_k, ln_w, ln_b, v_first, vres):
    B, T, _ = u.shape
    heads = lambda t: t.reshape(B, T, RWKV_HEADS, RWKV_HEAD)
    uf = _token_shift(u, mu).astype(F32)
    r, k, v, wd, ad, gd = _split(uf, (BRANCH_W, BRANCH_W, BRANCH_W, RWKV_DECAY_LORA, RWKV_A_LORA, RWKV_GATE_LORA))
    w_log = -jax.nn.softplus(-(w0 + jnp.tanh(wd) @ w2)) - 0.5
    a = jax.nn.sigmoid(a0 + ad @ a2)
    g = jax.nn.sigmoid(gd) @ g2
    if vres is not None:
        vd, v0, v_up = vres
        v = v + (v_first - v) * jax.nn.sigmoid(v0 + vd.astype(F32) @ v_up)
    kk = heads(k * k_k)
    kk = kk * lax.rsqrt(jnp.maximum(jnp.sum(kk * kk, axis=-1, keepdims=True), 1e-24))
    k = k * (1.0 + (a - 1.0) * k_a)
    rh, kh, vh, ah = heads(r), heads(k), heads(v), heads(a)
    decay = heads(jnp.exp(-jnp.exp(w_log)))

    def step(S, inp):
        r_t, w_t, k_t, v_t, kk_t, a_t = inp
        s_kk = jnp.einsum('bhvk,bhk->bhv', S, kk_t)
        S = S * w_t[:, :, None, :] - s_kk[..., None] * (kk_t * a_t)[:, :, None, :] + v_t[..., None] * k_t[:, :, None, :]
        return S, jnp.einsum('bhvk,bhk->bhv', S, r_t)

    xs = tuple(jnp.moveaxis(t, 1, 0) for t in (rh, decay, kh, vh, kk, ah))
    S0 = jnp.zeros((B, RWKV_HEADS, RWKV_HEAD, RWKV_HEAD), F32)
    _, y = lax.scan(step, S0, xs)
    y = jnp.moveaxis(y, 0, 1)
    y_mu = jnp.mean(y, axis=-1, keepdims=True)
    y_var = jnp.mean(jnp.square(y - y_mu), axis=-1, keepdims=True)
    y = ((y - y_mu) * lax.rsqrt(y_var + RWKV_GN_EPS)).reshape(B, T, BRANCH_W) * ln_w + ln_b
    bonus = jnp.sum(rh * kh * r_k.reshape(RWKV_HEADS, RWKV_HEAD), axis=-1, keepdims=True) * vh
    out = (y + bonus.reshape(B, T, BRANCH_W)) * g
    return out.astype(u.dtype), v


def _nsa(u, qk_gain, cmp_pos, cmp_w1, cmp_b1, cmp_w2):
    B, T, _ = u.shape
    scale = NSA_HEAD ** -0.5
    q, kc, vc, ks, vs, kw, vw, gl = _split(u, (BRANCH_W,) + (NSA_KV_W,) * 6 + (3 * NSA_Q_HEADS,))
    kv_heads = lambda t: t.reshape(B, T, NSA_KV_HEADS, NSA_HEAD)
    q = _rms(q.reshape(B, T, NSA_KV_HEADS, NSA_GROUP, NSA_HEAD), qk_gain[0])
    t_pos = jnp.arange(T)

    n_cmp = (T - COMP_L) // COMP_STRIDE + 1
    blk = np.arange(n_cmp)[:, None] * COMP_STRIDE + np.arange(COMP_L)[None, :]

    def compress(t, i):
        blocks = kv_heads(t)[:, blk] + cmp_pos[i][:, None, :]
        blocks = jnp.moveaxis(blocks, 3, 2).reshape(B, n_cmp, NSA_KV_HEADS, COMP_L * NSA_HEAD)
        return jax.nn.gelu(blocks @ cmp_w1[i] + cmp_b1[i]) @ cmp_w2[i]

    k_cmp = _rms(compress(kc, 0), qk_gain[1])
    v_cmp = compress(vc, 1)
    cmp_mask = (np.arange(n_cmp) * COMP_STRIDE + COMP_L - 1)[None, :] <= t_pos[:, None]
    p_cmp = _masked_softmax(jnp.einsum('bthgd,bchd->bhgtc', q, k_cmp), cmp_mask, scale)
    o_cmp = jnp.einsum('bhgtc,bchd->bthgd', p_cmp, v_cmp)

    n_sel = T // SEL_L
    k_top = min(SEL_N, n_sel)
    c0 = np.arange(n_cmp)[:, None] * COMP_STRIDE
    s0 = np.arange(n_sel)[None, :] * SEL_L
    overlap = np.clip(np.minimum(c0 + COMP_L, s0 + SEL_L) - np.maximum(c0, s0), 0, None) / COMP_L
    imp = jnp.einsum('bhgtc,cs->bhts', p_cmp, jnp.asarray(overlap, F32))
    cur = (t_pos // SEL_L)[:, None]
    sid = jnp.arange(n_sel)[None, :]
    forced = (sid == 0) | (sid == cur) | (sid == cur - 1)
    imp = jnp.where(forced, 1e9, jnp.where(sid <= cur, imp, -1e9))
    top_val, top_idx = lax.top_k(imp, k_top)
    top_ok = top_val > -1e8

    def sel_blocks(t):
        return jnp.moveaxis(t.reshape(B, n_sel, SEL_L, NSA_KV_HEADS, NSA_HEAD), 3, 1)

    k_sel_all = sel_blocks(_rms(kv_heads(ks), qk_gain[2]))
    v_sel_all = sel_blocks(kv_heads(vs))
    pad = ((0, 0), (WINDOW, 0), (0, 0), (0, 0))
    k_win_all = jnp.pad(_rms(kv_heads(kw), qk_gain[3]), pad)
    v_win_all = jnp.pad(kv_heads(vw), pad)
    bi = jnp.arange(B)[:, None, None, None]
    hi = jnp.arange(NSA_KV_HEADS)[None, :, None, None]
    m_len = k_top * SEL_L

    def query_block(args):
        qb, idx, ok, start = args
        tq = start + jnp.arange(Q_BLOCK)
        k_g = k_sel_all[bi, hi, idx]
        v_g = v_sel_all[bi, hi, idx].reshape(B, NSA_KV_HEADS, Q_BLOCK, m_len, NSA_HEAD)
        kpos = idx[..., None] * SEL_L + jnp.arange(SEL_L)
        m_sel = (ok[..., None] & (kpos <= tq[None, None, :, None, None])).reshape(B, NSA_KV_HEADS, 1, Q_BLOCK, m_len)
        s_sel = jnp.einsum('bqhgd,bhqnkd->bhgqnk', qb, k_g).reshape(B, NSA_KV_HEADS, NSA_GROUP, Q_BLOCK, m_len)
        p_sel = _masked_softmax(s_sel, m_sel, scale)
        o_s = jnp.einsum('bhgqm,bhqmd->bqhgd', p_sel, v_g)
        k_w = lax.dynamic_slice_in_dim(k_win_all, start, WINDOW + Q_BLOCK, axis=1)
        v_w = lax.dynamic_slice_in_dim(v_win_all, start, WINDOW + Q_BLOCK, axis=1)
        wpos = start - WINDOW + jnp.arange(WINDOW + Q_BLOCK)
        m_win = (wpos[None, :] <= tq[:, None]) & (wpos[None, :] > tq[:, None] - WINDOW) & (wpos[None, :] >= 0)
        p_win = _masked_softmax(jnp.einsum('bqhgd,bkhd->bhgqk', qb, k_w), m_win, scale)
        o_w = jnp.einsum('bhgqk,bkhd->bqhgd', p_win, v_w)
        return o_s, o_w

    n_qb = T // Q_BLOCK
    to_blocks = lambda t, ax: jnp.moveaxis(t.reshape(t.shape[:ax] + (n_qb, Q_BLOCK) + t.shape[ax + 1:]), ax, 0)
    xs = (to_blocks(q, 1), to_blocks(top_idx, 2), to_blocks(top_ok, 2), jnp.arange(n_qb) * Q_BLOCK)
    o_sel, o_win = lax.map(query_block, xs)
    from_blocks = lambda t: jnp.moveaxis(t, 0, 1).reshape(B, T, NSA_KV_HEADS, NSA_GROUP, NSA_HEAD)

    g = jax.nn.sigmoid(gl.astype(F32)).reshape(B, T, NSA_KV_HEADS, NSA_GROUP, 3)
    o = g[..., 0:1] * o_cmp + g[..., 1:2] * from_blocks(o_sel) + g[..., 2:3] * from_blocks(o_win)
    return o.reshape(B, T, BRANCH_W).astype(u.dtype)


def _short_conv(u, conv_w):
    b_gate, c_gate, x_in = _split(u, (BRANCH_W, BRANCH_W, BRANCH_W))
    z = c_gate * x_in
    y = lax.conv_general_dilated(z, conv_w[:, None, :].astype(z.dtype), window_strides=(1,),
                                 padding=[(CONV_W - 1, 0)], dimension_numbers=('NWC', 'WIO', 'NWC'),
                                 feature_group_count=BRANCH_W)
    return b_gate * y


def _pool(u, pool_w, pool_scale):
    B, T, _ = u.shape
    uf = u.astype(F32)
    cs = jnp.cumsum(uf, axis=1)
    count = jnp.arange(1, T + 1, dtype=F32)[None, :, None]
    outs = []
    for gi, w in enumerate(POOL_WINDOWS):
        sl = slice(gi * POOL_GROUP, (gi + 1) * POOL_GROUP)
        c = cs[..., sl]
        lag = jnp.pad(c, ((0, 0), (w, 0), (0, 0)))[:, :T]
        outs.append((c - lag) / jnp.minimum(count, w) - uf[..., sl])
    pooled = jnp.stack(outs, axis=2).astype(u.dtype)
    y = jnp.einsum('btgc,gcd->btgd', pooled, pool_w).reshape(B, T, D_MODEL)
    return y * pool_scale


def _mem_attn(u, mem_n, w_kv, qk_gain):
    B, T, _ = u.shape
    M = mem_n.shape[1]
    q = _rms(u.reshape(B, T, MEM_HEADS, MEM_HEAD), qk_gain[0])
    k, v = jnp.split(mem_n @ w_kv, 2, axis=-1)
    k = _rms(k.reshape(B, M, MEM_HEADS, MEM_HEAD), qk_gain[1])
    v = v.reshape(B, M, MEM_HEADS, MEM_HEAD)
    s = jnp.einsum('bthd,bmhd->bhtm', q, k).astype(F32) * (MEM_HEAD ** -0.5)
    p = jax.nn.softmax(s, axis=-1)
    o = jnp.einsum('bhtm,bmhd->bthd', p, v)
    return o.reshape(B, T, BRANCH_W).astype(u.dtype)


def _swiglu(h, w1, w3, w2):
    return (jax.nn.silu(h @ w1) * (h @ w3)) @ w2


def _moe(h, router, w1, w3, w2):
    B, T, D = h.shape
    hf = h.reshape(B * T, D)
    logits = (hf @ router).astype(F32)
    top_logit, top_e = lax.top_k(logits, TOP_K)
    top_w = jax.nn.softmax(top_logit, axis=-1)
    combine = jnp.sum(jax.nn.one_hot(top_e, N_EXPERTS, dtype=F32) * top_w[..., None], axis=1)
    out = jnp.zeros((B * T, D), F32)
    for e in range(N_EXPERTS):
        out = out + combine[:, e:e + 1] * _swiglu(hf, w1[e], w3[e], w2[e])
    return out.reshape(B, T, D).astype(h.dtype)


def setup_inputs(seed: int = 0) -> dict:
    key = jax.random.key(seed)
    ks = iter(jax.random.split(key, 48))
    nrm = lambda shape, fan_in: jax.random.normal(next(ks), shape, F32) * (fan_in ** -0.5)
    gain = lambda shape: 1.0 + 0.02 * jax.random.normal(next(ks), shape, F32)
    small = lambda shape, s: s * jax.random.normal(next(ks), shape, F32)
    unif = lambda shape, lo, hi: jax.random.uniform(next(ks), shape, F32, lo, hi)
    L, V = DEPTH, DEPTH - 1
    return {
        'x': jax.random.normal(next(ks), (BATCH, SEQ, D_MODEL), F32),
        'mem': jax.random.normal(next(ks), (BATCH, MEM_LEN, D_MODEL), F32),
        'norm_mix': gain((L, D_MODEL)),
        'norm_ffn': gain((L, D_MODEL)),
        'norm_mem': gain((L, D_MODEL)),
        'w_in': nrm((L, D_MODEL, N_IN), D_MODEL),
        'rwkv_mu': unif((L, RWKV_COLS), 0.0, 1.0),
        'rwkv_w0': unif((L, BRANCH_W), -6.0, -1.0),
        'rwkv_w2': nrm((L, RWKV_DECAY_LORA, BRANCH_W), RWKV_DECAY_LORA),
        'rwkv_a0': small((L, BRANCH_W), 0.1),
        'rwkv_a2': nrm((L, RWKV_A_LORA, BRANCH_W), RWKV_A_LORA),
        'rwkv_g2': nrm((L, RWKV_GATE_LORA, BRANCH_W), RWKV_GATE_LORA),
        'rwkv_kk': 1.0 + small((L, BRANCH_W), 0.1),
        'rwkv_ka': 1.0 + small((L, BRANCH_W), 0.1),
        'rwkv_rk': small((L, BRANCH_W), 0.1),
        'rwkv_ln_w': gain((L, BRANCH_W)),
        'rwkv_ln_b': small((L, BRANCH_W), 0.02),
        'vres_in': nrm((V, D_MODEL, RWKV_V_LORA), D_MODEL),
        'vres_mu': unif((V, RWKV_V_LORA), 0.0, 1.0),
        'vres_v0': small((V, BRANCH_W), 0.1),
        'vres_up': nrm((V, RWKV_V_LORA, BRANCH_W), RWKV_V_LORA),
        'nsa_qk_gain': gain((L, 4, NSA_HEAD)),
        'nsa_cmp_pos': small((L, 2, COMP_L, NSA_HEAD), 0.02),
        'nsa_cmp_w1': nrm((L, 2, COMP_L * NSA_HEAD, COMP_HIDDEN), COMP_L * NSA_HEAD),
        'nsa_cmp_b1': small((L, 2, COMP_HIDDEN), 0.02),
        'nsa_cmp_w2': nrm((L, 2, COMP_HIDDEN, NSA_HEAD), COMP_HIDDEN),
        'conv_w': nrm((L, CONV_W, BRANCH_W), CONV_W),
        'pool_w': nrm((L, len(POOL_WINDOWS), POOL_GROUP, POOL_OUT), POOL_GROUP),
        'pool_scale': gain((L, D_MODEL)),
        'mem_wkv': nrm((L, D_MODEL, 2 * BRANCH_W), D_MODEL),
        'mem_qk_gain': gain((L, 2, MEM_HEAD)),
        'w_branch': nrm((L, 4, BRANCH_W, D_MODEL), BRANCH_W),
        'w_out': nrm((L, D_MODEL, D_MODEL), D_MODEL),
        'ffn_w1': nrm((N_DENSE, D_MODEL, D_FF), D_MODEL),
        'ffn_w3': nrm((N_DENSE, D_MODEL, D_FF), D_MODEL),
        'ffn_w2': nrm((N_DENSE, D_FF, D_MODEL), D_FF),
        'moe_router': nrm((N_MOE, D_MODEL, N_EXPERTS), D_MODEL),
        'moe_w1': nrm((N_MOE, N_EXPERTS, D_MODEL, EXPERT_FF), D_MODEL),
        'moe_w3': nrm((N_MOE, N_EXPERTS, D_MODEL, EXPERT_FF), D_MODEL),
        'moe_w2': nrm((N_MOE, N_EXPERTS, EXPERT_FF, D_MODEL), EXPERT_FF),
    }


def reference(x, mem, norm_mix, norm_ffn, norm_mem, w_in, rwkv_mu, rwkv_w0, rwkv_w2, rwkv_a0,
              rwkv_a2, rwkv_g2, rwkv_kk, rwkv_ka, rwkv_rk, rwkv_ln_w, rwkv_ln_b, vres_in, vres_mu,
              vres_v0, vres_up, nsa_qk_gain, nsa_cmp_pos, nsa_cmp_w1, nsa_cmp_b1, nsa_cmp_w2, conv_w,
              pool_w, pool_scale, mem_wkv, mem_qk_gain, w_branch, w_out, ffn_w1, ffn_w3, ffn_w2,
              moe_router, moe_w1, moe_w3, moe_w2):
    B, T, _ = x.shape
    v_first = None
    for l in range(DEPTH):
        h = _rms(x, norm_mix[l])
        if l == 0:
            p = h @ w_in[l]
            parts = _split(p, IN_SIZES)
            vres = None
        else:
            p = h @ jnp.concatenate([w_in[l], vres_in[l - 1]], axis=1)
            parts = _split(p, IN_SIZES + (RWKV_V_LORA,))
            vres = (_token_shift(parts[6], vres_mu[l - 1]), vres_v0[l - 1], vres_up[l - 1])
        p_rwkv, p_nsa, p_conv, p_pool, p_mem, p_gate = parts[:6]

        y_rwkv, v_l = _rwkv7_time_mix(p_rwkv, rwkv_mu[l], rwkv_w0[l], rwkv_w2[l], rwkv_a0[l], rwkv_a2[l],
                                      rwkv_g2[l], rwkv_kk[l], rwkv_ka[l], rwkv_rk[l], rwkv_ln_w[l],
                                      rwkv_ln_b[l], v_first, vres)
        if l == 0:
            v_first = v_l
        y_nsa = _nsa(p_nsa, nsa_qk_gain[l], nsa_cmp_pos[l], nsa_cmp_w1[l], nsa_cmp_b1[l], nsa_cmp_w2[l])
        y_conv = _short_conv(p_conv, conv_w[l])
        y_mem = _mem_attn(p_mem, _rms(mem, norm_mem[l]), mem_wkv[l], mem_qk_gain[l])
        z_pool = _pool(p_pool, pool_w[l], pool_scale[l])

        gates = jax.nn.sigmoid(p_gate.astype(F32)).reshape(B, T, N_BRANCHES, D_MODEL)
        merged = gates[:, :, 4] * z_pool
        ys = (y_rwkv, y_nsa, y_conv, y_mem)
        for i in range(4):
            merged = merged + gates[:, :, i] * (ys[i] @ w_branch[l, i])
        x = x + (merged.astype(x.dtype) @ w_out[l])

        h2 = _rms(x, norm_ffn[l])
        if l % 2 == 0:
            x = x + _swiglu(h2, ffn_w1[l // 2], ffn_w3[l // 2], ffn_w2[l // 2])
        else:
            x = x + _moe(h2, moe_router[l // 2], moe_w1[l // 2], moe_w3[l // 2], moe_w2[l // 2])
    return x
```

```cpp
#include <hip/hip_runtime.h>
#include <cstdio>
#include <cstdint>
#include <type_traits>

#ifndef F8_G
#define F8_G 1
#endif
#ifndef F8_F1
#define F8_F1 0
#endif
#ifndef F8_M1
#define F8_M1 1
#endif
#ifndef F8_M2
#define F8_M2 1
#endif
#ifndef MK_ONE_LAUNCH
#define MK_ONE_LAUNCH 1
#endif

#define GAS __attribute__((address_space(1)))
#define LAS __attribute__((address_space(3)))
typedef unsigned short bf16;
typedef short bf16x8 __attribute__((ext_vector_type(8)));
typedef float f32x4 __attribute__((ext_vector_type(4)));
typedef float f32x2 __attribute__((ext_vector_type(2)));
typedef unsigned u32x4 __attribute__((ext_vector_type(4)));
typedef unsigned u32x2 __attribute__((ext_vector_type(2)));

constexpr int M = 8192, T = 4096, D = 2048;
constexpr int LDP = 6144;
constexpr int NP0 = 5888, NP1 = 6144;
constexpr int PC_R = 0, PC_K = 512, PC_V = 1024, PC_WD = 1536, PC_AD = 1632, PC_GD = 1728;
constexpr int PC_Q = 1984, PC_KC = 2496, PC_VC = 2624, PC_KS = 2752, PC_VS = 2880, PC_KW = 3008, PC_VW = 3136, PC_GL = 3264;
constexpr int PC_CB = 3288, PC_CC = 3800, PC_CX = 4312, PC_POOL = 4824, PC_MEM = 5336, PC_GATE = 5848, PC_VRES = 5848;
constexpr int NIN = 16088;
constexpr int FF = 5632, EFF = 2816, NE = 8;
constexpr float NORM_EPS = 1e-6f;
constexpr float CQ_NSA = 0.125f * 1.4426950408889634f, CQ_MEM = 0.08838834764831845f * 1.4426950408889634f;
constexpr int SLOTS = 18432;

constexpr size_t al4k(size_t x) { return (x + 4095) & ~(size_t)4095; }
constexpr size_t MiB = 1u << 20;
constexpr size_t WS_CTL = 0, CTL_BYTES = MiB;
constexpr size_t SZ_WPT0 = (size_t)NP0 * 2048 * 2, SZ_WPT1 = (size_t)NP1 * 2048 * 2;
constexpr size_t SZ_WGT = (size_t)8192 * 2048 * 2, SZ_WBT = (size_t)5 * 2048 * 512 * 2, SZ_WOT = (size_t)2048 * 2048 * 2, SZ_WLT = (size_t)2048 * 512 * 2;
constexpr size_t SZ_WKVT = (size_t)1024 * 2048 * 2, SZ_WC1T = (size_t)2 * 256 * 2048 * 2;
constexpr size_t WS_WPT0 = WS_CTL + CTL_BYTES;
constexpr size_t WS_WPT1 = WS_WPT0 + SZ_WPT0;
constexpr size_t WS_WGT0 = WS_WPT1 + SZ_WPT1, WS_WGT1 = WS_WGT0 + SZ_WGT;
constexpr size_t WS_WG4T0 = WS_WGT1 + SZ_WGT, WS_WG4T1 = WS_WG4T0 + (size_t)2048 * 2048;
constexpr size_t WS_WBT0 = WS_WG4T1 + (size_t)2048 * 2048, WS_WBT1 = WS_WBT0 + SZ_WBT;
constexpr size_t WS_WOT0 = WS_WBT1 + SZ_WBT, WS_WOT1 = WS_WOT0 + SZ_WOT;
constexpr size_t WS_WLT0 = WS_WOT1 + SZ_WOT, WS_WLT1 = WS_WLT0 + SZ_WLT;
constexpr size_t WS_WKVT0 = WS_WLT1 + SZ_WLT, WS_WKVT1 = WS_WKVT0 + SZ_WKVT;
constexpr size_t WS_WC1T0 = WS_WKVT1 + SZ_WKVT, WS_WC1T1 = WS_WC1T0 + SZ_WC1T;
constexpr size_t WS_WC2T = WS_WC1T1 + SZ_WC1T;
constexpr size_t WS_W13T = WS_WC2T + (size_t)65536;
constexpr size_t WS_W2T = WS_W13T + (size_t)2 * FF * 2048 * 2;
constexpr size_t WS_MW13T = WS_W2T + (size_t)2048 * FF * 2;
constexpr size_t WS_MW2T = WS_MW13T + (size_t)NE * 2 * EFF * 2048 * 2;
constexpr size_t WS_XA = WS_MW2T + (size_t)NE * 2048 * EFF * 2;
constexpr size_t WS_XH = WS_XA + (size_t)M * D * 4;
constexpr size_t WS_MEMN = WS_XH + (size_t)M * D * 2;
constexpr size_t WS_G4 = WS_MEMN + (size_t)512 * 2048 * 2;
constexpr size_t WS_Y = WS_G4 + (size_t)M * D * 2;
constexpr size_t WS_VFIRST = WS_Y + (size_t)M * 2560 * 2;
constexpr size_t WS_KVRAW = WS_VFIRST + (size_t)M * 512 * 4;
constexpr size_t WS_XH8 = WS_KVRAW + (size_t)512 * 2048 * 4;
constexpr size_t WS_OV = WS_XH8 + (size_t)M * D;
constexpr size_t WS_P = WS_OV;
constexpr size_t WS_ALORA = WS_P + (size_t)M * LDP * 2;
constexpr size_t WS_LO = WS_ALORA + (size_t)M * 512 * 2;
constexpr size_t WS_YL = WS_LO + (size_t)M * 2048 * 4;
constexpr size_t WS_ZL = WS_YL + (size_t)M * 512 * 4;
constexpr size_t WS_QF = WS_ZL + (size_t)M * 512 * 4;
constexpr size_t WS_PF = WS_QF + (size_t)2048 * 4096 * 4;
constexpr size_t WS_SINIT = WS_PF + (size_t)2048 * 4096 * 4;
constexpr size_t WS_VCUR = WS_SINIT + (size_t)2048 * 4096 * 4;
constexpr size_t WS_BON = WS_VCUR + (size_t)M * 512 * 4;
constexpr size_t WS_QN = WS_BON + (size_t)M * 8 * 4;
constexpr size_t WS_KS = WS_QN + (size_t)M * 512 * 2;
constexpr size_t WS_KW = WS_KS + (size_t)M * 128 * 2;
constexpr size_t WS_VST = WS_KW + (size_t)M * 128 * 2;
constexpr size_t WS_VWT = WS_VST + (size_t)M * 128 * 2;
constexpr size_t WS_ACMP = WS_VWT + (size_t)M * 128 * 2;
constexpr size_t WS_KC = WS_ACMP + (size_t)2 * 1024 * 2048 * 2;
constexpr size_t WS_VCT = WS_KC + (size_t)4 * 256 * 64 * 2;
constexpr size_t WS_QM = WS_VCT + (size_t)4 * 256 * 64 * 2;
constexpr size_t WS_KMEM = WS_QM + (size_t)M * 512 * 2;
constexpr size_t WS_VMEMT = WS_KMEM + (size_t)8 * 256 * 128 * 2;
constexpr size_t WS_HP = WS_VMEMT + (size_t)8 * 256 * 128 * 2;
constexpr size_t WS_MIX_END = WS_HP + (size_t)4 * 2 * 1024 * 128 * 4;
constexpr size_t WS_ZB = WS_OV;
constexpr size_t WS_MG = WS_ZB + (size_t)5 * M * D * 2;
constexpr size_t WS_ACT = WS_OV;
constexpr size_t WS_XG = WS_OV;
constexpr size_t WS_ACTM = WS_XG + (size_t)SLOTS * 2048 * 2;
constexpr size_t WS_YS = WS_ACTM + (size_t)SLOTS * EFF * 2;
constexpr size_t WS_RSS = WS_YS + (size_t)SLOTS * 2048 * 2;
constexpr size_t WS_MOE_END = WS_RSS + (size_t)SLOTS * 4;
constexpr size_t WS_END = WS_MIX_END > WS_MOE_END ? WS_MIX_END : WS_MOE_END;
static_assert(WS_END <= (size_t)1119977216, "workspace map exceeds the guaranteed d_ws size");
static_assert(WS_MG + (size_t)M * D * 2 <= WS_MIX_END, "Z view inside overlay");

constexpr int CW_BAR = 4096;
constexpr int CW_SSQ = 16384;
constexpr int CW_CNT = CW_SSQ + 4 * 8192 * 2;
constexpr int CW_QCTR = CW_CNT + 512;
constexpr int CW_ROUTE = CW_CNT + 1024;
static_assert((CW_ROUTE + 8 * 8192) * 4 <= (int)CTL_BYTES, "CTL map");

constexpr int RING_BYTES = 131072;
constexpr int MISC_OFF = RING_BYTES + 320;
constexpr int LDS_BYTES = 147456;

#define RLX_AGENT __ATOMIC_RELAXED, __HIP_MEMORY_SCOPE_AGENT
#define LDS_WAIT() asm volatile("s_waitcnt lgkmcnt(0)" ::: "memory")
#define VM_WAIT() asm volatile("s_waitcnt vmcnt(0)" ::: "memory")
__device__ __forceinline__ unsigned f2bf(float f) { unsigned u = __builtin_bit_cast(unsigned, f); return (u + 0x7fffu + ((u >> 16) & 1u)) >> 16; }
__device__ __forceinline__ float bf2f(unsigned b) { return __builtin_bit_cast(float, b << 16); }
typedef __bf16 bf16x2_t __attribute__((ext_vector_type(2)));
__device__ __forceinline__ unsigned pk2(float lo, float hi) { const bf16x2_t b = __builtin_convertvector((f32x2){lo, hi}, bf16x2_t); return __builtin_bit_cast(unsigned, b); }
__device__ __forceinline__ unsigned pk4_fp8(float a, float b, float c, float d) { unsigned w = 0u; w = (unsigned)__builtin_amdgcn_cvt_pk_fp8_f32(a, b, (int)w, false); w = (unsigned)__builtin_amdgcn_cvt_pk_fp8_f32(c, d, (int)w, true); return w; }
constexpr float W8S = 64.0f, W8SI = 1.0f / 64.0f;
__device__ __forceinline__ float sigmoidf_(float x) { return __builtin_amdgcn_rcpf(1.f + __builtin_amdgcn_exp2f(x * -1.4426950408889634f)); }
#define DPPF(v, ctrl) __builtin_bit_cast(float, __builtin_amdgcn_update_dpp(0, __builtin_bit_cast(int, (v)), (ctrl), 0xf, 0xf, true))
__device__ __forceinline__ float red16_max(float v) { v = fmaxf(v, DPPF(v, 0xB1)); v = fmaxf(v, DPPF(v, 0x4E)); v = fmaxf(v, DPPF(v, 0x141)); v = fmaxf(v, DPPF(v, 0x140)); return v; }
__device__ __forceinline__ float red16_sum(float v) { v += DPPF(v, 0xB1); v += DPPF(v, 0x4E); v += DPPF(v, 0x141); v += DPPF(v, 0x140); return v; }
__device__ __forceinline__ float wave_sum(float v) {
#pragma unroll
    for (int o = 1; o < 64; o <<= 1) v += __shfl_xor(v, o);
    return v;
}

#define XB_TMO      128
#define XB_XCNT(j)  (256  + 64 * (j))
#define XB_XSUB(j)  (1280 + 64 * (j))
#define XB_XGEN(j)  (2304 + 64 * (j))
#define XB_TOP      3328
#define XB_TOPGEN   3392
#define XCD_BAR_WORDS 3456
#define XB_SPIN_CAP (1u << 18)
__device__ __forceinline__ unsigned xb_ld(unsigned* p)              { return __hip_atomic_load(p, __ATOMIC_RELAXED, __HIP_MEMORY_SCOPE_AGENT); }
__device__ __forceinline__ unsigned xb_add(unsigned* p, unsigned v) { return __hip_atomic_fetch_add(p, v, __ATOMIC_RELAXED, __HIP_MEMORY_SCOPE_AGENT); }
__device__ __forceinline__ unsigned xb_xcc_id() { return (unsigned)__builtin_amdgcn_s_getreg((3 << 11) | 20) & 0xFu; }
#define XB_SPIN(cond, bar) do { unsigned _sp = 0; while (cond) { __builtin_amdgcn_s_sleep(1); \
    if ((++_sp & 255u) == 0u) { if (xb_ld(&(bar)[XB_TMO])) break; if (_sp > XB_SPIN_CAP) { atomicAdd(&(bar)[XB_TMO], 1u); break; } } } } while (0)
struct XcdBarrier { unsigned* bar; unsigned x; volatile LAS unsigned* st; int wave; };
__device__ __forceinline__ bool xb_t0(int wave) { return wave == 0 && __builtin_amdgcn_mbcnt_hi(~0u, __builtin_amdgcn_mbcnt_lo(~0u, 0u)) == 0u; }
__device__ __forceinline__ XcdBarrier xcd_barrier_post(unsigned* bar, volatile LAS unsigned* st, int wave) {
    XcdBarrier b; b.bar = bar; b.x = xb_xcc_id(); b.st = st; b.wave = wave;
    if (xb_t0(wave)) (void)xb_add(&bar[XB_XCNT(b.x)], 1u);
    return b;
}
__device__ __forceinline__ void xcd_barrier_complete(unsigned* bar, unsigned x, unsigned& nloc, unsigned& nx) {
    const unsigned G = gridDim.x * gridDim.y * gridDim.z;
    unsigned sum, cnt, mine, sp = 0u;
    for (;;) {
        sum = 0u; cnt = 0u; mine = 0u;
#pragma unroll
        for (unsigned j = 0; j < 16; ++j) { const unsigned c = xb_ld(&bar[XB_XCNT(j)]); sum += c; cnt += (c > 0u) ? 1u : 0u; mine = (j == x) ? c : mine; }
        if (sum == G) break;
        __builtin_amdgcn_s_sleep(1);
        if ((++sp & 255u) == 0u) { if (xb_ld(&bar[XB_TMO])) break; if (sp > XB_SPIN_CAP) { atomicAdd(&bar[XB_TMO], 1u); break; } }
    }
    nloc = mine > 0u ? mine : 1u; nx = cnt > 0u ? cnt : 1u;
}
__device__ __forceinline__ void xcd_barrier(const XcdBarrier& b) {
    asm volatile("s_waitcnt vmcnt(0)" ::: "memory");
    __syncthreads();
    if (xb_t0(b.wave)) {
        unsigned* bar = b.bar;
        __builtin_amdgcn_s_waitcnt(0);
        unsigned nloc = b.st[0], nx = b.st[1];
        if (nloc == 0u) { xcd_barrier_complete(bar, b.x, nloc, nx); b.st[0] = nloc; b.st[1] = nx; }
        const unsigned old = xb_add(&bar[XB_XSUB(b.x)], 1u);
        const unsigned gen = old / nloc;
        if (old + 1u == (gen + 1u) * nloc) {
            __builtin_amdgcn_fence(__ATOMIC_RELEASE, "agent");
            asm volatile("s_waitcnt vmcnt(0)" ::: "memory");
            const unsigned og = xb_add(&bar[XB_TOP], 1u);
            const unsigned tg = og / nx;
            if (og + 1u == (tg + 1u) * nx) xb_add(&bar[XB_TOPGEN], 1u);
            else XB_SPIN(xb_ld(&bar[XB_TOPGEN]) == tg, bar);
            __builtin_amdgcn_fence(__ATOMIC_ACQUIRE, "agent");
            xb_add(&bar[XB_XGEN(b.x)], 1u);
            asm volatile("s_waitcnt vmcnt(0)" ::: "memory");
        } else {
            XB_SPIN(xb_ld(&bar[XB_XGEN(b.x)]) == gen, bar);
            __builtin_amdgcn_fence(__ATOMIC_ACQUIRE, "agent");
            asm volatile("s_waitcnt vmcnt(0)" ::: "memory");
        }
    }
    __syncthreads();
}

namespace pg8 {
typedef int v4i_t __attribute__((ext_vector_type(4)));
typedef int v8i_t __attribute__((ext_vector_type(8)));
constexpr int BM = 256, BK = 64, HALF = 128, HTB = HALF * BK * 2, STAGE_BYTES = 8 * HTB, NXCD = 8, WGM = 8;
__host__ __device__ __forceinline__ int lds_byte(int r, int c) { const int st = (r >> 4) * 2 + (c >> 5), rr = r & 15, cc = c & 31, ob = rr * 64 + cc * 2; return st * 1024 + (ob ^ (((ob >> 9) & 1) << 5)); }
__host__ __device__ __forceinline__ void stage_rc(int b, int& R, int& C) { const int st = b / 1024, sb = b % 1024, swz = sb ^ (((sb >> 9) & 1) << 5); R = (st >> 1) * 16 + swz / 64; C = (st & 1) * 32 + (swz % 64) / 2; }
__host__ __device__ __forceinline__ int perm32(int rho) { const int n = rho >> 4, i = rho & 15; return 8 * (i >> 2) + 4 * n + (i & 3); }
struct Unit { int pm, pn, z; };
struct Gemm { const bf16* A; const bf16* Bt; int lda, ldb, K; size_t az, bz; };

struct GridOrder {
    int nM, nN, nZ, G, c;
    __device__ void init(int nM_, int nN_, int nZ_, int G_, int c_) { nM = nM_; nN = nN_; nZ = nZ_; G = G_; c = c_; }
    __device__ bool next(int i, Unit& u) const {
        const long L = (long)i * G + c; const int nwg = nM * nN; if (L >= (long)nwg * nZ) return false;
        u.z = (int)(L / nwg); int wgid = (int)(L % nwg);
        { const int q = nwg / NXCD, r = nwg % NXCD, xcd = wgid % NXCD, off = wgid / NXCD; wgid = (xcd < r ? xcd * (q + 1) : r * (q + 1) + (xcd - r) * q) + off; }
        const int nig = WGM * nN, gid = wgid / nig, fm = gid * WGM, gsz = (nM - fm) < WGM ? (nM - fm) : WGM;
        u.pm = fm + ((wgid % nig) % gsz); u.pn = (wgid % nig) / gsz; return true;
    }
    __device__ __forceinline__ void a_ready(const Unit&) const {}
    __device__ __forceinline__ void done(const Unit&) const {}
};
struct PBOrder {
    GridOrder base; int nP, nX;
    __device__ bool next(int i, Unit& u) const {
        const long L = (long)i * base.G + base.c;
        if (L < nP) return base.next(i, u);
        const int e = (int)(L - nP); if (e >= nX) return false;
        u.z = 1; u.pm = e & 1; u.pn = e >> 1; return true; }
    __device__ __forceinline__ void a_ready(const Unit&) const {}
    __device__ __forceinline__ void done(const Unit&) const {}
};
struct MoeOrder {
    int ts[9]; int nN, G, c;
    __device__ bool next(int i, Unit& u) const {
        const long L = (long)i * G + c; const int rt = (int)(L / nN); if (rt >= ts[8]) return false;
        u.pn = (int)(L % nN); u.pm = rt; int e = 0;
#pragma unroll
        for (int j = 1; j < 8; ++j) e += (rt >= ts[j]) ? 1 : 0;
        u.z = e; return true;
    }
    __device__ __forceinline__ void a_ready(const Unit&) const {}
    __device__ __forceinline__ void done(const Unit&) const {}
};

template <class Epi, class Sched, bool ALIGN_EPI = true, bool F8 = false>
__device__ __forceinline__ void gemm_phase(LAS unsigned char* lds, const Gemm g, const Sched& S, const Epi& E, int wave0) {
    int lane_ = (int)__builtin_amdgcn_mbcnt_hi(~0u, __builtin_amdgcn_mbcnt_lo(~0u, 0u)); asm volatile("" : "+v"(lane_));
    const int wid = wave0, lane = lane_, tid = wid * 64 + lane, wr = wid >> 2, wc = wid & 3, fr = lane & 15, fq = lane >> 4;
    const int K = g.K, nt = K / BK;
    unsigned voffA[2], voffB[2];
#pragma unroll
    for (int i = 0; i < 2; ++i) { int R, C; stage_rc(tid * 16 + i * 8192, R, C); const int Rb = Epi::PERM ? ((R & ~31) + perm32(R & 31)) : R;
        voffA[i] = (unsigned)(R * g.lda + C) * 2u; voffB[i] = (unsigned)(Rb * g.ldb + C) * 2u; }
    const size_t kstep = (size_t)(BK * 2);
    const size_t hA = (size_t)HALF * g.lda * 2, hB = (size_t)HALF * g.ldb * 2;
    const unsigned ldsw = (unsigned)wid * 1024u;
    const int aoff = lds_byte(wr * 64 + fr, fq * 8), boff = lds_byte(wc * 32 + fr, fq * 8);
#define PG8_SA(b, h) (((b) * 2 + (h)) * HTB)
#define PG8_SB(b, h) ((4 + (b) * 2 + (h)) * HTB)
#define PG8_STAGE(bufoff, gbase, voff) do { _Pragma("unroll") for (int _i = 0; _i < 2; ++_i) \
        __builtin_amdgcn_global_load_lds((const unsigned*)((const char*)(gbase) + (voff)[_i]), (LAS unsigned*)(lds + (bufoff) + ldsw + _i * 8192), 16, 0, 0); } while (0)
#define PG8_LDA(dst, b, h) do { _Pragma("unroll") for (int m = 0; m < 4; ++m) _Pragma("unroll") for (int k = 0; k < 2; ++k) dst[m][k] = *(const LAS bf16x8*)(lds + PG8_SA(b, h) + aoff + m * 2048 + k * 1024); } while (0)
#define PG8_LDB(dst, b, h) do { _Pragma("unroll") for (int n = 0; n < 2; ++n) _Pragma("unroll") for (int k = 0; k < 2; ++k) dst[n][k] = *(const LAS bf16x8*)(lds + PG8_SB(b, h) + boff + n * 2048 + k * 1024); } while (0)
#define PG8_MMA(ai, bj, At, Bt) do { __builtin_amdgcn_s_setprio(1); \
        if constexpr (F8) { _Pragma("unroll") for (int m = 0; m < 4; ++m) _Pragma("unroll") for (int n = 0; n < 2; ++n) { \
            const v4i_t b0 = __builtin_bit_cast(v4i_t, Bt[n][0]), b1 = __builtin_bit_cast(v4i_t, Bt[n][1]), a0 = __builtin_bit_cast(v4i_t, At[m][0]), a1 = __builtin_bit_cast(v4i_t, At[m][1]); \
            const v8i_t b8 = __builtin_shufflevector(b0, b1, 0, 1, 2, 3, 4, 5, 6, 7), a8 = __builtin_shufflevector(a0, a1, 0, 1, 2, 3, 4, 5, 6, 7); \
            asm volatile("v_mfma_f32_16x16x128_f8f6f4 %0, %1, %2, %0" : "+v"(acc[ai][bj][m][n]) : "v"(b8), "v"(a8)); } }     \
        else { _Pragma("unroll") for (int m = 0; m < 4; ++m) _Pragma("unroll") for (int n = 0; n < 2; ++n) _Pragma("unroll") for (int k = 0; k < 2; ++k) \
            acc[ai][bj][m][n] = __builtin_amdgcn_mfma_f32_16x16x32_bf16(Bt[n][k], At[m][k], acc[ai][bj][m][n], 0, 0, 0); } \
        __builtin_amdgcn_s_setprio(0); } while (0)
#define PG8_WAIT_V(n) asm volatile("s_waitcnt vmcnt(" #n ")" ::: "memory")
#define PG8_WAIT_L(n) asm volatile("s_waitcnt lgkmcnt(" #n ")" ::: "memory")
#define PG8_BAR __builtin_amdgcn_s_barrier()
#define PG8_SCHED __builtin_amdgcn_sched_barrier(0)
    Unit cur, nxt; int ui = 0;
    if (!S.next(0, cur)) return;
    f32x4 acc[2][2][4][2];
#pragma unroll
    for (int a = 0; a < 2; ++a)
#pragma unroll
        for (int b = 0; b < 2; ++b)
#pragma unroll
            for (int m = 0; m < 4; ++m)
#pragma unroll
                for (int n = 0; n < 2; ++n) acc[a][b][m][n] = (f32x4){0.f, 0.f, 0.f, 0.f};
    bf16x8 At[4][2], B0[2][2], B1[2][2];
    const char* cA = (const char*)g.A + (size_t)cur.z * g.az + (size_t)cur.pm * 2 * hA; const char* cB = (const char*)g.Bt + (size_t)cur.z * g.bz + (size_t)cur.pn * 2 * hB;
    S.a_ready(cur);
    PG8_STAGE(PG8_SB(0, 0), cB, voffB); PG8_STAGE(PG8_SB(0, 1), cB + hB, voffB); PG8_STAGE(PG8_SA(0, 0), cA, voffA); PG8_STAGE(PG8_SA(0, 1), cA + hA, voffA);
    if (wr == 1) PG8_BAR;
    PG8_WAIT_V(2); PG8_BAR;
    PG8_STAGE(PG8_SB(1, 0), cB + kstep, voffB); PG8_STAGE(PG8_SA(1, 0), cA + kstep, voffA); PG8_STAGE(PG8_SB(1, 1), cB + hB + kstep, voffB);
    PG8_WAIT_V(6); PG8_BAR;
    for (;;) {
        const bool has_next = S.next(ui + 1, nxt);
        const char* nA = has_next ? (const char*)g.A + (size_t)nxt.z * g.az + (size_t)nxt.pm * 2 * hA : cA; const char* nB = has_next ? (const char*)g.Bt + (size_t)nxt.z * g.bz + (size_t)nxt.pn * 2 * hB : cB;
        for (int t = 0; t < nt; t += 2) {
            const bool last = (t == nt - 2);
            const char* a1 = cA + (size_t)(t + 1) * kstep;
            const char* a2 = last ? nA : cA + (size_t)(t + 2) * kstep; const char* b2 = last ? nB : cB + (size_t)(t + 2) * kstep;
            const char* a3 = a2 + kstep; const char* b3 = b2 + kstep;
            if (last && has_next) S.a_ready(nxt);
            PG8_LDB(B0, 0, 0); PG8_LDB(B1, 0, 1); PG8_SCHED; PG8_LDA(At, 0, 0); PG8_STAGE(PG8_SA(1, 1), a1 + hA, voffA);
            PG8_WAIT_V(8); PG8_WAIT_L(0); PG8_BAR; PG8_MMA(0, 0, At, B0); PG8_MMA(0, 1, At, B1); PG8_BAR; PG8_SCHED;
            PG8_LDA(At, 0, 1); PG8_STAGE(PG8_SB(0, 0), b2, voffB); PG8_STAGE(PG8_SB(0, 1), b2 + hB, voffB); PG8_STAGE(PG8_SA(0, 0), a2, voffA);
            PG8_WAIT_V(8); PG8_WAIT_L(0); PG8_BAR; PG8_MMA(1, 0, At, B0); PG8_MMA(1, 1, At, B1); PG8_BAR; PG8_SCHED;
            PG8_LDB(B0, 1, 0); PG8_LDB(B1, 1, 1); PG8_SCHED; PG8_LDA(At, 1, 0); PG8_STAGE(PG8_SA(0, 1), a2 + hA, voffA);
            PG8_WAIT_V(8); PG8_WAIT_L(0); PG8_BAR; PG8_MMA(0, 0, At, B0); PG8_MMA(0, 1, At, B1); PG8_BAR; PG8_SCHED;
            PG8_LDA(At, 1, 1); PG8_STAGE(PG8_SB(1, 0), b3, voffB); PG8_STAGE(PG8_SB(1, 1), b3 + hB, voffB); PG8_STAGE(PG8_SA(1, 0), a3, voffA);
            PG8_WAIT_V(8); PG8_WAIT_L(0); PG8_BAR; PG8_MMA(1, 0, At, B0); PG8_MMA(1, 1, At, B1); PG8_BAR; PG8_SCHED;
        }
        if constexpr (ALIGN_EPI) { if (wr == 0) PG8_BAR; }
        if constexpr (F8) asm volatile("s_nop 15\n\ts_nop 15\n\ts_nop 15\n\ts_nop 15" ::: "memory");
        if constexpr (!Epi::AFTER_DRAIN) { E(acc, cur, wr, wc, fr, fq); S.done(cur); }
        if (!has_next) break;
#pragma unroll
        for (int a = 0; a < 2; ++a)
#pragma unroll
            for (int b = 0; b < 2; ++b)
#pragma unroll
                for (int m = 0; m < 4; ++m)
#pragma unroll
                    for (int n = 0; n < 2; ++n) acc[a][b][m][n] = (f32x4){0.f, 0.f, 0.f, 0.f};
        cur = nxt; cA = nA; cB = nB; ++ui;
        if constexpr (ALIGN_EPI) { if (wr == 1) PG8_BAR; }
    }
    PG8_WAIT_V(0);
    if constexpr (!ALIGN_EPI) { if (wr == 0) PG8_BAR; }
    PG8_BAR;
    if constexpr (Epi::AFTER_DRAIN) { E.fused(acc, cur, wr, wc, fr, fq, lds, wid, lane); S.done(cur); }
#undef PG8_SA
#undef PG8_SB
#undef PG8_STAGE
#undef PG8_LDA
#undef PG8_LDB
#undef PG8_MMA
#undef PG8_WAIT_V
#undef PG8_WAIT_L
#undef PG8_BAR
#undef PG8_SCHED
}
}
using pg8::Unit; using pg8::HALF; using pg8::BM;
typedef const f32x4 (&AccT)[2][2][4][2];

typedef unsigned long long u64;
__device__ __forceinline__ float rstd_of(const u64* ssq, int row) { return 1.0f / sqrtf((float)ssq[row] * (1.0f / 4294967296.0f) * (1.0f / D) + NORM_EPS); }
__device__ __forceinline__ u64 ssq_fix(float s) { return (u64)(s * 4294967296.0f); }

struct EpiP {
    static constexpr bool PERM = true, AFTER_DRAIN = false;
    bf16* P; bf16* G4; const u64* ssq; int nNP;
    __device__ __forceinline__ void operator()(AccT acc, const Unit& u, int wr, int wc, int fr, int fq) const {
        const int row0 = u.pm * BM + wr * 64 + fr; const bool gate = u.pn >= nNP;
        bf16* base = gate ? G4 : P; const int ld = gate ? D : LDP; const int col0 = (gate ? (u.pn - nNP) : u.pn) * BM + wc * 32 + 8 * fq;
        float rs8[2][4];
#pragma unroll
        for (int ai = 0; ai < 2; ++ai)
#pragma unroll
            for (int m = 0; m < 4; ++m) rs8[ai][m] = rstd_of(ssq, row0 + ai * HALF + m * 16);
#pragma unroll
        for (int ai = 0; ai < 2; ++ai)
#pragma unroll
            for (int m = 0; m < 4; ++m) { const int row = row0 + ai * HALF + m * 16; const float rs = rs8[ai][m]; bf16* rowp = base + (size_t)row * ld + col0;
#pragma unroll
                for (int bj = 0; bj < 2; ++bj) { f32x4 v0 = acc[ai][bj][m][0] * rs, v1 = acc[ai][bj][m][1] * rs;
                    if (gate) {
#pragma unroll
                        for (int j = 0; j < 4; ++j) { v0[j] = sigmoidf_(v0[j]); v1[j] = sigmoidf_(v1[j]); } }
                    u32x4 w; w.x = pk2(v0[0], v0[1]); w.y = pk2(v0[2], v0[3]); w.z = pk2(v1[0], v1[1]); w.w = pk2(v1[2], v1[3]);
                    *(u32x4*)(rowp + bj * HALF) = w; } }
    }
};
struct EpiGate4 {
    static constexpr bool PERM = true, AFTER_DRAIN = false;
    bf16* G4; const u64* ssq;
    __device__ __forceinline__ void operator()(AccT acc, const Unit& u, int wr, int wc, int fr, int fq) const {
        const int row0 = u.pm * BM + wr * 64 + fr, col0 = u.pn * BM + wc * 32 + 8 * fq;
        float rs8[2][4];
#pragma unroll
        for (int ai = 0; ai < 2; ++ai)
#pragma unroll
            for (int m = 0; m < 4; ++m) rs8[ai][m] = rstd_of(ssq, row0 + ai * HALF + m * 16) * W8SI;
#pragma unroll
        for (int ai = 0; ai < 2; ++ai)
#pragma unroll
            for (int m = 0; m < 4; ++m) { const int row = row0 + ai * HALF + m * 16; const float rs = rs8[ai][m]; bf16* rowp = G4 + (size_t)row * D + col0;
#pragma unroll
                for (int bj = 0; bj < 2; ++bj) { f32x4 v0 = acc[ai][bj][m][0] * rs, v1 = acc[ai][bj][m][1] * rs;
#pragma unroll
                    for (int j = 0; j < 4; ++j) { v0[j] = sigmoidf_(v0[j]); v1[j] = sigmoidf_(v1[j]); }
                    u32x4 w; w.x = pk2(v0[0], v0[1]); w.y = pk2(v0[2], v0[3]); w.z = pk2(v1[0], v1[1]); w.w = pk2(v1[2], v1[3]);
                    *(u32x4*)(rowp + bj * HALF) = w; } }
    }
};
struct EpiF32 {
    static constexpr bool PERM = false, AFTER_DRAIN = false;
    float* C; int ldc;
    __device__ __forceinline__ void operator()(AccT acc, const Unit& u, int wr, int wc, int fr, int fq) const {
        const int row0 = u.pm * BM + wr * 64 + fr, col0 = u.pn * BM + wc * 32 + 4 * fq;
#pragma unroll
        for (int ai = 0; ai < 2; ++ai)
#pragma unroll
            for (int m = 0; m < 4; ++m) { float* rowp = C + (size_t)(row0 + ai * HALF + m * 16) * ldc + col0;
#pragma unroll
                for (int bj = 0; bj < 2; ++bj)
#pragma unroll
                    for (int n = 0; n < 2; ++n) *(f32x4*)(rowp + bj * HALF + n * 16) = acc[ai][bj][m][n]; }
    }
};
struct EpiLora {
    static constexpr bool PERM = false, AFTER_DRAIN = false;
    float* LO; const float* w0; const float* a0; const float* v0; int has_v;
    __device__ __forceinline__ void operator()(AccT acc, const Unit& u, int wr, int wc, int fr, int fq) const {
        const int row0 = u.pm * BM + wr * 64 + fr, col0 = u.pn * BM + wc * 32 + 4 * fq; const int blk = u.pn >> 1;
        f32x4 bias4[2][2];
#pragma unroll
        for (int bj = 0; bj < 2; ++bj)
#pragma unroll
            for (int n = 0; n < 2; ++n) { const int j = (col0 + bj * HALF + n * 16) & 511; f32x4 bb = (f32x4){0.f, 0.f, 0.f, 0.f};
                if (blk == 0) bb = *(const f32x4*)(w0 + j); else if (blk == 1) bb = *(const f32x4*)(a0 + j); else if (blk == 3 && has_v) bb = *(const f32x4*)(v0 + j);
                bias4[bj][n] = bb; }
#pragma unroll
        for (int bj = 0; bj < 2; ++bj)
#pragma unroll
            for (int n = 0; n < 2; ++n) { const int col = col0 + bj * HALF + n * 16; const f32x4 bias = bias4[bj][n];
#pragma unroll
                for (int ai = 0; ai < 2; ++ai)
#pragma unroll
                    for (int m = 0; m < 4; ++m) { f32x4 v = acc[ai][bj][m][n] + bias;
                        if (blk == 0) {
#pragma unroll
                            for (int e = 0; e < 4; ++e) { const float x = v[e]; const float sp = fmaxf(-x, 0.f) + log1pf(__expf(-fabsf(x)));
                                v[e] = __expf(-__expf(-sp - 0.5f)); } }
                        else if (blk != 2) {
#pragma unroll
                            for (int e = 0; e < 4; ++e) v[e] = sigmoidf_(v[e]); }
                        *(f32x4*)(LO + (size_t)(row0 + ai * HALF + m * 16) * 2048 + col) = v; } }
    }
};
struct EpiZ {
    static constexpr bool PERM = true, AFTER_DRAIN = false;
    bf16* ZB;
    __device__ __forceinline__ void operator()(AccT acc, const Unit& u, int wr, int wc, int fr, int fq) const {
        const int row0 = u.pm * BM + wr * 64 + fr, col0 = u.pn * BM + wc * 32 + 8 * fq; bf16* base = ZB + (size_t)u.z * M * D;
#pragma unroll
        for (int ai = 0; ai < 2; ++ai)
#pragma unroll
            for (int m = 0; m < 4; ++m) { bf16* rowp = base + (size_t)(row0 + ai * HALF + m * 16) * D + col0;
#pragma unroll
                for (int bj = 0; bj < 2; ++bj) { const f32x4 v0 = acc[ai][bj][m][0], v1 = acc[ai][bj][m][1];
                    u32x4 w; w.x = pk2(v0[0], v0[1]); w.y = pk2(v0[2], v0[3]); w.z = pk2(v1[0], v1[1]); w.w = pk2(v1[2], v1[3]);
                    *(u32x4*)(rowp + bj * HALF) = w; } }
    }
};
struct EpiG {
    static constexpr bool PERM = false, AFTER_DRAIN = false;
    const bf16* ZB; const bf16* G4; bf16* MG; const u64* ssq; float wsi;
    __device__ __forceinline__ void operator()(AccT acc, const Unit& u, int wr, int wc, int fr, int fq) const {
        const int row0 = u.pm * BM + wr * 64 + fr, c0 = u.pn * 64 + wc * 16 + 4 * fq;
#pragma unroll
        for (int ai = 0; ai < 2; ++ai) {
            float rs4[4]; u32x2 g4[4], z4[4], zz[4][4];
#pragma unroll
            for (int m = 0; m < 4; ++m) { const int row = row0 + ai * HALF + m * 16; const size_t off = (size_t)row * D + c0; rs4[m] = rstd_of(ssq, row) * wsi;
                g4[m] = *(const u32x2*)(G4 + off); z4[m] = *(const u32x2*)(ZB + (size_t)4 * M * D + off);
#pragma unroll
                for (int br = 0; br < 4; ++br) zz[m][br] = *(const u32x2*)(ZB + (size_t)br * M * D + off); }
#pragma unroll
            for (int m = 0; m < 4; ++m) { const int row = row0 + ai * HALF + m * 16; const float rs = rs4[m]; const size_t off = (size_t)row * D + c0;
                f32x4 s;
                s[0] = bf2f(g4[m].x & 0xffffu) * bf2f(z4[m].x & 0xffffu); s[1] = bf2f(g4[m].x >> 16) * bf2f(z4[m].x >> 16);
                s[2] = bf2f(g4[m].y & 0xffffu) * bf2f(z4[m].y & 0xffffu); s[3] = bf2f(g4[m].y >> 16) * bf2f(z4[m].y >> 16);
#pragma unroll
                for (int bj = 0; bj < 2; ++bj)
#pragma unroll
                    for (int n = 0; n < 2; ++n) { const int br = 2 * bj + n; const u32x2 z = zz[m][br]; const f32x4 a = acc[ai][bj][m][n] * rs;
                        s[0] += sigmoidf_(a[0]) * bf2f(z.x & 0xffffu); s[1] += sigmoidf_(a[1]) * bf2f(z.x >> 16);
                        s[2] += sigmoidf_(a[2]) * bf2f(z.y & 0xffffu); s[3] += sigmoidf_(a[3]) * bf2f(z.y >> 16); }
                u32x2 w; w.x = pk2(s[0], s[1]); w.y = pk2(s[2], s[3]); *(u32x2*)(MG + off) = w; } }
    }
};
struct EpiRes {
    static constexpr bool PERM = false, AFTER_DRAIN = false;
    const float* res; float* out; bf16* XH; u64* ssq; unsigned char* XH8;
    __device__ __forceinline__ void operator()(AccT acc, const Unit& u, int wr, int wc, int fr, int fq) const {
        const int row0 = u.pm * BM + wr * 64 + fr, col0 = u.pn * BM + wc * 32 + 4 * fq;
#pragma unroll
        for (int ai = 0; ai < 2; ++ai)
#pragma unroll
            for (int mp = 0; mp < 4; mp += 4) {
                f32x4 rv[4][2][2];
#pragma unroll
                for (int mm = 0; mm < 4; ++mm) { const size_t off = (size_t)(row0 + ai * HALF + (mp + mm) * 16) * D + col0;
#pragma unroll
                    for (int bj = 0; bj < 2; ++bj)
#pragma unroll
                        for (int n = 0; n < 2; ++n) rv[mm][bj][n] = *(const f32x4*)(res + off + bj * HALF + n * 16); }
#pragma unroll
                for (int mm = 0; mm < 4; ++mm) { const int m = mp + mm; const int row = row0 + ai * HALF + m * 16; const size_t off = (size_t)row * D + col0; float sq = 0.f;
#pragma unroll
                    for (int bj = 0; bj < 2; ++bj)
#pragma unroll
                        for (int n = 0; n < 2; ++n) { const size_t o = off + bj * HALF + n * 16; const f32x4 v = rv[mm][bj][n] + acc[ai][bj][m][n];
                            *(f32x4*)(out + o) = v; sq += (v[0] * v[0] + v[1] * v[1]) + (v[2] * v[2] + v[3] * v[3]);
                            u32x2 w; w.x = pk2(v[0], v[1]); w.y = pk2(v[2], v[3]); *(u32x2*)(XH + o) = w; *(unsigned*)(XH8 + o) = pk4_fp8(v[0], v[1], v[2], v[3]); }
                    sq += __shfl_xor(sq, 16); sq += __shfl_xor(sq, 32);
                    if (fq == 0) atomicAdd(ssq + row, ssq_fix(sq)); }
                asm volatile("" ::: "memory"); }
    }
};
template <bool OUT8> struct EpiSwiglu {
    static constexpr bool PERM = true, AFTER_DRAIN = false;
    bf16* ACT; int ldc; const u64* ssq; const float* rss; float wsi; float osc;
    __device__ __forceinline__ void operator()(AccT acc, const Unit& u, int wr, int wc, int fr, int fq) const {
        const int row0 = u.pm * BM + wr * 64 + fr, col0 = u.pn * HALF + wc * 32 + 8 * fq;
        float rs8[2][4];
#pragma unroll
        for (int ai = 0; ai < 2; ++ai)
#pragma unroll
            for (int m = 0; m < 4; ++m) { const int row = row0 + ai * HALF + m * 16; rs8[ai][m] = (rss ? rss[row] : rstd_of(ssq, row)) * wsi; }
#pragma unroll
        for (int ai = 0; ai < 2; ++ai)
#pragma unroll
            for (int m = 0; m < 4; ++m) { const int row = row0 + ai * HALF + m * 16; const float rs = rs8[ai][m];
                float o[8];
#pragma unroll
                for (int n = 0; n < 2; ++n)
#pragma unroll
                    for (int e = 0; e < 4; ++e) { const float a = acc[ai][0][m][n][e] * rs, b = acc[ai][1][m][n][e] * rs; o[4 * n + e] = a * sigmoidf_(a) * b; }
                if constexpr (OUT8) { u32x2 w; w.x = pk4_fp8(o[0] * osc, o[1] * osc, o[2] * osc, o[3] * osc); w.y = pk4_fp8(o[4] * osc, o[5] * osc, o[6] * osc, o[7] * osc);
                    *(u32x2*)((unsigned char*)ACT + (size_t)row * ldc + col0) = w; }
                else { u32x4 w; w.x = pk2(o[0], o[1]); w.y = pk2(o[2], o[3]); w.z = pk2(o[4], o[5]); w.w = pk2(o[6], o[7]);
                    *(u32x4*)(ACT + (size_t)row * ldc + col0) = w; } }
    }
};
struct EpiBf {
    static constexpr bool PERM = true, AFTER_DRAIN = false;
    bf16* O; int ldc; float sc;
    __device__ __forceinline__ void operator()(AccT acc, const Unit& u, int wr, int wc, int fr, int fq) const {
        const int row0 = u.pm * BM + wr * 64 + fr, col0 = u.pn * BM + wc * 32 + 8 * fq;
#pragma unroll
        for (int ai = 0; ai < 2; ++ai)
#pragma unroll
            for (int m = 0; m < 4; ++m) { bf16* rowp = O + (size_t)(row0 + ai * HALF + m * 16) * ldc + col0;
#pragma unroll
                for (int bj = 0; bj < 2; ++bj) { const f32x4 v0 = acc[ai][bj][m][0] * sc, v1 = acc[ai][bj][m][1] * sc;
                    u32x4 w; w.x = pk2(v0[0], v0[1]); w.y = pk2(v0[2], v0[3]); w.z = pk2(v1[0], v1[1]); w.w = pk2(v1[2], v1[3]);
                    *(u32x4*)(rowp + bj * HALF) = w; } }
    }
};
struct EpiHP {
    static constexpr bool PERM = false, AFTER_DRAIN = false;
    float* HP;
    __device__ __forceinline__ void operator()(AccT acc, const Unit& u, int wr, int wc, int fr, int fq) const {
        const int row0 = u.pm * BM + wr * 64 + fr, col0 = wc * 32 + 4 * fq; float* base = HP + (size_t)u.z * 1024 * 128;
#pragma unroll
        for (int ai = 0; ai < 2; ++ai)
#pragma unroll
            for (int m = 0; m < 4; ++m) { float* rowp = base + (size_t)(row0 + ai * HALF + m * 16) * 128 + col0;
#pragma unroll
                for (int n = 0; n < 2; ++n) *(f32x4*)(rowp + n * 16) = acc[ai][0][m][n]; }
    }
};
struct CmpFin { const float* HP; const float* b1; const bf16* w2t; const float* gain; bf16* KC; bf16* VCT; };
__device__ __forceinline__ void cmp_finalize(const CmpFin& C_, int z, int pm, LAS unsigned char* lds, int wid, int lane) {
        LAS bf16* H = (LAS bf16*)lds;
        { const int tid = wid * 64 + lane, r = tid >> 1, c0 = (tid & 1) * 64;
#pragma unroll
          for (int j = 0; j < 16; ++j) { const int c = c0 + 4 * j; f32x4 v = *(const f32x4*)(C_.b1 + z * 128 + c);
#pragma unroll
              for (int kp = 0; kp < 4; ++kp) v += *(const f32x4*)(C_.HP + ((size_t)(kp * 2 + z) * 1024 + pm * 256 + r) * 128 + c);
#pragma unroll
              for (int e = 0; e < 4; ++e) { const float x = v[e]; const float t = 0.7978845608f * (x + 0.044715f * x * x * x); const float th = 1.f - 2.f / (__expf(2.f * t) + 1.f); v[e] = 0.5f * x * (1.f + th); }
              u32x2 w; w.x = pk2(v[0], v[1]); w.y = pk2(v[2], v[3]); *(LAS u32x2*)(H + r * 136 + c) = w; } }
        LDS_WAIT(); __syncthreads();
        bf16x8 af[2][4], bfr[4][4];
#pragma unroll
        for (int mt = 0; mt < 2; ++mt)
#pragma unroll
            for (int ks = 0; ks < 4; ++ks) af[mt][ks] = *(const LAS bf16x8*)(H + (wid * 32 + mt * 16 + (lane & 15)) * 136 + ks * 32 + 8 * (lane >> 4));
#pragma unroll
        for (int n = 0; n < 4; ++n)
#pragma unroll
            for (int ks = 0; ks < 4; ++ks) bfr[n][ks] = *(const bf16x8*)(C_.w2t + (size_t)z * 64 * 128 + (16 * n + (lane & 15)) * 128 + ks * 32 + 8 * (lane >> 4));
        asm volatile("s_waitcnt vmcnt(0) lgkmcnt(0)" ::: "memory"); __builtin_amdgcn_sched_barrier(0);
        f32x4 C[2][4];
#pragma unroll
        for (int mt = 0; mt < 2; ++mt)
#pragma unroll
            for (int n = 0; n < 4; ++n) { C[mt][n] = (f32x4){0.f, 0.f, 0.f, 0.f};
#pragma unroll
                for (int ks = 0; ks < 4; ++ks) C[mt][n] = __builtin_amdgcn_mfma_f32_16x16x32_bf16(af[mt][ks], bfr[n][ks], C[mt][n], 0, 0, 0); }
        __builtin_amdgcn_sched_barrier(0);
#pragma unroll
        for (int mt = 0; mt < 2; ++mt)
#pragma unroll
            for (int r = 0; r < 4; ++r) { const int grow = pm * 256 + wid * 32 + mt * 16 + 4 * (lane >> 4) + r;
                const int hh = grow & 1, bc = grow >> 1, b = bc >> 8, c = bc & 255;
                float ss = 0.f;
#pragma unroll
                for (int n = 0; n < 4; ++n) ss += C[mt][n][r] * C[mt][n][r];
                ss = red16_sum(ss);
                if (c < 255) {
                    if (z == 0) { const float rs = 1.0f / sqrtf(ss * (1.f / 64.f) + NORM_EPS); bf16* dst = C_.KC + ((size_t)(b * 2 + hh) * 256 + c) * 64;
#pragma unroll
                        for (int n = 0; n < 4; ++n) { const int d = 16 * n + (lane & 15); dst[d] = (bf16)f2bf(C[mt][n][r] * rs * C_.gain[d]); } }
                    else { bf16* dst = C_.VCT + (size_t)(b * 2 + hh) * 64 * 256 + c;
#pragma unroll
                        for (int n = 0; n < 4; ++n) { const int d = 16 * n + (lane & 15); dst[(size_t)d * 256] = (bf16)f2bf(C[mt][n][r]); } } } }
        __syncthreads();
}

struct Frame {
    LAS unsigned char* lds; int tid, lane, wave, G, bid;
    const float* const* in; unsigned char* ws; unsigned* ctl;
};
__device__ __forceinline__ Frame relaunder(const Frame& F0) { Frame F = F0; int ln = (int)__builtin_amdgcn_mbcnt_hi(~0u, __builtin_amdgcn_mbcnt_lo(~0u, 0u)); asm volatile("" : "+v"(ln)); F.lane = ln; F.wave = F0.wave; F.tid = F0.wave * 64 + ln; return F; }
#define INP(k) (F.in[k])
__device__ __forceinline__ float ldbf(const bf16* p) { return bf2f(*p); }
__device__ __forceinline__ void ld8(const bf16* p, float (&v)[8]) { const u32x4 r = *(const u32x4*)p;
    v[0] = bf2f(r.x & 0xffffu); v[1] = bf2f(r.x >> 16); v[2] = bf2f(r.y & 0xffffu); v[3] = bf2f(r.y >> 16); v[4] = bf2f(r.z & 0xffffu); v[5] = bf2f(r.z >> 16); v[6] = bf2f(r.w & 0xffffu); v[7] = bf2f(r.w >> 16); }
__device__ __forceinline__ void st8(bf16* p, const float (&v)[8]) { u32x4 w; w.x = pk2(v[0], v[1]); w.y = pk2(v[2], v[3]); w.z = pk2(v[4], v[5]); w.w = pk2(v[6], v[7]); *(u32x4*)p = w; }
__device__ __forceinline__ void ldf8(const float* p, float (&v)[8]) { const f32x4 a = *(const f32x4*)p, b = *(const f32x4*)(p + 4); v[0] = a[0]; v[1] = a[1]; v[2] = a[2]; v[3] = a[3]; v[4] = b[0]; v[5] = b[1]; v[6] = b[2]; v[7] = b[3]; }

template <class Fsrc, bool F8 = false>
__device__ __forceinline__ void tr_matrix(const Frame& F, Fsrc f, int nrows, int K, bf16* dst) {
    LAS float* scr = (LAS float*)(F.lds + F.wave * 16384);
    const int gw = F.bid * 8 + F.wave, NGW = F.G * 8, lane = F.lane;
    const int nblk = nrows / 32, nitems = (K / 64) * nblk;
    const int kq = lane >> 3, n4 = (lane & 7) * 4;
    for (int it = gw; it < nitems; it += NGW) {
        const int kb = it / nblk, nb = it % nblk, k0 = 64 * kb, n0 = 32 * nb;
        f32x4 v[8];
#pragma unroll
        for (int i = 0; i < 8; ++i) v[i] = f(n0 + n4, k0 + 8 * i + kq);
#pragma unroll
        for (int i = 0; i < 8; ++i) { LAS float* d = scr + (8 * i + kq) * 33 + n4; d[0] = v[i][0]; d[1] = v[i][1]; d[2] = v[i][2]; d[3] = v[i][3]; }
        LDS_WAIT(); asm volatile("" ::: "memory");
        const int c = lane & 7;
#pragma unroll
        for (int j = 0; j < 4; ++j) { const int n = (lane >> 3) + 8 * j; const LAS float* sp = scr + (8 * c) * 33 + n;
            if constexpr (F8) { u32x2 o; o.x = pk4_fp8(sp[0 * 33], sp[1 * 33], sp[2 * 33], sp[3 * 33]); o.y = pk4_fp8(sp[4 * 33], sp[5 * 33], sp[6 * 33], sp[7 * 33]);
                *(u32x2*)((unsigned char*)dst + (size_t)(n0 + n) * K + k0 + 8 * c) = o; }
            else { u32x4 o; o.x = pk2(sp[0 * 33], sp[1 * 33]); o.y = pk2(sp[2 * 33], sp[3 * 33]); o.z = pk2(sp[4 * 33], sp[5 * 33]); o.w = pk2(sp[6 * 33], sp[7 * 33]);
                *(u32x4*)(dst + (size_t)(n0 + n) * K + k0 + 8 * c) = o; } }
        LDS_WAIT(); asm volatile("" ::: "memory");
    }
}
#define F4Z ((f32x4){0.f, 0.f, 0.f, 0.f})
struct SrcWP { const float* win; const float* vres; const float* gain; int l, NP;
    __device__ __forceinline__ f32x4 operator()(int n, int k) const {
        f32x4 v;
        if (n < 5848) v = *(const f32x4*)(win + (size_t)k * NIN + n);
        else if (n < NP) v = (l == 1 && n < 5912) ? *(const f32x4*)(vres + (size_t)k * 64 + (n - 5848)) : F4Z;
        else v = *(const f32x4*)(win + (size_t)k * NIN + PC_GATE + 4 * 2048 + (n - NP));
        return v * gain[k]; } };
struct SrcWG4 { const float* win; const float* gain;
    __device__ __forceinline__ f32x4 operator()(int n, int k) const { return *(const f32x4*)(win + (size_t)k * NIN + PC_GATE + 4 * 2048 + n) * (gain[k] * W8S); } };
struct SrcWG { const float* win; const float* gain; float sc;
    __device__ __forceinline__ f32x4 operator()(int n, int k) const {
        const int j = n >> 8, rho = n & 255, bj = rho >> 7, wc = (rho >> 5) & 3, nn = (rho >> 4) & 1, q = (rho >> 2) & 3;
        const int br = 2 * bj + nn, c = 64 * j + 16 * wc + 4 * q;
        return *(const f32x4*)(win + (size_t)k * NIN + PC_GATE + br * 2048 + c) * (gain[k] * sc); } };
struct SrcWB { const float* wb; const float* pw; const float* ps;
    __device__ __forceinline__ f32x4 operator()(int n, int k) const {
        if (n < 8192) { const int i = n >> 11, c = n & 2047; return *(const f32x4*)(wb + ((size_t)i * 512 + k) * 2048 + c); }
        const int c = n - 8192, g = c >> 9;
        if ((k >> 7) != g) return F4Z;
        return *(const f32x4*)(pw + ((size_t)g * 128 + (k & 127)) * 512 + (c & 511)) * *(const f32x4*)(ps + c); } };
struct SrcPlain { const float* w; int ldw;
    __device__ __forceinline__ f32x4 operator()(int n, int k) const { return *(const f32x4*)(w + (size_t)k * ldw + n); } };
struct SrcPlainS { const float* w; int ldw; float sc;
    __device__ __forceinline__ f32x4 operator()(int n, int k) const { return *(const f32x4*)(w + (size_t)k * ldw + n) * sc; } };
struct SrcPlainG { const float* w; int ldw; const float* gain;
    __device__ __forceinline__ f32x4 operator()(int n, int k) const { return *(const f32x4*)(w + (size_t)k * ldw + n) * gain[k]; } };
struct SrcLora { const float* w2; const float* a2; const float* g2; const float* vup; int l;
    __device__ __forceinline__ f32x4 operator()(int n, int k) const {
        const int blk = n >> 9, j = n & 511;
        if (blk == 0) return k < 96 ? *(const f32x4*)(w2 + (size_t)k * 512 + j) : F4Z;
        if (blk == 1) return (k >= 96 && k < 192) ? *(const f32x4*)(a2 + (size_t)(k - 96) * 512 + j) : F4Z;
        if (blk == 2) return (k >= 192 && k < 448) ? *(const f32x4*)(g2 + (size_t)(k - 192) * 512 + j) : F4Z;
        return (l == 1 && k >= 448) ? *(const f32x4*)(vup + (size_t)(k - 448) * 512 + j) : F4Z; } };
struct SrcC1 { const float* w1;
    __device__ __forceinline__ f32x4 operator()(int n, int k) const { const int i = n >> 8, c = n & 255; return c < 128 ? *(const f32x4*)(w1 + ((size_t)i * 2048 + k) * 128 + c) : F4Z; } };
struct SrcW13 { const float* w1; const float* w3; const float* gain; int ffw; float sc;
    __device__ __forceinline__ f32x4 operator()(int n, int k) const { const int t = n >> 8, which = (n >> 7) & 1, ff = 128 * t + (n & 127);
        const uintptr_t a = (uintptr_t)w1, dlt = (uintptr_t)w3 - a; const float* p = (const float*)(a + (which ? dlt : (uintptr_t)0));
        return *(const f32x4*)(p + (size_t)k * ffw + ff) * (gain[k] * sc); } };

__device__ __forceinline__ void phase_prologue(const Frame& F0) {
    const Frame F = relaunder(F0);
    unsigned char* ws = F.ws;
    for (int l = 0; l < 2; ++l) {
        const float* win = INP(5) + (size_t)l * D * NIN; const float* gmix = INP(2) + l * D;
        tr_matrix(F, SrcWP{win, INP(17), gmix, l, l ? NP1 : NP0}, (l ? NP1 : NP0), 2048, (bf16*)(ws + (l ? WS_WPT1 : WS_WPT0)));
        tr_matrix<SrcWG4, true>(F, SrcWG4{win, gmix}, 2048, 2048, (bf16*)(ws + (l ? WS_WG4T1 : WS_WG4T0)));
        tr_matrix<SrcWG, F8_G != 0>(F, SrcWG{win, gmix, F8_G ? W8S : 1.f}, 8192, 2048, (bf16*)(ws + (l ? WS_WGT1 : WS_WGT0)));
        tr_matrix(F, SrcWB{INP(31) + (size_t)l * 4 * 512 * 2048, INP(27) + (size_t)l * 4 * 128 * 512, INP(28) + l * D}, 10240, 512, (bf16*)(ws + (l ? WS_WBT1 : WS_WBT0)));
        tr_matrix(F, SrcPlain{INP(32) + (size_t)l * D * D, D}, 2048, 2048, (bf16*)(ws + (l ? WS_WOT1 : WS_WOT0)));
        tr_matrix(F, SrcLora{INP(8) + (size_t)l * 96 * 512, INP(10) + (size_t)l * 96 * 512, INP(11) + (size_t)l * 256 * 512, INP(20), l}, 2048, 512, (bf16*)(ws + (l ? WS_WLT1 : WS_WLT0)));
        tr_matrix(F, SrcPlainG{INP(29) + (size_t)l * D * 1024, 1024, INP(4) + l * D}, 1024, 2048, (bf16*)(ws + (l ? WS_WKVT1 : WS_WKVT0)));
        tr_matrix(F, SrcC1{INP(23) + (size_t)l * 2 * 2048 * 128}, 512, 2048, (bf16*)(ws + (l ? WS_WC1T1 : WS_WC1T0)));
        for (int i = 0; i < 2; ++i) tr_matrix(F, SrcPlain{INP(25) + (size_t)(l * 2 + i) * 128 * 64, 64}, 64, 128, (bf16*)(ws + WS_WC2T) + (size_t)(l * 2 + i) * 64 * 128);
    }
    tr_matrix<SrcW13, F8_F1 != 0>(F, SrcW13{INP(33), INP(34), INP(3), FF, F8_F1 ? W8S : 1.f}, 2 * FF, 2048, (bf16*)(ws + WS_W13T));
    tr_matrix(F, SrcPlain{INP(35), D}, 2048, FF, (bf16*)(ws + WS_W2T));
    for (int e = 0; e < NE; ++e) {
        tr_matrix<SrcW13, F8_M1 != 0>(F, SrcW13{INP(37) + (size_t)e * D * EFF, INP(38) + (size_t)e * D * EFF, INP(3) + D, EFF, F8_M1 ? W8S : 1.f}, 2 * EFF, 2048, (bf16*)(ws + WS_MW13T + (size_t)e * 2 * EFF * 2048 * (F8_M1 ? 1 : 2)));
        tr_matrix<SrcPlainS, F8_M2 != 0>(F, SrcPlainS{INP(39) + (size_t)e * EFF * D, D, F8_M2 ? W8S : 1.f}, 2048, EFF, (bf16*)(ws + WS_MW2T + (size_t)e * 2048 * EFF * (F8_M2 ? 1 : 2)));
    }
    const int gw = F.bid * 8 + F.wave, NGW = F.G * 8;
    u64* ssq = (u64*)(F.ctl + CW_SSQ);
    for (int base = F.bid * 16; base < M + 512; base += F.G * 16) for (int q = 0; q < 2; ++q) { const int m = base + F.wave * 2 + q;
        const bool ismem = m >= M; const float* src = ismem ? INP(1) + (size_t)(m - M) * D : INP(0) + (size_t)m * D;
        const f32x4* xr = (const f32x4*)src + F.lane; f32x4 v[8]; float s = 0.f;
#pragma unroll
        for (int j = 0; j < 8; ++j) { v[j] = xr[64 * j]; s += (v[j][0] * v[j][0] + v[j][1] * v[j][1]) + (v[j][2] * v[j][2] + v[j][3] * v[j][3]); }
        s = wave_sum(s);
        float sc = 1.f;
        if (ismem) sc = 1.0f / sqrtf(s * (1.f / D) + NORM_EPS); else if (F.lane == 0) ssq[m] = ssq_fix(s);
        bf16* dst = ismem ? (bf16*)(ws + WS_MEMN) + (size_t)(m - M) * D : (bf16*)(ws + WS_XH) + (size_t)m * D;
#pragma unroll
        for (int j = 0; j < 8; ++j) { u32x2 w; w.x = pk2(v[j][0] * sc, v[j][1] * sc); w.y = pk2(v[j][2] * sc, v[j][3] * sc); *((u32x2*)dst + F.lane + 64 * j) = w;
            if (!ismem) *((unsigned*)(ws + WS_XH8 + (size_t)m * D) + F.lane + 64 * j) = pk4_fp8(v[j][0], v[j][1], v[j][2], v[j][3]); }
    }
}

__device__ __forceinline__ float shiftP(const bf16* P, int m, int t, int col, float mu) {
    const float u = ldbf(P + (size_t)m * LDP + col); const float pv = t > 0 ? ldbf(P + (size_t)(m - 1) * LDP + col) : 0.f; return u + (pv - u) * mu;
}
__device__ __forceinline__ void phase_prep(const Frame& F0, int l) {
    const Frame F = relaunder(F0);
    unsigned char* ws = F.ws; const bf16* P = (const bf16*)(ws + WS_P);
    const float* mu = INP(6) + l * 1984; const float* vmu = INP(18);
    bf16* AL = (bf16*)(ws + WS_ALORA); bf16* QN = (bf16*)(ws + WS_QN); bf16* QM = (bf16*)(ws + WS_QM); bf16* Y = (bf16*)(ws + WS_Y);
    const float* qkg = INP(21) + l * 4 * 64; const float* mqg = INP(30) + l * 2 * 128;
    const float* cpos = INP(22) + (size_t)l * 2 * 32 * 64; const float* cw = INP(26) + l * 3 * 512;
    const int tid = F.tid, lane = F.lane, wave = F.wave;
    for (int tile = F.bid; tile < M / 32; tile += F.G) {
        const int m0 = tile * 32, b = m0 / T, t0 = m0 % T;
#pragma unroll
        for (int it_ = 0; it_ < 4; ++it_) { const int it = tid + it_ * 512; const int tt = it >> 6, g = it & 63, c = g * 8, m = m0 + tt, t = t0 + tt;
            int pc, kind; const float* mup;
            if (c < 96) { pc = PC_WD + c; kind = 0; mup = mu + pc; } else if (c < 192) { pc = PC_AD + c - 96; kind = 1; mup = mu + pc; }
            else if (c < 448) { pc = PC_GD + c - 192; kind = 2; mup = mu + pc; } else { pc = PC_VRES + c - 448; kind = 3; mup = vmu + (c - 448); }
            float o[8];
            if (kind == 3 && l == 0) {
#pragma unroll
                for (int j = 0; j < 8; ++j) o[j] = 0.f; }
            else { float u[8], pv[8], mm[8]; ld8(P + (size_t)m * LDP + pc, u); ldf8(mup, mm);
                if (t > 0) ld8(P + (size_t)(m - 1) * LDP + pc, pv); else {
#pragma unroll
                    for (int j = 0; j < 8; ++j) pv[j] = 0.f; }
#pragma unroll
                for (int j = 0; j < 8; ++j) { const float x = u[j] + (pv[j] - u[j]) * mm[j]; o[j] = kind == 0 ? tanhf(x) : (kind == 2 ? sigmoidf_(x) : x); } }
            st8(AL + (size_t)m * 512 + c, o); }
        for (int tt = wave; tt < 32; tt += 8) { const int m = m0 + tt;
            { float v[8]; float s = 0.f; const u32x4 raw = *(const u32x4*)(P + (size_t)m * LDP + PC_Q + lane * 8);
              v[0] = bf2f(raw.x & 0xffffu); v[1] = bf2f(raw.x >> 16); v[2] = bf2f(raw.y & 0xffffu); v[3] = bf2f(raw.y >> 16); v[4] = bf2f(raw.z & 0xffffu); v[5] = bf2f(raw.z >> 16); v[6] = bf2f(raw.w & 0xffffu); v[7] = bf2f(raw.w >> 16);
#pragma unroll
              for (int j = 0; j < 8; ++j) s += v[j] * v[j];
              s += __shfl_xor(s, 1); s += __shfl_xor(s, 2); s += __shfl_xor(s, 4);
              const float rs = CQ_NSA / sqrtf(s * (1.f / 64.f) + NORM_EPS); const int d0 = (lane & 7) * 8;
              u32x4 w; w.x = pk2(v[0] * rs * qkg[d0 + 0], v[1] * rs * qkg[d0 + 1]); w.y = pk2(v[2] * rs * qkg[d0 + 2], v[3] * rs * qkg[d0 + 3]); w.z = pk2(v[4] * rs * qkg[d0 + 4], v[5] * rs * qkg[d0 + 5]); w.w = pk2(v[6] * rs * qkg[d0 + 6], v[7] * rs * qkg[d0 + 7]);
              *(u32x4*)(QN + (size_t)m * 512 + lane * 8) = w; }
            { float v[8]; float s = 0.f; const u32x4 raw = *(const u32x4*)(P + (size_t)m * LDP + PC_MEM + lane * 8);
              v[0] = bf2f(raw.x & 0xffffu); v[1] = bf2f(raw.x >> 16); v[2] = bf2f(raw.y & 0xffffu); v[3] = bf2f(raw.y >> 16); v[4] = bf2f(raw.z & 0xffffu); v[5] = bf2f(raw.z >> 16); v[6] = bf2f(raw.w & 0xffffu); v[7] = bf2f(raw.w >> 16);
#pragma unroll
              for (int j = 0; j < 8; ++j) s += v[j] * v[j];
              s += __shfl_xor(s, 1); s += __shfl_xor(s, 2); s += __shfl_xor(s, 4); s += __shfl_xor(s, 8);
              const float rs = CQ_MEM / sqrtf(s * (1.f / 128.f) + NORM_EPS); const int d0 = (lane & 15) * 8;
              u32x4 w; w.x = pk2(v[0] * rs * mqg[d0 + 0], v[1] * rs * mqg[d0 + 1]); w.y = pk2(v[2] * rs * mqg[d0 + 2], v[3] * rs * mqg[d0 + 3]); w.z = pk2(v[4] * rs * mqg[d0 + 4], v[5] * rs * mqg[d0 + 5]); w.w = pk2(v[6] * rs * mqg[d0 + 6], v[7] * rs * mqg[d0 + 7]);
              *(u32x4*)(QM + (size_t)m * 512 + lane * 8) = w; }
            for (int which = 0; which < 2; ++which) { const int pc = which ? PC_KW : PC_KS; const float* gn = qkg + (which ? 3 : 2) * 64;
                const unsigned raw = *(const unsigned*)(P + (size_t)m * LDP + pc + lane * 2); const float a = bf2f(raw & 0xffffu), c2 = bf2f(raw >> 16);
                float s = a * a + c2 * c2; s += __shfl_xor(s, 1); s += __shfl_xor(s, 2); s += __shfl_xor(s, 4); s += __shfl_xor(s, 8); s += __shfl_xor(s, 16);
                const float rs = 1.0f / sqrtf(s * (1.f / 64.f) + NORM_EPS); const int kvh = lane >> 5, d = (lane & 31) * 2;
                bf16* dst = (bf16*)(ws + (which ? WS_KW : WS_KS)) + ((size_t)(b * 2 + kvh) * T + (t0 + tt)) * 64 + d;
                *(unsigned*)dst = pk2(a * rs * gn[d], c2 * rs * gn[d + 1]); }
        }
        if ((tile & 1) == 0) { const int col = tid & 127, tq = tid >> 7, kvh = col >> 6, d = col & 63;
          for (int which = 0; which < 2; ++which) { const int pc = which ? PC_VW : PC_VS;
            for (int q2 = 0; q2 < 2; ++q2) { const int tg = tq + 4 * q2; unsigned short v[8];
#pragma unroll
              for (int i = 0; i < 8; ++i) v[i] = P[(size_t)(m0 + tg * 8 + i) * LDP + pc + col];
              u32x4 w; w.x = v[0] | ((unsigned)v[1] << 16); w.y = v[2] | ((unsigned)v[3] << 16); w.z = v[4] | ((unsigned)v[5] << 16); w.w = v[6] | ((unsigned)v[7] << 16);
              *(u32x4*)((bf16*)(ws + (which ? WS_VWT : WS_VST)) + ((size_t)(b * 2 + kvh) * 64 + d) * T + t0 + tg * 8) = w; } } }
#pragma unroll
        for (int it_ = 0; it_ < 2; ++it_) { const int it = tid + it_ * 512; const int tt = it >> 5, r = (it & 31) * 8, i = r >> 7, h = (r >> 6) & 1, d = r & 63, t = t0 + tt, m = m0 + tt;
            float v[8], p1[8], o[8]; ld8(P + (size_t)m * LDP + PC_KC + r, v);
            bf16* A = (bf16*)(ws + WS_ACMP) + (size_t)i * 1024 * 2048;
            const int c1 = t >> 4, l1 = t & 15;
            if (c1 <= 254) { ldf8(cpos + (i * 32 + l1) * 64 + d, p1);
#pragma unroll
                for (int j = 0; j < 8; ++j) o[j] = v[j] + p1[j];
                st8(A + ((size_t)(b * 256 + c1) * 2 + h) * 2048 + l1 * 64 + d, o); }
            if (c1 >= 1) { ldf8(cpos + (i * 32 + l1 + 16) * 64 + d, p1);
#pragma unroll
                for (int j = 0; j < 8; ++j) o[j] = v[j] + p1[j];
                st8(A + ((size_t)(b * 256 + c1 - 1) * 2 + h) * 2048 + (l1 + 16) * 64 + d, o); } }
#pragma unroll
        for (int it_ = 0; it_ < 4; ++it_) { const int it = tid + it_ * 512; const int tt = it >> 6, c = (it & 63) * 8, m = m0 + tt, t = t0 + tt;
            float acc[8], bg[8];
#pragma unroll
            for (int j = 0; j < 8; ++j) acc[j] = 0.f;
#pragma unroll
            for (int k = 0; k < 3; ++k) { const int dt = 2 - k; if (t - dt >= 0) { float cg[8], xg[8], wv[8]; const size_t o = (size_t)(m - dt) * LDP; ld8(P + o + PC_CC + c, cg); ld8(P + o + PC_CX + c, xg); ldf8(cw + k * 512 + c, wv);
#pragma unroll
                    for (int j = 0; j < 8; ++j) acc[j] += wv[j] * cg[j] * xg[j]; } }
            ld8(P + (size_t)m * LDP + PC_CB + c, bg);
#pragma unroll
            for (int j = 0; j < 8; ++j) acc[j] *= bg[j];
            st8(Y + (size_t)m * 2560 + 1024 + c, acc); }
        { const int cgp = tid & 63, tg = tid >> 6, c = cgp * 8, w = 2 << (cgp >> 4); const int ts = t0 + tg * 4, ms = m0 + tg * 4;
          float sum[8];
#pragma unroll
          for (int j = 0; j < 8; ++j) sum[j] = 0.f;
#pragma unroll
          for (int k = 1; k < 16; ++k) if (k < w && ts - k >= 0) { float u[8]; ld8(P + (size_t)(ms - k) * LDP + PC_POOL + c, u);
#pragma unroll
              for (int j = 0; j < 8; ++j) sum[j] += u[j]; }
          for (int q = 0; q < 4; ++q) { const int t = ts + q, m = ms + q; float u[8], o[8]; ld8(P + (size_t)m * LDP + PC_POOL + c, u);
#pragma unroll
              for (int j = 0; j < 8; ++j) sum[j] += u[j];
              const int cnt = (t + 1) < w ? (t + 1) : w; const float ic = 1.f / (float)cnt;
#pragma unroll
              for (int j = 0; j < 8; ++j) o[j] = sum[j] * ic - u[j];
              st8(Y + (size_t)m * 2560 + 2048 + c, o);
              if (t - w + 1 >= 0) { float ud[8]; ld8(P + (size_t)(m - w + 1) * LDP + PC_POOL + c, ud);
#pragma unroll
                  for (int j = 0; j < 8; ++j) sum[j] -= ud[j]; } } }
    }
    { const float* KV = (const float*)(ws + WS_KVRAW) + l * 1024; bf16* KM = (bf16*)(ws + WS_KMEM); bf16* VM = (bf16*)(ws + WS_VMEMT); const float* kg = mqg + 128;
      for (int r = F.bid * 8 + wave; r < 512; r += F.G * 8) { const int b = r >> 8, j = r & 255;
          for (int h = 0; h < 4; ++h) { const float a = KV[(size_t)r * 2048 + h * 128 + lane], c2 = KV[(size_t)r * 2048 + h * 128 + 64 + lane];
              const float s = wave_sum(a * a + c2 * c2); const float rs = 1.0f / sqrtf(s * (1.f / 128.f) + NORM_EPS);
              bf16* dst = KM + ((size_t)(b * 4 + h) * 256 + j) * 128; dst[lane] = (bf16)f2bf(a * rs * kg[lane]); dst[64 + lane] = (bf16)f2bf(c2 * rs * kg[64 + lane]); } }
      for (int it = F.bid * 8 + wave; it < 1024; it += F.G * 8) { const int b = it >> 9, h = (it >> 7) & 3, d = it & 127;
#pragma unroll
          for (int k = 0; k < 4; ++k) { const int j = lane + 64 * k; VM[((size_t)(b * 4 + h) * 128 + d) * 256 + j] = (bf16)f2bf(KV[(size_t)(b * 256 + j) * 2048 + 512 + h * 128 + d]); } } }
}

template <int DH> struct AttL { static constexpr int KB = 64 * (DH + 8) * 2, VB = DH * 72 * 2, BUF = KB + VB, PW = 2 * BUF, END = PW + 8 * 16 * 72 * 2; };
constexpr int AT_PT = AttL<64>::END, AT_IMP = AT_PT + 32768, AT_SEL = AT_IMP + 8192, AT_UNI = AT_SEL + 256;
static_assert(AttL<128>::END <= RING_BYTES && AT_UNI + 64 <= RING_BYTES, "attention LDS map");
template <int DH, int MODE>
__device__ __forceinline__ void attn_pass(LAS unsigned char* lds, int tid, int lane, int wave, const bf16* Kg, const bf16* VTg, int ldvt, int jlo, int jhi,
                                          const bf16x8 (&qf)[DH / 32], f32x4 (&O)[DH / 16], float (&lsum)[4], int trow, unsigned sel0, unsigned sel1, unsigned uni0, unsigned uni1) {
    typedef AttL<DH> L;
    constexpr int KS = DH + 8;
    LAS bf16* PW = (LAS bf16*)(lds + L::PW) + wave * 16 * 72;
    const unsigned long long um = MODE == 2 ? (((unsigned long long)uni1 << 32) | uni0) : ~0ull;
    auto next_tile = [&](int from) -> int {
        if (from > jhi) return jhi + 1;
        if (MODE != 2) return from;
        const unsigned long long m = um >> from; if (m == 0ull) return jhi + 1;
        const int nx = from + __builtin_ctzll(m); return nx > jhi ? jhi + 1 : nx; };
    u32x4 kreg[DH / 64], vreg[DH / 64];
#define AT_LOADREGS(jt) do { _Pragma("unroll") for (int i = 0; i < DH / 64; ++i) { const int e = tid + i * 512; const int kr = e / (DH / 8), kc = (e % (DH / 8)) * 8; const int vr = e >> 3, vc = (e & 7) * 8; \
        kreg[i] = *(const u32x4*)(Kg + (size_t)(64 * (jt) + kr) * DH + kc); vreg[i] = *(const u32x4*)(VTg + (size_t)vr * ldvt + 64 * (jt) + vc); } } while (0)
#define AT_WRITELDS(bf) do { LAS bf16* KTw = (LAS bf16*)(lds + (bf) * L::BUF); LAS bf16* VTw = (LAS bf16*)(lds + (bf) * L::BUF + L::KB); \
        _Pragma("unroll") for (int i = 0; i < DH / 64; ++i) { const int e = tid + i * 512; const int kr = e / (DH / 8), kc = (e % (DH / 8)) * 8; const int vr = e >> 3, vc = (e & 7) * 8; \
        const int krp = 16 * (2 * (kr >> 5) + (kr & 1)) + ((kr >> 1) & 15); \
        *(LAS u32x4*)(KTw + krp * KS + kc) = kreg[i]; *(LAS u32x4*)(VTw + vr * 72 + vc) = vreg[i]; } } while (0)
    int jc = next_tile(jlo);
    if (jc > jhi) return;
    AT_LOADREGS(jc);
    __syncthreads();
    AT_WRITELDS(0);
    int jn = next_tile(jc + 1);
    if (jn <= jhi) AT_LOADREGS(jn);
    LDS_WAIT(); __syncthreads();
    int cur = 0;
    for (;;) {
        int jnn = jhi + 1;
        if (jn <= jhi) { AT_WRITELDS(cur ^ 1); jnn = next_tile(jn + 1); if (jnn <= jhi) AT_LOADREGS(jnn); }
        const int j = jc;
        const LAS bf16* KT = (const LAS bf16*)(lds + cur * L::BUF); const LAS bf16* VT = (const LAS bf16*)(lds + cur * L::BUF + L::KB);
        bool doit = true;
        if (MODE == 2) { const unsigned sb = j < 32 ? (sel0 >> j) : (sel1 >> (j - 32)); doit = __builtin_amdgcn_ballot_w64((sb & 1u) != 0u) != 0ull; }
        if (doit) {
        f32x4 S[4];
        { bf16x8 kfr[4][DH / 32];
#pragma unroll
          for (int n = 0; n < 4; ++n)
#pragma unroll
              for (int ks = 0; ks < DH / 32; ++ks) kfr[n][ks] = *(const LAS bf16x8*)(KT + (16 * n + (lane & 15)) * KS + ks * 32 + 8 * (lane >> 4));
          LDS_WAIT(); __builtin_amdgcn_sched_barrier(0);
#pragma unroll
          for (int n = 0; n < 4; ++n) { S[n] = (f32x4){0.f, 0.f, 0.f, 0.f};
#pragma unroll
              for (int ks = 0; ks < DH / 32; ++ks) S[n] = __builtin_amdgcn_mfma_f32_16x16x32_bf16(qf[ks], kfr[n][ks], S[n], 0, 0, 0); }
          __builtin_amdgcn_sched_barrier(0); }
        bool valid[4];
#pragma unroll
        for (int n = 0; n < 4; ++n) { const int key = 64 * j + 32 * (n >> 1) + 2 * (lane & 15) + (n & 1);
            if (MODE == 0) valid[n] = true;
            else if (MODE == 1) valid[n] = (key <= 254) && (16 * key + 31 <= trow);
            else if (MODE == 2) { const unsigned sb = j < 32 ? (sel0 >> j) : (sel1 >> (j - 32)); valid[n] = (sb & 1u) && key <= trow; }
            else valid[n] = key <= trow && key > trow - 512; }
#pragma unroll
        for (int a2 = 0; a2 < 2; ++a2)
#pragma unroll
            for (int r = 0; r < 4; ++r) { float p0 = __builtin_amdgcn_exp2f(S[2 * a2][r]), p1 = __builtin_amdgcn_exp2f(S[2 * a2 + 1][r]);
                if (MODE != 0) { p0 = valid[2 * a2] ? p0 : 0.f; p1 = valid[2 * a2 + 1] ? p1 : 0.f; }
                lsum[r] += p0 + p1;
                *(LAS unsigned*)(PW + (4 * (lane >> 4) + r) * 72 + 32 * a2 + 2 * (lane & 15)) = pk2(p0, p1); }
        LDS_WAIT(); asm volatile("" ::: "memory");
        { bf16x8 pfr[2], vfr[2][DH / 16];
#pragma unroll
          for (int ks = 0; ks < 2; ++ks) { pfr[ks] = *(const LAS bf16x8*)(PW + (lane & 15) * 72 + ks * 32 + 8 * (lane >> 4));
#pragma unroll
              for (int nd = 0; nd < DH / 16; ++nd) vfr[ks][nd] = *(const LAS bf16x8*)(VT + (16 * nd + (lane & 15)) * 72 + ks * 32 + 8 * (lane >> 4)); }
          LDS_WAIT(); __builtin_amdgcn_sched_barrier(0);
#pragma unroll
          for (int ks = 0; ks < 2; ++ks)
#pragma unroll
              for (int nd = 0; nd < DH / 16; ++nd) O[nd] = __builtin_amdgcn_mfma_f32_16x16x32_bf16(pfr[ks], vfr[ks][nd], O[nd], 0, 0, 0);
          __builtin_amdgcn_sched_barrier(0); }
        }
        if (jn > jhi) break;
        LDS_WAIT(); __syncthreads();
        cur ^= 1; jc = jn; jn = jnn;
    }
#undef AT_LOADREGS
#undef AT_WRITELDS
}

__device__ __forceinline__ void phase_memattn(const Frame& F0) {
    const Frame F = relaunder(F0);
    unsigned char* ws = F.ws; const bf16* QM = (const bf16*)(ws + WS_QM); const bf16* KM = (const bf16*)(ws + WS_KMEM); const bf16* VM = (const bf16*)(ws + WS_VMEMT); bf16* Y = (bf16*)(ws + WS_Y);
    const int lane = F.lane, wave = F.wave; const float c = 0.08838834764831845f * 1.4426950408889634f;
    for (int u = F.bid; u < 256; u += F.G) { const int b = u >> 7, h = (u >> 5) & 3, tile = u & 31; const int m0 = b * T + tile * 128 + wave * 16;
        bf16x8 qf[4];
#pragma unroll
        for (int ks = 0; ks < 4; ++ks) qf[ks] = *(const bf16x8*)(QM + (size_t)(m0 + (lane & 15)) * 512 + h * 128 + ks * 32 + 8 * (lane >> 4));
        f32x4 O[8]; float ls[4];
#pragma unroll
        for (int i = 0; i < 8; ++i) O[i] = (f32x4){0.f, 0.f, 0.f, 0.f};
#pragma unroll
        for (int r = 0; r < 4; ++r) ls[r] = 0.f;
        attn_pass<128, 0>(F.lds, F.tid, lane, wave, KM + (size_t)(b * 4 + h) * 256 * 128, VM + (size_t)(b * 4 + h) * 128 * 256, 256, 0, 3, qf, O, ls, 0, 0u, 0u, 0u, 0u);
#pragma unroll
        for (int r = 0; r < 4; ++r) { const float lr = red16_sum(ls[r]); const float inv = lr > 0.f ? 1.f / lr : 0.f; const int m = m0 + 4 * (lane >> 4) + r;
#pragma unroll
            for (int nd = 0; nd < 8; ++nd) Y[(size_t)m * 2560 + 1536 + h * 128 + 16 * nd + (lane & 15)] = (bf16)f2bf(O[nd][r] * inv); }
        __syncthreads();
    }
}

__device__ __forceinline__ void phase_nsa(const Frame& F0, unsigned* qctr) {
    const Frame F = relaunder(F0);
    unsigned char* ws = F.ws; const bf16* P = (const bf16*)(ws + WS_P); const bf16* QN = (const bf16*)(ws + WS_QN); bf16* Y = (bf16*)(ws + WS_Y);
    const int lane = F.lane, wave = F.wave, tid = F.tid; const float c = 0.125f * 1.4426950408889634f;
    LAS float* PT = (LAS float*)(F.lds + AT_PT); LAS float* IMP = (LAS float*)(F.lds + AT_IMP); LAS unsigned* SEL = (LAS unsigned*)(F.lds + AT_SEL); LAS unsigned* UNI = (LAS unsigned*)(F.lds + AT_UNI);
    LAS int* UQ = (LAS int*)(F.lds + AT_UNI + 16);
    int nxtq = 0; if (tid == 0) nxtq = (int)atomicAdd(qctr, 1u);
    for (;;) {
        __syncthreads();
        if (tid == 0) UQ[0] = nxtq;
        LDS_WAIT(); __syncthreads();
        const int uq = UQ[0]; if (uq >= 512) break;
        if (tid == 0) nxtq = (int)atomicAdd(qctr, 1u);
        const int tile = 127 - (uq >> 2), b = (uq >> 1) & 1, kvh = uq & 1;
        const int t0 = tile * 32, m0 = b * T + t0; const int cur = t0 >> 6;
        const int tl = wave * 4 + (lane >> 4);
        const int trow = t0 + tl;
        bf16x8 qf[2];
        { const int rho = lane & 15; const int mq = m0 + wave * 4 + (rho >> 2), g = rho & 3;
#pragma unroll
          for (int ks = 0; ks < 2; ++ks) qf[ks] = *(const bf16x8*)(QN + (size_t)mq * 512 + (kvh * 4 + g) * 64 + ks * 32 + 8 * (lane >> 4)); }
        const bf16* KCg = (const bf16*)(ws + WS_KC) + (size_t)(b * 2 + kvh) * 256 * 64; const bf16* VCg = (const bf16*)(ws + WS_VCT) + (size_t)(b * 2 + kvh) * 64 * 256;
        const bf16* KSg = (const bf16*)(ws + WS_KS) + (size_t)(b * 2 + kvh) * T * 64; const bf16* VSg = (const bf16*)(ws + WS_VST) + (size_t)(b * 2 + kvh) * 64 * T;
        const bf16* KWg = (const bf16*)(ws + WS_KW) + (size_t)(b * 2 + kvh) * T * 64; const bf16* VWg = (const bf16*)(ws + WS_VWT) + (size_t)(b * 2 + kvh) * 64 * T;
        f32x4 OF[4];
#pragma unroll
        for (int i = 0; i < 4; ++i) OF[i] = (f32x4){0.f, 0.f, 0.f, 0.f};
        float gate[3][4];
#pragma unroll
        for (int r = 0; r < 4; ++r)
#pragma unroll
            for (int k = 0; k < 3; ++k) gate[k][r] = sigmoidf_(ldbf(P + (size_t)(m0 + tl) * LDP + PC_GL + (kvh * 4 + r) * 3 + k));
        f32x4 O[4]; float lr[4];
#pragma unroll
        for (int i = 0; i < 4; ++i) O[i] = (f32x4){0.f, 0.f, 0.f, 0.f};
#pragma unroll
        for (int r = 0; r < 4; ++r) lr[r] = 0.f;
        attn_pass<64, 1>(F.lds, tid, lane, wave, KCg, VCg, 256, 0, 3, qf, O, lr, trow, 0u, 0u, 0u, 0u);
#pragma unroll
        for (int r = 0; r < 4; ++r) lr[r] = red16_sum(lr[r]);
#pragma unroll
        for (int r = 0; r < 4; ++r) { const float inv = lr[r] > 0.f ? 1.f / lr[r] : 0.f;
#pragma unroll
            for (int nd = 0; nd < 4; ++nd) OF[nd][r] += gate[0][r] * O[nd][r] * inv; }
        { LAS bf16* KT = (LAS bf16*)(F.lds);
          for (int j = 0; j < 4; ++j) {
              __syncthreads();
              { const int kr = tid >> 3, kc = (tid & 7) * 8; *(LAS u32x4*)(KT + kr * 72 + kc) = *(const u32x4*)(KCg + (size_t)(64 * j + kr) * 64 + kc); }
              LDS_WAIT(); __syncthreads();
              bf16x8 kfr[4][2]; f32x4 S4[4];
#pragma unroll
              for (int n = 0; n < 4; ++n)
#pragma unroll
                  for (int ks = 0; ks < 2; ++ks) kfr[n][ks] = *(const LAS bf16x8*)(KT + (16 * n + (lane & 15)) * 72 + ks * 32 + 8 * (lane >> 4));
              LDS_WAIT(); __builtin_amdgcn_sched_barrier(0);
#pragma unroll
              for (int n = 0; n < 4; ++n) { S4[n] = (f32x4){0.f, 0.f, 0.f, 0.f};
#pragma unroll
                  for (int ks = 0; ks < 2; ++ks) S4[n] = __builtin_amdgcn_mfma_f32_16x16x32_bf16(qf[ks], kfr[n][ks], S4[n], 0, 0, 0); }
              __builtin_amdgcn_sched_barrier(0);
#pragma unroll
              for (int n = 0; n < 4; ++n) { const f32x4 S = S4[n];
                  const int key = 64 * j + 16 * n + (lane & 15); const bool valid = (key <= 254) && (16 * key + 31 <= trow); float ps = 0.f;
#pragma unroll
                  for (int r = 0; r < 4; ++r) { const float inv = lr[r] > 0.f ? 1.f / lr[r] : 0.f; ps += valid ? __builtin_amdgcn_exp2f(S[r]) * inv : 0.f; }
                  PT[tl * 256 + key] = ps; } }
          if (tid < 64) SEL[tid] = 0u; if (tid < 2) UNI[tid] = 0u;
          LDS_WAIT(); __syncthreads(); }
        { const int tk = tid >> 4, sg = (tid & 15) * 4;
#pragma unroll
          for (int i = 0; i < 4; ++i) { const int s = sg + i; const LAS float* p = PT + tk * 256 + 4 * s; float v = p[0] + p[1] + p[2] + 0.5f * p[3]; if (s > 0) v += 0.5f * p[-1];
              const bool forced = (s == 0) || (s == cur) || (s == cur - 1); IMP[tk * 64 + s] = forced ? 1e9f : (s <= cur ? v : -1e9f); }
          LDS_WAIT(); __syncthreads();
          float mine[4]; int cnt[4];
#pragma unroll
          for (int i = 0; i < 4; ++i) { mine[i] = IMP[tk * 64 + sg + i]; cnt[i] = 0; }
          for (int s2 = 0; s2 < 64; ++s2) { const float o = IMP[tk * 64 + s2];
#pragma unroll
              for (int i = 0; i < 4; ++i) cnt[i] += (o > mine[i] || (o == mine[i] && s2 < sg + i)) ? 1 : 0; }
          unsigned bits = 0u;
#pragma unroll
          for (int i = 0; i < 4; ++i) if (cnt[i] < 16 && mine[i] > -1e8f) bits |= 1u << ((sg + i) & 31);
          if (bits) { atomicOr((unsigned*)(SEL + tk * 2 + (sg >> 5)), bits); atomicOr((unsigned*)(UNI + (sg >> 5)), bits); }
          LDS_WAIT(); __syncthreads(); }
        const unsigned sel0 = SEL[tl * 2], sel1 = SEL[tl * 2 + 1], uni0 = UNI[0], uni1 = UNI[1];
#pragma unroll
        for (int i = 0; i < 4; ++i) O[i] = (f32x4){0.f, 0.f, 0.f, 0.f};
#pragma unroll
        for (int r = 0; r < 4; ++r) lr[r] = 0.f;
        attn_pass<64, 2>(F.lds, tid, lane, wave, KSg, VSg, T, 0, cur, qf, O, lr, trow, sel0, sel1, uni0, uni1);
#pragma unroll
        for (int r = 0; r < 4; ++r) lr[r] = red16_sum(lr[r]);
#pragma unroll
        for (int r = 0; r < 4; ++r) { const float inv = lr[r] > 0.f ? 1.f / lr[r] : 0.f;
#pragma unroll
            for (int nd = 0; nd < 4; ++nd) OF[nd][r] += gate[1][r] * O[nd][r] * inv; }
#pragma unroll
        for (int i = 0; i < 4; ++i) O[i] = (f32x4){0.f, 0.f, 0.f, 0.f};
#pragma unroll
        for (int r = 0; r < 4; ++r) lr[r] = 0.f;
        { const int lo = t0 - 511; attn_pass<64, 3>(F.lds, tid, lane, wave, KWg, VWg, T, lo > 0 ? (lo >> 6) : 0, cur, qf, O, lr, trow, 0u, 0u, 0u, 0u); }
#pragma unroll
        for (int r = 0; r < 4; ++r) lr[r] = red16_sum(lr[r]);
#pragma unroll
        for (int r = 0; r < 4; ++r) { const float inv = lr[r] > 0.f ? 1.f / lr[r] : 0.f;
#pragma unroll
            for (int nd = 0; nd < 4; ++nd) OF[nd][r] += gate[2][r] * O[nd][r] * inv; }
#pragma unroll
        for (int r = 0; r < 4; ++r)
#pragma unroll
            for (int nd = 0; nd < 4; ++nd) Y[(size_t)(m0 + tl) * 2560 + 512 + (kvh * 4 + r) * 64 + 16 * nd + (lane & 15)] = (bf16)f2bf(OF[nd][r]);
        __syncthreads();
    }
}

constexpr int CL = 32, NCH = T / CL;
constexpr int SC_STEPS = 8;
__device__ __forceinline__ void phase_scan(const Frame& F0, int l) {
    const Frame F = relaunder(F0);
    unsigned char* ws = F.ws; const bf16* P = (const bf16*)(ws + WS_P); const float* LO = (const float*)(ws + WS_LO);
    float* VF = (float*)(ws + WS_VFIRST); float* VC = (float*)(ws + WS_VCUR); float* BON = (float*)(ws + WS_BON);
    float* YL = (float*)(ws + WS_YL); float* ZL = (float*)(ws + WS_ZL); float* QF = (float*)(ws + WS_QF); float* PF = (float*)(ws + WS_PF);
    const float* mu = INP(6) + l * 1984; const float* kk_ = INP(12) + l * 512; const float* ka_ = INP(13) + l * 512; const float* rk_ = INP(14) + l * 512;
    const int wave = F.wave;
    LAS float* ST = (LAS float*)F.lds + wave * (SC_STEPS * 5 * 64 + 64);
    for (int u = F.bid; u < 256; u += F.G) {
        int lane = F.lane; asm volatile("" : "+v"(lane));
        const int b = u >> 7, h = (u >> 4) & 7, cq = u & 15;
        const int jc = h * 64 + lane;
        const float mu_r = mu[PC_R + jc], mu_k = mu[PC_K + jc], mu_v = mu[PC_V + jc], kkw = kk_[jc], kaw = ka_[jc], rkw = rk_[jc];
        const int chunk = cq * 8 + wave;
        f32x2 Sq[32], Sp[32];
#pragma unroll
        for (int k = 0; k < 32; ++k) { Sq[k] = (f32x2){0.f, 0.f}; Sp[k] = (f32x2){(2 * k == lane) ? 1.f : 0.f, (2 * k + 1 == lane) ? 1.f : 0.f}; }
        const int tbase = chunk * CL;
        float gam = 1.f;
        for (int sb = 0; sb < CL / SC_STEPS; ++sb) {
            LDS_WAIT(); asm volatile("" ::: "memory");
#pragma unroll 1
            for (int hb = 0; hb < 2; ++hb) { const int st0 = hb * 4; const int tf = tbase + sb * SC_STEPS + st0, mf = b * T + tf;
              float ur[5], uk[5], uv[5], wv[4], av[4], vgv[4], vfv[4];
#pragma unroll
              for (int i = 0; i < 5; ++i) { const bool ok = (tf - 1 + i) >= 0; const bf16* pr = P + (size_t)(ok ? (mf - 1 + i) : mf) * LDP + h * 64;
                  const float sc = ok ? 1.f : 0.f;
                  ur[i] = ldbf(pr + PC_R + lane) * sc; uk[i] = ldbf(pr + PC_K + lane) * sc; uv[i] = ldbf(pr + PC_V + lane) * sc; }
#pragma unroll
              for (int i = 0; i < 4; ++i) { const float* lr = LO + (size_t)(mf + i) * 2048 + h * 64; wv[i] = lr[lane]; av[i] = lr[512 + lane];
                  vgv[i] = l ? lr[1536 + lane] : 0.f; vfv[i] = l ? (VF + (size_t)(mf + i) * 512 + h * 64)[lane] : 0.f; }
              float rr[4], kv[4], vv4[4], kmod4[4], red[8];
#pragma unroll
              for (int i = 0; i < 4; ++i) { const int m = mf + i;
                  const float r = ur[i + 1] + (ur[i] - ur[i + 1]) * mu_r, k = uk[i + 1] + (uk[i] - uk[i + 1]) * mu_k; float v = uv[i + 1] + (uv[i] - uv[i + 1]) * mu_v;
                  if (l == 0) (VF + (size_t)m * 512 + h * 64)[lane] = v; else v = v + (vfv[i] - v) * vgv[i];
                  (VC + (size_t)m * 512 + h * 64)[lane] = v;
                  const float kkv = k * kkw; const float kmod = k * (1.f + (av[i] - 1.f) * kaw);
                  rr[i] = r; kv[i] = kkv; vv4[i] = v; kmod4[i] = kmod; red[2 * i] = kkv * kkv; red[2 * i + 1] = r * kmod * rkw; }
#pragma unroll
              for (int o = 1; o < 64; o <<= 1) { float t8[8];
#pragma unroll
                  for (int j = 0; j < 8; ++j) t8[j] = __shfl_xor(red[j], o);
#pragma unroll
                  for (int j = 0; j < 8; ++j) red[j] += t8[j]; }
#pragma unroll
              for (int i = 0; i < 4; ++i) { const int m = mf + i; const float w = wv[i], a = av[i];
                  const float kkn = kv[i] * (1.0f / sqrtf(fmaxf(red[2 * i], 1e-24f)));
                  if (lane == 0) __hip_atomic_store((unsigned*)BON + (size_t)m * 8 + h, __builtin_bit_cast(unsigned, red[2 * i + 1]), RLX_AGENT);
                  const float gprev = gam; gam *= w; const float ig = 1.0f / gam;
                  LAS float* dst = ST + ((st0 + i) * 5) * 64 + lane;
                  dst[0] = kkn * gprev; dst[64] = kkn * a * ig; dst[128] = kmod4[i] * ig; dst[192] = rr[i] * gam; dst[256] = vv4[i]; } }
            LDS_WAIT(); asm volatile("" ::: "memory");
            for (int st = 0; st < SC_STEPS; ++st) { const LAS float* sp = ST + (st * 5) * 64; const int t = tbase + sb * SC_STEPS + st;
                const float vv = sp[256 + lane]; const f32x2 vv2 = (f32x2){vv, vv};
                f32x2 qa = (f32x2){0.f, 0.f}, qb = qa, pa = qa, pb = qa;
                { f32x4 buf[2][2];
#pragma unroll
                  for (int i = 0; i < 2; ++i) buf[0][i] = *(const LAS f32x4*)(sp + 4 * i);
#pragma unroll
                  for (int g = 0; g < 8; ++g) {
                      if (g < 7) {
#pragma unroll
                          for (int i = 0; i < 2; ++i) buf[(g + 1) & 1][i] = *(const LAS f32x4*)(sp + 8 * (g + 1) + 4 * i); }
                      asm volatile("" ::: "memory");
#pragma unroll
                      for (int i = 0; i < 2; ++i) { const int k2 = 4 * g + 2 * i; const f32x4 kk4 = buf[g & 1][i]; const f32x2 klo = (f32x2){kk4[0], kk4[1]}, khi = (f32x2){kk4[2], kk4[3]};
                          qa += Sq[k2] * klo; qb += Sq[k2 + 1] * khi; pa += Sp[k2] * klo; pb += Sp[k2 + 1] * khi; } } }
                const f32x2 qs = qa + qb, ps = pa + pb; const float nq = -(qs.x + qs.y), np = -(ps.x + ps.y); const f32x2 nq2 = (f32x2){nq, nq}, np2 = (f32x2){np, np};
                f32x2 ya = (f32x2){0.f, 0.f}, yb = ya, za = ya, zb = ya;
                { f32x4 bb[2], bk[2], br[2];
                  bb[0] = *(const LAS f32x4*)(sp + 64); bk[0] = *(const LAS f32x4*)(sp + 128); br[0] = *(const LAS f32x4*)(sp + 192);
#pragma unroll
                  for (int g = 0; g < 16; ++g) {
                      if (g < 15) { bb[(g + 1) & 1] = *(const LAS f32x4*)(sp + 64 + 4 * (g + 1)); bk[(g + 1) & 1] = *(const LAS f32x4*)(sp + 128 + 4 * (g + 1)); br[(g + 1) & 1] = *(const LAS f32x4*)(sp + 192 + 4 * (g + 1)); }
                      asm volatile("" ::: "memory");
                      { const int k2 = 2 * g; const f32x4 b4 = bb[g & 1], k4 = bk[g & 1], r4 = br[g & 1];
                        const f32x2 blo = (f32x2){b4[0], b4[1]}, bhi = (f32x2){b4[2], b4[3]}, klo = (f32x2){k4[0], k4[1]}, khi = (f32x2){k4[2], k4[3]}, rlo = (f32x2){r4[0], r4[1]}, rhi = (f32x2){r4[2], r4[3]};
                        Sq[k2] += vv2 * klo + nq2 * blo; Sq[k2 + 1] += vv2 * khi + nq2 * bhi; Sp[k2] += np2 * blo; Sp[k2 + 1] += np2 * bhi;
                        ya += Sq[k2] * rlo; yb += Sq[k2 + 1] * rhi; za += Sp[k2] * rlo; zb += Sp[k2 + 1] * rhi; } } }
                const f32x2 ys = ya + yb, zs = za + zb;
                const size_t o = (size_t)(b * T + t) * 512 + h * 64 + lane;
                YL[o] = ys.x + ys.y; ZL[o] = zs.x + zs.y; }
        }
        { LAS float* GL = ST + SC_STEPS * 5 * 64; LDS_WAIT(); asm volatile("" ::: "memory"); GL[lane] = gam; LDS_WAIT(); asm volatile("" ::: "memory");
#pragma unroll
          for (int k = 0; k < 32; k += 2) { const f32x4 g4 = *(const LAS f32x4*)(GL + 2 * k); const f32x2 glo = (f32x2){g4[0], g4[1]}, ghi = (f32x2){g4[2], g4[3]};
              Sq[k] *= glo; Sq[k + 1] *= ghi; Sp[k] *= glo; Sp[k + 1] *= ghi; } }
        { const size_t un = ((size_t)(b * 8 + h) * NCH + chunk) * 4096;
#pragma unroll
          for (int k = 0; k < 32; k += 4) { u32x4 w; w.x = pk2(Sq[k].x, Sq[k].y); w.y = pk2(Sq[k + 1].x, Sq[k + 1].y); w.z = pk2(Sq[k + 2].x, Sq[k + 2].y); w.w = pk2(Sq[k + 3].x, Sq[k + 3].y);
              *(u32x4*)((bf16*)QF + un + lane * 64 + 2 * k) = w; }
          { unsigned short* pf = (unsigned short*)PF + un + ((lane >> 2) & 3) * 16 + (lane >> 4) * 4 + (lane & 3);
#pragma unroll
            for (int k = 0; k < 32; ++k) { const unsigned w = pk2(Sp[k].x, Sp[k].y); pf[(2 * k) * 64] = (unsigned short)w; pf[(2 * k + 1) * 64] = (unsigned short)(w >> 16); } } }
    }
}
constexpr int CPF = 8;
__device__ __forceinline__ void phase_carry(const Frame& F0) {
    const Frame F = relaunder(F0);
    unsigned char* ws = F.ws; const unsigned char* QFb = ws + WS_QF; const unsigned char* PFb = ws + WS_PF; float* SI = (float*)(ws + WS_SINIT);
    const int lane = F.lane, wave = F.wave;
    LAS unsigned char* ring = F.lds;
    for (int chain = F.bid; chain < 16; chain += F.G) {
        const size_t cb = (size_t)chain * NCH * 8192;
        if (wave >= 4) {
            const int pt = (wave - 4) * 64 + lane;
            u32x4 rt[CPF][2], rq[CPF][2];
#pragma unroll
            for (int d = 0; d < CPF; ++d) { const size_t o = cb + (size_t)d * 8192 + pt * 16;
                rt[d][0] = *(const u32x4*)(PFb + o); rt[d][1] = *(const u32x4*)(PFb + o + 4096); rq[d][0] = *(const u32x4*)(QFb + o); rq[d][1] = *(const u32x4*)(QFb + o + 4096); }
            asm volatile("s_waitcnt vmcnt(%0)" :: "n"(4 * (CPF - 1)) : "memory");
            { LAS unsigned char* sl = ring + pt * 16; *(LAS u32x4*)(sl) = rt[0][0]; *(LAS u32x4*)(sl + 4096) = rt[0][1]; *(LAS u32x4*)(sl + 8192) = rq[0][0]; *(LAS u32x4*)(sl + 12288) = rq[0][1]; }
            { const size_t o = cb + (size_t)CPF * 8192 + pt * 16;
              rt[0][0] = *(const u32x4*)(PFb + o); rt[0][1] = *(const u32x4*)(PFb + o + 4096); rq[0][0] = *(const u32x4*)(QFb + o); rq[0][1] = *(const u32x4*)(QFb + o + 4096); }
            LDS_WAIT(); __syncthreads();
            for (int c0 = 0; c0 < NCH; c0 += CPF) {
#pragma unroll
                for (int d = 0; d < CPF; ++d) { const int c = c0 + d;
                    constexpr int DUMMY = 0; (void)DUMMY;
                    const int e = (d + 1) % CPF;
                    if (c + 1 < NCH) {
                        asm volatile("s_waitcnt vmcnt(%0)" :: "n"(4 * (CPF - 1)) : "memory");
                        LAS unsigned char* sl = ring + ((c + 1) & 1) * 16384 + pt * 16;
                        *(LAS u32x4*)(sl) = rt[e][0]; *(LAS u32x4*)(sl + 4096) = rt[e][1]; *(LAS u32x4*)(sl + 8192) = rq[e][0]; *(LAS u32x4*)(sl + 12288) = rq[e][1];
                        const int cn = c + 1 + CPF < NCH ? c + 1 + CPF : NCH - 1;
                        const size_t o = cb + (size_t)cn * 8192 + pt * 16;
                        rt[e][0] = *(const u32x4*)(PFb + o); rt[e][1] = *(const u32x4*)(PFb + o + 4096); rq[e][0] = *(const u32x4*)(QFb + o); rq[e][1] = *(const u32x4*)(QFb + o + 4096);
                    }
                    LDS_WAIT(); __syncthreads();
                }
            }
            asm volatile("s_waitcnt vmcnt(0)" ::: "memory");
        } else {
            const int row = wave * 16 + (lane & 15), g = lane >> 4;
            const int aoff = ((lane & 15) * 64 + g * 16) * 2, qoff = (row * 64 + 4 * g) * 2;
            f32x4 S[4];
#pragma unroll
            for (int mt = 0; mt < 4; ++mt) S[mt] = (f32x4){0.f, 0.f, 0.f, 0.f};
            u32x4 a[4][2]; u32x2 q[4];
            __syncthreads();
#pragma unroll
            for (int mt = 0; mt < 4; ++mt) { a[mt][0] = *(const LAS u32x4*)(ring + mt * 2048 + aoff); a[mt][1] = *(const LAS u32x4*)(ring + mt * 2048 + aoff + 16); q[mt] = *(const LAS u32x2*)(ring + 8192 + qoff + 32 * mt); }
            LDS_WAIT(); __builtin_amdgcn_sched_barrier(0);
            for (int c = 0; c < NCH; ++c) { const size_t un = ((size_t)chain * NCH + c) * 4096;
#pragma unroll
                for (int mt = 0; mt < 4; ++mt) *(f32x4*)(SI + un + (qoff >> 1) + 16 * mt) = S[mt];
                bf16x8 bh[2], bl[2];
#pragma unroll
                for (int ks = 0; ks < 2; ++ks) { u32x4 wh, wl; const f32x4 s0 = S[2 * ks], s1 = S[2 * ks + 1];
                    wh.x = pk2(s0[0], s0[1]); wh.y = pk2(s0[2], s0[3]); wh.z = pk2(s1[0], s1[1]); wh.w = pk2(s1[2], s1[3]);
                    wl.x = pk2(s0[0] - bf2f(wh.x & 0xffffu), s0[1] - bf2f(wh.x >> 16)); wl.y = pk2(s0[2] - bf2f(wh.y & 0xffffu), s0[3] - bf2f(wh.y >> 16));
                    wl.z = pk2(s1[0] - bf2f(wh.z & 0xffffu), s1[1] - bf2f(wh.z >> 16)); wl.w = pk2(s1[2] - bf2f(wh.w & 0xffffu), s1[3] - bf2f(wh.w >> 16));
                    bh[ks] = __builtin_bit_cast(bf16x8, wh); bl[ks] = __builtin_bit_cast(bf16x8, wl); }
                __builtin_amdgcn_sched_barrier(0);
#pragma unroll
                for (int mt = 0; mt < 4; ++mt) { f32x4 d = (f32x4){bf2f(q[mt].x & 0xffffu), bf2f(q[mt].x >> 16), bf2f(q[mt].y & 0xffffu), bf2f(q[mt].y >> 16)};
#pragma unroll
                    for (int ks = 0; ks < 2; ++ks) { const bf16x8 af = __builtin_bit_cast(bf16x8, a[mt][ks]);
                        d = __builtin_amdgcn_mfma_f32_16x16x32_bf16(af, bh[ks], d, 0, 0, 0); d = __builtin_amdgcn_mfma_f32_16x16x32_bf16(af, bl[ks], d, 0, 0, 0); }
                    S[mt] = d; }
                asm volatile("s_nop 7\n\ts_nop 7" ::: "memory");
                __builtin_amdgcn_sched_barrier(0);
                __syncthreads();
                if (c + 1 < NCH) { LAS unsigned char* sl = ring + ((c + 1) & 1) * 16384;
#pragma unroll
                    for (int mt = 0; mt < 4; ++mt) { a[mt][0] = *(const LAS u32x4*)(sl + mt * 2048 + aoff); a[mt][1] = *(const LAS u32x4*)(sl + mt * 2048 + aoff + 16); q[mt] = *(const LAS u32x2*)(sl + 8192 + qoff + 32 * mt); } }
                LDS_WAIT(); __builtin_amdgcn_sched_barrier(0);
            }
        }
        __syncthreads();
    }
}
__device__ __forceinline__ void phase_rwkv_fin(const Frame& F0, int l) {
    const Frame F = relaunder(F0);
    unsigned char* ws = F.ws; const float* SI = (const float*)(ws + WS_SINIT); const float* YL = (const float*)(ws + WS_YL); const float* ZL = (const float*)(ws + WS_ZL);
    const float* LO = (const float*)(ws + WS_LO); const float* VC = (const float*)(ws + WS_VCUR); const float* BON = (const float*)(ws + WS_BON); bf16* Y = (bf16*)(ws + WS_Y);
    const float* lnw = INP(15) + l * 512; const float* lnb = INP(16) + l * 512;
    const int lane = F.lane, wave = F.wave;
    for (int u = F.bid; u < 16 * (NCH / 4); u += F.G) { const int chain = u / (NCH / 4), c = (u % (NCH / 4)) * 4 + (wave >> 1), b = chain >> 3, h = chain & 7; const size_t un = ((size_t)chain * NCH + c) * 4096;
        const int m0 = b * T + c * CL + (wave & 1) * 16;
        bf16x8 af[2], bfr[4][2];
#pragma unroll
        for (int ks = 0; ks < 2; ++ks) { float t8[8]; ldf8(ZL + (size_t)(m0 + (lane & 15)) * 512 + h * 64 + ks * 32 + 8 * (lane >> 4), t8);
            u32x4 w; w.x = pk2(t8[0], t8[1]); w.y = pk2(t8[2], t8[3]); w.z = pk2(t8[4], t8[5]); w.w = pk2(t8[6], t8[7]); af[ks] = __builtin_bit_cast(bf16x8, w); }
#pragma unroll
        for (int n = 0; n < 4; ++n)
#pragma unroll
            for (int ks = 0; ks < 2; ++ks) { float t8[8]; ldf8(SI + un + (size_t)(16 * n + (lane & 15)) * 64 + ks * 32 + 8 * (lane >> 4), t8);
                u32x4 w; w.x = pk2(t8[0], t8[1]); w.y = pk2(t8[2], t8[3]); w.z = pk2(t8[4], t8[5]); w.w = pk2(t8[6], t8[7]); bfr[n][ks] = __builtin_bit_cast(bf16x8, w); }
        float yl[4][4], vc[4][4], gg[4][4], bn[4];
#pragma unroll
        for (int r = 0; r < 4; ++r) { const int m = m0 + 4 * (lane >> 4) + r; bn[r] = BON[(size_t)m * 8 + h];
#pragma unroll
            for (int n = 0; n < 4; ++n) { const int j = h * 64 + 16 * n + (lane & 15); yl[n][r] = YL[(size_t)m * 512 + j]; vc[n][r] = VC[(size_t)m * 512 + j]; gg[n][r] = LO[(size_t)m * 2048 + 1024 + j]; } }
        asm volatile("s_waitcnt vmcnt(0)" ::: "memory"); __builtin_amdgcn_sched_barrier(0);
        f32x4 C[4];
#pragma unroll
        for (int n = 0; n < 4; ++n) { C[n] = (f32x4){yl[n][0], yl[n][1], yl[n][2], yl[n][3]};
#pragma unroll
            for (int ks = 0; ks < 2; ++ks) C[n] = __builtin_amdgcn_mfma_f32_16x16x32_bf16(af[ks], bfr[n][ks], C[n], 0, 0, 0); }
        __builtin_amdgcn_sched_barrier(0);
#pragma unroll
        for (int r = 0; r < 4; ++r) { const int m = m0 + 4 * (lane >> 4) + r;
            float sm = (C[0][r] + C[1][r]) + (C[2][r] + C[3][r]); sm = red16_sum(sm); const float mean = sm * (1.f / 64.f);
            float d[4], sv = 0.f;
#pragma unroll
            for (int n = 0; n < 4; ++n) { d[n] = C[n][r] - mean; sv += d[n] * d[n]; }
            sv = red16_sum(sv); const float rs = 1.0f / sqrtf(sv * (1.f / 64.f) + 64e-5f);
#pragma unroll
            for (int n = 0; n < 4; ++n) { const int j = h * 64 + 16 * n + (lane & 15); const float yn = d[n] * rs * lnw[j] + lnb[j];
                Y[(size_t)m * 2560 + j] = (bf16)f2bf((yn + bn[r] * vc[n][r]) * gg[n][r]); } }
    }
}

__device__ __forceinline__ void phase_route(const Frame& F0, const float* X) {
    const Frame F = relaunder(F0);
    const float* R = INP(36); const float* gain = INP(3) + D; const u64* ssq = (const u64*)(F.ctl + CW_SSQ) + 3 * 8192;
    unsigned* cnt = F.ctl + CW_CNT; unsigned* route = F.ctl + CW_ROUTE;
    const int lane = F.lane;
    for (int m = F.bid * 8 + F.wave; m < M; m += F.G * 8) {
        float acc[8];
#pragma unroll
        for (int e = 0; e < 8; ++e) acc[e] = 0.f;
#pragma unroll 8
        for (int i = 0; i < 32; ++i) { const int k = lane + 64 * i; const float xv = X[(size_t)m * D + k] * gain[k]; const f32x4 r0 = *(const f32x4*)(R + k * 8), r1 = *(const f32x4*)(R + k * 8 + 4);
            acc[0] += xv * r0[0]; acc[1] += xv * r0[1]; acc[2] += xv * r0[2]; acc[3] += xv * r0[3]; acc[4] += xv * r1[0]; acc[5] += xv * r1[1]; acc[6] += xv * r1[2]; acc[7] += xv * r1[3]; }
        const float rs = rstd_of(ssq, m);
#pragma unroll
        for (int e = 0; e < 8; ++e) acc[e] = wave_sum(acc[e]) * rs;
        if (lane == 0) {
            int e0 = 0; float v0 = acc[0];
#pragma unroll
            for (int e = 1; e < 8; ++e) if (acc[e] > v0) { v0 = acc[e]; e0 = e; }
            int e1 = -1; float v1 = -3.0e38f;
#pragma unroll
            for (int e = 0; e < 8; ++e) if (e != e0 && acc[e] > v1) { v1 = acc[e]; e1 = e; }
            const float p1 = __expf(v1 - v0); const float w0 = 1.f / (1.f + p1), w1 = p1 / (1.f + p1);
            const unsigned pos0 = atomicAdd(cnt + 64 * e0, 1u), pos1 = atomicAdd(cnt + 64 * e1, 1u);
            unsigned* rr = route + (size_t)m * 8; rr[0] = (unsigned)e0; rr[1] = (unsigned)e1; rr[2] = __builtin_bit_cast(unsigned, w0); rr[3] = __builtin_bit_cast(unsigned, w1); rr[4] = pos0; rr[5] = pos1; rr[6] = __builtin_bit_cast(unsigned, rs); }
    }
}
__device__ __forceinline__ void moe_tiles(const Frame& F, int (&ts)[9]) {
    ts[0] = 0;
#pragma unroll
    for (int e = 0; e < 8; ++e) { const unsigned c = __hip_atomic_load(F.ctl + CW_CNT + 64 * e, RLX_AGENT); ts[e + 1] = ts[e] + (int)((c + 255u) >> 8); }
}
__device__ __forceinline__ void phase_gather(const Frame& F0, float* RSS) {
    const Frame F = relaunder(F0);
    constexpr int RB = F8_M1 ? D : 2 * D;
    unsigned char* ws = F.ws; const unsigned char* XH = ws + (F8_M1 ? WS_XH8 : WS_XH); unsigned char* XG = ws + WS_XG; const unsigned* route = F.ctl + CW_ROUTE;
    int ts[9]; moe_tiles(F, ts);
    for (int m = F.bid * 8 + F.wave; m < M; m += F.G * 8) { const unsigned* rr = route + (size_t)m * 8;
        const u32x4* src = (const u32x4*)(XH + (size_t)m * RB);
#pragma unroll
        for (int s = 0; s < 2; ++s) { const int e = (int)rr[s]; int base = 0;
#pragma unroll
            for (int j = 0; j < 8; ++j) base = (j == e) ? ts[j] : base;
            const int slot = base * 256 + (int)rr[4 + s]; u32x4* dst = (u32x4*)(XG + (size_t)slot * RB);
#pragma unroll
            for (int i = 0; i < RB / 1024; ++i) dst[F.lane + 64 * i] = src[F.lane + 64 * i];
            if (F.lane == 0) __hip_atomic_store((unsigned*)RSS + slot, rr[6], RLX_AGENT); } }
}
__device__ __forceinline__ void phase_combine(const Frame& F0, const float* X, float* out) {
    const Frame F = relaunder(F0);
    unsigned char* ws = F.ws; const bf16* YS = (const bf16*)(ws + WS_YS); const unsigned* route = F.ctl + CW_ROUTE;
    int ts[9]; moe_tiles(F, ts);
    for (int m = F.bid * 8 + F.wave; m < M; m += F.G * 8) { const unsigned* rr = route + (size_t)m * 8; int slot[2]; float w[2];
#pragma unroll
        for (int s = 0; s < 2; ++s) { const int e = (int)rr[s]; int base = 0;
#pragma unroll
            for (int j = 0; j < 8; ++j) base = (j == e) ? ts[j] : base;
            slot[s] = base * 256 + (int)rr[4 + s]; w[s] = __builtin_bit_cast(float, rr[2 + s]); }
#pragma unroll
        for (int i = 0; i < 8; ++i) { const int c = (F.lane + 64 * i) * 4; f32x4 v = *(const f32x4*)(X + (size_t)m * D + c);
            const u32x2 a = *(const u32x2*)(YS + (size_t)slot[0] * D + c), b2 = *(const u32x2*)(YS + (size_t)slot[1] * D + c);
            v[0] += w[0] * bf2f(a.x & 0xffffu) + w[1] * bf2f(b2.x & 0xffffu); v[1] += w[0] * bf2f(a.x >> 16) + w[1] * bf2f(b2.x >> 16);
            v[2] += w[0] * bf2f(a.y & 0xffffu) + w[1] * bf2f(b2.y & 0xffffu); v[3] += w[0] * bf2f(a.y >> 16) + w[1] * bf2f(b2.y >> 16);
            *(f32x4*)(out + (size_t)m * D + c) = v; } }
}

constexpr int PH_PER_LAYER = 14, N_PHASES = 1 + 2 * PH_PER_LAYER;
struct Args { const float* in[40]; float* out; unsigned char* ws; int ph_lo, ph_hi; };
__global__ void __launch_bounds__(512, 2) mega_fwd(Args args) {
    extern __shared__ __attribute__((aligned(16))) unsigned char lds_raw[];
    Frame F; F.lds = (LAS unsigned char*)lds_raw; F.tid = threadIdx.x; F.lane = F.tid & 63; F.wave = __builtin_amdgcn_readfirstlane(F.tid >> 6); F.G = gridDim.x; F.bid = blockIdx.x;
    F.in = args.in; F.ws = args.ws; F.ctl = (unsigned*)(args.ws + WS_CTL);
    volatile LAS unsigned* MISC = (volatile LAS unsigned*)(F.lds + MISC_OFF);
    for (int u = F.tid; u < (LDS_BYTES - RING_BYTES) / 4; u += 512) ((LAS unsigned*)(F.lds + RING_BYTES))[u] = 0u;
    __syncthreads();
    const int lo = args.ph_lo, hi = args.ph_hi;
    XcdBarrier bar; bar.bar = F.ctl + CW_BAR; bar.x = 0; bar.st = nullptr; bar.wave = F.wave;
    if (hi - lo > 1) bar = xcd_barrier_post(F.ctl + CW_BAR, MISC + 8, F.wave);
#ifndef PHMASK
#define PHMASK 0xFFFFFFFFu
#endif
#define KD(j) (((PHMASK) >> (j)) & 1u)
#define IN(k) (lo <= (k) && (k) < hi)
#define SEAM(k) do { if (IN((k) + 1)) xcd_barrier(bar); } while (0)
    unsigned char* ws = args.ws;
    u64* ssq_all = (u64*)(F.ctl + CW_SSQ);
    LAS unsigned char* lds = F.lds;

    if (KD(0) && IN(0)) { phase_prologue(F); SEAM(0); }

    auto run_layer = [&](auto LC) __attribute__((always_inline)) {
        constexpr int l = decltype(LC)::value;
        const int pb = 1 + l * PH_PER_LAYER;
        const u64* ssq_mix = ssq_all + (2 * l) * 8192; u64* ssq_ffn = ssq_all + (2 * l + 1) * 8192;
        bf16* XH = (bf16*)(ws + WS_XH);
        const float* xin = l == 0 ? args.in[0] : args.out; float* xmid = (float*)(ws + WS_XA); float* xout = args.out;
        if (KD(1) && IN(pb + 0)) {
            const int nNP = (l ? NP1 : NP0) / 256;
            { pg8::Gemm g{XH, (const bf16*)(ws + (l ? WS_WPT1 : WS_WPT0)), D, D, D, 0, 0}; pg8::GridOrder S; S.init(M / 256, nNP, 1, F.G, F.bid);
              EpiP E{(bf16*)(ws + WS_P), (bf16*)(ws + WS_G4), ssq_mix, nNP}; pg8::gemm_phase<EpiP, pg8::GridOrder>(lds, g, S, E, F.wave); }
            if (l == 0 && F.G >= 16 && F.bid >= F.G - 16) { pg8::Gemm g{(const bf16*)(ws + WS_MEMN), (const bf16*)(ws + WS_WKVT0), D, D, D, 0, 0}; pg8::GridOrder S; S.init(2, 8, 1, 16, F.bid - (F.G - 16));
              EpiF32 E{(float*)(ws + WS_KVRAW), 2048}; pg8::gemm_phase<EpiF32, pg8::GridOrder>(lds, g, S, E, F.wave); }
            SEAM(pb + 0);
        }
        if (KD(2) && IN(pb + 1)) { phase_prep(F, l); SEAM(pb + 1); }
        if (KD(3) && IN(pb + 2)) {
            if (KD(17)) { pg8::Gemm g{(const bf16*)(ws + WS_ALORA), (const bf16*)(ws + (l ? WS_WLT1 : WS_WLT0)), 512, 512, 512, 0, 0}; pg8::GridOrder S; S.init(M / 256, 8, 1, F.G, F.bid);
              EpiLora E{(float*)(ws + WS_LO), args.in[7] + l * 512, args.in[9] + l * 512, args.in[19], l}; pg8::gemm_phase<EpiLora, pg8::GridOrder>(lds, g, S, E, F.wave); }
            if (KD(18) && F.bid < 32) { const int kp = F.bid >> 3;
              pg8::Gemm g{(const bf16*)(ws + WS_ACMP) + kp * 512, (const bf16*)(ws + (l ? WS_WC1T1 : WS_WC1T0)) + kp * 512, 2048, 2048, 512, (size_t)1024 * 2048 * 2, (size_t)256 * 2048 * 2}; pg8::GridOrder S; S.init(4, 1, 2, 8, F.bid & 7);
              EpiHP E{(float*)(ws + WS_HP) + (size_t)kp * 2 * 1024 * 128}; pg8::gemm_phase<EpiHP, pg8::GridOrder>(lds, g, S, E, F.wave); }
            __syncthreads();
            if (KD(19)) phase_memattn(F);
            SEAM(pb + 2);
        }
        if (KD(4) && IN(pb + 3)) {
            if (F.bid < 8) { const CmpFin CF{(const float*)(ws + WS_HP), args.in[24] + l * 256, (const bf16*)(ws + WS_WC2T) + (size_t)l * 2 * 64 * 128, args.in[21] + l * 256 + 64, (bf16*)(ws + WS_KC), (bf16*)(ws + WS_VCT)};
                cmp_finalize(CF, F.bid >> 2, F.bid & 3, lds, F.wave, F.lane); }
            phase_scan(F, l); SEAM(pb + 3); }
        if (KD(5) && IN(pb + 4)) { phase_carry(F); phase_nsa(F, F.ctl + CW_QCTR + 64 * l); SEAM(pb + 4); }
        if (KD(6) && IN(pb + 5)) { phase_rwkv_fin(F, l); SEAM(pb + 5); }
        if (KD(7) && IN(pb + 6)) {
            pg8::Gemm g{(const bf16*)(ws + WS_Y), (const bf16*)(ws + (l ? WS_WBT1 : WS_WBT0)), 2560, 512, 512, (size_t)512 * 2, (size_t)2048 * 512 * 2}; pg8::GridOrder S; S.init(M / 256, 8, 5, F.G, F.bid);
            EpiZ E{(bf16*)(ws + WS_ZB)}; pg8::gemm_phase<EpiZ, pg8::GridOrder>(lds, g, S, E, F.wave);
            { pg8::Gemm g4{(const bf16*)(ws + WS_XH8), (const bf16*)(ws + (l ? WS_WG4T1 : WS_WG4T0)), D / 2, D / 2, D / 2, 0, 0}; pg8::GridOrder S4; S4.init(M / 256, 8, 1, F.G, F.bid);
              EpiGate4 E4{(bf16*)(ws + WS_G4), ssq_mix}; pg8::gemm_phase<EpiGate4, pg8::GridOrder, true, true>(lds, g4, S4, E4, F.wave); }
            SEAM(pb + 6);
        }
        if (KD(8) && IN(pb + 7)) {
            constexpr int KD2 = F8_G ? D / 2 : D; pg8::Gemm g{F8_G ? (const bf16*)(ws + WS_XH8) : (const bf16*)XH, (const bf16*)(ws + (l ? WS_WGT1 : WS_WGT0)), KD2, KD2, KD2, 0, 0}; pg8::GridOrder S; S.init(M / 256, 32, 1, F.G, F.bid);
            EpiG E{(const bf16*)(ws + WS_ZB), (const bf16*)(ws + WS_G4), (bf16*)(ws + WS_MG), ssq_mix, F8_G ? W8SI : 1.f}; pg8::gemm_phase<EpiG, pg8::GridOrder, true, F8_G != 0>(lds, g, S, E, F.wave);
            SEAM(pb + 7);
        }
        if (KD(9) && IN(pb + 8)) {
            pg8::Gemm g{(const bf16*)(ws + WS_MG), (const bf16*)(ws + (l ? WS_WOT1 : WS_WOT0)), D, D, D, 0, 0}; pg8::GridOrder S; S.init(M / 256, 8, 1, F.G, F.bid);
            EpiRes E{xin, xmid, XH, ssq_ffn, ws + WS_XH8}; pg8::gemm_phase<EpiRes, pg8::GridOrder>(lds, g, S, E, F.wave);
            SEAM(pb + 8);
        }
        if (l == 0) {
            if (KD(10) && IN(pb + 9)) {
                constexpr int KD2 = F8_F1 ? D / 2 : D; pg8::Gemm g{F8_F1 ? (const bf16*)(ws + WS_XH8) : (const bf16*)XH, (const bf16*)(ws + WS_W13T), KD2, KD2, KD2, 0, 0}; pg8::GridOrder S; S.init(M / 256, 2 * FF / 256, 1, F.G, F.bid);
                EpiSwiglu<false> E{(bf16*)(ws + WS_ACT), FF, ssq_ffn, nullptr, F8_F1 ? W8SI : 1.f, 1.f}; pg8::gemm_phase<EpiSwiglu<false>, pg8::GridOrder, true, F8_F1 != 0>(lds, g, S, E, F.wave);
                SEAM(pb + 9);
            }
            if (KD(11) && IN(pb + 10)) {
                pg8::Gemm g{(const bf16*)(ws + WS_ACT), (const bf16*)(ws + WS_W2T), FF, FF, FF, 0, 0}; pg8::GridOrder S; S.init(M / 256, 8, 1, F.G, F.bid);
                EpiRes E{xmid, xout, XH, ssq_all + 2 * 8192, ws + WS_XH8}; pg8::gemm_phase<EpiRes, pg8::GridOrder>(lds, g, S, E, F.wave);
                SEAM(pb + 13);
            }
        } else {
            float* RSS = (float*)(ws + WS_RSS);
            if (KD(12) && IN(pb + 9)) { phase_route(F, xmid); SEAM(pb + 9); }
            if (KD(13) && IN(pb + 10)) { phase_gather(F, RSS); SEAM(pb + 10); }
            if (KD(14) && IN(pb + 11)) {
                pg8::MoeOrder S; moe_tiles(F, S.ts); S.nN = 2 * EFF / 256; S.G = F.G; S.c = F.bid;
                constexpr int KD2 = F8_M1 ? D / 2 : D; pg8::Gemm g{(const bf16*)(ws + WS_XG), (const bf16*)(ws + WS_MW13T), KD2, KD2, KD2, 0, (size_t)2 * EFF * 2048 * (F8_M1 ? 1 : 2)};
                EpiSwiglu<F8_M2 != 0> E{(bf16*)(ws + WS_ACTM), EFF, nullptr, RSS, F8_M1 ? W8SI : 1.f, 8.f}; pg8::gemm_phase<EpiSwiglu<F8_M2 != 0>, pg8::MoeOrder, true, F8_M1 != 0>(lds, g, S, E, F.wave);
                SEAM(pb + 11);
            }
            if (KD(15) && IN(pb + 12)) {
                pg8::MoeOrder S; moe_tiles(F, S.ts); S.nN = 8; S.G = F.G; S.c = F.bid;
                constexpr int KE2 = F8_M2 ? EFF / 2 : EFF; pg8::Gemm g{(const bf16*)(ws + WS_ACTM), (const bf16*)(ws + WS_MW2T), KE2, KE2, KE2, 0, (size_t)2048 * EFF * (F8_M2 ? 1 : 2)};
                EpiBf E{(bf16*)(ws + WS_YS), D, F8_M2 ? W8SI / 8.f : 1.f}; pg8::gemm_phase<EpiBf, pg8::MoeOrder, true, F8_M2 != 0>(lds, g, S, E, F.wave);
                SEAM(pb + 12);
            }
            if (KD(16) && IN(pb + 13)) { phase_combine(F, xmid, xout); }
        }
    };
    run_layer(std::integral_constant<int, 0>{});
    run_layer(std::integral_constant<int, 1>{});
#undef IN
#undef SEAM
}

#ifdef DBG_STOP
__global__ void dbg_dump(const unsigned char* buf, size_t nelem, int is_bf16, float* out, int nout) {
    for (int i = blockIdx.x * blockDim.x + threadIdx.x; i < nout; i += gridDim.x * blockDim.x) { float s = 0.f;
        for (size_t j = (size_t)i; j < nelem; j += (size_t)nout) s += is_bf16 ? bf2f(((const bf16*)buf)[j]) : ((const float*)buf)[j];
        out[i] = s; }
}
__global__ void dbg_cols(const bf16* buf, int ld, int c0, int w, float* out) {
    for (int i = blockIdx.x * blockDim.x + threadIdx.x; i < M * D; i += gridDim.x * blockDim.x) { const int row = i >> 11, c = i & 2047; out[i] = bf2f(buf[(size_t)row * ld + c0 + (c % w)]); }
}
#endif
extern "C" void kernel_launch(void* const* d_in, const int* in_sizes, int n_in, void* d_out, int out_size, void* d_ws, size_t ws_size, hipStream_t stream) {
    static int grid = 0;
    if (grid == 0) {
        if (n_in != 40 || out_size != M * D || ws_size < WS_END) { fprintf(stderr, "kernel_launch: unexpected shapes (n_in %d out %d ws %zu need %zu)\n", n_in, out_size, ws_size, (size_t)WS_END); grid = -1; return; }
        int dev = 0, cus = 0, per_cu = 0;
        if (hipGetDevice(&dev) != hipSuccess || hipDeviceGetAttribute(&cus, hipDeviceAttributeMultiprocessorCount, dev) != hipSuccess) { grid = -1; return; }
        if (hipFuncSetAttribute((const void*)mega_fwd, hipFuncAttributeMaxDynamicSharedMemorySize, LDS_BYTES) != hipSuccess) { fprintf(stderr, "kernel_launch: hipFuncSetAttribute failed\n"); grid = -1; return; }
        if (hipOccupancyMaxActiveBlocksPerMultiprocessor(&per_cu, (const void*)mega_fwd, 512, LDS_BYTES) != hipSuccess || per_cu < 1) fprintf(stderr, "kernel_launch: occupancy query reports %d\n", per_cu);
        (void)hipGetLastError();
        grid = cus;
    }
    if (grid < 0) return;
    if (hipMemsetAsync((char*)d_ws + WS_CTL, 0, CTL_BYTES, stream) != hipSuccess) return;
    Args a{};
    for (int i = 0; i < 40; ++i) a.in[i] = (const float*)d_in[i];
    a.out = (float*)d_out; a.ws = (unsigned char*)d_ws;
#if MK_ONE_LAUNCH
    a.ph_lo = 0; a.ph_hi = N_PHASES;
    hipLaunchKernelGGL(mega_fwd, dim3(grid), dim3(512), LDS_BYTES, stream, a);
#else
    for (int p = 0; p < N_PHASES; ++p) {
        if (p >= 1 + 11 && p < 1 + PH_PER_LAYER) continue;
#ifdef DBG_STOP
        if (p > DBG_STOP) break;
#endif
        a.ph_lo = p; a.ph_hi = p + 1;
        hipLaunchKernelGGL(mega_fwd, dim3(grid), dim3(512), LDS_BYTES, stream, a);
    }
#ifdef DBG_STOP
#ifdef DBG_C0
    hipLaunchKernelGGL(dbg_cols, dim3(2048), dim3(256), 0, stream, (const bf16*)((const unsigned char*)d_ws + (size_t)(DBG_OFF)), (int)(DBG_LD), (int)(DBG_C0), (int)(DBG_W), (float*)d_out);
#else
    hipLaunchKernelGGL(dbg_dump, dim3(2048), dim3(256), 0, stream, (const unsigned char*)d_ws + (size_t)(DBG_OFF), (size_t)(DBG_NELEM), (int)(DBG_BF16), (float*)d_out, M * D);
#endif
#endif
#endif
}
```

```cpp
#include <hip/hip_runtime.h>
#include <cstdio>
#include <cstdint>
#include <type_traits>

#ifndef F8_G
#define F8_G 1
#endif
#ifndef F8_F1
#define F8_F1 0
#endif
#ifndef F8_M1
#define F8_M1 1
#endif
#ifndef F8_M2
#define F8_M2 1
#endif
#ifndef MK_ONE_LAUNCH
#define MK_ONE_LAUNCH 1
#endif

#define GAS __attribute__((address_space(1)))
#define LAS __attribute__((address_space(3)))
typedef unsigned short bf16;
typedef short bf16x8 __attribute__((ext_vector_type(8)));
typedef float f32x4 __attribute__((ext_vector_type(4)));
typedef float f32x2 __attribute__((ext_vector_type(2)));
typedef unsigned u32x4 __attribute__((ext_vector_type(4)));
typedef unsigned u32x2 __attribute__((ext_vector_type(2)));

constexpr int M = 8192, T = 4096, D = 2048;
constexpr int LDP = 6144;
constexpr int NP0 = 5888, NP1 = 6144;
constexpr int PC_R = 0, PC_K = 512, PC_V = 1024, PC_WD = 1536, PC_AD = 1632, PC_GD = 1728;
constexpr int PC_Q = 1984, PC_KC = 2496, PC_VC = 2624, PC_KS = 2752, PC_VS = 2880, PC_KW = 3008, PC_VW = 3136, PC_GL = 3264;
constexpr int PC_CB = 3288, PC_CC = 3800, PC_CX = 4312, PC_POOL = 4824, PC_MEM = 5336, PC_GATE = 5848, PC_VRES = 5848;
constexpr int NIN = 16088;
constexpr int FF = 5632, EFF = 2816, NE = 8;
constexpr float NORM_EPS = 1e-6f;
constexpr float CQ_NSA = 0.125f * 1.4426950408889634f, CQ_MEM = 0.08838834764831845f * 1.4426950408889634f;
constexpr int SLOTS = 18432;

constexpr size_t al4k(size_t x) { return (x + 4095) & ~(size_t)4095; }
constexpr size_t MiB = 1u << 20;
constexpr size_t WS_CTL = 0, CTL_BYTES = MiB;
constexpr size_t SZ_WPT0 = (size_t)NP0 * 2048 * 2, SZ_WPT1 = (size_t)NP1 * 2048 * 2;
constexpr size_t SZ_WGT = (size_t)8192 * 2048 * 2, SZ_WBT = (size_t)5 * 2048 * 512 * 2, SZ_WOT = (size_t)2048 * 2048 * 2, SZ_WLT = (size_t)2048 * 512 * 2;
constexpr size_t SZ_WKVT = (size_t)1024 * 2048 * 2, SZ_WC1T = (size_t)2 * 256 * 2048 * 2;
constexpr size_t WS_WPT0 = WS_CTL + CTL_BYTES;
constexpr size_t WS_WPT1 = WS_WPT0 + SZ_WPT0;
constexpr size_t WS_WGT0 = WS_WPT1 + SZ_WPT1, WS_WGT1 = WS_WGT0 + SZ_WGT;
constexpr size_t WS_WG4T0 = WS_WGT1 + SZ_WGT, WS_WG4T1 = WS_WG4T0 + (size_t)2048 * 2048;
constexpr size_t WS_WBT0 = WS_WG4T1 + (size_t)2048 * 2048, WS_WBT1 = WS_WBT0 + SZ_WBT;
constexpr size_t WS_WOT0 = WS_WBT1 + SZ_WBT, WS_WOT1 = WS_WOT0 + SZ_WOT;
constexpr size_t WS_WLT0 = WS_WOT1 + SZ_WOT, WS_WLT1 = WS_WLT0 + SZ_WLT;
constexpr size_t WS_WKVT0 = WS_WLT1 + SZ_WLT, WS_WKVT1 = WS_WKVT0 + SZ_WKVT;
constexpr size_t WS_WC1T0 = WS_WKVT1 + SZ_WKVT, WS_WC1T1 = WS_WC1T0 + SZ_WC1T;
constexpr size_t WS_WC2T = WS_WC1T1 + SZ_WC1T;
constexpr size_t WS_W13T = WS_WC2T + (size_t)65536;
constexpr size_t WS_W2T = WS_W13T + (size_t)2 * FF * 2048 * 2;
constexpr size_t WS_MW13T = WS_W2T + (size_t)2048 * FF * 2;
constexpr size_t WS_MW2T = WS_MW13T + (size_t)NE * 2 * EFF * 2048 * 2;
constexpr size_t WS_XA = WS_MW2T + (size_t)NE * 2048 * EFF * 2;
constexpr size_t WS_XH = WS_XA + (size_t)M * D * 4;
constexpr size_t WS_MEMN = WS_XH + (size_t)M * D * 2;
constexpr size_t WS_G4 = WS_MEMN + (size_t)512 * 2048 * 2;
constexpr size_t WS_Y = WS_G4 + (size_t)M * D * 2;
constexpr size_t WS_VFIRST = WS_Y + (size_t)M * 2560 * 2;
constexpr size_t WS_KVRAW = WS_VFIRST + (size_t)M * 512 * 4;
constexpr size_t WS_XH8 = WS_KVRAW + (size_t)512 * 2048 * 4;
constexpr size_t WS_OV = WS_XH8 + (size_t)M * D;
constexpr size_t WS_P = WS_OV;
constexpr size_t WS_ALORA = WS_P + (size_t)M * LDP * 2;
constexpr size_t WS_LO = WS_ALORA + (size_t)M * 512 * 2;
constexpr size_t WS_YL = WS_LO + (size_t)M * 2048 * 4;
constexpr size_t WS_ZL = WS_YL + (size_t)M * 512 * 4;
constexpr size_t WS_QF = WS_ZL + (size_t)M * 512 * 4;
constexpr size_t WS_PF = WS_QF + (size_t)2048 * 4096 * 4;
constexpr size_t WS_SINIT = WS_PF + (size_t)2048 * 4096 * 4;
constexpr size_t WS_VCUR = WS_SINIT + (size_t)2048 * 4096 * 4;
constexpr size_t WS_BON = WS_VCUR + (size_t)M * 512 * 4;
constexpr size_t WS_QN = WS_BON + (size_t)M * 8 * 4;
constexpr size_t WS_KS = WS_QN + (size_t)M * 512 * 2;
constexpr size_t WS_KW = WS_KS + (size_t)M * 128 * 2;
constexpr size_t WS_VST = WS_KW + (size_t)M * 128 * 2;
constexpr size_t WS_VWT = WS_VST + (size_t)M * 128 * 2;
constexpr size_t WS_ACMP = WS_VWT + (size_t)M * 128 * 2;
constexpr size_t WS_KC = WS_ACMP + (size_t)2 * 1024 * 2048 * 2;
constexpr size_t WS_VCT = WS_KC + (size_t)4 * 256 * 64 * 2;
constexpr size_t WS_QM = WS_VCT + (size_t)4 * 256 * 64 * 2;
constexpr size_t WS_KMEM = WS_QM + (size_t)M * 512 * 2;
constexpr size_t WS_VMEMT = WS_KMEM + (size_t)8 * 256 * 128 * 2;
constexpr size_t WS_HP = WS_VMEMT + (size_t)8 * 256 * 128 * 2;
constexpr size_t WS_MIX_END = WS_HP + (size_t)4 * 2 * 1024 * 128 * 4;
constexpr size_t WS_ZB = WS_OV;
constexpr size_t WS_MG = WS_ZB + (size_t)5 * M * D * 2;
constexpr size_t WS_ACT = WS_OV;
constexpr size_t WS_XG = WS_OV;
constexpr size_t WS_ACTM = WS_XG + (size_t)SLOTS * 2048 * 2;
constexpr size_t WS_YS = WS_ACTM + (size_t)SLOTS * EFF * 2;
constexpr size_t WS_RSS = WS_YS + (size_t)SLOTS * 2048 * 2;
constexpr size_t WS_MOE_END = WS_RSS + (size_t)SLOTS * 4;
constexpr size_t WS_END = WS_MIX_END > WS_MOE_END ? WS_MIX_END : WS_MOE_END;
static_assert(WS_END <= (size_t)1119977216, "workspace map exceeds the guaranteed d_ws size");
static_assert(WS_MG + (size_t)M * D * 2 <= WS_MIX_END, "Z view inside overlay");

constexpr int CW_BAR = 4096;
constexpr int CW_SSQ = 16384;
constexpr int CW_CNT = CW_SSQ + 4 * 8192 * 2;
constexpr int CW_QCTR = CW_CNT + 512;
constexpr int CW_ROUTE = CW_CNT + 1024;
static_assert((CW_ROUTE + 8 * 8192) * 4 <= (int)CTL_BYTES, "CTL map");

constexpr int RING_BYTES = 131072;
constexpr int MISC_OFF = RING_BYTES + 320;
constexpr int LDS_BYTES = 147456;

#define RLX_AGENT __ATOMIC_RELAXED, __HIP_MEMORY_SCOPE_AGENT
#define LDS_WAIT() asm volatile("s_waitcnt lgkmcnt(0)" ::: "memory")
#define VM_WAIT() asm volatile("s_waitcnt vmcnt(0)" ::: "memory")
__device__ __forceinline__ unsigned f2bf(float f) { unsigned u = __builtin_bit_cast(unsigned, f); return (u + 0x7fffu + ((u >> 16) & 1u)) >> 16; }
__device__ __forceinline__ float bf2f(unsigned b) { return __builtin_bit_cast(float, b << 16); }
typedef __bf16 bf16x2_t __attribute__((ext_vector_type(2)));
__device__ __forceinline__ unsigned pk2(float lo, float hi) { const bf16x2_t b = __builtin_convertvector((f32x2){lo, hi}, bf16x2_t); return __builtin_bit_cast(unsigned, b); }
__device__ __forceinline__ unsigned pk4_fp8(float a, float b, float c, float d) { unsigned w = 0u; w = (unsigned)__builtin_amdgcn_cvt_pk_fp8_f32(a, b, (int)w, false); w = (unsigned)__builtin_amdgcn_cvt_pk_fp8_f32(c, d, (int)w, true); return w; }
constexpr float W8S = 64.0f, W8SI = 1.0f / 64.0f;
__device__ __forceinline__ float sigmoidf_(float x) { return __builtin_amdgcn_rcpf(1.f + __builtin_amdgcn_exp2f(x * -1.4426950408889634f)); }
#define DPPF(v, ctrl) __builtin_bit_cast(float, __builtin_amdgcn_update_dpp(0, __builtin_bit_cast(int, (v)), (ctrl), 0xf, 0xf, true))
__device__ __forceinline__ float red16_max(float v) { v = fmaxf(v, DPPF(v, 0xB1)); v = fmaxf(v, DPPF(v, 0x4E)); v = fmaxf(v, DPPF(v, 0x141)); v = fmaxf(v, DPPF(v, 0x140)); return v; }
__device__ __forceinline__ float red16_sum(float v) { v += DPPF(v, 0xB1); v += DPPF(v, 0x4E); v += DPPF(v, 0x141); v += DPPF(v, 0x140); return v; }
__device__ __forceinline__ float wave_sum(float v) {
#pragma unroll
    for (int o = 1; o < 64; o <<= 1) v += __shfl_xor(v, o);
    return v;
}

#define XB_TMO      128
#define XB_XCNT(j)  (256  + 64 * (j))
#define XB_XSUB(j)  (1280 + 64 * (j))
#define XB_XGEN(j)  (2304 + 64 * (j))
#define XB_TOP      3328
#define XB_TOPGEN   3392
#define XCD_BAR_WORDS 3456
#define XB_SPIN_CAP (1u << 18)
__device__ __forceinline__ unsigned xb_ld(unsigned* p)              { return __hip_atomic_load(p, __ATOMIC_RELAXED, __HIP_MEMORY_SCOPE_AGENT); }
__device__ __forceinline__ unsigned xb_add(unsigned* p, unsigned v) { return __hip_atomic_fetch_add(p, v, __ATOMIC_RELAXED, __HIP_MEMORY_SCOPE_AGENT); }
__device__ __forceinline__ unsigned xb_xcc_id() { return (unsigned)__builtin_amdgcn_s_getreg((3 << 11) | 20) & 0xFu; }
#define XB_SPIN(cond, bar) do { unsigned _sp = 0; while (cond) { __builtin_amdgcn_s_sleep(1); \
    if ((++_sp & 255u) == 0u) { if (xb_ld(&(bar)[XB_TMO])) break; if (_sp > XB_SPIN_CAP) { atomicAdd(&(bar)[XB_TMO], 1u); break; } } } } while (0)
struct XcdBarrier { unsigned* bar; unsigned x; volatile LAS unsigned* st; int wave; };
__device__ __forceinline__ bool xb_t0(int wave) { return wave == 0 && __builtin_amdgcn_mbcnt_hi(~0u, __builtin_amdgcn_mbcnt_lo(~0u, 0u)) == 0u; }
__device__ __forceinline__ XcdBarrier xcd_barrier_post(unsigned* bar, volatile LAS unsigned* st, int wave) {
    XcdBarrier b; b.bar = bar; b.x = xb_xcc_id(); b.st = st; b.wave = wave;
    if (xb_t0(wave)) (void)xb_add(&bar[XB_XCNT(b.x)], 1u);
    return b;
}
__device__ __forceinline__ void xcd_barrier_complete(unsigned* bar, unsigned x, unsigned& nloc, unsigned& nx) {
    const unsigned G = gridDim.x * gridDim.y * gridDim.z;
    unsigned sum, cnt, mine, sp = 0u;
    for (;;) {
        sum = 0u; cnt = 0u; mine = 0u;
#pragma unroll
        for (unsigned j = 0; j < 16; ++j) { const unsigned c = xb_ld(&bar[XB_XCNT(j)]); sum += c; cnt += (c > 0u) ? 1u : 0u; mine = (j == x) ? c : mine; }
        if (sum == G) break;
        __builtin_amdgcn_s_sleep(1);
        if ((++sp & 255u) == 0u) { if (xb_ld(&bar[XB_TMO])) break; if (sp > XB_SPIN_CAP) { atomicAdd(&bar[XB_TMO], 1u); break; } }
    }
    nloc = mine > 0u ? mine : 1u; nx = cnt > 0u ? cnt : 1u;
}
__device__ __forceinline__ void xcd_barrier(const XcdBarrier& b) {
    asm volatile("s_waitcnt vmcnt(0)" ::: "memory");
    __syncthreads();
    if (xb_t0(b.wave)) {
        unsigned* bar = b.bar;
        __builtin_amdgcn_s_waitcnt(0);
        unsigned nloc = b.st[0], nx = b.st[1];
        if (nloc == 0u) { xcd_barrier_complete(bar, b.x, nloc, nx); b.st[0] = nloc; b.st[1] = nx; }
        const unsigned old = xb_add(&bar[XB_XSUB(b.x)], 1u);
        const unsigned gen = old / nloc;
        if (old + 1u == (gen + 1u) * nloc) {
            __builtin_amdgcn_fence(__ATOMIC_RELEASE, "agent");
            asm volatile("s_waitcnt vmcnt(0)" ::: "memory");
            const unsigned og = xb_add(&bar[XB_TOP], 1u);
            const unsigned tg = og / nx;
            if (og + 1u == (tg + 1u) * nx) xb_add(&bar[XB_TOPGEN], 1u);
            else XB_SPIN(xb_ld(&bar[XB_TOPGEN]) == tg, bar);
            __builtin_amdgcn_fence(__ATOMIC_ACQUIRE, "agent");
            xb_add(&bar[XB_XGEN(b.x)], 1u);
            asm volatile("s_waitcnt vmcnt(0)" ::: "memory");
        } else {
            XB_SPIN(xb_ld(&bar[XB_XGEN(b.x)]) == gen, bar);
            __builtin_amdgcn_fence(__ATOMIC_ACQUIRE, "agent");
            asm volatile("s_waitcnt vmcnt(0)" ::: "memory");
        }
    }
    __syncthreads();
}

namespace pg8 {
typedef int v4i_t __attribute__((ext_vector_type(4)));
typedef int v8i_t __attribute__((ext_vector_type(8)));
constexpr int BM = 256, BK = 64, HALF = 128, HTB = HALF * BK * 2, STAGE_BYTES = 8 * HTB, NXCD = 8, WGM = 8;
__host__ __device__ __forceinline__ int lds_byte(int r, int c) { const int st = (r >> 4) * 2 + (c >> 5), rr = r & 15, cc = c & 31, ob = rr * 64 + cc * 2; return st * 1024 + (ob ^ (((ob >> 9) & 1) << 5)); }
__host__ __device__ __forceinline__ void stage_rc(int b, int& R, int& C) { const int st = b / 1024, sb = b % 1024, swz = sb ^ (((sb >> 9) & 1) << 5); R = (st >> 1) * 16 + swz / 64; C = (st & 1) * 32 + (swz % 64) / 2; }
__host__ __device__ __forceinline__ int perm32(int rho) { const int n = rho >> 4, i = rho & 15; return 8 * (i >> 2) + 4 * n + (i & 3); }
struct Unit { int pm, pn, z; };
struct Gemm { const bf16* A; const bf16* Bt; int lda, ldb, K; size_t az, bz; };

struct GridOrder {
    int nM, nN, nZ, G, c;
    __device__ void init(int nM_, int nN_, int nZ_, int G_, int c_) { nM = nM_; nN = nN_; nZ = nZ_; G = G_; c = c_; }
    __device__ bool next(int i, Unit& u) const {
        const long L = (long)i * G + c; const int nwg = nM * nN; if (L >= (long)nwg * nZ) return false;
        u.z = (int)(L / nwg); int wgid = (int)(L % nwg);
        { const int q = nwg / NXCD, r = nwg % NXCD, xcd = wgid % NXCD, off = wgid / NXCD; wgid = (xcd < r ? xcd * (q + 1) : r * (q + 1) + (xcd - r) * q) + off; }
        const int nig = WGM * nN, gid = wgid / nig, fm = gid * WGM, gsz = (nM - fm) < WGM ? (nM - fm) : WGM;
        u.pm = fm + ((wgid % nig) % gsz); u.pn = (wgid % nig) / gsz; return true;
    }
    __device__ __forceinline__ void a_ready(const Unit&) const {}
    __device__ __forceinline__ void done(const Unit&) const {}
};
struct PBOrder {
    GridOrder base; int nP, nX;
    __device__ bool next(int i, Unit& u) const {
        const long L = (long)i * base.G + base.c;
        if (L < nP) return base.next(i, u);
        const int e = (int)(L - nP); if (e >= nX) return false;
        u.z = 1; u.pm = e & 1; u.pn = e >> 1; return true; }
    __device__ __forceinline__ void a_ready(const Unit&) const {}
    __device__ __forceinline__ void done(const Unit&) const {}
};
struct MoeOrder {
    int ts[9]; int nN, G, c;
    __device__ bool next(int i, Unit& u) const {
        const long L = (long)i * G + c; const int rt = (int)(L / nN); if (rt >= ts[8]) return false;
        u.pn = (int)(L % nN); u.pm = rt; int e = 0;
#pragma unroll
        for (int j = 1; j < 8; ++j) e += (rt >= ts[j]) ? 1 : 0;
        u.z = e; return true;
    }
    __device__ __forceinline__ void a_ready(const Unit&) const {}
    __device__ __forceinline__ void done(const Unit&) const {}
};

template <class Epi, class Sched, bool ALIGN_EPI = true, bool F8 = false>
__device__ __forceinline__ void gemm_phase(LAS unsigned char* lds, const Gemm g, const Sched& S, const Epi& E, int wave0) {
    int lane_ = (int)__builtin_amdgcn_mbcnt_hi(~0u, __builtin_amdgcn_mbcnt_lo(~0u, 0u)); asm volatile("" : "+v"(lane_));
    const int wid = wave0, lane = lane_, tid = wid * 64 + lane, wr = wid >> 2, wc = wid & 3, fr = lane & 15, fq = lane >> 4;
    const int K = g.K, nt = K / BK;
    unsigned voffA[2], voffB[2];
#pragma unroll
    for (int i = 0; i < 2; ++i) { int R, C; stage_rc(tid * 16 + i * 8192, R, C); const int Rb = Epi::PERM ? ((R & ~31) + perm32(R & 31)) : R;
        voffA[i] = (unsigned)(R * g.lda + C) * 2u; voffB[i] = (unsigned)(Rb * g.ldb + C) * 2u; }
    const size_t kstep = (size_t)(BK * 2);
    const size_t hA = (size_t)HALF * g.lda * 2, hB = (size_t)HALF * g.ldb * 2;
    const unsigned ldsw = (unsigned)wid * 1024u;
    const int aoff = lds_byte(wr * 64 + fr, fq * 8), boff = lds_byte(wc * 32 + fr, fq * 8);
#define PG8_SA(b, h) (((b) * 2 + (h)) * HTB)
#define PG8_SB(b, h) ((4 + (b) * 2 + (h)) * HTB)
#define PG8_STAGE(bufoff, gbase, voff) do { _Pragma("unroll") for (int _i = 0; _i < 2; ++_i) \
        __builtin_amdgcn_global_load_lds((const unsigned*)((const char*)(gbase) + (voff)[_i]), (LAS unsigned*)(lds + (bufoff) + ldsw + _i * 8192), 16, 0, 0); } while (0)
#define PG8_LDA(dst, b, h) do { _Pragma("unroll") for (int m = 0; m < 4; ++m) _Pragma("unroll") for (int k = 0; k < 2; ++k) dst[m][k] = *(const LAS bf16x8*)(lds + PG8_SA(b, h) + aoff + m * 2048 + k * 1024); } while (0)
#define PG8_LDB(dst, b, h) do { _Pragma("unroll") for (int n = 0; n < 2; ++n) _Pragma("unroll") for (int k = 0; k < 2; ++k) dst[n][k] = *(const LAS bf16x8*)(lds + PG8_SB(b, h) + boff + n * 2048 + k * 1024); } while (0)
#define PG8_MMA(ai, bj, At, Bt) do { __builtin_amdgcn_s_setprio(1); \
        if constexpr (F8) { _Pragma("unroll") for (int m = 0; m < 4; ++m) _Pragma("unroll") for (int n = 0; n < 2; ++n) { \
            const v4i_t b0 = __builtin_bit_cast(v4i_t, Bt[n][0]), b1 = __builtin_bit_cast(v4i_t, Bt[n][1]), a0 = __builtin_bit_cast(v4i_t, At[m][0]), a1 = __builtin_bit_cast(v4i_t, At[m][1]); \
            const v8i_t b8 = __builtin_shufflevector(b0, b1, 0, 1, 2, 3, 4, 5, 6, 7), a8 = __builtin_shufflevector(a0, a1, 0, 1, 2, 3, 4, 5, 6, 7); \
            asm volatile("v_mfma_f32_16x16x128_f8f6f4 %0, %1, %2, %0" : "+v"(acc[ai][bj][m][n]) : "v"(b8), "v"(a8)); } }     \
        else { _Pragma("unroll") for (int m = 0; m < 4; ++m) _Pragma("unroll") for (int n = 0; n < 2; ++n) _Pragma("unroll") for (int k = 0; k < 2; ++k) \
            acc[ai][bj][m][n] = __builtin_amdgcn_mfma_f32_16x16x32_bf16(Bt[n][k], At[m][k], acc[ai][bj][m][n], 0, 0, 0); } \
        __builtin_amdgcn_s_setprio(0); } while (0)
#define PG8_WAIT_V(n) asm volatile("s_waitcnt vmcnt(" #n ")" ::: "memory")
#define PG8_WAIT_L(n) asm volatile("s_waitcnt lgkmcnt(" #n ")" ::: "memory")
#define PG8_BAR __builtin_amdgcn_s_barrier()
#define PG8_SCHED __builtin_amdgcn_sched_barrier(0)
    Unit cur, nxt; int ui = 0;
    if (!S.next(0, cur)) return;
    f32x4 acc[2][2][4][2];
#pragma unroll
    for (int a = 0; a < 2; ++a)
#pragma unroll
        for (int b = 0; b < 2; ++b)
#pragma unroll
            for (int m = 0; m < 4; ++m)
#pragma unroll
                for (int n = 0; n < 2; ++n) acc[a][b][m][n] = (f32x4){0.f, 0.f, 0.f, 0.f};
    bf16x8 At[4][2], B0[2][2], B1[2][2];
    const char* cA = (const char*)g.A + (size_t)cur.z * g.az + (size_t)cur.pm * 2 * hA; const char* cB = (const char*)g.Bt + (size_t)cur.z * g.bz + (size_t)cur.pn * 2 * hB;
    S.a_ready(cur);
    PG8_STAGE(PG8_SB(0, 0), cB, voffB); PG8_STAGE(PG8_SB(0, 1), cB + hB, voffB); PG8_STAGE(PG8_SA(0, 0), cA, voffA); PG8_STAGE(PG8_SA(0, 1), cA + hA, voffA);
    if (wr == 1) PG8_BAR;
    PG8_WAIT_V(2); PG8_BAR;
    PG8_STAGE(PG8_SB(1, 0), cB + kstep, voffB); PG8_STAGE(PG8_SA(1, 0), cA + kstep, voffA); PG8_STAGE(PG8_SB(1, 1), cB + hB + kstep, voffB);
    PG8_WAIT_V(6); PG8_BAR;
    for (;;) {
        const bool has_next = S.next(ui + 1, nxt);
        const char* nA = has_next ? (const char*)g.A + (size_t)nxt.z * g.az + (size_t)nxt.pm * 2 * hA : cA; const char* nB = has_next ? (const char*)g.Bt + (size_t)nxt.z * g.bz + (size_t)nxt.pn * 2 * hB : cB;
        for (int t = 0; t < nt; t += 2) {
            const bool last = (t == nt - 2);
            const char* a1 = cA + (size_t)(t + 1) * kstep;
            const char* a2 = last ? nA : cA + (size_t)(t + 2) * kstep; const char* b2 = last ? nB : cB + (size_t)(t + 2) * kstep;
            const char* a3 = a2 + kstep; const char* b3 = b2 + kstep;
            if (last && has_next) S.a_ready(nxt);
            PG8_LDB(B0, 0, 0); PG8_LDB(B1, 0, 1); PG8_SCHED; PG8_LDA(At, 0, 0); PG8_STAGE(PG8_SA(1, 1), a1 + hA, voffA);
            PG8_WAIT_V(8); PG8_WAIT_L(0); PG8_BAR; PG8_MMA(0, 0, At, B0); PG8_MMA(0, 1, At, B1); PG8_BAR; PG8_SCHED;
            PG8_LDA(At, 0, 1); PG8_STAGE(PG8_SB(0, 0), b2, voffB); PG8_STAGE(PG8_SB(0, 1), b2 + hB, voffB); PG8_STAGE(PG8_SA(0, 0), a2, voffA);
            PG8_WAIT_V(8); PG8_WAIT_L(0); PG8_BAR; PG8_MMA(1, 0, At, B0); PG8_MMA(1, 1, At, B1); PG8_BAR; PG8_SCHED;
            PG8_LDB(B0, 1, 0); PG8_LDB(B1, 1, 1); PG8_SCHED; PG8_LDA(At, 1, 0); PG8_STAGE(PG8_SA(0, 1), a2 + hA, voffA);
            PG8_WAIT_V(8); PG8_WAIT_L(0); PG8_BAR; PG8_MMA(0, 0, At, B0); PG8_MMA(0, 1, At, B1); PG8_BAR; PG8_SCHED;
            PG8_LDA(At, 1, 1); PG8_STAGE(PG8_SB(1, 0), b3, voffB); PG8_STAGE(PG8_SB(1, 1), b3 + hB, voffB); PG8_STAGE(PG8_SA(1, 0), a3, voffA);
            PG8_WAIT_V(8); PG8_WAIT_L(0); PG8_BAR; PG8_MMA(1, 0, At, B0); PG8_MMA(1, 1, At, B1); PG8_BAR; PG8_SCHED;
        }
        if constexpr (ALIGN_EPI) { if (wr == 0) PG8_BAR; }
        if constexpr (F8) asm volatile("s_nop 15\n\ts_nop 15\n\ts_nop 15\n\ts_nop 15" ::: "memory");
        if constexpr (!Epi::AFTER_DRAIN) { E(acc, cur, wr, wc, fr, fq); S.done(cur); }
        if (!has_next) break;
#pragma unroll
        for (int a = 0; a < 2; ++a)
#pragma unroll
            for (int b = 0; b < 2; ++b)
#pragma unroll
                for (int m = 0; m < 4; ++m)
#pragma unroll
                    for (int n = 0; n < 2; ++n) acc[a][b][m][n] = (f32x4){0.f, 0.f, 0.f, 0.f};
        cur = nxt; cA = nA; cB = nB; ++ui;
        if constexpr (ALIGN_EPI) { if (wr == 1) PG8_BAR; }
    }
    PG8_WAIT_V(0);
    if constexpr (!ALIGN_EPI) { if (wr == 0) PG8_BAR; }
    PG8_BAR;
    if constexpr (Epi::AFTER_DRAIN) { E.fused(acc, cur, wr, wc, fr, fq, lds, wid, lane); S.done(cur); }
#undef PG8_SA
#undef PG8_SB
#undef PG8_STAGE
#undef PG8_LDA
#undef PG8_LDB
#undef PG8_MMA
#undef PG8_WAIT_V
#undef PG8_WAIT_L
#undef PG8_BAR
#undef PG8_SCHED
}
}
using pg8::Unit; using pg8::HALF; using pg8::BM;
typedef const f32x4 (&AccT)[2][2][4][2];

typedef unsigned long long u64;
__device__ __forceinline__ float rstd_of(const u64* ssq, int row) { return 1.0f / sqrtf((float)ssq[row] * (1.0f / 4294967296.0f) * (1.0f / D) + NORM_EPS); }
__device__ __forceinline__ u64 ssq_fix(float s) { return (u64)(s * 4294967296.0f); }

struct EpiP {
    static constexpr bool PERM = true, AFTER_DRAIN = false;
    bf16* P; bf16* G4; const u64* ssq; int nNP;
    __device__ __forceinline__ void operator()(AccT acc, const Unit& u, int wr, int wc, int fr, int fq) const {
        const int row0 = u.pm * BM + wr * 64 + fr; const bool gate = u.pn >= nNP;
        bf16* base = gate ? G4 : P; const int ld = gate ? D : LDP; const int col0 = (gate ? (u.pn - nNP) : u.pn) * BM + wc * 32 + 8 * fq;
        float rs8[2][4];
#pragma unroll
        for (int ai = 0; ai < 2; ++ai)
#pragma unroll
            for (int m = 0; m < 4; ++m) rs8[ai][m] = rstd_of(ssq, row0 + ai * HALF + m * 16);
#pragma unroll
        for (int ai = 0; ai < 2; ++ai)
#pragma unroll
            for (int m = 0; m < 4; ++m) { const int row = row0 + ai * HALF + m * 16; const float rs = rs8[ai][m]; bf16* rowp = base + (size_t)row * ld + col0;
#pragma unroll
                for (int bj = 0; bj < 2; ++bj) { f32x4 v0 = acc[ai][bj][m][0] * rs, v1 = acc[ai][bj][m][1] * rs;
                    if (gate) {
#pragma unroll
                        for (int j = 0; j < 4; ++j) { v0[j] = sigmoidf_(v0[j]); v1[j] = sigmoidf_(v1[j]); } }
                    u32x4 w; w.x = pk2(v0[0], v0[1]); w.y = pk2(v0[2], v0[3]); w.z = pk2(v1[0], v1[1]); w.w = pk2(v1[2], v1[3]);
                    *(u32x4*)(rowp + bj * HALF) = w; } }
    }
};
struct EpiGate4 {
    static constexpr bool PERM = true, AFTER_DRAIN = false;
    bf16* G4; const u64* ssq;
    __device__ __forceinline__ void operator()(AccT acc, const Unit& u, int wr, int wc, int fr, int fq) const {
        const int row0 = u.pm * BM + wr * 64 + fr, col0 = u.pn * BM + wc * 32 + 8 * fq;
        float rs8[2][4];
#pragma unroll
        for (int ai = 0; ai < 2; ++ai)
#pragma unroll
            for (int m = 0; m < 4; ++m) rs8[ai][m] = rstd_of(ssq, row0 + ai * HALF + m * 16) * W8SI;
#pragma unroll
        for (int ai = 0; ai < 2; ++ai)
#pragma unroll
            for (int m = 0; m < 4; ++m) { const int row = row0 + ai * HALF + m * 16; const float rs = rs8[ai][m]; bf16* rowp = G4 + (size_t)row * D + col0;
#pragma unroll
                for (int bj = 0; bj < 2; ++bj) { f32x4 v0 = acc[ai][bj][m][0] * rs, v1 = acc[ai][bj][m][1] * rs;
#pragma unroll
                    for (int j = 0; j < 4; ++j) { v0[j] = sigmoidf_(v0[j]); v1[j] = sigmoidf_(v1[j]); }
                    u32x4 w; w.x = pk2(v0[0], v0[1]); w.y = pk2(v0[2], v0[3]); w.z = pk2(v1[0], v1[1]); w.w = pk2(v1[2], v1[3]);
                    *(u32x4*)(rowp + bj * HALF) = w; } }
    }
};
struct EpiF32 {
    static constexpr bool PERM = false, AFTER_DRAIN = false;
    float* C; int ldc;
    __device__ __forceinline__ void operator()(AccT acc, const Unit& u, int wr, int wc, int fr, int fq) const {
        const int row0 = u.pm * BM + wr * 64 + fr, col0 = u.pn * BM + wc * 32 + 4 * fq;
#pragma unroll
        for (int ai = 0; ai < 2; ++ai)
#pragma unroll
            for (int m = 0; m < 4; ++m) { float* rowp = C + (size_t)(row0 + ai * HALF + m * 16) * ldc + col0;
#pragma unroll
                for (int bj = 0; bj < 2; ++bj)
#pragma unroll
                    for (int n = 0; n < 2; ++n) *(f32x4*)(rowp + bj * HALF + n * 16) = acc[ai][bj][m][n]; }
    }
};
struct EpiLora {
    static constexpr bool PERM = false, AFTER_DRAIN = false;
    float* LO; const float* w0; const float* a0; const float* v0; int has_v;
    __device__ __forceinline__ void operator()(AccT acc, const Unit& u, int wr, int wc, int fr, int fq) const {
        const int row0 = u.pm * BM + wr * 64 + fr, col0 = u.pn * BM + wc * 32 + 4 * fq; const int blk = u.pn >> 1;
        f32x4 bias4[2][2];
#pragma unroll
        for (int bj = 0; bj < 2; ++bj)
#pragma unroll
            for (int n = 0; n < 2; ++n) { const int j = (col0 + bj * HALF + n * 16) & 511; f32x4 bb = (f32x4){0.f, 0.f, 0.f, 0.f};
                if (blk == 0) bb = *(const f32x4*)(w0 + j); else if (blk == 1) bb = *(const f32x4*)(a0 + j); else if (blk == 3 && has_v) bb = *(const f32x4*)(v0 + j);
                bias4[bj][n] = bb; }
#pragma unroll
        for (int bj = 0; bj < 2; ++bj)
#pragma unroll
            for (int n = 0; n < 2; ++n) { const int col = col0 + bj * HALF + n * 16; const f32x4 bias = bias4[bj][n];
#pragma unroll
                for (int ai = 0; ai < 2; ++ai)
#pragma unroll
                    for (int m = 0; m < 4; ++m) { f32x4 v = acc[ai][bj][m][n] + bias;
                        if (blk == 0) {
#pragma unroll
                            for (int e = 0; e < 4; ++e) { const float x = v[e]; const float sp = fmaxf(-x, 0.f) + log1pf(__expf(-fabsf(x)));
                                v[e] = __expf(-__expf(-sp - 0.5f)); } }
                        else if (blk != 2) {
#pragma unroll
                            for (int e = 0; e < 4; ++e) v[e] = sigmoidf_(v[e]); }
                        *(f32x4*)(LO + (size_t)(row0 + ai * HALF + m * 16) * 2048 + col) = v; } }
    }
};
struct EpiZ {
    static constexpr bool PERM = true, AFTER_DRAIN = false;
    bf16* ZB;
    __device__ __forceinline__ void operator()(AccT acc, const Unit& u, int wr, int wc, int fr, int fq) const {
        const int row0 = u.pm * BM + wr * 64 + fr, col0 = u.pn * BM + wc * 32 + 8 * fq; bf16* base = ZB + (size_t)u.z * M * D;
#pragma unroll
        for (int ai = 0; ai < 2; ++ai)
#pragma unroll
            for (int m = 0; m < 4; ++m) { bf16* rowp = base + (size_t)(row0 + ai * HALF + m * 16) * D + col0;
#pragma unroll
                for (int bj = 0; bj < 2; ++bj) { const f32x4 v0 = acc[ai][bj][m][0], v1 = acc[ai][bj][m][1];
                    u32x4 w; w.x = pk2(v0[0], v0[1]); w.y = pk2(v0[2], v0[3]); w.z = pk2(v1[0], v1[1]); w.w = pk2(v1[2], v1[3]);
                    *(u32x4*)(rowp + bj * HALF) = w; } }
    }
};
struct EpiG {
    static constexpr bool PERM = false, AFTER_DRAIN = false;
    const bf16* ZB; const bf16* G4; bf16* MG; const u64* ssq; float wsi;
    __device__ __forceinline__ void operator()(AccT acc, const Unit& u, int wr, int wc, int fr, int fq) const {
        const int row0 = u.pm * BM + wr * 64 + fr, c0 = u.pn * 64 + wc * 16 + 4 * fq;
#pragma unroll
        for (int ai = 0; ai < 2; ++ai) {
            float rs4[4]; u32x2 g4[4], z4[4], zz[4][4];
#pragma unroll
            for (int m = 0; m < 4; ++m) { const int row = row0 + ai * HALF + m * 16; const size_t off = (size_t)row * D + c0; rs4[m] = rstd_of(ssq, row) * wsi;
                g4[m] = *(const u32x2*)(G4 + off); z4[m] = *(const u32x2*)(ZB + (size_t)4 * M * D + off);
#pragma unroll
                for (int br = 0; br < 4; ++br) zz[m][br] = *(const u32x2*)(ZB + (size_t)br * M * D + off); }
#pragma unroll
            for (int m = 0; m < 4; ++m) { const int row = row0 + ai * HALF + m * 16; const float rs = rs4[m]; const size_t off = (size_t)row * D + c0;
                f32x4 s;
                s[0] = bf2f(g4[m].x & 0xffffu) * bf2f(z4[m].x & 0xffffu); s[1] = bf2f(g4[m].x >> 16) * bf2f(z4[m].x >> 16);
                s[2] = bf2f(g4[m].y & 0xffffu) * bf2f(z4[m].y & 0xffffu); s[3] = bf2f(g4[m].y >> 16) * bf2f(z4[m].y >> 16);
#pragma unroll
                for (int bj = 0; bj < 2; ++bj)
#pragma unroll
                    for (int n = 0; n < 2; ++n) { const int br = 2 * bj + n; const u32x2 z = zz[m][br]; const f32x4 a = acc[ai][bj][m][n] * rs;
                        s[0] += sigmoidf_(a[0]) * bf2f(z.x & 0xffffu); s[1] += sigmoidf_(a[1]) * bf2f(z.x >> 16);
                        s[2] += sigmoidf_(a[2]) * bf2f(z.y & 0xffffu); s[3] += sigmoidf_(a[3]) * bf2f(z.y >> 16); }
                u32x2 w; w.x = pk2(s[0], s[1]); w.y = pk2(s[2], s[3]); *(u32x2*)(MG + off) = w; } }
    }
};
struct EpiRes {
    static constexpr bool PERM = false, AFTER_DRAIN = false;
    const float* res; float* out; bf16* XH; u64* ssq; unsigned char* XH8;
    __device__ __forceinline__ void operator()(AccT acc, const Unit& u, int wr, int wc, int fr, int fq) const {
        const int row0 = u.pm * BM + wr * 64 + fr, col0 = u.pn * BM + wc * 32 + 4 * fq;
#pragma unroll
        for (int ai = 0; ai < 2; ++ai)
#pragma unroll
            for (int mp = 0; mp < 4; mp += 4) {
                f32x4 rv[4][2][2];
#pragma unroll
                for (int mm = 0; mm < 4; ++mm) { const size_t off = (size_t)(row0 + ai * HALF + (mp + mm) * 16) * D + col0;
#pragma unroll
                    for (int bj = 0; bj < 2; ++bj)
#pragma unroll
                        for (int n = 0; n < 2; ++n) rv[mm][bj][n] = *(const f32x4*)(res + off + bj * HALF + n * 16); }
#pragma unroll
                for (int mm = 0; mm < 4; ++mm) { const int m = mp + mm; const int row = row0 + ai * HALF + m * 16; const size_t off = (size_t)row * D + col0; float sq = 0.f;
#pragma unroll
                    for (int bj = 0; bj < 2; ++bj)
#pragma unroll
                        for (int n = 0; n < 2; ++n) { const size_t o = off + bj * HALF + n * 16; const f32x4 v = rv[mm][bj][n] + acc[ai][bj][m][n];
                            *(f32x4*)(out + o) = v; sq += (v[0] * v[0] + v[1] * v[1]) + (v[2] * v[2] + v[3] * v[3]);
                            u32x2 w; w.x = pk2(v[0], v[1]); w.y = pk2(v[2], v[3]); *(u32x2*)(XH + o) = w; *(unsigned*)(XH8 + o) = pk4_fp8(v[0], v[1], v[2], v[3]); }
                    sq += __shfl_xor(sq, 16); sq += __shfl_xor(sq, 32);
                    if (fq == 0) atomicAdd(ssq + row, ssq_fix(sq)); }
                asm volatile("" ::: "memory"); }
    }
};
template <bool OUT8> struct EpiSwiglu {
    static constexpr bool PERM = true, AFTER_DRAIN = false;
    bf16* ACT; int ldc; const u64* ssq; const float* rss; float wsi; float osc;
    __device__ __forceinline__ void operator()(AccT acc, const Unit& u, int wr, int wc, int fr, int fq) const {
        const int row0 = u.pm * BM + wr * 64 + fr, col0 = u.pn * HALF + wc * 32 + 8 * fq;
        float rs8[2][4];
#pragma unroll
        for (int ai = 0; ai < 2; ++ai)
#pragma unroll
            for (int m = 0; m < 4; ++m) { const int row = row0 + ai * HALF + m * 16; rs8[ai][m] = (rss ? rss[row] : rstd_of(ssq, row)) * wsi; }
#pragma unroll
        for (int ai = 0; ai < 2; ++ai)
#pragma unroll
            for (int m = 0; m < 4; ++m) { const int row = row0 + ai * HALF + m * 16; const float rs = rs8[ai][m];
                float o[8];
#pragma unroll
                for (int n = 0; n < 2; ++n)
#pragma unroll
                    for (int e = 0; e < 4; ++e) { const float a = acc[ai][0][m][n][e] * rs, b = acc[ai][1][m][n][e] * rs; o[4 * n + e] = a * sigmoidf_(a) * b; }
                if constexpr (OUT8) { u32x2 w; w.x = pk4_fp8(o[0] * osc, o[1] * osc, o[2] * osc, o[3] * osc); w.y = pk4_fp8(o[4] * osc, o[5] * osc, o[6] * osc, o[7] * osc);
                    *(u32x2*)((unsigned char*)ACT + (size_t)row * ldc + col0) = w; }
                else { u32x4 w; w.x = pk2(o[0], o[1]); w.y = pk2(o[2], o[3]); w.z = pk2(o[4], o[5]); w.w = pk2(o[6], o[7]);
                    *(u32x4*)(ACT + (size_t)row * ldc + col0) = w; } }
    }
};
struct EpiBf {
    static constexpr bool PERM = true, AFTER_DRAIN = false;
    bf16* O; int ldc; float sc;
    __device__ __forceinline__ void operator()(AccT acc, const Unit& u, int wr, int wc, int fr, int fq) const {
        const int row0 = u.pm * BM + wr * 64 + fr, col0 = u.pn * BM + wc * 32 + 8 * fq;
#pragma unroll
        for (int ai = 0; ai < 2; ++ai)
#pragma unroll
            for (int m = 0; m < 4; ++m) { bf16* rowp = O + (size_t)(row0 + ai * HALF + m * 16) * ldc + col0;
#pragma unroll
                for (int bj = 0; bj < 2; ++bj) { const f32x4 v0 = acc[ai][bj][m][0] * sc, v1 = acc[ai][bj][m][1] * sc;
                    u32x4 w; w.x = pk2(v0[0], v0[1]); w.y = pk2(v0[2], v0[3]); w.z = pk2(v1[0], v1[1]); w.w = pk2(v1[2], v1[3]);
                    *(u32x4*)(rowp + bj * HALF) = w; } }
    }
};
struct EpiHP {
    static constexpr bool PERM = false, AFTER_DRAIN = false;
    float* HP;
    __device__ __forceinline__ void operator()(AccT acc, const Unit& u, int wr, int wc, int fr, int fq) const {
        const int row0 = u.pm * BM + wr * 64 + fr, col0 = wc * 32 + 4 * fq; float* base = HP + (size_t)u.z * 1024 * 128;
#pragma unroll
        for (int ai = 0; ai < 2; ++ai)
#pragma unroll
            for (int m = 0; m < 4; ++m) { float* rowp = base + (size_t)(row0 + ai * HALF + m * 16) * 128 + col0;
#pragma unroll
                for (int n = 0; n < 2; ++n) *(f32x4*)(rowp + n * 16) = acc[ai][0][m][n]; }
    }
};
struct CmpFin { const float* HP; const float* b1; const bf16* w2t; const float* gain; bf16* KC; bf16* VCT; };
__device__ __forceinline__ void cmp_finalize(const CmpFin& C_, int z, int pm, LAS unsigned char* lds, int wid, int lane) {
        LAS bf16* H = (LAS bf16*)lds;
        { const int tid = wid * 64 + lane, r = tid >> 1, c0 = (tid & 1) * 64;
#pragma unroll
          for (int j = 0; j < 16; ++j) { const int c = c0 + 4 * j; f32x4 v = *(const f32x4*)(C_.b1 + z * 128 + c);
#pragma unroll
              for (int kp = 0; kp < 4; ++kp) v += *(const f32x4*)(C_.HP + ((size_t)(kp * 2 + z) * 1024 + pm * 256 + r) * 128 + c);
#pragma unroll
              for (int e = 0; e < 4; ++e) { const float x = v[e]; const float t = 0.7978845608f * (x + 0.044715f * x * x * x); const float th = 1.f - 2.f / (__expf(2.f * t) + 1.f); v[e] = 0.5f * x * (1.f + th); }
              u32x2 w; w.x = pk2(v[0], v[1]); w.y = pk2(v[2], v[3]); *(LAS u32x2*)(H + r * 136 + c) = w; } }
        LDS_WAIT(); __syncthreads();
        bf16x8 af[2][4], bfr[4][4];
#pragma unroll
        for (int mt = 0; mt < 2; ++mt)
#pragma unroll
            for (int ks = 0; ks < 4; ++ks) af[mt][ks] = *(const LAS bf16x8*)(H + (wid * 32 + mt * 16 + (lane & 15)) * 136 + ks * 32 + 8 * (lane >> 4));
#pragma unroll
        for (int n = 0; n < 4; ++n)
#pragma unroll
            for (int ks = 0; ks < 4; ++ks) bfr[n][ks] = *(const bf16x8*)(C_.w2t + (size_t)z * 64 * 128 + (16 * n + (lane & 15)) * 128 + ks * 32 + 8 * (lane >> 4));
        asm volatile("s_waitcnt vmcnt(0) lgkmcnt(0)" ::: "memory"); __builtin_amdgcn_sched_barrier(0);
        f32x4 C[2][4];
#pragma unroll
        for (int mt = 0; mt < 2; ++mt)
#pragma unroll
            for (int n = 0; n < 4; ++n) { C[mt][n] = (f32x4){0.f, 0.f, 0.f, 0.f};
#pragma unroll
                for (int ks = 0; ks < 4; ++ks) C[mt][n] = __builtin_amdgcn_mfma_f32_16x16x32_bf16(af[mt][ks], bfr[n][ks], C[mt][n], 0, 0, 0); }
        __builtin_amdgcn_sched_barrier(0);
#pragma unroll
        for (int mt = 0; mt < 2; ++mt)
#pragma unroll
            for (int r = 0; r < 4; ++r) { const int grow = pm * 256 + wid * 32 + mt * 16 + 4 * (lane >> 4) + r;
                const int hh = grow & 1, bc = grow >> 1, b = bc >> 8, c = bc & 255;
                float ss = 0.f;
#pragma unroll
                for (int n = 0; n < 4; ++n) ss += C[mt][n][r] * C[mt][n][r];
                ss = red16_sum(ss);
                if (c < 255) {
                    if (z == 0) { const float rs = 1.0f / sqrtf(ss * (1.f / 64.f) + NORM_EPS); bf16* dst = C_.KC + ((size_t)(b * 2 + hh) * 256 + c) * 64;
#pragma unroll
                        for (int n = 0; n < 4; ++n) { const int d = 16 * n + (lane & 15); dst[d] = (bf16)f2bf(C[mt][n][r] * rs * C_.gain[d]); } }
                    else { bf16* dst = C_.VCT + (size_t)(b * 2 + hh) * 64 * 256 + c;
#pragma unroll
                        for (int n = 0; n < 4; ++n) { const int d = 16 * n + (lane & 15); dst[(size_t)d * 256] = (bf16)f2bf(C[mt][n][r]); } } } }
        __syncthreads();
}

struct Frame {
    LAS unsigned char* lds; int tid, lane, wave, G, bid;
    const float* const* in; unsigned char* ws; unsigned* ctl;
};
__device__ __forceinline__ Frame relaunder(const Frame& F0) { Frame F = F0; int ln = (int)__builtin_amdgcn_mbcnt_hi(~0u, __builtin_amdgcn_mbcnt_lo(~0u, 0u)); asm volatile("" : "+v"(ln)); F.lane = ln; F.wave = F0.wave; F.tid = F0.wave * 64 + ln; return F; }
#define INP(k) (F.in[k])
__device__ __forceinline__ float ldbf(const bf16* p) { return bf2f(*p); }
__device__ __forceinline__ void ld8(const bf16* p, float (&v)[8]) { const u32x4 r = *(const u32x4*)p;
    v[0] = bf2f(r.x & 0xffffu); v[1] = bf2f(r.x >> 16); v[2] = bf2f(r.y & 0xffffu); v[3] = bf2f(r.y >> 16); v[4] = bf2f(r.z & 0xffffu); v[5] = bf2f(r.z >> 16); v[6] = bf2f(r.w & 0xffffu); v[7] = bf2f(r.w >> 16); }
__device__ __forceinline__ void st8(bf16* p, const float (&v)[8]) { u32x4 w; w.x = pk2(v[0], v[1]); w.y = pk2(v[2], v[3]); w.z = pk2(v[4], v[5]); w.w = pk2(v[6], v[7]); *(u32x4*)p = w; }
__device__ __forceinline__ void ldf8(const float* p, float (&v)[8]) { const f32x4 a = *(const f32x4*)p, b = *(const f32x4*)(p + 4); v[0] = a[0]; v[1] = a[1]; v[2] = a[2]; v[3] = a[3]; v[4] = b[0]; v[5] = b[1]; v[6] = b[2]; v[7] = b[3]; }

template <class Fsrc, bool F8 = false>
__device__ __forceinline__ void tr_matrix(const Frame& F, Fsrc f, int nrows, int K, bf16* dst) {
    LAS float* scr = (LAS float*)(F.lds + F.wave * 16384);
    const int gw = F.bid * 8 + F.wave, NGW = F.G * 8, lane = F.lane;
    const int nblk = nrows / 32, nitems = (K / 64) * nblk;
    const int kq = lane >> 3, n4 = (lane & 7) * 4;
    for (int it = gw; it < nitems; it += NGW) {
        const int kb = it / nblk, nb = it % nblk, k0 = 64 * kb, n0 = 32 * nb;
        f32x4 v[8];
#pragma unroll
        for (int i = 0; i < 8; ++i) v[i] = f(n0 + n4, k0 + 8 * i + kq);
#pragma unroll
        for (int i = 0; i < 8; ++i) { LAS float* d = scr + (8 * i + kq) * 33 + n4; d[0] = v[i][0]; d[1] = v[i][1]; d[2] = v[i][2]; d[3] = v[i][3]; }
        LDS_WAIT(); asm volatile("" ::: "memory");
        const int c = lane & 7;
#pragma unroll
        for (int j = 0; j < 4; ++j) { const int n = (lane >> 3) + 8 * j; const LAS float* sp = scr + (8 * c) * 33 + n;
            if constexpr (F8) { u32x2 o; o.x = pk4_fp8(sp[0 * 33], sp[1 * 33], sp[2 * 33], sp[3 * 33]); o.y = pk4_fp8(sp[4 * 33], sp[5 * 33], sp[6 * 33], sp[7 * 33]);
                *(u32x2*)((unsigned char*)dst + (size_t)(n0 + n) * K + k0 + 8 * c) = o; }
            else { u32x4 o; o.x = pk2(sp[0 * 33], sp[1 * 33]); o.y = pk2(sp[2 * 33], sp[3 * 33]); o.z = pk2(sp[4 * 33], sp[5 * 33]); o.w = pk2(sp[6 * 33], sp[7 * 33]);
                *(u32x4*)(dst + (size_t)(n0 + n) * K + k0 + 8 * c) = o; } }
        LDS_WAIT(); asm volatile("" ::: "memory");
    }
}
#define F4Z ((f32x4){0.f, 0.f, 0.f, 0.f})
struct SrcWP { const float* win; const float* vres; const float* gain; int l, NP;
    __device__ __forceinline__ f32x4 operator()(int n, int k) const {
        f32x4 v;
        if (n < 5848) v = *(const f32x4*)(win + (size_t)k * NIN + n);
        else if (n < NP) v = (l == 1 && n < 5912) ? *(const f32x4*)(vres + (size_t)k * 64 + (n - 5848)) : F4Z;
        else v = *(const f32x4*)(win + (size_t)k * NIN + PC_GATE + 4 * 2048 + (n - NP));
        return v * gain[k]; } };
struct SrcWG4 { const float* win; const float* gain;
    __device__ __forceinline__ f32x4 operator()(int n, int k) const { return *(const f32x4*)(win + (size_t)k * NIN + PC_GATE + 4 * 2048 + n) * (gain[k] * W8S); } };
struct SrcWG { const float* win; const float* gain; float sc;
    __device__ __forceinline__ f32x4 operator()(int n, int k) const {
        const int j = n >> 8, rho = n & 255, bj = rho >> 7, wc = (rho >> 5) & 3, nn = (rho >> 4) & 1, q = (rho >> 2) & 3;
        const int br = 2 * bj + nn, c = 64 * j + 16 * wc + 4 * q;
        return *(const f32x4*)(win + (size_t)k * NIN + PC_GATE + br * 2048 + c) * (gain[k] * sc); } };
struct SrcWB { const float* wb; const float* pw; const float* ps;
    __device__ __forceinline__ f32x4 operator()(int n, int k) const {
        if (n < 8192) { const int i = n >> 11, c = n & 2047; return *(const f32x4*)(wb + ((size_t)i * 512 + k) * 2048 + c); }
        const int c = n - 8192, g = c >> 9;
        if ((k >> 7) != g) return F4Z;
        return *(const f32x4*)(pw + ((size_t)g * 128 + (k & 127)) * 512 + (c & 511)) * *(const f32x4*)(ps + c); } };
struct SrcPlain { const float* w; int ldw;
    __device__ __forceinline__ f32x4 operator()(int n, int k) const { return *(const f32x4*)(w + (size_t)k * ldw + n); } };
struct SrcPlainS { const float* w; int ldw; float sc;
    __device__ __forceinline__ f32x4 operator()(int n, int k) const { return *(const f32x4*)(w + (size_t)k * ldw + n) * sc; } };
struct SrcPlainG { const float* w; int ldw; const float* gain;
    __device__ __forceinline__ f32x4 operator()(int n, int k) const { return *(const f32x4*)(w + (size_t)k * ldw + n) * gain[k]; } };
struct SrcLora { const float* w2; const float* a2; const float* g2; const float* vup; int l;
    __device__ __forceinline__ f32x4 operator()(int n, int k) const {
        const int blk = n >> 9, j = n & 511;
        if (blk == 0) return k < 96 ? *(const f32x4*)(w2 + (size_t)k * 512 + j) : F4Z;
        if (blk == 1) return (k >= 96 && k < 192) ? *(const f32x4*)(a2 + (size_t)(k - 96) * 512 + j) : F4Z;
        if (blk == 2) return (k >= 192 && k < 448) ? *(const f32x4*)(g2 + (size_t)(k - 192) * 512 + j) : F4Z;
        return (l == 1 && k >= 448) ? *(const f32x4*)(vup + (size_t)(k - 448) * 512 + j) : F4Z; } };
struct SrcC1 { const float* w1;
    __device__ __forceinline__ f32x4 operator()(int n, int k) const { const int i = n >> 8, c = n & 255; return c < 128 ? *(const f32x4*)(w1 + ((size_t)i * 2048 + k) * 128 + c) : F4Z; } };
struct SrcW13 { const float* w1; const float* w3; const float* gain; int ffw; float sc;
    __device__ __forceinline__ f32x4 operator()(int n, int k) const { const int t = n >> 8, which = (n >> 7) & 1, ff = 128 * t + (n & 127);
        const uintptr_t a = (uintptr_t)w1, dlt = (uintptr_t)w3 - a; const float* p = (const float*)(a + (which ? dlt : (uintptr_t)0));
        return *(const f32x4*)(p + (size_t)k * ffw + ff) * (gain[k] * sc); } };

__device__ __forceinline__ void phase_prologue(const Frame& F0) {
    const Frame F = relaunder(F0);
    unsigned char* ws = F.ws;
    for (int l = 0; l < 2; ++l) {
        const float* win = INP(5) + (size_t)l * D * NIN; const float* gmix = INP(2) + l * D;
        tr_matrix(F, SrcWP{win, INP(17), gmix, l, l ? NP1 : NP0}, (l ? NP1 : NP0), 2048, (bf16*)(ws + (l ? WS_WPT1 : WS_WPT0)));
        tr_matrix<SrcWG4, true>(F, SrcWG4{win, gmix}, 2048, 2048, (bf16*)(ws + (l ? WS_WG4T1 : WS_WG4T0)));
        tr_matrix<SrcWG, F8_G != 0>(F, SrcWG{win, gmix, F8_G ? W8S : 1.f}, 8192, 2048, (bf16*)(ws + (l ? WS_WGT1 : WS_WGT0)));
        tr_matrix(F, SrcWB{INP(31) + (size_t)l * 4 * 512 * 2048, INP(27) + (size_t)l * 4 * 128 * 512, INP(28) + l * D}, 10240, 512, (bf16*)(ws + (l ? WS_WBT1 : WS_WBT0)));
        tr_matrix(F, SrcPlain{INP(32) + (size_t)l * D * D, D}, 2048, 2048, (bf16*)(ws + (l ? WS_WOT1 : WS_WOT0)));
        tr_matrix(F, SrcLora{INP(8) + (size_t)l * 96 * 512, INP(10) + (size_t)l * 96 * 512, INP(11) + (size_t)l * 256 * 512, INP(20), l}, 2048, 512, (bf16*)(ws + (l ? WS_WLT1 : WS_WLT0)));
        tr_matrix(F, SrcPlainG{INP(29) + (size_t)l * D * 1024, 1024, INP(4) + l * D}, 1024, 2048, (bf16*)(ws + (l ? WS_WKVT1 : WS_WKVT0)));
        tr_matrix(F, SrcC1{INP(23) + (size_t)l * 2 * 2048 * 128}, 512, 2048, (bf16*)(ws + (l ? WS_WC1T1 : WS_WC1T0)));
        for (int i = 0; i < 2; ++i) tr_matrix(F, SrcPlain{INP(25) + (size_t)(l * 2 + i) * 128 * 64, 64}, 64, 128, (bf16*)(ws + WS_WC2T) + (size_t)(l * 2 + i) * 64 * 128);
    }
    tr_matrix<SrcW13, F8_F1 != 0>(F, SrcW13{INP(33), INP(34), INP(3), FF, F8_F1 ? W8S : 1.f}, 2 * FF, 2048, (bf16*)(ws + WS_W13T));
    tr_matrix(F, SrcPlain{INP(35), D}, 2048, FF, (bf16*)(ws + WS_W2T));
    for (int e = 0; e < NE; ++e) {
        tr_matrix<SrcW13, F8_M1 != 0>(F, SrcW13{INP(37) + (size_t)e * D * EFF, INP(38) + (size_t)e * D * EFF, INP(3) + D, EFF, F8_M1 ? W8S : 1.f}, 2 * EFF, 2048, (bf16*)(ws + WS_MW13T + (size_t)e * 2 * EFF * 2048 * (F8_M1 ? 1 : 2)));
        tr_matrix<SrcPlainS, F8_M2 != 0>(F, SrcPlainS{INP(39) + (size_t)e * EFF * D, D, F8_M2 ? W8S : 1.f}, 2048, EFF, (bf16*)(ws + WS_MW2T + (size_t)e * 2048 * EFF * (F8_M2 ? 1 : 2)));
    }
    const int gw = F.bid * 8 + F.wave, NGW = F.G * 8;
    u64* ssq = (u64*)(F.ctl + CW_SSQ);
    for (int base = F.bid * 16; base < M + 512; base += F.G * 16) for (int q = 0; q < 2; ++q) { const int m = base + F.wave * 2 + q;
        const bool ismem = m >= M; const float* src = ismem ? INP(1) + (size_t)(m - M) * D : INP(0) + (size_t)m * D;
        const f32x4* xr = (const f32x4*)src + F.lane; f32x4 v[8]; float s = 0.f;
#pragma unroll
        for (int j = 0; j < 8; ++j) { v[j] = xr[64 * j]; s += (v[j][0] * v[j][0] + v[j][1] * v[j][1]) + (v[j][2] * v[j][2] + v[j][3] * v[j][3]); }
        s = wave_sum(s);
        float sc = 1.f;
        if (ismem) sc = 1.0f / sqrtf(s * (1.f / D) + NORM_EPS); else if (F.lane == 0) ssq[m] = ssq_fix(s);
        bf16* dst = ismem ? (bf16*)(ws + WS_MEMN) + (size_t)(m - M) * D : (bf16*)(ws + WS_XH) + (size_t)m * D;
#pragma unroll
        for (int j = 0; j < 8; ++j) { u32x2 w; w.x = pk2(v[j][0] * sc, v[j][1] * sc); w.y = pk2(v[j][2] * sc, v[j][3] * sc); *((u32x2*)dst + F.lane + 64 * j) = w;
            if (!ismem) *((unsigned*)(ws + WS_XH8 + (size_t)m * D) + F.lane + 64 * j) = pk4_fp8(v[j][0], v[j][1], v[j][2], v[j][3]); }
    }
}

__device__ __forceinline__ float shiftP(const bf16* P, int m, int t, int col, float mu) {
    const float u = ldbf(P + (size_t)m * LDP + col); const float pv = t > 0 ? ldbf(P + (size_t)(m - 1) * LDP + col) : 0.f; return u + (pv - u) * mu;
}
__device__ __forceinline__ void phase_prep(const Frame& F0, int l) {
    const Frame F = relaunder(F0);
    unsigned char* ws = F.ws; const bf16* P = (const bf16*)(ws + WS_P);
    const float* mu = INP(6) + l * 1984; const float* vmu = INP(18);
    bf16* AL = (bf16*)(ws + WS_ALORA); bf16* QN = (bf16*)(ws + WS_QN); bf16* QM = (bf16*)(ws + WS_QM); bf16* Y = (bf16*)(ws + WS_Y);
    const float* qkg = INP(21) + l * 4 * 64; const float* mqg = INP(30) + l * 2 * 128;
    const float* cpos = INP(22) + (size_t)l * 2 * 32 * 64; const float* cw = INP(26) + l * 3 * 512;
    const int tid = F.tid, lane = F.lane, wave = F.wave;
    for (int tile = F.bid; tile < M / 32; tile += F.G) {
        const int m0 = tile * 32, b = m0 / T, t0 = m0 % T;
#pragma unroll
        for (int it_ = 0; it_ < 4; ++it_) { const int it = tid + it_ * 512; const int tt = it >> 6, g = it & 63, c = g * 8, m = m0 + tt, t = t0 + tt;
            int pc, kind; const float* mup;
            if (c < 96) { pc = PC_WD + c; kind = 0; mup = mu + pc; } else if (c < 192) { pc = PC_AD + c - 96; kind = 1; mup = mu + pc; }
            else if (c < 448) { pc = PC_GD + c - 192; kind = 2; mup = mu + pc; } else { pc = PC_VRES + c - 448; kind = 3; mup = vmu + (c - 448); }
            float o[8];
            if (kind == 3 && l == 0) {
#pragma unroll
                for (int j = 0; j < 8; ++j) o[j] = 0.f; }
            else { float u[8], pv[8], mm[8]; ld8(P + (size_t)m * LDP + pc, u); ldf8(mup, mm);
                if (t > 0) ld8(P + (size_t)(m - 1) * LDP + pc, pv); else {
#pragma unroll
                    for (int j = 0; j < 8; ++j) pv[j] = 0.f; }
#pragma unroll
                for (int j = 0; j < 8; ++j) { const float x = u[j] + (pv[j] - u[j]) * mm[j]; o[j] = kind == 0 ? tanhf(x) : (kind == 2 ? sigmoidf_(x) : x); } }
            st8(AL + (size_t)m * 512 + c, o); }
        for (int tt = wave; tt < 32; tt += 8) { const int m = m0 + tt;
            { float v[8]; float s = 0.f; const u32x4 raw = *(const u32x4*)(P + (size_t)m * LDP + PC_Q + lane * 8);
              v[0] = bf2f(raw.x & 0xffffu); v[1] = bf2f(raw.x >> 16); v[2] = bf2f(raw.y & 0xffffu); v[3] = bf2f(raw.y >> 16); v[4] = bf2f(raw.z & 0xffffu); v[5] = bf2f(raw.z >> 16); v[6] = bf2f(raw.w & 0xffffu); v[7] = bf2f(raw.w >> 16);
#pragma unroll
              for (int j = 0; j < 8; ++j) s += v[j] * v[j];
              s += __shfl_xor(s, 1); s += __shfl_xor(s, 2); s += __shfl_xor(s, 4);
              const float rs = CQ_NSA / sqrtf(s * (1.f / 64.f) + NORM_EPS); const int d0 = (lane & 7) * 8;
              u32x4 w; w.x = pk2(v[0] * rs * qkg[d0 + 0], v[1] * rs * qkg[d0 + 1]); w.y = pk2(v[2] * rs * qkg[d0 + 2], v[3] * rs * qkg[d0 + 3]); w.z = pk2(v[4] * rs * qkg[d0 + 4], v[5] * rs * qkg[d0 + 5]); w.w = pk2(v[6] * rs * qkg[d0 + 6], v[7] * rs * qkg[d0 + 7]);
              *(u32x4*)(QN + (size_t)m * 512 + lane * 8) = w; }
            { float v[8]; float s = 0.f; const u32x4 raw = *(const u32x4*)(P + (size_t)m * LDP + PC_MEM + lane * 8);
              v[0] = bf2f(raw.x & 0xffffu); v[1] = bf2f(raw.x >> 16); v[2] = bf2f(raw.y & 0xffffu); v[3] = bf2f(raw.y >> 16); v[4] = bf2f(raw.z & 0xffffu); v[5] = bf2f(raw.z >> 16); v[6] = bf2f(raw.w & 0xffffu); v[7] = bf2f(raw.w >> 16);
#pragma unroll
              for (int j = 0; j < 8; ++j) s += v[j] * v[j];
              s += __shfl_xor(s, 1); s += __shfl_xor(s, 2); s += __shfl_xor(s, 4); s += __shfl_xor(s, 8);
              const float rs = CQ_MEM / sqrtf(s * (1.f / 128.f) + NORM_EPS); const int d0 = (lane & 15) * 8;
              u32x4 w; w.x = pk2(v[0] * rs * mqg[d0 + 0], v[1] * rs * mqg[d0 + 1]); w.y = pk2(v[2] * rs * mqg[d0 + 2], v[3] * rs * mqg[d0 + 3]); w.z = pk2(v[4] * rs * mqg[d0 + 4], v[5] * rs * mqg[d0 + 5]); w.w = pk2(v[6] * rs * mqg[d0 + 6], v[7] * rs * mqg[d0 + 7]);
              *(u32x4*)(QM + (size_t)m * 512 + lane * 8) = w; }
            for (int which = 0; which < 2; ++which) { const int pc = which ? PC_KW : PC_KS; const float* gn = qkg + (which ? 3 : 2) * 64;
                const unsigned raw = *(const unsigned*)(P + (size_t)m * LDP + pc + lane * 2); const float a = bf2f(raw & 0xffffu), c2 = bf2f(raw >> 16);
                float s = a * a + c2 * c2; s += __shfl_xor(s, 1); s += __shfl_xor(s, 2); s += __shfl_xor(s, 4); s += __shfl_xor(s, 8); s += __shfl_xor(s, 16);
                const float rs = 1.0f / sqrtf(s * (1.f / 64.f) + NORM_EPS); const int kvh = lane >> 5, d = (lane & 31) * 2;
                bf16* dst = (bf16*)(ws + (which ? WS_KW : WS_KS)) + ((size_t)(b * 2 + kvh) * T + (t0 + tt)) * 64 + d;
                *(unsigned*)dst = pk2(a * rs * gn[d], c2 * rs * gn[d + 1]); }
        }
        if ((tile & 1) == 0) { const int col = tid & 127, tq = tid >> 7, kvh = col >> 6, d = col & 63;
          for (int which = 0; which < 2; ++which) { const int pc = which ? PC_VW : PC_VS;
            for (int q2 = 0; q2 < 2; ++q2) { const int tg = tq + 4 * q2; unsigned short v[8];
#pragma unroll
              for (int i = 0; i < 8; ++i) v[i] = P[(size_t)(m0 + tg * 8 + i) * LDP + pc + col];
              u32x4 w; w.x = v[0] | ((unsigned)v[1] << 16); w.y = v[2] | ((unsigned)v[3] << 16); w.z = v[4] | ((unsigned)v[5] << 16); w.w = v[6] | ((unsigned)v[7] << 16);
              *(u32x4*)((bf16*)(ws + (which ? WS_VWT : WS_VST)) + ((size_t)(b * 2 + kvh) * 64 + d) * T + t0 + tg * 8) = w; } } }
#pragma unroll
        for (int it_ = 0; it_ < 2; ++it_) { const int it = tid + it_ * 512; const int tt = it >> 5, r = (it & 31) * 8, i = r >> 7, h = (r >> 6) & 1, d = r & 63, t = t0 + tt, m = m0 + tt;
            float v[8], p1[8], o[8]; ld8(P + (size_t)m * LDP + PC_KC + r, v);
            bf16* A = (bf16*)(ws + WS_ACMP) + (size_t)i * 1024 * 2048;
            const int c1 = t >> 4, l1 = t & 15;
            if (c1 <= 254) { ldf8(cpos + (i * 32 + l1) * 64 + d, p1);
#pragma unroll
                for (int j = 0; j < 8; ++j) o[j] = v[j] + p1[j];
                st8(A + ((size_t)(b * 256 + c1) * 2 + h) * 2048 + l1 * 64 + d, o); }
            if (c1 >= 1) { ldf8(cpos + (i * 32 + l1 + 16) * 64 + d, p1);
#pragma unroll
                for (int j = 0; j < 8; ++j) o[j] = v[j] + p1[j];
                st8(A + ((size_t)(b * 256 + c1 - 1) * 2 + h) * 2048 + (l1 + 16) * 64 + d, o); } }
#pragma unroll
        for (int it_ = 0; it_ < 4; ++it_) { const int it = tid + it_ * 512; const int tt = it >> 6, c = (it & 63) * 8, m = m0 + tt, t = t0 + tt;
            float acc[8], bg[8];
#pragma unroll
            for (int j = 0; j < 8; ++j) acc[j] = 0.f;
#pragma unroll
            for (int k = 0; k < 3; ++k) { const int dt = 2 - k; if (t - dt >= 0) { float cg[8], xg[8], wv[8]; const size_t o = (size_t)(m - dt) * LDP; ld8(P + o + PC_CC + c, cg); ld8(P + o + PC_CX + c, xg); ldf8(cw + k * 512 + c, wv);
#pragma unroll
                    for (int j = 0; j < 8; ++j) acc[j] += wv[j] * cg[j] * xg[j]; } }
            ld8(P + (size_t)m * LDP + PC_CB + c, bg);
#pragma unroll
            for (int j = 0; j < 8; ++j) acc[j] *= bg[j];
            st8(Y + (size_t)m * 2560 + 1024 + c, acc); }
        { const int cgp = tid & 63, tg = tid >> 6, c = cgp * 8, w = 2 << (cgp >> 4); const int ts = t0 + tg * 4, ms = m0 + tg * 4;
          float sum[8];
#pragma unroll
          for (int j = 0; j < 8; ++j) sum[j] = 0.f;
#pragma unroll
          for (int k = 1; k < 16; ++k) if (k < w && ts - k >= 0) { float u[8]; ld8(P + (size_t)(ms - k) * LDP + PC_POOL + c, u);
#pragma unroll
              for (int j = 0; j < 8; ++j) sum[j] += u[j]; }
          for (int q = 0; q < 4; ++q) { const int t = ts + q, m = ms + q; float u[8], o[8]; ld8(P + (size_t)m * LDP + PC_POOL + c, u);
#pragma unroll
              for (int j = 0; j < 8; ++j) sum[j] += u[j];
              const int cnt = (t + 1) < w ? (t + 1) : w; const float ic = 1.f / (float)cnt;
#pragma unroll
              for (int j = 0; j < 8; ++j) o[j] = sum[j] * ic - u[j];
              st8(Y + (size_t)m * 2560 + 2048 + c, o);
              if (t - w + 1 >= 0) { float ud[8]; ld8(P + (size_t)(m - w + 1) * LDP + PC_POOL + c, ud);
#pragma unroll
                  for (int j = 0; j < 8; ++j) sum[j] -= ud[j]; } } }
    }
    { const float* KV = (const float*)(ws + WS_KVRAW) + l * 1024; bf16* KM = (bf16*)(ws + WS_KMEM); bf16* VM = (bf16*)(ws + WS_VMEMT); const float* kg = mqg + 128;
      for (int r = F.bid * 8 + wave; r < 512; r += F.G * 8) { const int b = r >> 8, j = r & 255;
          for (int h = 0; h < 4; ++h) { const float a = KV[(size_t)r * 2048 + h * 128 + lane], c2 = KV[(size_t)r * 2048 + h * 128 + 64 + lane];
              const float s = wave_sum(a * a + c2 * c2); const float rs = 1.0f / sqrtf(s * (1.f / 128.f) + NORM_EPS);
              bf16* dst = KM + ((size_t)(b * 4 + h) * 256 + j) * 128; dst[lane] = (bf16)f2bf(a * rs * kg[lane]); dst[64 + lane] = (bf16)f2bf(c2 * rs * kg[64 + lane]); } }
      for (int it = F.bid * 8 + wave; it < 1024; it += F.G * 8) { const int b = it >> 9, h = (it >> 7) & 3, d = it & 127;
#pragma unroll
          for (int k = 0; k < 4; ++k) { const int j = lane + 64 * k; VM[((size_t)(b * 4 + h) * 128 + d) * 256 + j] = (bf16)f2bf(KV[(size_t)(b * 256 + j) * 2048 + 512 + h * 128 + d]); } } }
}

template <int DH> struct AttL { static constexpr int KB = 64 * (DH + 8) * 2, VB = DH * 72 * 2, BUF = KB + VB, PW = 2 * BUF, END = PW + 8 * 16 * 72 * 2; };
constexpr int AT_PT = AttL<64>::END, AT_IMP = AT_PT + 32768, AT_SEL = AT_IMP + 8192, AT_UNI = AT_SEL + 256;
static_assert(AttL<128>::END <= RING_BYTES && AT_UNI + 64 <= RING_BYTES, "attention LDS map");
template <int DH, int MODE>
__device__ __forceinline__ void attn_pass(LAS unsigned char* lds, int tid, int lane, int wave, const bf16* Kg, const bf16* VTg, int ldvt, int jlo, int jhi,
                                          const bf16x8 (&qf)[DH / 32], f32x4 (&O)[DH / 16], float (&lsum)[4], int trow, unsigned sel0, unsigned sel1, unsigned uni0, unsigned uni1) {
    typedef AttL<DH> L;
    constexpr int KS = DH + 8;
    LAS bf16* PW = (LAS bf16*)(lds + L::PW) + wave * 16 * 72;
    const unsigned long long um = MODE == 2 ? (((unsigned long long)uni1 << 32) | uni0) : ~0ull;
    auto next_tile = [&](int from) -> int {
        if (from > jhi) return jhi + 1;
        if (MODE != 2) return from;
        const unsigned long long m = um >> from; if (m == 0ull) return jhi + 1;
        const int nx = from + __builtin_ctzll(m); return nx > jhi ? jhi + 1 : nx; };
    u32x4 kreg[DH / 64], vreg[DH / 64];
#define AT_LOADREGS(jt) do { _Pragma("unroll") for (int i = 0; i < DH / 64; ++i) { const int e = tid + i * 512; const int kr = e / (DH / 8), kc = (e % (DH / 8)) * 8; const int vr = e >> 3, vc = (e & 7) * 8; \
        kreg[i] = *(const u32x4*)(Kg + (size_t)(64 * (jt) + kr) * DH + kc); vreg[i] = *(const u32x4*)(VTg + (size_t)vr * ldvt + 64 * (jt) + vc); } } while (0)
#define AT_WRITELDS(bf) do { LAS bf16* KTw = (LAS bf16*)(lds + (bf) * L::BUF); LAS bf16* VTw = (LAS bf16*)(lds + (bf) * L::BUF + L::KB); \
        _Pragma("unroll") for (int i = 0; i < DH / 64; ++i) { const int e = tid + i * 512; const int kr = e / (DH / 8), kc = (e % (DH / 8)) * 8; const int vr = e >> 3, vc = (e & 7) * 8; \
        const int krp = 16 * (2 * (kr >> 5) + (kr & 1)) + ((kr >> 1) & 15); \
        *(LAS u32x4*)(KTw + krp * KS + kc) = kreg[i]; *(LAS u32x4*)(VTw + vr * 72 + vc) = vreg[i]; } } while (0)
    int jc = next_tile(jlo);
    if (jc > jhi) return;
    AT_LOADREGS(jc);
    __syncthreads();
    AT_WRITELDS(0);
    int jn = next_tile(jc + 1);
    if (jn <= jhi) AT_LOADREGS(jn);
    LDS_WAIT(); __syncthreads();
    int cur = 0;
    for (;;) {
        int jnn = jhi + 1;
        if (jn <= jhi) { AT_WRITELDS(cur ^ 1); jnn = next_tile(jn + 1); if (jnn <= jhi) AT_LOADREGS(jnn); }
        const int j = jc;
        const LAS bf16* KT = (const LAS bf16*)(lds + cur * L::BUF); const LAS bf16* VT = (const LAS bf16*)(lds + cur * L::BUF + L::KB);
        bool doit = true;
        if (MODE == 2) { const unsigned sb = j < 32 ? (sel0 >> j) : (sel1 >> (j - 32)); doit = __builtin_amdgcn_ballot_w64((sb & 1u) != 0u) != 0ull; }
        if (doit) {
        f32x4 S[4];
        { bf16x8 kfr[4][DH / 32];
#pragma unroll
          for (int n = 0; n < 4; ++n)
#pragma unroll
              for (int ks = 0; ks < DH / 32; ++ks) kfr[n][ks] = *(const LAS bf16x8*)(KT + (16 * n + (lane & 15)) * KS + ks * 32 + 8 * (lane >> 4));
          LDS_WAIT(); __builtin_amdgcn_sched_barrier(0);
#pragma unroll
          for (int n = 0; n < 4; ++n) { S[n] = (f32x4){0.f, 0.f, 0.f, 0.f};
#pragma unroll
              for (int ks = 0; ks < DH / 32; ++ks) S[n] = __builtin_amdgcn_mfma_f32_16x16x32_bf16(qf[ks], kfr[n][ks], S[n], 0, 0, 0); }
          __builtin_amdgcn_sched_barrier(0); }
        bool valid[4];
#pragma unroll
        for (int n = 0; n < 4; ++n) { const int key = 64 * j + 32 * (n >> 1) + 2 * (lane & 15) + (n & 1);
            if (MODE == 0) valid[n] = true;
            else if (MODE == 1) valid[n] = (key <= 254) && (16 * key + 31 <= trow);
            else if (MODE == 2) { const unsigned sb = j < 32 ? (sel0 >> j) : (sel1 >> (j - 32)); valid[n] = (sb & 1u) && key <= trow; }
            else valid[n] = key <= trow && key > trow - 512; }
#pragma unroll
        for (int a2 = 0; a2 < 2; ++a2)
#pragma unroll
            for (int r = 0; r < 4; ++r) { float p0 = __builtin_amdgcn_exp2f(S[2 * a2][r]), p1 = __builtin_amdgcn_exp2f(S[2 * a2 + 1][r]);
                if (MODE != 0) { p0 = valid[2 * a2] ? p0 : 0.f; p1 = valid[2 * a2 + 1] ? p1 : 0.f; }
                lsum[r] += p0 + p1;
                *(LAS unsigned*)(PW + (4 * (lane >> 4) + r) * 72 + 32 * a2 + 2 * (lane & 15)) = pk2(p0, p1); }
        LDS_WAIT(); asm volatile("" ::: "memory");
        { bf16x8 pfr[2], vfr[2][DH / 16];
#pragma unroll
          for (int ks = 0; ks < 2; ++ks) { pfr[ks] = *(const LAS bf16x8*)(PW + (lane & 15) * 72 + ks * 32 + 8 * (lane >> 4));
#pragma unroll
              for (int nd = 0; nd < DH / 16; ++nd) vfr[ks][nd] = *(const LAS bf16x8*)(VT + (16 * nd + (lane & 15)) * 72 + ks * 32 + 8 * (lane >> 4)); }
          LDS_WAIT(); __builtin_amdgcn_sched_barrier(0);
#pragma unroll
          for (int ks = 0; ks < 2; ++ks)
#pragma unroll
              for (int nd = 0; nd < DH / 16; ++nd) O[nd] = __builtin_amdgcn_mfma_f32_16x16x32_bf16(pfr[ks], vfr[ks][nd], O[nd], 0, 0, 0);
          __builtin_amdgcn_sched_barrier(0); }
        }
        if (jn > jhi) break;
        LDS_WAIT(); __syncthreads();
        cur ^= 1; jc = jn; jn = jnn;
    }
#undef AT_LOADREGS
#undef AT_WRITELDS
}

__device__ __forceinline__ void phase_memattn(const Frame& F0) {
    const Frame F = relaunder(F0);
    unsigned char* ws = F.ws; const bf16* QM = (const bf16*)(ws + WS_QM); const bf16* KM = (const bf16*)(ws + WS_KMEM); const bf16* VM = (const bf16*)(ws + WS_VMEMT); bf16* Y = (bf16*)(ws + WS_Y);
    const int lane = F.lane, wave = F.wave; const float c = 0.08838834764831845f * 1.4426950408889634f;
    for (int u = F.bid; u < 256; u += F.G) { const int b = u >> 7, h = (u >> 5) & 3, tile = u & 31; const int m0 = b * T + tile * 128 + wave * 16;
        bf16x8 qf[4];
#pragma unroll
        for (int ks = 0; ks < 4; ++ks) qf[ks] = *(const bf16x8*)(QM + (size_t)(m0 + (lane & 15)) * 512 + h * 128 + ks * 32 + 8 * (lane >> 4));
        f32x4 O[8]; float ls[4];
#pragma unroll
        for (int i = 0; i < 8; ++i) O[i] = (f32x4){0.f, 0.f, 0.f, 0.f};
#pragma unroll
        for (int r = 0; r < 4; ++r) ls[r] = 0.f;
        attn_pass<128, 0>(F.lds, F.tid, lane, wave, KM + (size_t)(b * 4 + h) * 256 * 128, VM + (size_t)(b * 4 + h) * 128 * 256, 256, 0, 3, qf, O, ls, 0, 0u, 0u, 0u, 0u);
#pragma unroll
        for (int r = 0; r < 4; ++r) { const float lr = red16_sum(ls[r]); const float inv = lr > 0.f ? 1.f / lr : 0.f; const int m = m0 + 4 * (lane >> 4) + r;
#pragma unroll
            for (int nd = 0; nd < 8; ++nd) Y[(size_t)m * 2560 + 1536 + h * 128 + 16 * nd + (lane & 15)] = (bf16)f2bf(O[nd][r] * inv); }
        __syncthreads();
    }
}

__device__ __forceinline__ void phase_nsa(const Frame& F0, unsigned* qctr) {
    const Frame F = relaunder(F0);
    unsigned char* ws = F.ws; const bf16* P = (const bf16*)(ws + WS_P); const bf16* QN = (const bf16*)(ws + WS_QN); bf16* Y = (bf16*)(ws + WS_Y);
    const int lane = F.lane, wave = F.wave, tid = F.tid; const float c = 0.125f * 1.4426950408889634f;
    LAS float* PT = (LAS float*)(F.lds + AT_PT); LAS float* IMP = (LAS float*)(F.lds + AT_IMP); LAS unsigned* SEL = (LAS unsigned*)(F.lds + AT_SEL); LAS unsigned* UNI = (LAS unsigned*)(F.lds + AT_UNI);
    LAS int* UQ = (LAS int*)(F.lds + AT_UNI + 16);
    int nxtq = 0; if (tid == 0) nxtq = (int)atomicAdd(qctr, 1u);
    for (;;) {
        __syncthreads();
        if (tid == 0) UQ[0] = nxtq;
        LDS_WAIT(); __syncthreads();
        const int uq = UQ[0]; if (uq >= 512) break;
        if (tid == 0) nxtq = (int)atomicAdd(qctr, 1u);
        const int tile = 127 - (uq >> 2), b = (uq >> 1) & 1, kvh = uq & 1;
        const int t0 = tile * 32, m0 = b * T + t0; const int cur = t0 >> 6;
        const int tl = wave * 4 + (lane >> 4);
        const int trow = t0 + tl;
        bf16x8 qf[2];
        { const int rho = lane & 15; const int mq = m0 + wave * 4 + (rho >> 2), g = rho & 3;
#pragma unroll
          for (int ks = 0; ks < 2; ++ks) qf[ks] = *(const bf16x8*)(QN + (size_t)mq * 512 + (kvh * 4 + g) * 64 + ks * 32 + 8 * (lane >> 4)); }
        const bf16* KCg = (const bf16*)(ws + WS_KC) + (size_t)(b * 2 + kvh) * 256 * 64; const bf16* VCg = (const bf16*)(ws + WS_VCT) + (size_t)(b * 2 + kvh) * 64 * 256;
        const bf16* KSg = (const bf16*)(ws + WS_KS) + (size_t)(b * 2 + kvh) * T * 64; const bf16* VSg = (const bf16*)(ws + WS_VST) + (size_t)(b * 2 + kvh) * 64 * T;
        const bf16* KWg = (const bf16*)(ws + WS_KW) + (size_t)(b * 2 + kvh) * T * 64; const bf16* VWg = (const bf16*)(ws + WS_VWT) + (size_t)(b * 2 + kvh) * 64 * T;
        f32x4 OF[4];
#pragma unroll
        for (int i = 0; i < 4; ++i) OF[i] = (f32x4){0.f, 0.f, 0.f, 0.f};
        float gate[3][4];
#pragma unroll
        for (int r = 0; r < 4; ++r)
#pragma unroll
            for (int k = 0; k < 3; ++k) gate[k][r] = sigmoidf_(ldbf(P + (size_t)(m0 + tl) * LDP + PC_GL + (kvh * 4 + r) * 3 + k));
        f32x4 O[4]; float lr[4];
#pragma unroll
        for (int i = 0; i < 4; ++i) O[i] = (f32x4){0.f, 0.f, 0.f, 0.f};
#pragma unroll
        for (int r = 0; r < 4; ++r) lr[r] = 0.f;
        attn_pass<64, 1>(F.lds, tid, lane, wave, KCg, VCg, 256, 0, 3, qf, O, lr, trow, 0u, 0u, 0u, 0u);
#pragma unroll
        for (int r = 0; r < 4; ++r) lr[r] = red16_sum(lr[r]);
#pragma unroll
        for (int r = 0; r < 4; ++r) { const float inv = lr[r] > 0.f ? 1.f / lr[r] : 0.f;
#pragma unroll
            for (int nd = 0; nd < 4; ++nd) OF[nd][r] += gate[0][r] * O[nd][r] * inv; }
        { LAS bf16* KT = (LAS bf16*)(F.lds);
          for (int j = 0; j < 4; ++j) {
              __syncthreads();
              { const int kr = tid >> 3, kc = (tid & 7) * 8; *(LAS u32x4*)(KT + kr * 72 + kc) = *(const u32x4*)(KCg + (size_t)(64 * j + kr) * 64 + kc); }
              LDS_WAIT(); __syncthreads();
              bf16x8 kfr[4][2]; f32x4 S4[4];
#pragma unroll
              for (int n = 0; n < 4; ++n)
#pragma unroll
                  for (int ks = 0; ks < 2; ++ks) kfr[n][ks] = *(const LAS bf16x8*)(KT + (16 * n + (lane & 15)) * 72 + ks * 32 + 8 * (lane >> 4));
              LDS_WAIT(); __builtin_amdgcn_sched_barrier(0);
#pragma unroll
              for (int n = 0; n < 4; ++n) { S4[n] = (f32x4){0.f, 0.f, 0.f, 0.f};
#pragma unroll
                  for (int ks = 0; ks < 2; ++ks) S4[n] = __builtin_amdgcn_mfma_f32_16x16x32_bf16(qf[ks], kfr[n][ks], S4[n], 0, 0, 0); }
              __builtin_amdgcn_sched_barrier(0);
#pragma unroll
              for (int n = 0; n < 4; ++n) { const f32x4 S = S4[n];
                  const int key = 64 * j + 16 * n + (lane & 15); const bool valid = (key <= 254) && (16 * key + 31 <= trow); float ps = 0.f;
#pragma unroll
                  for (int r = 0; r < 4; ++r) { const float inv = lr[r] > 0.f ? 1.f / lr[r] : 0.f; ps += valid ? __builtin_amdgcn_exp2f(S[r]) * inv : 0.f; }
                  PT[tl * 256 + key] = ps; } }
          if (tid < 64) SEL[tid] = 0u; if (tid < 2) UNI[tid] = 0u;
          LDS_WAIT(); __syncthreads(); }
        { const int tk = tid >> 4, sg = (tid & 15) * 4;
#pragma unroll
          for (int i = 0; i < 4; ++i) { const int s = sg + i; const LAS float* p = PT + tk * 256 + 4 * s; float v = p[0] + p[1] + p[2] + 0.5f * p[3]; if (s > 0) v += 0.5f * p[-1];
              const bool forced = (s == 0) || (s == cur) || (s == cur - 1); IMP[tk * 64 + s] = forced ? 1e9f : (s <= cur ? v : -1e9f); }
          LDS_WAIT(); __syncthreads();
          float mine[4]; int cnt[4];
#pragma unroll
          for (int i = 0; i < 4; ++i) { mine[i] = IMP[tk * 64 + sg + i]; cnt[i] = 0; }
          for (int s2 = 0; s2 < 64; ++s2) { const float o = IMP[tk * 64 + s2];
#pragma unroll
              for (int i = 0; i < 4; ++i) cnt[i] += (o > mine[i] || (o == mine[i] && s2 < sg + i)) ? 1 : 0; }
          unsigned bits = 0u;
#pragma unroll
          for (int i = 0; i < 4; ++i) if (cnt[i] < 16 && mine[i] > -1e8f) bits |= 1u << ((sg + i) & 31);
          if (bits) { atomicOr((unsigned*)(SEL + tk * 2 + (sg >> 5)), bits); atomicOr((unsigned*)(UNI + (sg >> 5)), bits); }
          LDS_WAIT(); __syncthreads(); }
        const unsigned sel0 = SEL[tl * 2], sel1 = SEL[tl * 2 + 1], uni0 = UNI[0], uni1 = UNI[1];
#pragma unroll
        for (int i = 0; i < 4; ++i) O[i] = (f32x4){0.f, 0.f, 0.f, 0.f};
#pragma unroll
        for (int r = 0; r < 4; ++r) lr[r] = 0.f;
        attn_pass<64, 2>(F.lds, tid, lane, wave, KSg, VSg, T, 0, cur, qf, O, lr, trow, sel0, sel1, uni0, uni1);
#pragma unroll
        for (int r = 0; r < 4; ++r) lr[r] = red16_sum(lr[r]);
#pragma unroll
        for (int r = 0; r < 4; ++r) { const float inv = lr[r] > 0.f ? 1.f / lr[r] : 0.f;
#pragma unroll
            for (int nd = 0; nd < 4; ++nd) OF[nd][r] += gate[1][r] * O[nd][r] * inv; }
#pragma unroll
        for (int i = 0; i < 4; ++i) O[i] = (f32x4){0.f, 0.f, 0.f, 0.f};
#pragma unroll
        for (int r = 0; r < 4; ++r) lr[r] = 0.f;
        { const int lo = t0 - 511; attn_pass<64, 3>(F.lds, tid, lane, wave, KWg, VWg, T, lo > 0 ? (lo >> 6) : 0, cur, qf, O, lr, trow, 0u, 0u, 0u, 0u); }
#pragma unroll
        for (int r = 0; r < 4; ++r) lr[r] = red16_sum(lr[r]);
#pragma unroll
        for (int r = 0; r < 4; ++r) { const float inv = lr[r] > 0.f ? 1.f / lr[r] : 0.f;
#pragma unroll
            for (int nd = 0; nd < 4; ++nd) OF[nd][r] += gate[2][r] * O[nd][r] * inv; }
#pragma unroll
        for (int r = 0; r < 4; ++r)
#pragma unroll
            for (int nd = 0; nd < 4; ++nd) Y[(size_t)(m0 + tl) * 2560 + 512 + (kvh * 4 + r) * 64 + 16 * nd + (lane & 15)] = (bf16)f2bf(OF[nd][r]);
        __syncthreads();
    }
}

constexpr int CL = 32, NCH = T / CL;
constexpr int SC_STEPS = 8;
__device__ __forceinline__ void phase_scan(const Frame& F0, int l) {
    const Frame F = relaunder(F0);
    unsigned char* ws = F.ws; const bf16* P = (const bf16*)(ws + WS_P); const float* LO = (const float*)(ws + WS_LO);
    float* VF = (float*)(ws + WS_VFIRST); float* VC = (float*)(ws + WS_VCUR); float* BON = (float*)(ws + WS_BON);
    float* YL = (float*)(ws + WS_YL); float* ZL = (float*)(ws + WS_ZL); float* QF = (float*)(ws + WS_QF); float* PF = (float*)(ws + WS_PF);
    const float* mu = INP(6) + l * 1984; const float* kk_ = INP(12) + l * 512; const float* ka_ = INP(13) + l * 512; const float* rk_ = INP(14) + l * 512;
    const int wave = F.wave;
    LAS float* ST = (LAS float*)F.lds + wave * (SC_STEPS * 5 * 64 + 64);
    for (int u = F.bid; u < 256; u += F.G) {
        int lane = F.lane; asm volatile("" : "+v"(lane));
        const int b = u >> 7, h = (u >> 4) & 7, cq = u & 15;
        const int jc = h * 64 + lane;
        const float mu_r = mu[PC_R + jc], mu_k = mu[PC_K + jc], mu_v = mu[PC_V + jc], kkw = kk_[jc], kaw = ka_[jc], rkw = rk_[jc];
        const int chunk = cq * 8 + wave;
        f32x2 Sq[32], Sp[32];
#pragma unroll
        for (int k = 0; k < 32; ++k) { Sq[k] = (f32x2){0.f, 0.f}; Sp[k] = (f32x2){(2 * k == lane) ? 1.f : 0.f, (2 * k + 1 == lane) ? 1.f : 0.f}; }
        const int tbase = chunk * CL;
        float gam = 1.f;
        for (int sb = 0; sb < CL / SC_STEPS; ++sb) {
            LDS_WAIT(); asm volatile("" ::: "memory");
#pragma unroll 1
            for (int hb = 0; hb < 2; ++hb) { const int st0 = hb * 4; const int tf = tbase + sb * SC_STEPS + st0, mf = b * T + tf;
              float ur[5], uk[5], uv[5], wv[4], av[4], vgv[4], vfv[4];
#pragma unroll
              for (int i = 0; i < 5; ++i) { const bool ok = (tf - 1 + i) >= 0; const bf16* pr = P + (size_t)(ok ? (mf - 1 + i) : mf) * LDP + h * 64;
                  const float sc = ok ? 1.f : 0.f;
                  ur[i] = ldbf(pr + PC_R + lane) * sc; uk[i] = ldbf(pr + PC_K + lane) * sc; uv[i] = ldbf(pr + PC_V + lane) * sc; }
#pragma unroll
              for (int i = 0; i < 4; ++i) { const float* lr = LO + (size_t)(mf + i) * 2048 + h * 64; wv[i] = lr[lane]; av[i] = lr[512 + lane];
                  vgv[i] = l ? lr[1536 + lane] : 0.f; vfv[i] = l ? (VF + (size_t)(mf + i) * 512 + h * 64)[lane] : 0.f; }
              float rr[4], kv[4], vv4[4], kmod4[4], red[8];
#pragma unroll
              for (int i = 0; i < 4; ++i) { const int m = mf + i;
                  const float r = ur[i + 1] + (ur[i] - ur[i + 1]) * mu_r, k = uk[i + 1] + (uk[i] - uk[i + 1]) * mu_k; float v = uv[i + 1] + (uv[i] - uv[i + 1]) * mu_v;
                  if (l == 0) (VF + (size_t)m * 512 + h * 64)[lane] = v; else v = v + (vfv[i] - v) * vgv[i];
                  (VC + (size_t)m * 512 + h * 64)[lane] = v;
                  const float kkv = k * kkw; const float kmod = k * (1.f + (av[i] - 1.f) * kaw);
                  rr[i] = r; kv[i] = kkv; vv4[i] = v; kmod4[i] = kmod; red[2 * i] = kkv * kkv; red[2 * i + 1] = r * kmod * rkw; }
#pragma unroll
              for (int o = 1; o < 64; o <<= 1) { float t8[8];
#pragma unroll
                  for (int j = 0; j < 8; ++j) t8[j] = __shfl_xor(red[j], o);
#pragma unroll
                  for (int j = 0; j < 8; ++j) red[j] += t8[j]; }
#pragma unroll
              for (int i = 0; i < 4; ++i) { const int m = mf + i; const float w = wv[i], a = av[i];
                  const float kkn = kv[i] * (1.0f / sqrtf(fmaxf(red[2 * i], 1e-24f)));
                  if (lane == 0) __hip_atomic_store((unsigned*)BON + (size_t)m * 8 + h, __builtin_bit_cast(unsigned, red[2 * i + 1]), RLX_AGENT);
                  const float gprev = gam; gam *= w; const float ig = 1.0f / gam;
                  LAS float* dst = ST + ((st0 + i) * 5) * 64 + lane;
                  dst[0] = kkn * gprev; dst[64] = kkn * a * ig; dst[128] = kmod4[i] * ig; dst[192] = rr[i] * gam; dst[256] = vv4[i]; } }
            LDS_WAIT(); asm volatile("" ::: "memory");
            for (int st = 0; st < SC_STEPS; ++st) { const LAS float* sp = ST + (st * 5) * 64; const int t = tbase + sb * SC_STEPS + st;
                const float vv = sp[256 + lane]; const f32x2 vv2 = (f32x2){vv, vv};
                f32x2 qa = (f32x2){0.f, 0.f}, qb = qa, pa = qa, pb = qa;
                { f32x4 buf[2][2];
#pragma unroll
                  for (int i = 0; i < 2; ++i) buf[0][i] = *(const LAS f32x4*)(sp + 4 * i);
#pragma unroll
                  for (int g = 0; g < 8; ++g) {
                      if (g < 7) {
#pragma unroll
                          for (int i = 0; i < 2; ++i) buf[(g + 1) & 1][i] = *(const LAS f32x4*)(sp + 8 * (g + 1) + 4 * i); }
                      asm volatile("" ::: "memory");
#pragma unroll
                      for (int i = 0; i < 2; ++i) { const int k2 = 4 * g + 2 * i; const f32x4 kk4 = buf[g & 1][i]; const f32x2 klo = (f32x2){kk4[0], kk4[1]}, khi = (f32x2){kk4[2], kk4[3]};
                          qa += Sq[k2] * klo; qb += Sq[k2 + 1] * khi; pa += Sp[k2] * klo; pb += Sp[k2 + 1] * khi; } } }
                const f32x2 qs = qa + qb, ps = pa + pb; const float nq = -(qs.x + qs.y), np = -(ps.x + ps.y); const f32x2 nq2 = (f32x2){nq, nq}, np2 = (f32x2){np, np};
                f32x2 ya = (f32x2){0.f, 0.f}, yb = ya, za = ya, zb = ya;
                { f32x4 bb[2], bk[2], br[2];
                  bb[0] = *(const LAS f32x4*)(sp + 64); bk[0] = *(const LAS f32x4*)(sp + 128); br[0] = *(const LAS f32x4*)(sp + 192);
#pragma unroll
                  for (int g = 0; g < 16; ++g) {
                      if (g < 15) { bb[(g + 1) & 1] = *(const LAS f32x4*)(sp + 64 + 4 * (g + 1)); bk[(g + 1) & 1] = *(const LAS f32x4*)(sp + 128 + 4 * (g + 1)); br[(g + 1) & 1] = *(const LAS f32x4*)(sp + 192 + 4 * (g + 1)); }
                      asm volatile("" ::: "memory");
                      { const int k2 = 2 * g; const f32x4 b4 = bb[g & 1], k4 = bk[g & 1], r4 = br[g & 1];
                        const f32x2 blo = (f32x2){b4[0], b4[1]}, bhi = (f32x2){b4[2], b4[3]}, klo = (f32x2){k4[0], k4[1]}, khi = (f32x2){k4[2], k4[3]}, rlo = (f32x2){r4[0], r4[1]}, rhi = (f32x2){r4[2], r4[3]};
                        Sq[k2] += vv2 * klo + nq2 * blo; Sq[k2 + 1] += vv2 * khi + nq2 * bhi; Sp[k2] += np2 * blo; Sp[k2 + 1] += np2 * bhi;
                        ya += Sq[k2] * rlo; yb += Sq[k2 + 1] * rhi; za += Sp[k2] * rlo; zb += Sp[k2 + 1] * rhi; } } }
                const f32x2 ys = ya + yb, zs = za + zb;
                const size_t o = (size_t)(b * T + t) * 512 + h * 64 + lane;
                YL[o] = ys.x + ys.y; ZL[o] = zs.x + zs.y; }
        }
        { LAS float* GL = ST + SC_STEPS * 5 * 64; LDS_WAIT(); asm volatile("" ::: "memory"); GL[lane] = gam; LDS_WAIT(); asm volatile("" ::: "memory");
#pragma unroll
          for (int k = 0; k < 32; k += 2) { const f32x4 g4 = *(const LAS f32x4*)(GL + 2 * k); const f32x2 glo = (f32x2){g4[0], g4[1]}, ghi = (f32x2){g4[2], g4[3]};
              Sq[k] *= glo; Sq[k + 1] *= ghi; Sp[k] *= glo; Sp[k + 1] *= ghi; } }
        { const size_t un = ((size_t)(b * 8 + h) * NCH + chunk) * 4096;
#pragma unroll
          for (int k = 0; k < 32; k += 4) { u32x4 w; w.x = pk2(Sq[k].x, Sq[k].y); w.y = pk2(Sq[k + 1].x, Sq[k + 1].y); w.z = pk2(Sq[k + 2].x, Sq[k + 2].y); w.w = pk2(Sq[k + 3].x, Sq[k + 3].y);
              *(u32x4*)((bf16*)QF + un + lane * 64 + 2 * k) = w; }
          { unsigned short* pf = (unsigned short*)PF + un + ((lane >> 2) & 3) * 16 + (lane >> 4) * 4 + (lane & 3);
#pragma unroll
            for (int k = 0; k < 32; ++k) { const unsigned w = pk2(Sp[k].x, Sp[k].y); pf[(2 * k) * 64] = (unsigned short)w; pf[(2 * k + 1) * 64] = (unsigned short)(w >> 16); } } }
    }
}
constexpr int CPF = 8;
__device__ __forceinline__ void phase_carry(const Frame& F0, unsigned* flags) {
    const Frame F = relaunder(F0);
    unsigned char* ws = F.ws; const unsigned char* QFb = ws + WS_QF; const unsigned char* PFb = ws + WS_PF; float* SI = (float*)(ws + WS_SINIT);
    const int lane = F.lane, wave = F.wave;
    LAS unsigned char* ring = F.lds;
    for (int chain = F.bid; chain < 16; chain += F.G) {
        const size_t cb = (size_t)chain * NCH * 8192;
        if (wave >= 4) {
            const int pt = (wave - 4) * 64 + lane;
            u32x4 rt[CPF][2], rq[CPF][2];
#pragma unroll
            for (int d = 0; d < CPF; ++d) { const size_t o = cb + (size_t)d * 8192 + pt * 16;
                rt[d][0] = *(const u32x4*)(PFb + o); rt[d][1] = *(const u32x4*)(PFb + o + 4096); rq[d][0] = *(const u32x4*)(QFb + o); rq[d][1] = *(const u32x4*)(QFb + o + 4096); }
            asm volatile("s_waitcnt vmcnt(%0)" :: "n"(4 * (CPF - 1)) : "memory");
            { LAS unsigned char* sl = ring + pt * 16; *(LAS u32x4*)(sl) = rt[0][0]; *(LAS u32x4*)(sl + 4096) = rt[0][1]; *(LAS u32x4*)(sl + 8192) = rq[0][0]; *(LAS u32x4*)(sl + 12288) = rq[0][1]; }
            { const size_t o = cb + (size_t)CPF * 8192 + pt * 16;
              rt[0][0] = *(const u32x4*)(PFb + o); rt[0][1] = *(const u32x4*)(PFb + o + 4096); rq[0][0] = *(const u32x4*)(QFb + o); rq[0][1] = *(const u32x4*)(QFb + o + 4096); }
            LDS_WAIT(); __syncthreads();
            for (int c0 = 0; c0 < NCH; c0 += CPF) {
#pragma unroll
                for (int d = 0; d < CPF; ++d) { const int c = c0 + d;
                    constexpr int DUMMY = 0; (void)DUMMY;
                    const int e = (d + 1) % CPF;
                    if (c + 1 < NCH) {
                        asm volatile("s_waitcnt vmcnt(%0)" :: "n"(4 * (CPF - 1)) : "memory");
                        LAS unsigned char* sl = ring + ((c + 1) & 1) * 16384 + pt * 16;
                        *(LAS u32x4*)(sl) = rt[e][0]; *(LAS u32x4*)(sl + 4096) = rt[e][1]; *(LAS u32x4*)(sl + 8192) = rq[e][0]; *(LAS u32x4*)(sl + 12288) = rq[e][1];
                        const int cn = c + 1 + CPF < NCH ? c + 1 + CPF : NCH - 1;
                        const size_t o = cb + (size_t)cn * 8192 + pt * 16;
                        rt[e][0] = *(const u32x4*)(PFb + o); rt[e][1] = *(const u32x4*)(PFb + o + 4096); rq[e][0] = *(const u32x4*)(QFb + o); rq[e][1] = *(const u32x4*)(QFb + o + 4096);
                    }
                    LDS_WAIT(); __syncthreads();
                }
            }
            asm volatile("s_waitcnt vmcnt(0)" ::: "memory");
        } else {
            const int row = wave * 16 + (lane & 15), g = lane >> 4;
            const int aoff = ((lane & 15) * 64 + g * 16) * 2, qoff = (row * 64 + 4 * g) * 2;
            f32x4 S[4];
#pragma unroll
            for (int mt = 0; mt < 4; ++mt) S[mt] = (f32x4){0.f, 0.f, 0.f, 0.f};
            u32x4 a[4][2]; u32x2 q[4];
            __syncthreads();
#pragma unroll
            for (int mt = 0; mt < 4; ++mt) { a[mt][0] = *(const LAS u32x4*)(ring + mt * 2048 + aoff); a[mt][1] = *(const LAS u32x4*)(ring + mt * 2048 + aoff + 16); q[mt] = *(const LAS u32x2*)(ring + 8192 + qoff + 32 * mt); }
            LDS_WAIT(); __builtin_amdgcn_sched_barrier(0);
            for (int c = 0; c < NCH; ++c) { const size_t un = ((size_t)chain * NCH + c) * 4096;
#pragma unroll
                for (int mt = 0; mt < 4; ++mt) *(f32x4*)(SI + un + (qoff >> 1) + 16 * mt) = S[mt];
                bf16x8 bh[2], bl[2];
#pragma unroll
                for (int ks = 0; ks < 2; ++ks) { u32x4 wh, wl; const f32x4 s0 = S[2 * ks], s1 = S[2 * ks + 1];
                    wh.x = pk2(s0[0], s0[1]); wh.y = pk2(s0[2], s0[3]); wh.z = pk2(s1[0], s1[1]); wh.w = pk2(s1[2], s1[3]);
                    wl.x = pk2(s0[0] - bf2f(wh.x & 0xffffu), s0[1] - bf2f(wh.x >> 16)); wl.y = pk2(s0[2] - bf2f(wh.y & 0xffffu), s0[3] - bf2f(wh.y >> 16));
                    wl.z = pk2(s1[0] - bf2f(wh.z & 0xffffu), s1[1] - bf2f(wh.z >> 16)); wl.w = pk2(s1[2] - bf2f(wh.w & 0xffffu), s1[3] - bf2f(wh.w >> 16));
                    bh[ks] = __builtin_bit_cast(bf16x8, wh); bl[ks] = __builtin_bit_cast(bf16x8, wl); }
                __builtin_amdgcn_sched_barrier(0);
#pragma unroll
                for (int mt = 0; mt < 4; ++mt) { f32x4 d = (f32x4){bf2f(q[mt].x & 0xffffu), bf2f(q[mt].x >> 16), bf2f(q[mt].y & 0xffffu), bf2f(q[mt].y >> 16)};
#pragma unroll
                    for (int ks = 0; ks < 2; ++ks) { const bf16x8 af = __builtin_bit_cast(bf16x8, a[mt][ks]);
                        d = __builtin_amdgcn_mfma_f32_16x16x32_bf16(af, bh[ks], d, 0, 0, 0); d = __builtin_amdgcn_mfma_f32_16x16x32_bf16(af, bl[ks], d, 0, 0, 0); }
                    S[mt] = d; }
                asm volatile("s_nop 7\n\ts_nop 7" ::: "memory");
                __builtin_amdgcn_sched_barrier(0);
                __syncthreads();
                if (c + 1 < NCH) { LAS unsigned char* sl = ring + ((c + 1) & 1) * 16384;
#pragma unroll
                    for (int mt = 0; mt < 4; ++mt) { a[mt][0] = *(const LAS u32x4*)(sl + mt * 2048 + aoff); a[mt][1] = *(const LAS u32x4*)(sl + mt * 2048 + aoff + 16); q[mt] = *(const LAS u32x2*)(sl + 8192 + qoff + 32 * mt); } }
                LDS_WAIT(); __builtin_amdgcn_sched_barrier(0);
            }
        }
        asm volatile("s_waitcnt vmcnt(0)" ::: "memory");
        __syncthreads();
        if (xb_t0(wave)) { __builtin_amdgcn_fence(__ATOMIC_RELEASE, "agent"); asm volatile("s_waitcnt vmcnt(0)" ::: "memory"); __hip_atomic_store(flags + chain, 1u, __ATOMIC_RELAXED, __HIP_MEMORY_SCOPE_AGENT); }
    }
}
__device__ __forceinline__ void phase_rwkv_fin(const Frame& F0, int l, unsigned* flags, unsigned* qctr) {
    const Frame F = relaunder(F0);
    unsigned char* ws = F.ws; const float* SI = (const float*)(ws + WS_SINIT); const float* YL = (const float*)(ws + WS_YL); const float* ZL = (const float*)(ws + WS_ZL);
    const float* LO = (const float*)(ws + WS_LO); const float* VC = (const float*)(ws + WS_VCUR); const float* BON = (const float*)(ws + WS_BON); bf16* Y = (bf16*)(ws + WS_Y);
    const float* lnw = INP(15) + l * 512; const float* lnb = INP(16) + l * 512;
    const int lane = F.lane, wave = F.wave;
    (void)qctr;
    __syncthreads();
    if (xb_t0(wave)) {
        for (int u = F.bid; u < 16 * (NCH / 4); u += F.G) { unsigned* fl = flags + u / (NCH / 4); unsigned sp = 0u;
            while (xb_ld(fl) == 0u && ++sp < (1u << 22)) __builtin_amdgcn_s_sleep(1); }
        __builtin_amdgcn_fence(__ATOMIC_ACQUIRE, "agent"); asm volatile("s_waitcnt vmcnt(0)" ::: "memory"); }
    __syncthreads();
    for (int u = F.bid; u < 16 * (NCH / 4); u += F.G) {
        const int chain = u / (NCH / 4), c = (u % (NCH / 4)) * 4 + (wave >> 1), b = chain >> 3, h = chain & 7; const size_t un = ((size_t)chain * NCH + c) * 4096;
        const int m0 = b * T + c * CL + (wave & 1) * 16;
        bf16x8 af[2], bfr[4][2];
#pragma unroll
        for (int ks = 0; ks < 2; ++ks) { float t8[8]; ldf8(ZL + (size_t)(m0 + (lane & 15)) * 512 + h * 64 + ks * 32 + 8 * (lane >> 4), t8);
            u32x4 w; w.x = pk2(t8[0], t8[1]); w.y = pk2(t8[2], t8[3]); w.z = pk2(t8[4], t8[5]); w.w = pk2(t8[6], t8[7]); af[ks] = __builtin_bit_cast(bf16x8, w); }
#pragma unroll
        for (int n = 0; n < 4; ++n)
#pragma unroll
            for (int ks = 0; ks < 2; ++ks) { float t8[8]; ldf8(SI + un + (size_t)(16 * n + (lane & 15)) * 64 + ks * 32 + 8 * (lane >> 4), t8);
                u32x4 w; w.x = pk2(t8[0], t8[1]); w.y = pk2(t8[2], t8[3]); w.z = pk2(t8[4], t8[5]); w.w = pk2(t8[6], t8[7]); bfr[n][ks] = __builtin_bit_cast(bf16x8, w); }
        float yl[4][4], vc[4][4], gg[4][4], bn[4];
#pragma unroll
        for (int r = 0; r < 4; ++r) { const int m = m0 + 4 * (lane >> 4) + r; bn[r] = BON[(size_t)m * 8 + h];
#pragma unroll
            for (int n = 0; n < 4; ++n) { const int j = h * 64 + 16 * n + (lane & 15); yl[n][r] = YL[(size_t)m * 512 + j]; vc[n][r] = VC[(size_t)m * 512 + j]; gg[n][r] = LO[(size_t)m * 2048 + 1024 + j]; } }
        asm volatile("s_waitcnt vmcnt(0)" ::: "memory"); __builtin_amdgcn_sched_barrier(0);
        f32x4 C[4];
#pragma unroll
        for (int n = 0; n < 4; ++n) { C[n] = (f32x4){yl[n][0], yl[n][1], yl[n][2], yl[n][3]};
#pragma unroll
            for (int ks = 0; ks < 2; ++ks) C[n] = __builtin_amdgcn_mfma_f32_16x16x32_bf16(af[ks], bfr[n][ks], C[n], 0, 0, 0); }
        __builtin_amdgcn_sched_barrier(0);
#pragma unroll
        for (int r = 0; r < 4; ++r) { const int m = m0 + 4 * (lane >> 4) + r;
            float sm = (C[0][r] + C[1][r]) + (C[2][r] + C[3][r]); sm = red16_sum(sm); const float mean = sm * (1.f / 64.f);
            float d[4], sv = 0.f;
#pragma unroll
            for (int n = 0; n < 4; ++n) { d[n] = C[n][r] - mean; sv += d[n] * d[n]; }
            sv = red16_sum(sv); const float rs = 1.0f / sqrtf(sv * (1.f / 64.f) + 64e-5f);
#pragma unroll
            for (int n = 0; n < 4; ++n) { const int j = h * 64 + 16 * n + (lane & 15); const float yn = d[n] * rs * lnw[j] + lnb[j];
                Y[(size_t)m * 2560 + j] = (bf16)f2bf((yn + bn[r] * vc[n][r]) * gg[n][r]); } }
    }
}

__device__ __forceinline__ void phase_route(const Frame& F0, const float* X) {
    const Frame F = relaunder(F0);
    const float* R = INP(36); const float* gain = INP(3) + D; const u64* ssq = (const u64*)(F.ctl + CW_SSQ) + 3 * 8192;
    unsigned* cnt = F.ctl + CW_CNT; unsigned* route = F.ctl + CW_ROUTE;
    const int lane = F.lane;
    for (int m = F.bid * 8 + F.wave; m < M; m += F.G * 8) {
        float acc[8];
#pragma unroll
        for (int e = 0; e < 8; ++e) acc[e] = 0.f;
#pragma unroll 8
        for (int i = 0; i < 32; ++i) { const int k = lane + 64 * i; const float xv = X[(size_t)m * D + k] * gain[k]; const f32x4 r0 = *(const f32x4*)(R + k * 8), r1 = *(const f32x4*)(R + k * 8 + 4);
            acc[0] += xv * r0[0]; acc[1] += xv * r0[1]; acc[2] += xv * r0[2]; acc[3] += xv * r0[3]; acc[4] += xv * r1[0]; acc[5] += xv * r1[1]; acc[6] += xv * r1[2]; acc[7] += xv * r1[3]; }
        const float rs = rstd_of(ssq, m);
#pragma unroll
        for (int e = 0; e < 8; ++e) acc[e] = wave_sum(acc[e]) * rs;
        if (lane == 0) {
            int e0 = 0; float v0 = acc[0];
#pragma unroll
            for (int e = 1; e < 8; ++e) if (acc[e] > v0) { v0 = acc[e]; e0 = e; }
            int e1 = -1; float v1 = -3.0e38f;
#pragma unroll
            for (int e = 0; e < 8; ++e) if (e != e0 && acc[e] > v1) { v1 = acc[e]; e1 = e; }
            const float p1 = __expf(v1 - v0); const float w0 = 1.f / (1.f + p1), w1 = p1 / (1.f + p1);
            const unsigned pos0 = atomicAdd(cnt + 64 * e0, 1u), pos1 = atomicAdd(cnt + 64 * e1, 1u);
            unsigned* rr = route + (size_t)m * 8; rr[0] = (unsigned)e0; rr[1] = (unsigned)e1; rr[2] = __builtin_bit_cast(unsigned, w0); rr[3] = __builtin_bit_cast(unsigned, w1); rr[4] = pos0; rr[5] = pos1; rr[6] = __builtin_bit_cast(unsigned, rs); }
    }
}
__device__ __forceinline__ void moe_tiles(const Frame& F, int (&ts)[9]) {
    ts[0] = 0;
#pragma unroll
    for (int e = 0; e < 8; ++e) { const unsigned c = __hip_atomic_load(F.ctl + CW_CNT + 64 * e, RLX_AGENT); ts[e + 1] = ts[e] + (int)((c + 255u) >> 8); }
}
__device__ __forceinline__ void phase_gather(const Frame& F0, float* RSS) {
    const Frame F = relaunder(F0);
    constexpr int RB = F8_M1 ? D : 2 * D;
    unsigned char* ws = F.ws; const unsigned char* XH = ws + (F8_M1 ? WS_XH8 : WS_XH); unsigned char* XG = ws + WS_XG; const unsigned* route = F.ctl + CW_ROUTE;
    int ts[9]; moe_tiles(F, ts);
    for (int m = F.bid * 8 + F.wave; m < M; m += F.G * 8) { const unsigned* rr = route + (size_t)m * 8;
        const u32x4* src = (const u32x4*)(XH + (size_t)m * RB);
#pragma unroll
        for (int s = 0; s < 2; ++s) { const int e = (int)rr[s]; int base = 0;
#pragma unroll
            for (int j = 0; j < 8; ++j) base = (j == e) ? ts[j] : base;
            const int slot = base * 256 + (int)rr[4 + s]; u32x4* dst = (u32x4*)(XG + (size_t)slot * RB);
#pragma unroll
            for (int i = 0; i < RB / 1024; ++i) dst[F.lane + 64 * i] = src[F.lane + 64 * i];
            if (F.lane == 0) __hip_atomic_store((unsigned*)RSS + slot, rr[6], RLX_AGENT); } }
}
__device__ __forceinline__ void phase_combine(const Frame& F0, const float* X, float* out) {
    const Frame F = relaunder(F0);
    unsigned char* ws = F.ws; const bf16* YS = (const bf16*)(ws + WS_YS); const unsigned* route = F.ctl + CW_ROUTE;
    int ts[9]; moe_tiles(F, ts);
    for (int m = F.bid * 8 + F.wave; m < M; m += F.G * 8) { const unsigned* rr = route + (size_t)m * 8; int slot[2]; float w[2];
#pragma unroll
        for (int s = 0; s < 2; ++s) { const int e = (int)rr[s]; int base = 0;
#pragma unroll
            for (int j = 0; j < 8; ++j) base = (j == e) ? ts[j] : base;
            slot[s] = base * 256 + (int)rr[4 + s]; w[s] = __builtin_bit_cast(float, rr[2 + s]); }
#pragma unroll
        for (int i = 0; i < 8; ++i) { const int c = (F.lane + 64 * i) * 4; f32x4 v = *(const f32x4*)(X + (size_t)m * D + c);
            const u32x2 a = *(const u32x2*)(YS + (size_t)slot[0] * D + c), b2 = *(const u32x2*)(YS + (size_t)slot[1] * D + c);
            v[0] += w[0] * bf2f(a.x & 0xffffu) + w[1] * bf2f(b2.x & 0xffffu); v[1] += w[0] * bf2f(a.x >> 16) + w[1] * bf2f(b2.x >> 16);
            v[2] += w[0] * bf2f(a.y & 0xffffu) + w[1] * bf2f(b2.y & 0xffffu); v[3] += w[0] * bf2f(a.y >> 16) + w[1] * bf2f(b2.y >> 16);
            *(f32x4*)(out + (size_t)m * D + c) = v; } }
}

constexpr int PH_PER_LAYER = 14, N_PHASES = 1 + 2 * PH_PER_LAYER;
struct Args { const float* in[40]; float* out; unsigned char* ws; int ph_lo, ph_hi; };
__global__ void __launch_bounds__(512, 2) mega_fwd(Args args) {
    extern __shared__ __attribute__((aligned(16))) unsigned char lds_raw[];
    Frame F; F.lds = (LAS unsigned char*)lds_raw; F.tid = threadIdx.x; F.lane = F.tid & 63; F.wave = __builtin_amdgcn_readfirstlane(F.tid >> 6); F.G = gridDim.x; F.bid = blockIdx.x;
    F.in = args.in; F.ws = args.ws; F.ctl = (unsigned*)(args.ws + WS_CTL);
    volatile LAS unsigned* MISC = (volatile LAS unsigned*)(F.lds + MISC_OFF);
    for (int u = F.tid; u < (LDS_BYTES - RING_BYTES) / 4; u += 512) ((LAS unsigned*)(F.lds + RING_BYTES))[u] = 0u;
    __syncthreads();
    const int lo = args.ph_lo, hi = args.ph_hi;
    XcdBarrier bar; bar.bar = F.ctl + CW_BAR; bar.x = 0; bar.st = nullptr; bar.wave = F.wave;
    if (hi - lo > 1) bar = xcd_barrier_post(F.ctl + CW_BAR, MISC + 8, F.wave);
#ifndef PHMASK
#define PHMASK 0xFFFFFFFFu
#endif
#define KD(j) (((PHMASK) >> (j)) & 1u)
#define IN(k) (lo <= (k) && (k) < hi)
#define SEAM(k) do { if (IN((k) + 1)) xcd_barrier(bar); } while (0)
    unsigned char* ws = args.ws;
    u64* ssq_all = (u64*)(F.ctl + CW_SSQ);
    LAS unsigned char* lds = F.lds;

    if (KD(0) && IN(0)) { phase_prologue(F); SEAM(0); }

    auto run_layer = [&](auto LC) __attribute__((always_inline)) {
        constexpr int l = decltype(LC)::value;
        const int pb = 1 + l * PH_PER_LAYER;
        const u64* ssq_mix = ssq_all + (2 * l) * 8192; u64* ssq_ffn = ssq_all + (2 * l + 1) * 8192;
        bf16* XH = (bf16*)(ws + WS_XH);
        const float* xin = l == 0 ? args.in[0] : args.out; float* xmid = (float*)(ws + WS_XA); float* xout = args.out;
        if (KD(1) && IN(pb + 0)) {
            const int nNP = (l ? NP1 : NP0) / 256;
            { pg8::Gemm g{XH, (const bf16*)(ws + (l ? WS_WPT1 : WS_WPT0)), D, D, D, 0, 0}; pg8::GridOrder S; S.init(M / 256, nNP, 1, F.G, F.bid);
              EpiP E{(bf16*)(ws + WS_P), (bf16*)(ws + WS_G4), ssq_mix, nNP}; pg8::gemm_phase<EpiP, pg8::GridOrder>(lds, g, S, E, F.wave); }
            if (l == 0 && F.G >= 16 && F.bid >= F.G - 16) { pg8::Gemm g{(const bf16*)(ws + WS_MEMN), (const bf16*)(ws + WS_WKVT0), D, D, D, 0, 0}; pg8::GridOrder S; S.init(2, 8, 1, 16, F.bid - (F.G - 16));
              EpiF32 E{(float*)(ws + WS_KVRAW), 2048}; pg8::gemm_phase<EpiF32, pg8::GridOrder>(lds, g, S, E, F.wave); }
            SEAM(pb + 0);
        }
        if (KD(2) && IN(pb + 1)) { phase_prep(F, l); SEAM(pb + 1); }
        if (KD(3) && IN(pb + 2)) {
            if (KD(17)) { pg8::Gemm g{(const bf16*)(ws + WS_ALORA), (const bf16*)(ws + (l ? WS_WLT1 : WS_WLT0)), 512, 512, 512, 0, 0}; pg8::GridOrder S; S.init(M / 256, 8, 1, F.G, F.bid);
              EpiLora E{(float*)(ws + WS_LO), args.in[7] + l * 512, args.in[9] + l * 512, args.in[19], l}; pg8::gemm_phase<EpiLora, pg8::GridOrder>(lds, g, S, E, F.wave); }
            if (KD(18) && F.bid < 32) { const int kp = F.bid >> 3;
              pg8::Gemm g{(const bf16*)(ws + WS_ACMP) + kp * 512, (const bf16*)(ws + (l ? WS_WC1T1 : WS_WC1T0)) + kp * 512, 2048, 2048, 512, (size_t)1024 * 2048 * 2, (size_t)256 * 2048 * 2}; pg8::GridOrder S; S.init(4, 1, 2, 8, F.bid & 7);
              EpiHP E{(float*)(ws + WS_HP) + (size_t)kp * 2 * 1024 * 128}; pg8::gemm_phase<EpiHP, pg8::GridOrder>(lds, g, S, E, F.wave); }
            __syncthreads();
            if (KD(19)) phase_memattn(F);
            SEAM(pb + 2);
        }
        if (KD(4) && IN(pb + 3)) {
            if (F.bid < 8) { const CmpFin CF{(const float*)(ws + WS_HP), args.in[24] + l * 256, (const bf16*)(ws + WS_WC2T) + (size_t)l * 2 * 64 * 128, args.in[21] + l * 256 + 64, (bf16*)(ws + WS_KC), (bf16*)(ws + WS_VCT)};
                cmp_finalize(CF, F.bid >> 2, F.bid & 3, lds, F.wave, F.lane); }
            phase_scan(F, l); SEAM(pb + 3); }
        if (KD(5) && IN(pb + 4)) { unsigned* cflags = F.ctl + CW_QCTR + 256 + 64 * l; phase_carry(F, cflags); phase_nsa(F, F.ctl + CW_QCTR + 64 * l); phase_rwkv_fin(F, l, cflags, F.ctl + CW_QCTR + 128 + 64 * l); SEAM(pb + 4); }
        if (KD(7) && IN(pb + 6)) {
            pg8::Gemm g{(const bf16*)(ws + WS_Y), (const bf16*)(ws + (l ? WS_WBT1 : WS_WBT0)), 2560, 512, 512, (size_t)512 * 2, (size_t)2048 * 512 * 2}; pg8::GridOrder S; S.init(M / 256, 8, 5, F.G, F.bid);
            EpiZ E{(bf16*)(ws + WS_ZB)}; pg8::gemm_phase<EpiZ, pg8::GridOrder>(lds, g, S, E, F.wave);
            { pg8::Gemm g4{(const bf16*)(ws + WS_XH8), (const bf16*)(ws + (l ? WS_WG4T1 : WS_WG4T0)), D / 2, D / 2, D / 2, 0, 0}; pg8::GridOrder S4; S4.init(M / 256, 8, 1, F.G, F.bid);
              EpiGate4 E4{(bf16*)(ws + WS_G4), ssq_mix}; pg8::gemm_phase<EpiGate4, pg8::GridOrder, true, true>(lds, g4, S4, E4, F.wave); }
            SEAM(pb + 6);
        }
        if (KD(8) && IN(pb + 7)) {
            constexpr int KD2 = F8_G ? D / 2 : D; pg8::Gemm g{F8_G ? (const bf16*)(ws + WS_XH8) : (const bf16*)XH, (const bf16*)(ws + (l ? WS_WGT1 : WS_WGT0)), KD2, KD2, KD2, 0, 0}; pg8::GridOrder S; S.init(M / 256, 32, 1, F.G, F.bid);
            EpiG E{(const bf16*)(ws + WS_ZB), (const bf16*)(ws + WS_G4), (bf16*)(ws + WS_MG), ssq_mix, F8_G ? W8SI : 1.f}; pg8::gemm_phase<EpiG, pg8::GridOrder, true, F8_G != 0>(lds, g, S, E, F.wave);
            SEAM(pb + 7);
        }
        if (KD(9) && IN(pb + 8)) {
            pg8::Gemm g{(const bf16*)(ws + WS_MG), (const bf16*)(ws + (l ? WS_WOT1 : WS_WOT0)), D, D, D, 0, 0}; pg8::GridOrder S; S.init(M / 256, 8, 1, F.G, F.bid);
            EpiRes E{xin, xmid, XH, ssq_ffn, ws + WS_XH8}; pg8::gemm_phase<EpiRes, pg8::GridOrder>(lds, g, S, E, F.wave);
            SEAM(pb + 8);
        }
        if (l == 0) {
            if (KD(10) && IN(pb + 9)) {
                constexpr int KD2 = F8_F1 ? D / 2 : D; pg8::Gemm g{F8_F1 ? (const bf16*)(ws + WS_XH8) : (const bf16*)XH, (const bf16*)(ws + WS_W13T), KD2, KD2, KD2, 0, 0}; pg8::GridOrder S; S.init(M / 256, 2 * FF / 256, 1, F.G, F.bid);
                EpiSwiglu<false> E{(bf16*)(ws + WS_ACT), FF, ssq_ffn, nullptr, F8_F1 ? W8SI : 1.f, 1.f}; pg8::gemm_phase<EpiSwiglu<false>, pg8::GridOrder, true, F8_F1 != 0>(lds, g, S, E, F.wave);
                SEAM(pb + 9);
            }
            if (KD(11) && IN(pb + 10)) {
                pg8::Gemm g{(const bf16*)(ws + WS_ACT), (const bf16*)(ws + WS_W2T), FF, FF, FF, 0, 0}; pg8::GridOrder S; S.init(M / 256, 8, 1, F.G, F.bid);
                EpiRes E{xmid, xout, XH, ssq_all + 2 * 8192, ws + WS_XH8}; pg8::gemm_phase<EpiRes, pg8::GridOrder>(lds, g, S, E, F.wave);
                SEAM(pb + 13);
            }
        } else {
            float* RSS = (float*)(ws + WS_RSS);
            if (KD(12) && IN(pb + 9)) { phase_route(F, xmid); SEAM(pb + 9); }
            if (KD(13) && IN(pb + 10)) { phase_gather(F, RSS); SEAM(pb + 10); }
            if (KD(14) && IN(pb + 11)) {
                pg8::MoeOrder S; moe_tiles(F, S.ts); S.nN = 2 * EFF / 256; S.G = F.G; S.c = F.bid;
                constexpr int KD2 = F8_M1 ? D / 2 : D; pg8::Gemm g{(const bf16*)(ws + WS_XG), (const bf16*)(ws + WS_MW13T), KD2, KD2, KD2, 0, (size_t)2 * EFF * 2048 * (F8_M1 ? 1 : 2)};
                EpiSwiglu<F8_M2 != 0> E{(bf16*)(ws + WS_ACTM), EFF, nullptr, RSS, F8_M1 ? W8SI : 1.f, 8.f}; pg8::gemm_phase<EpiSwiglu<F8_M2 != 0>, pg8::MoeOrder, true, F8_M1 != 0>(lds, g, S, E, F.wave);
                SEAM(pb + 11);
            }
            if (KD(15) && IN(pb + 12)) {
                pg8::MoeOrder S; moe_tiles(F, S.ts); S.nN = 8; S.G = F.G; S.c = F.bid;
                constexpr int KE2 = F8_M2 ? EFF / 2 : EFF; pg8::Gemm g{(const bf16*)(ws + WS_ACTM), (const bf16*)(ws + WS_MW2T), KE2, KE2, KE2, 0, (size_t)2048 * EFF * (F8_M2 ? 1 : 2)};
                EpiBf E{(bf16*)(ws + WS_YS), D, F8_M2 ? W8SI / 8.f : 1.f}; pg8::gemm_phase<EpiBf, pg8::MoeOrder, true, F8_M2 != 0>(lds, g, S, E, F.wave);
                SEAM(pb + 12);
            }
            if (KD(16) && IN(pb + 13)) { phase_combine(F, xmid, xout); }
        }
    };
    run_layer(std::integral_constant<int, 0>{});
    run_layer(std::integral_constant<int, 1>{});
#undef IN
#undef SEAM
}

#ifdef DBG_STOP
__global__ void dbg_dump(const unsigned char* buf, size_t nelem, int is_bf16, float* out, int nout) {
    for (int i = blockIdx.x * blockDim.x + threadIdx.x; i < nout; i += gridDim.x * blockDim.x) { float s = 0.f;
        for (size_t j = (size_t)i; j < nelem; j += (size_t)nout) s += is_bf16 ? bf2f(((const bf16*)buf)[j]) : ((const float*)buf)[j];
        out[i] = s; }
}
__global__ void dbg_cols(const bf16* buf, int ld, int c0, int w, float* out) {
    for (int i = blockIdx.x * blockDim.x + threadIdx.x; i < M * D; i += gridDim.x * blockDim.x) { const int row = i >> 11, c = i & 2047; out[i] = bf2f(buf[(size_t)row * ld + c0 + (c % w)]); }
}
#endif
extern "C" void kernel_launch(void* const* d_in, const int* in_sizes, int n_in, void* d_out, int out_size, void* d_ws, size_t ws_size, hipStream_t stream) {
    static int grid = 0;
    if (grid == 0) {
        if (n_in != 40 || out_size != M * D || ws_size < WS_END) { fprintf(stderr, "kernel_launch: unexpected shapes (n_in %d out %d ws %zu need %zu)\n", n_in, out_size, ws_size, (size_t)WS_END); grid = -1; return; }
        int dev = 0, cus = 0, per_cu = 0;
        if (hipGetDevice(&dev) != hipSuccess || hipDeviceGetAttribute(&cus, hipDeviceAttributeMultiprocessorCount, dev) != hipSuccess) { grid = -1; return; }
        if (hipFuncSetAttribute((const void*)mega_fwd, hipFuncAttributeMaxDynamicSharedMemorySize, LDS_BYTES) != hipSuccess) { fprintf(stderr, "kernel_launch: hipFuncSetAttribute failed\n"); grid = -1; return; }
        if (hipOccupancyMaxActiveBlocksPerMultiprocessor(&per_cu, (const void*)mega_fwd, 512, LDS_BYTES) != hipSuccess || per_cu < 1) fprintf(stderr, "kernel_launch: occupancy query reports %d\n", per_cu);
        (void)hipGetLastError();
        grid = cus;
    }
    if (grid < 0) return;
    if (hipMemsetAsync((char*)d_ws + WS_CTL, 0, CTL_BYTES, stream) != hipSuccess) return;
    Args a{};
    for (int i = 0; i < 40; ++i) a.in[i] = (const float*)d_in[i];
    a.out = (float*)d_out; a.ws = (unsigned char*)d_ws;
#if MK_ONE_LAUNCH
    a.ph_lo = 0; a.ph_hi = N_PHASES;
    hipLaunchKernelGGL(mega_fwd, dim3(grid), dim3(512), LDS_BYTES, stream, a);
#else
    for (int p = 0; p < N_PHASES; ++p) {
        if (p >= 1 + 11 && p < 1 + PH_PER_LAYER) continue;
#ifdef DBG_STOP
        if (p > DBG_STOP) break;
#endif
        a.ph_lo = p; a.ph_hi = p + 1;
        hipLaunchKernelGGL(mega_fwd, dim3(grid), dim3(512), LDS_BYTES, stream, a);
    }
#ifdef DBG_STOP
#ifdef DBG_C0
    hipLaunchKernelGGL(dbg_cols, dim3(2048), dim3(256), 0, stream, (const bf16*)((const unsigned char*)d_ws + (size_t)(DBG_OFF)), (int)(DBG_LD), (int)(DBG_C0), (int)(DBG_W), (float*)d_out);
#else
    hipLaunchKernelGGL(dbg_dump, dim3(2048), dim3(256), 0, stream, (const unsigned char*)d_ws + (size_t)(DBG_OFF), (size_t)(DBG_NELEM), (int)(DBG_BF16), (float*)d_out, M * D);
#endif
#endif
#endif
}
```

```cpp
#include <hip/hip_runtime.h>
#include <cstdio>
#include <cstdint>
#include <type_traits>

#ifndef F8_G
#define F8_G 1
#endif
#ifndef F8_F1
#define F8_F1 0
#endif
#ifndef F8_M1
#define F8_M1 1
#endif
#ifndef F8_M2
#define F8_M2 1
#endif
#ifndef MK_ONE_LAUNCH
#define MK_ONE_LAUNCH 1
#endif

#define GAS __attribute__((address_space(1)))
#define LAS __attribute__((address_space(3)))
typedef unsigned short bf16;
typedef short bf16x8 __attribute__((ext_vector_type(8)));
typedef float f32x4 __attribute__((ext_vector_type(4)));
typedef float f32x2 __attribute__((ext_vector_type(2)));
typedef unsigned u32x4 __attribute__((ext_vector_type(4)));
typedef unsigned u32x2 __attribute__((ext_vector_type(2)));

constexpr int M = 8192, T = 4096, D = 2048;
constexpr int LDP = 6144;
constexpr int NP0 = 5888, NP1 = 6144;
constexpr int PC_R = 0, PC_K = 512, PC_V = 1024, PC_WD = 1536, PC_AD = 1632, PC_GD = 1728;
constexpr int PC_Q = 1984, PC_KC = 2496, PC_VC = 2624, PC_KS = 2752, PC_VS = 2880, PC_KW = 3008, PC_VW = 3136, PC_GL = 3264;
constexpr int PC_CB = 3288, PC_CC = 3800, PC_CX = 4312, PC_POOL = 4824, PC_MEM = 5336, PC_GATE = 5848, PC_VRES = 5848;
constexpr int NIN = 16088;
constexpr int FF = 5632, EFF = 2816, NE = 8;
constexpr float NORM_EPS = 1e-6f;
constexpr float CQ_NSA = 0.125f * 1.4426950408889634f, CQ_MEM = 0.08838834764831845f * 1.4426950408889634f;
constexpr int SLOTS = 18432;

constexpr size_t al4k(size_t x) { return (x + 4095) & ~(size_t)4095; }
constexpr size_t MiB = 1u << 20;
constexpr size_t WS_CTL = 0, CTL_BYTES = MiB;
constexpr size_t SZ_WPT0 = (size_t)NP0 * 2048 * 2, SZ_WPT1 = (size_t)NP1 * 2048 * 2;
constexpr size_t SZ_WGT = (size_t)8192 * 2048 * 2, SZ_WBT = (size_t)5 * 2048 * 512 * 2, SZ_WOT = (size_t)2048 * 2048 * 2, SZ_WLT = (size_t)2048 * 512 * 2;
constexpr size_t SZ_WKVT = (size_t)1024 * 2048 * 2, SZ_WC1T = (size_t)2 * 256 * 2048 * 2;
constexpr size_t WS_WPT0 = WS_CTL + CTL_BYTES;
constexpr size_t WS_WPT1 = WS_WPT0 + SZ_WPT0;
constexpr size_t WS_WGT0 = WS_WPT1 + SZ_WPT1, WS_WGT1 = WS_WGT0 + SZ_WGT;
constexpr size_t WS_WG4T0 = WS_WGT1 + SZ_WGT, WS_WG4T1 = WS_WG4T0 + (size_t)2048 * 2048;
constexpr size_t WS_WBT0 = WS_WG4T1 + (size_t)2048 * 2048, WS_WBT1 = WS_WBT0 + SZ_WBT;
constexpr size_t WS_WOT0 = WS_WBT1 + SZ_WBT, WS_WOT1 = WS_WOT0 + SZ_WOT;
constexpr size_t WS_WLT0 = WS_WOT1 + SZ_WOT, WS_WLT1 = WS_WLT0 + SZ_WLT;
constexpr size_t WS_WKVT0 = WS_WLT1 + SZ_WLT, WS_WKVT1 = WS_WKVT0 + SZ_WKVT;
constexpr size_t WS_WC1T0 = WS_WKVT1 + SZ_WKVT, WS_WC1T1 = WS_WC1T0 + SZ_WC1T;
constexpr size_t WS_WC2T = WS_WC1T1 + SZ_WC1T;
constexpr size_t WS_W13T = WS_WC2T + (size_t)65536;
constexpr size_t WS_W2T = WS_W13T + (size_t)2 * FF * 2048 * 2;
constexpr size_t WS_MW13T = WS_W2T + (size_t)2048 * FF * 2;
constexpr size_t WS_MW2T = WS_MW13T + (size_t)NE * 2 * EFF * 2048 * 2;
constexpr size_t WS_XA = WS_MW2T + (size_t)NE * 2048 * EFF * 2;
constexpr size_t WS_XH = WS_XA + (size_t)M * D * 4;
constexpr size_t WS_MEMN = WS_XH + (size_t)M * D * 2;
constexpr size_t WS_G4 = WS_MEMN + (size_t)512 * 2048 * 2;
constexpr size_t WS_Y = WS_G4 + (size_t)M * D * 2;
constexpr size_t WS_VFIRST = WS_Y + (size_t)M * 2560 * 2;
constexpr size_t WS_KVRAW = WS_VFIRST + (size_t)M * 512 * 4;
constexpr size_t WS_XH8 = WS_KVRAW + (size_t)512 * 2048 * 4;
constexpr size_t WS_OV = WS_XH8 + (size_t)M * D;
constexpr size_t WS_P = WS_OV;
constexpr size_t WS_ALORA = WS_P + (size_t)M * LDP * 2;
constexpr size_t WS_LO = WS_ALORA + (size_t)M * 512 * 2;
constexpr size_t WS_YL = WS_LO + (size_t)M * 2048 * 4;
constexpr size_t WS_ZL = WS_YL + (size_t)M * 512 * 4;
constexpr size_t WS_QF = WS_ZL + (size_t)M * 512 * 4;
constexpr size_t WS_PF = WS_QF + (size_t)2048 * 4096 * 4;
constexpr size_t WS_SINIT = WS_PF + (size_t)2048 * 4096 * 4;
constexpr size_t WS_VCUR = WS_SINIT + (size_t)2048 * 4096 * 4;
constexpr size_t WS_BON = WS_VCUR + (size_t)M * 512 * 4;
constexpr size_t WS_QN = WS_BON + (size_t)M * 8 * 4;
constexpr size_t WS_KS = WS_QN + (size_t)M * 512 * 2;
constexpr size_t WS_KW = WS_KS + (size_t)M * 128 * 2;
constexpr size_t WS_VST = WS_KW + (size_t)M * 128 * 2;
constexpr size_t WS_VWT = WS_VST + (size_t)M * 128 * 2;
constexpr size_t WS_ACMP = WS_VWT + (size_t)M * 128 * 2;
constexpr size_t WS_KC = WS_ACMP + (size_t)2 * 1024 * 2048 * 2;
constexpr size_t WS_VCT = WS_KC + (size_t)4 * 256 * 64 * 2;
constexpr size_t WS_QM = WS_VCT + (size_t)4 * 256 * 64 * 2;
constexpr size_t WS_KMEM = WS_QM + (size_t)M * 512 * 2;
constexpr size_t WS_VMEMT = WS_KMEM + (size_t)8 * 256 * 128 * 2;
constexpr size_t WS_HP = WS_VMEMT + (size_t)8 * 256 * 128 * 2;
constexpr size_t WS_MIX_END = WS_HP + (size_t)4 * 2 * 1024 * 128 * 4;
constexpr size_t WS_ZB = WS_OV;
constexpr size_t WS_MG = WS_ZB + (size_t)5 * M * D * 2;
constexpr size_t WS_ACT = WS_OV;
constexpr size_t WS_XG = WS_OV;
constexpr size_t WS_ACTM = WS_XG + (size_t)SLOTS * 2048 * 2;
constexpr size_t WS_YS = WS_ACTM + (size_t)SLOTS * EFF * 2;
constexpr size_t WS_RSS = WS_YS + (size_t)SLOTS * 2048 * 2;
constexpr size_t WS_MOE_END = WS_RSS + (size_t)SLOTS * 4;
constexpr size_t WS_END = WS_MIX_END > WS_MOE_END ? WS_MIX_END : WS_MOE_END;
static_assert(WS_END <= (size_t)1119977216, "workspace map exceeds the guaranteed d_ws size");
static_assert(WS_MG + (size_t)M * D * 2 <= WS_MIX_END, "Z view inside overlay");

constexpr int CW_BAR = 4096;
constexpr int CW_SSQ = 16384;
constexpr int CW_CNT = CW_SSQ + 4 * 8192 * 2;
constexpr int CW_QCTR = CW_CNT + 512;
constexpr int CW_ROUTE = CW_CNT + 1024;
static_assert((CW_ROUTE + 8 * 8192) * 4 <= (int)CTL_BYTES, "CTL map");

constexpr int RING_BYTES = 131072;
constexpr int MISC_OFF = RING_BYTES + 320;
constexpr int LDS_BYTES = 147456;

#define RLX_AGENT __ATOMIC_RELAXED, __HIP_MEMORY_SCOPE_AGENT
#define LDS_WAIT() asm volatile("s_waitcnt lgkmcnt(0)" ::: "memory")
#define VM_WAIT() asm volatile("s_waitcnt vmcnt(0)" ::: "memory")
__device__ __forceinline__ unsigned f2bf(float f) { unsigned u = __builtin_bit_cast(unsigned, f); return (u + 0x7fffu + ((u >> 16) & 1u)) >> 16; }
__device__ __forceinline__ float bf2f(unsigned b) { return __builtin_bit_cast(float, b << 16); }
typedef __bf16 bf16x2_t __attribute__((ext_vector_type(2)));
__device__ __forceinline__ unsigned pk2(float lo, float hi) { const bf16x2_t b = __builtin_convertvector((f32x2){lo, hi}, bf16x2_t); return __builtin_bit_cast(unsigned, b); }
__device__ __forceinline__ unsigned pk4_fp8(float a, float b, float c, float d) { unsigned w = 0u; w = (unsigned)__builtin_amdgcn_cvt_pk_fp8_f32(a, b, (int)w, false); w = (unsigned)__builtin_amdgcn_cvt_pk_fp8_f32(c, d, (int)w, true); return w; }
constexpr float W8S = 64.0f, W8SI = 1.0f / 64.0f;
__device__ __forceinline__ float sigmoidf_(float x) { return __builtin_amdgcn_rcpf(1.f + __builtin_amdgcn_exp2f(x * -1.4426950408889634f)); }
#define DPPF(v, ctrl) __builtin_bit_cast(float, __builtin_amdgcn_update_dpp(0, __builtin_bit_cast(int, (v)), (ctrl), 0xf, 0xf, true))
__device__ __forceinline__ float red16_max(float v) { v = fmaxf(v, DPPF(v, 0xB1)); v = fmaxf(v, DPPF(v, 0x4E)); v = fmaxf(v, DPPF(v, 0x141)); v = fmaxf(v, DPPF(v, 0x140)); return v; }
__device__ __forceinline__ float red16_sum(float v) { v += DPPF(v, 0xB1); v += DPPF(v, 0x4E); v += DPPF(v, 0x141); v += DPPF(v, 0x140); return v; }
__device__ __forceinline__ float wave_sum(float v) {
#pragma unroll
    for (int o = 1; o < 64; o <<= 1) v += __shfl_xor(v, o);
    return v;
}

#define XB_TMO      128
#define XB_XCNT(j)  (256  + 64 * (j))
#define XB_XSUB(j)  (1280 + 64 * (j))
#define XB_XGEN(j)  (2304 + 64 * (j))
#define XB_TOP      3328
#define XB_TOPGEN   3392
#define XCD_BAR_WORDS 3456
#define XB_SPIN_CAP (1u << 18)
__device__ __forceinline__ unsigned xb_ld(unsigned* p)              { return __hip_atomic_load(p, __ATOMIC_RELAXED, __HIP_MEMORY_SCOPE_AGENT); }
__device__ __forceinline__ unsigned xb_add(unsigned* p, unsigned v) { return __hip_atomic_fetch_add(p, v, __ATOMIC_RELAXED, __HIP_MEMORY_SCOPE_AGENT); }
__device__ __forceinline__ unsigned xb_xcc_id() { return (unsigned)__builtin_amdgcn_s_getreg((3 << 11) | 20) & 0xFu; }
#define XB_SPIN(cond, bar) do { unsigned _sp = 0; while (cond) { __builtin_amdgcn_s_sleep(1); \
    if ((++_sp & 255u) == 0u) { if (xb_ld(&(bar)[XB_TMO])) break; if (_sp > XB_SPIN_CAP) { atomicAdd(&(bar)[XB_TMO], 1u); break; } } } } while (0)
struct XcdBarrier { unsigned* bar; unsigned x; volatile LAS unsigned* st; int wave; };
__device__ __forceinline__ bool xb_t0(int wave) { return wave == 0 && __builtin_amdgcn_mbcnt_hi(~0u, __builtin_amdgcn_mbcnt_lo(~0u, 0u)) == 0u; }
__device__ __forceinline__ XcdBarrier xcd_barrier_post(unsigned* bar, volatile LAS unsigned* st, int wave) {
    XcdBarrier b; b.bar = bar; b.x = xb_xcc_id(); b.st = st; b.wave = wave;
    if (xb_t0(wave)) (void)xb_add(&bar[XB_XCNT(b.x)], 1u);
    return b;
}
__device__ __forceinline__ void xcd_barrier_complete(unsigned* bar, unsigned x, unsigned& nloc, unsigned& nx) {
    const unsigned G = gridDim.x * gridDim.y * gridDim.z;
    unsigned sum, cnt, mine, sp = 0u;
    for (;;) {
        sum = 0u; cnt = 0u; mine = 0u;
#pragma unroll
        for (unsigned j = 0; j < 16; ++j) { const unsigned c = xb_ld(&bar[XB_XCNT(j)]); sum += c; cnt += (c > 0u) ? 1u : 0u; mine = (j == x) ? c : mine; }
        if (sum == G) break;
        __builtin_amdgcn_s_sleep(1);
        if ((++sp & 255u) == 0u) { if (xb_ld(&bar[XB_TMO])) break; if (sp > XB_SPIN_CAP) { atomicAdd(&bar[XB_TMO], 1u); break; } }
    }
    nloc = mine > 0u ? mine : 1u; nx = cnt > 0u ? cnt : 1u;
}
__device__ __forceinline__ void xcd_barrier(const XcdBarrier& b) {
    asm volatile("s_waitcnt vmcnt(0)" ::: "memory");
    __syncthreads();
    if (xb_t0(b.wave)) {
        unsigned* bar = b.bar;
        __builtin_amdgcn_s_waitcnt(0);
        unsigned nloc = b.st[0], nx = b.st[1];
        if (nloc == 0u) { xcd_barrier_complete(bar, b.x, nloc, nx); b.st[0] = nloc; b.st[1] = nx; }
        const unsigned old = xb_add(&bar[XB_XSUB(b.x)], 1u);
        const unsigned gen = old / nloc;
        if (old + 1u == (gen + 1u) * nloc) {
            __builtin_amdgcn_fence(__ATOMIC_RELEASE, "agent");
            asm volatile("s_waitcnt vmcnt(0)" ::: "memory");
            const unsigned og = xb_add(&bar[XB_TOP], 1u);
            const unsigned tg = og / nx;
            if (og + 1u == (tg + 1u) * nx) xb_add(&bar[XB_TOPGEN], 1u);
            else XB_SPIN(xb_ld(&bar[XB_TOPGEN]) == tg, bar);
            __builtin_amdgcn_fence(__ATOMIC_ACQUIRE, "agent");
            xb_add(&bar[XB_XGEN(b.x)], 1u);
            asm volatile("s_waitcnt vmcnt(0)" ::: "memory");
        } else {
            XB_SPIN(xb_ld(&bar[XB_XGEN(b.x)]) == gen, bar);
            __builtin_amdgcn_fence(__ATOMIC_ACQUIRE, "agent");
            asm volatile("s_waitcnt vmcnt(0)" ::: "memory");
        }
    }
    __syncthreads();
}

namespace pg8 {
typedef int v4i_t __attribute__((ext_vector_type(4)));
typedef int v8i_t __attribute__((ext_vector_type(8)));
constexpr int BM = 256, BK = 64, HALF = 128, HTB = HALF * BK * 2, STAGE_BYTES = 8 * HTB, NXCD = 8, WGM = 8;
__host__ __device__ __forceinline__ int lds_byte(int r, int c) { const int st = (r >> 4) * 2 + (c >> 5), rr = r & 15, cc = c & 31, ob = rr * 64 + cc * 2; return st * 1024 + (ob ^ (((ob >> 9) & 1) << 5)); }
__host__ __device__ __forceinline__ void stage_rc(int b, int& R, int& C) { const int st = b / 1024, sb = b % 1024, swz = sb ^ (((sb >> 9) & 1) << 5); R = (st >> 1) * 16 + swz / 64; C = (st & 1) * 32 + (swz % 64) / 2; }
__host__ __device__ __forceinline__ int perm32(int rho) { const int n = rho >> 4, i = rho & 15; return 8 * (i >> 2) + 4 * n + (i & 3); }
struct Unit { int pm, pn, z; };
struct Gemm { const bf16* A; const bf16* Bt; int lda, ldb, K; size_t az, bz; };

struct GridOrder {
    int nM, nN, nZ, G, c;
    __device__ void init(int nM_, int nN_, int nZ_, int G_, int c_) { nM = nM_; nN = nN_; nZ = nZ_; G = G_; c = c_; }
    __device__ bool next(int i, Unit& u) const {
        const long L = (long)i * G + c; const int nwg = nM * nN; if (L >= (long)nwg * nZ) return false;
        u.z = (int)(L / nwg); int wgid = (int)(L % nwg);
        { const int q = nwg / NXCD, r = nwg % NXCD, xcd = wgid % NXCD, off = wgid / NXCD; wgid = (xcd < r ? xcd * (q + 1) : r * (q + 1) + (xcd - r) * q) + off; }
        const int nig = WGM * nN, gid = wgid / nig, fm = gid * WGM, gsz = (nM - fm) < WGM ? (nM - fm) : WGM;
        u.pm = fm + ((wgid % nig) % gsz); u.pn = (wgid % nig) / gsz; return true;
    }
    __device__ __forceinline__ void a_ready(const Unit&) const {}
    __device__ __forceinline__ void done(const Unit&) const {}
};
struct PBOrder {
    GridOrder base; int nP, nX;
    __device__ bool next(int i, Unit& u) const {
        const long L = (long)i * base.G + base.c;
        if (L < nP) return base.next(i, u);
        const int e = (int)(L - nP); if (e >= nX) return false;
        u.z = 1; u.pm = e & 1; u.pn = e >> 1; return true; }
    __device__ __forceinline__ void a_ready(const Unit&) const {}
    __device__ __forceinline__ void done(const Unit&) const {}
};
struct MoeOrder {
    int ts[9]; int nN, G, c;
    __device__ bool next(int i, Unit& u) const {
        const long L = (long)i * G + c; const int rt = (int)(L / nN); if (rt >= ts[8]) return false;
        u.pn = (int)(L % nN); u.pm = rt; int e = 0;
#pragma unroll
        for (int j = 1; j < 8; ++j) e += (rt >= ts[j]) ? 1 : 0;
        u.z = e; return true;
    }
    __device__ __forceinline__ void a_ready(const Unit&) const {}
    __device__ __forceinline__ void done(const Unit&) const {}
};

template <class Epi, class Sched, bool ALIGN_EPI = true, bool F8 = false>
__device__ __forceinline__ void gemm_phase(LAS unsigned char* lds, const Gemm g, const Sched& S, const Epi& E, int wave0) {
    int lane_ = (int)__builtin_amdgcn_mbcnt_hi(~0u, __builtin_amdgcn_mbcnt_lo(~0u, 0u)); asm volatile("" : "+v"(lane_));
    const int wid = wave0, lane = lane_, tid = wid * 64 + lane, wr = wid >> 2, wc = wid & 3, fr = lane & 15, fq = lane >> 4;
    const int K = g.K, nt = K / BK;
    unsigned voffA[2], voffB[2];
#pragma unroll
    for (int i = 0; i < 2; ++i) { int R, C; stage_rc(tid * 16 + i * 8192, R, C); const int Rb = Epi::PERM ? ((R & ~31) + perm32(R & 31)) : R;
        voffA[i] = (unsigned)(R * g.lda + C) * 2u; voffB[i] = (unsigned)(Rb * g.ldb + C) * 2u; }
    const size_t kstep = (size_t)(BK * 2);
    const size_t hA = (size_t)HALF * g.lda * 2, hB = (size_t)HALF * g.ldb * 2;
    const unsigned ldsw = (unsigned)wid * 1024u;
    const int aoff = lds_byte(wr * 64 + fr, fq * 8), boff = lds_byte(wc * 32 + fr, fq * 8);
#define PG8_SA(b, h) (((b) * 2 + (h)) * HTB)
#define PG8_SB(b, h) ((4 + (b) * 2 + (h)) * HTB)
#define PG8_STAGE(bufoff, gbase, voff) do { _Pragma("unroll") for (int _i = 0; _i < 2; ++_i) \
        __builtin_amdgcn_global_load_lds((const unsigned*)((const char*)(gbase) + (voff)[_i]), (LAS unsigned*)(lds + (bufoff) + ldsw + _i * 8192), 16, 0, 0); } while (0)
#define PG8_LDA(dst, b, h) do { _Pragma("unroll") for (int m = 0; m < 4; ++m) _Pragma("unroll") for (int k = 0; k < 2; ++k) dst[m][k] = *(const LAS bf16x8*)(lds + PG8_SA(b, h) + aoff + m * 2048 + k * 1024); } while (0)
#define PG8_LDB(dst, b, h) do { _Pragma("unroll") for (int n = 0; n < 2; ++n) _Pragma("unroll") for (int k = 0; k < 2; ++k) dst[n][k] = *(const LAS bf16x8*)(lds + PG8_SB(b, h) + boff + n * 2048 + k * 1024); } while (0)
#define PG8_MMA(ai, bj, At, Bt) do { __builtin_amdgcn_s_setprio(1); \
        if constexpr (F8) { _Pragma("unroll") for (int m = 0; m < 4; ++m) _Pragma("unroll") for (int n = 0; n < 2; ++n) { \
            const v4i_t b0 = __builtin_bit_cast(v4i_t, Bt[n][0]), b1 = __builtin_bit_cast(v4i_t, Bt[n][1]), a0 = __builtin_bit_cast(v4i_t, At[m][0]), a1 = __builtin_bit_cast(v4i_t, At[m][1]); \
            const v8i_t b8 = __builtin_shufflevector(b0, b1, 0, 1, 2, 3, 4, 5, 6, 7), a8 = __builtin_shufflevector(a0, a1, 0, 1, 2, 3, 4, 5, 6, 7); \
            asm volatile("v_mfma_f32_16x16x128_f8f6f4 %0, %1, %2, %0" : "+v"(acc[ai][bj][m][n]) : "v"(b8), "v"(a8)); } }     \
        else { _Pragma("unroll") for (int m = 0; m < 4; ++m) _Pragma("unroll") for (int n = 0; n < 2; ++n) _Pragma("unroll") for (int k = 0; k < 2; ++k) \
            acc[ai][bj][m][n] = __builtin_amdgcn_mfma_f32_16x16x32_bf16(Bt[n][k], At[m][k], acc[ai][bj][m][n], 0, 0, 0); } \
        __builtin_amdgcn_s_setprio(0); } while (0)
#define PG8_WAIT_V(n) asm volatile("s_waitcnt vmcnt(" #n ")" ::: "memory")
#define PG8_WAIT_L(n) asm volatile("s_waitcnt lgkmcnt(" #n ")" ::: "memory")
#define PG8_BAR __builtin_amdgcn_s_barrier()
#define PG8_SCHED __builtin_amdgcn_sched_barrier(0)
    Unit cur, nxt; int ui = 0;
    if (!S.next(0, cur)) return;
    f32x4 acc[2][2][4][2];
#pragma unroll
    for (int a = 0; a < 2; ++a)
#pragma unroll
        for (int b = 0; b < 2; ++b)
#pragma unroll
            for (int m = 0; m < 4; ++m)
#pragma unroll
                for (int n = 0; n < 2; ++n) acc[a][b][m][n] = (f32x4){0.f, 0.f, 0.f, 0.f};
    bf16x8 At[4][2], B0[2][2], B1[2][2];
    const char* cA = (const char*)g.A + (size_t)cur.z * g.az + (size_t)cur.pm * 2 * hA; const char* cB = (const char*)g.Bt + (size_t)cur.z * g.bz + (size_t)cur.pn * 2 * hB;
    S.a_ready(cur);
    PG8_STAGE(PG8_SB(0, 0), cB, voffB); PG8_STAGE(PG8_SB(0, 1), cB + hB, voffB); PG8_STAGE(PG8_SA(0, 0), cA, voffA); PG8_STAGE(PG8_SA(0, 1), cA + hA, voffA);
    if (wr == 1) PG8_BAR;
    PG8_WAIT_V(2); PG8_BAR;
    PG8_STAGE(PG8_SB(1, 0), cB + kstep, voffB); PG8_STAGE(PG8_SA(1, 0), cA + kstep, voffA); PG8_STAGE(PG8_SB(1, 1), cB + hB + kstep, voffB);
    PG8_WAIT_V(6); PG8_BAR;
    for (;;) {
        const bool has_next = S.next(ui + 1, nxt);
        const char* nA = has_next ? (const char*)g.A + (size_t)nxt.z * g.az + (size_t)nxt.pm * 2 * hA : cA; const char* nB = has_next ? (const char*)g.Bt + (size_t)nxt.z * g.bz + (size_t)nxt.pn * 2 * hB : cB;
        for (int t = 0; t < nt; t += 2) {
            const bool last = (t == nt - 2);
            const char* a1 = cA + (size_t)(t + 1) * kstep;
            const char* a2 = last ? nA : cA + (size_t)(t + 2) * kstep; const char* b2 = last ? nB : cB + (size_t)(t + 2) * kstep;
            const char* a3 = a2 + kstep; const char* b3 = b2 + kstep;
            if (last && has_next) S.a_ready(nxt);
            PG8_LDB(B0, 0, 0); PG8_LDB(B1, 0, 1); PG8_SCHED; PG8_LDA(At, 0, 0); PG8_STAGE(PG8_SA(1, 1), a1 + hA, voffA);
            PG8_WAIT_V(8); PG8_WAIT_L(0); PG8_BAR; PG8_MMA(0, 0, At, B0); PG8_MMA(0, 1, At, B1); PG8_BAR; PG8_SCHED;
            PG8_LDA(At, 0, 1); PG8_STAGE(PG8_SB(0, 0), b2, voffB); PG8_STAGE(PG8_SB(0, 1), b2 + hB, voffB); PG8_STAGE(PG8_SA(0, 0), a2, voffA);
            PG8_WAIT_V(8); PG8_WAIT_L(0); PG8_BAR; PG8_MMA(1, 0, At, B0); PG8_MMA(1, 1, At, B1); PG8_BAR; PG8_SCHED;
            PG8_LDB(B0, 1, 0); PG8_LDB(B1, 1, 1); PG8_SCHED; PG8_LDA(At, 1, 0); PG8_STAGE(PG8_SA(0, 1), a2 + hA, voffA);
            PG8_WAIT_V(8); PG8_WAIT_L(0); PG8_BAR; PG8_MMA(0, 0, At, B0); PG8_MMA(0, 1, At, B1); PG8_BAR; PG8_SCHED;
            PG8_LDA(At, 1, 1); PG8_STAGE(PG8_SB(1, 0), b3, voffB); PG8_STAGE(PG8_SB(1, 1), b3 + hB, voffB); PG8_STAGE(PG8_SA(1, 0), a3, voffA);
            PG8_WAIT_V(8); PG8_WAIT_L(0); PG8_BAR; PG8_MMA(1, 0, At, B0); PG8_MMA(1, 1, At, B1); PG8_BAR; PG8_SCHED;
        }
        if constexpr (ALIGN_EPI) { if (wr == 0) PG8_BAR; }
        if constexpr (F8) asm volatile("s_nop 15\n\ts_nop 15\n\ts_nop 15\n\ts_nop 15" ::: "memory");
        if constexpr (!Epi::AFTER_DRAIN) { E(acc, cur, wr, wc, fr, fq); S.done(cur); }
        if (!has_next) break;
#pragma unroll
        for (int a = 0; a < 2; ++a)
#pragma unroll
            for (int b = 0; b < 2; ++b)
#pragma unroll
                for (int m = 0; m < 4; ++m)
#pragma unroll
                    for (int n = 0; n < 2; ++n) acc[a][b][m][n] = (f32x4){0.f, 0.f, 0.f, 0.f};
        cur = nxt; cA = nA; cB = nB; ++ui;
        if constexpr (ALIGN_EPI) { if (wr == 1) PG8_BAR; }
    }
    PG8_WAIT_V(0);
    if constexpr (!ALIGN_EPI) { if (wr == 0) PG8_BAR; }
    PG8_BAR;
    if constexpr (Epi::AFTER_DRAIN) { E.fused(acc, cur, wr, wc, fr, fq, lds, wid, lane); S.done(cur); }
#undef PG8_SA
#undef PG8_SB
#undef PG8_STAGE
#undef PG8_LDA
#undef PG8_LDB
#undef PG8_MMA
#undef PG8_WAIT_V
#undef PG8_WAIT_L
#undef PG8_BAR
#undef PG8_SCHED
}
}
using pg8::Unit; using pg8::HALF; using pg8::BM;
typedef const f32x4 (&AccT)[2][2][4][2];

typedef unsigned long long u64;
__device__ __forceinline__ float rstd_of(const u64* ssq, int row) { return 1.0f / sqrtf((float)ssq[row] * (1.0f / 4294967296.0f) * (1.0f / D) + NORM_EPS); }
__device__ __forceinline__ size_t zblk(int row, int col) { return ((size_t)(row >> 4) * (D / 16) + (col >> 4)) * 256 + (row & 15) * 16 + (col & 15); }
__device__ __forceinline__ float rstd_raw(u64 q) { return 1.0f / sqrtf((float)q * (1.0f / 4294967296.0f) * (1.0f / D) + NORM_EPS); }
__device__ __forceinline__ u64 ssq_fix(float s) { return (u64)(s * 4294967296.0f); }

struct EpiP {
    static constexpr bool PERM = true, AFTER_DRAIN = false;
    bf16* P; bf16* G4; const u64* ssq; int nNP;
    __device__ __forceinline__ void operator()(AccT acc, const Unit& u, int wr, int wc, int fr, int fq) const {
        const int row0 = u.pm * BM + wr * 64 + fr; const bool gate = u.pn >= nNP;
        bf16* base = gate ? G4 : P; const int ld = gate ? D : LDP; const int col0 = (gate ? (u.pn - nNP) : u.pn) * BM + wc * 32 + 8 * fq;
        float rs8[2][4];
#pragma unroll
        for (int ai = 0; ai < 2; ++ai)
#pragma unroll
            for (int m = 0; m < 4; ++m) rs8[ai][m] = rstd_of(ssq, row0 + ai * HALF + m * 16);
#pragma unroll
        for (int ai = 0; ai < 2; ++ai)
#pragma unroll
            for (int m = 0; m < 4; ++m) { const int row = row0 + ai * HALF + m * 16; const float rs = rs8[ai][m]; bf16* rowp = base + (size_t)row * ld + col0;
#pragma unroll
                for (int bj = 0; bj < 2; ++bj) { f32x4 v0 = acc[ai][bj][m][0] * rs, v1 = acc[ai][bj][m][1] * rs;
                    if (gate) {
#pragma unroll
                        for (int j = 0; j < 4; ++j) { v0[j] = sigmoidf_(v0[j]); v1[j] = sigmoidf_(v1[j]); } }
                    u32x4 w; w.x = pk2(v0[0], v0[1]); w.y = pk2(v0[2], v0[3]); w.z = pk2(v1[0], v1[1]); w.w = pk2(v1[2], v1[3]);
                    *(u32x4*)(rowp + bj * HALF) = w; } }
    }
};
struct EpiGate4 {
    static constexpr bool PERM = true, AFTER_DRAIN = false;
    bf16* G4; const u64* ssq;
    __device__ __forceinline__ void operator()(AccT acc, const Unit& u, int wr, int wc, int fr, int fq) const {
        const int row0 = u.pm * BM + wr * 64 + fr, col0 = u.pn * BM + wc * 32 + 8 * fq;
        float rs8[2][4];
#pragma unroll
        for (int ai = 0; ai < 2; ++ai)
#pragma unroll
            for (int m = 0; m < 4; ++m) rs8[ai][m] = rstd_of(ssq, row0 + ai * HALF + m * 16) * W8SI;
#pragma unroll
        for (int ai = 0; ai < 2; ++ai)
#pragma unroll
            for (int m = 0; m < 4; ++m) { const int row = row0 + ai * HALF + m * 16; const float rs = rs8[ai][m];
#pragma unroll
                for (int bj = 0; bj < 2; ++bj) { f32x4 v0 = acc[ai][bj][m][0] * rs, v1 = acc[ai][bj][m][1] * rs;
#pragma unroll
                    for (int j = 0; j < 4; ++j) { v0[j] = sigmoidf_(v0[j]); v1[j] = sigmoidf_(v1[j]); }
                    u32x4 w; w.x = pk2(v0[0], v0[1]); w.y = pk2(v0[2], v0[3]); w.z = pk2(v1[0], v1[1]); w.w = pk2(v1[2], v1[3]);
                    *(u32x4*)(G4 + zblk(row, col0 + bj * HALF)) = w; } }
    }
};
struct EpiF32 {
    static constexpr bool PERM = false, AFTER_DRAIN = false;
    float* C; int ldc;
    __device__ __forceinline__ void operator()(AccT acc, const Unit& u, int wr, int wc, int fr, int fq) const {
        const int row0 = u.pm * BM + wr * 64 + fr, col0 = u.pn * BM + wc * 32 + 4 * fq;
#pragma unroll
        for (int ai = 0; ai < 2; ++ai)
#pragma unroll
            for (int m = 0; m < 4; ++m) { float* rowp = C + (size_t)(row0 + ai * HALF + m * 16) * ldc + col0;
#pragma unroll
                for (int bj = 0; bj < 2; ++bj)
#pragma unroll
                    for (int n = 0; n < 2; ++n) *(f32x4*)(rowp + bj * HALF + n * 16) = acc[ai][bj][m][n]; }
    }
};
struct EpiLora {
    static constexpr bool PERM = false, AFTER_DRAIN = false;
    float* LO; const float* w0; const float* a0; const float* v0; int has_v;
    __device__ __forceinline__ void operator()(AccT acc, const Unit& u, int wr, int wc, int fr, int fq) const {
        const int row0 = u.pm * BM + wr * 64 + fr, col0 = u.pn * BM + wc * 32 + 4 * fq; const int blk = u.pn >> 1;
        f32x4 bias4[2][2];
#pragma unroll
        for (int bj = 0; bj < 2; ++bj)
#pragma unroll
            for (int n = 0; n < 2; ++n) { const int j = (col0 + bj * HALF + n * 16) & 511; f32x4 bb = (f32x4){0.f, 0.f, 0.f, 0.f};
                if (blk == 0) bb = *(const f32x4*)(w0 + j); else if (blk == 1) bb = *(const f32x4*)(a0 + j); else if (blk == 3 && has_v) bb = *(const f32x4*)(v0 + j);
                bias4[bj][n] = bb; }
#pragma unroll
        for (int bj = 0; bj < 2; ++bj)
#pragma unroll
            for (int n = 0; n < 2; ++n) { const int col = col0 + bj * HALF + n * 16; const f32x4 bias = bias4[bj][n];
#pragma unroll
                for (int ai = 0; ai < 2; ++ai)
#pragma unroll
                    for (int m = 0; m < 4; ++m) { f32x4 v = acc[ai][bj][m][n] + bias;
                        if (blk == 0) {
#pragma unroll
                            for (int e = 0; e < 4; ++e) { const float x = v[e]; const float sp = fmaxf(-x, 0.f) + log1pf(__expf(-fabsf(x)));
                                v[e] = __expf(-__expf(-sp - 0.5f)); } }
                        else if (blk != 2) {
#pragma unroll
                            for (int e = 0; e < 4; ++e) v[e] = sigmoidf_(v[e]); }
                        *(f32x4*)(LO + (size_t)(row0 + ai * HALF + m * 16) * 2048 + col) = v; } }
    }
};
struct EpiZ {
    static constexpr bool PERM = true, AFTER_DRAIN = false;
    bf16* ZB;
    __device__ __forceinline__ void operator()(AccT acc, const Unit& u, int wr, int wc, int fr, int fq) const {
        const int row0 = u.pm * BM + wr * 64 + fr, col0 = u.pn * BM + wc * 32 + 8 * fq; bf16* base = ZB + (size_t)u.z * M * D;
#pragma unroll
        for (int ai = 0; ai < 2; ++ai)
#pragma unroll
            for (int m = 0; m < 4; ++m) { const int row = row0 + ai * HALF + m * 16;
#pragma unroll
                for (int bj = 0; bj < 2; ++bj) { const f32x4 v0 = acc[ai][bj][m][0], v1 = acc[ai][bj][m][1];
                    u32x4 w; w.x = pk2(v0[0], v0[1]); w.y = pk2(v0[2], v0[3]); w.z = pk2(v1[0], v1[1]); w.w = pk2(v1[2], v1[3]);
                    *(u32x4*)(base + zblk(row, col0 + bj * HALF)) = w; } }
    }
};
struct EpiG {
    static constexpr bool PERM = false, AFTER_DRAIN = false;
    const bf16* ZB; const bf16* G4; bf16* MG; const u64* ssq; float wsi;
    struct Bat { u64 q[2]; u32x2 g4[2], z4[2], zz[2][4]; };
    __device__ __forceinline__ void load(Bat& B, int k, int row0, int c0) const {
#pragma unroll
        for (int mm = 0; mm < 2; ++mm) { const int row = row0 + (k >> 1) * HALF + (2 * (k & 1) + mm) * 16; const size_t off = zblk(row, c0);
            B.q[mm] = ssq[row]; B.g4[mm] = *(const u32x2*)(G4 + off); B.z4[mm] = *(const u32x2*)(ZB + (size_t)4 * M * D + off);
#pragma unroll
            for (int br = 0; br < 4; ++br) B.zz[mm][br] = *(const u32x2*)(ZB + (size_t)br * M * D + off); }
    }
    __device__ __forceinline__ void operator()(AccT acc, const Unit& u, int wr, int wc, int fr, int fq) const {
        const int row0 = u.pm * BM + wr * 64 + fr, c0 = u.pn * 64 + wc * 16 + 4 * fq;
        Bat b[2]; load(b[0], 0, row0, c0);
#pragma unroll
        for (int k = 0; k < 4; ++k) { const int ai = k >> 1;
            if (k < 3) load(b[(k + 1) & 1], k + 1, row0, c0);
            const Bat& B = b[k & 1];
#pragma unroll
            for (int mm = 0; mm < 2; ++mm) { const int m = 2 * (k & 1) + mm, row = row0 + ai * HALF + m * 16; const float rs = rstd_raw(B.q[mm]) * wsi;
                f32x4 s;
                s[0] = bf2f(B.g4[mm].x & 0xffffu) * bf2f(B.z4[mm].x & 0xffffu); s[1] = bf2f(B.g4[mm].x >> 16) * bf2f(B.z4[mm].x >> 16);
                s[2] = bf2f(B.g4[mm].y & 0xffffu) * bf2f(B.z4[mm].y & 0xffffu); s[3] = bf2f(B.g4[mm].y >> 16) * bf2f(B.z4[mm].y >> 16);
#pragma unroll
                for (int bj = 0; bj < 2; ++bj)
#pragma unroll
                    for (int n = 0; n < 2; ++n) { const int br = 2 * bj + n; const u32x2 z = B.zz[mm][br]; const f32x4 a = acc[ai][bj][m][n] * rs;
                        s[0] += sigmoidf_(a[0]) * bf2f(z.x & 0xffffu); s[1] += sigmoidf_(a[1]) * bf2f(z.x >> 16);
                        s[2] += sigmoidf_(a[2]) * bf2f(z.y & 0xffffu); s[3] += sigmoidf_(a[3]) * bf2f(z.y >> 16); }
                u32x2 w; w.x = pk2(s[0], s[1]); w.y = pk2(s[2], s[3]); *(u32x2*)(MG + (size_t)row * D + c0) = w; } }
    }
};
struct EpiRes {
    static constexpr bool PERM = false, AFTER_DRAIN = false;
    const float* res; float* out; bf16* XH; u64* ssq; unsigned char* XH8;
    __device__ __forceinline__ void operator()(AccT acc, const Unit& u, int wr, int wc, int fr, int fq) const {
        const int row0 = u.pm * BM + wr * 64 + fr, col0 = u.pn * BM + wc * 32 + 4 * fq;
#pragma unroll
        for (int ai = 0; ai < 2; ++ai)
#pragma unroll
            for (int mp = 0; mp < 4; mp += 4) {
                f32x4 rv[4][2][2];
#pragma unroll
                for (int mm = 0; mm < 4; ++mm) { const size_t off = (size_t)(row0 + ai * HALF + (mp + mm) * 16) * D + col0;
#pragma unroll
                    for (int bj = 0; bj < 2; ++bj)
#pragma unroll
                        for (int n = 0; n < 2; ++n) rv[mm][bj][n] = *(const f32x4*)(res + off + bj * HALF + n * 16); }
#pragma unroll
                for (int mm = 0; mm < 4; ++mm) { const int m = mp + mm; const int row = row0 + ai * HALF + m * 16; const size_t off = (size_t)row * D + col0; float sq = 0.f;
#pragma unroll
                    for (int bj = 0; bj < 2; ++bj)
#pragma unroll
                        for (int n = 0; n < 2; ++n) { const size_t o = off + bj * HALF + n * 16; const f32x4 v = rv[mm][bj][n] + acc[ai][bj][m][n];
                            *(f32x4*)(out + o) = v; sq += (v[0] * v[0] + v[1] * v[1]) + (v[2] * v[2] + v[3] * v[3]);
                            u32x2 w; w.x = pk2(v[0], v[1]); w.y = pk2(v[2], v[3]); *(u32x2*)(XH + o) = w; *(unsigned*)(XH8 + o) = pk4_fp8(v[0], v[1], v[2], v[3]); }
                    sq += __shfl_xor(sq, 16); sq += __shfl_xor(sq, 32);
                    if (fq == 0) atomicAdd(ssq + row, ssq_fix(sq)); }
                asm volatile("" ::: "memory"); }
    }
};
template <bool OUT8> struct EpiSwiglu {
    static constexpr bool PERM = true, AFTER_DRAIN = false;
    bf16* ACT; int ldc; const u64* ssq; const float* rss; float wsi; float osc;
    __device__ __forceinline__ void operator()(AccT acc, const Unit& u, int wr, int wc, int fr, int fq) const {
        const int row0 = u.pm * BM + wr * 64 + fr, col0 = u.pn * HALF + wc * 32 + 8 * fq;
        float rs8[2][4];
#pragma unroll
        for (int ai = 0; ai < 2; ++ai)
#pragma unroll
            for (int m = 0; m < 4; ++m) { const int row = row0 + ai * HALF + m * 16; rs8[ai][m] = (rss ? rss[row] : rstd_of(ssq, row)) * wsi; }
#pragma unroll
        for (int ai = 0; ai < 2; ++ai)
#pragma unroll
            for (int m = 0; m < 4; ++m) { const int row = row0 + ai * HALF + m * 16; const float rs = rs8[ai][m];
                float o[8];
#pragma unroll
                for (int n = 0; n < 2; ++n)
#pragma unroll
                    for (int e = 0; e < 4; ++e) { const float a = acc[ai][0][m][n][e] * rs, b = acc[ai][1][m][n][e] * rs; o[4 * n + e] = a * sigmoidf_(a) * b; }
                if constexpr (OUT8) { u32x2 w; w.x = pk4_fp8(o[0] * osc, o[1] * osc, o[2] * osc, o[3] * osc); w.y = pk4_fp8(o[4] * osc, o[5] * osc, o[6] * osc, o[7] * osc);
                    *(u32x2*)((unsigned char*)ACT + (size_t)row * ldc + col0) = w; }
                else { u32x4 w; w.x = pk2(o[0], o[1]); w.y = pk2(o[2], o[3]); w.z = pk2(o[4], o[5]); w.w = pk2(o[6], o[7]);
                    *(u32x4*)(ACT + (size_t)row * ldc + col0) = w; } }
    }
};
struct EpiBf {
    static constexpr bool PERM = true, AFTER_DRAIN = false;
    bf16* O; int ldc; float sc;
    __device__ __forceinline__ void operator()(AccT acc, const Unit& u, int wr, int wc, int fr, int fq) const {
        const int row0 = u.pm * BM + wr * 64 + fr, col0 = u.pn * BM + wc * 32 + 8 * fq;
#pragma unroll
        for (int ai = 0; ai < 2; ++ai)
#pragma unroll
            for (int m = 0; m < 4; ++m) { bf16* rowp = O + (size_t)(row0 + ai * HALF + m * 16) * ldc + col0;
#pragma unroll
                for (int bj = 0; bj < 2; ++bj) { const f32x4 v0 = acc[ai][bj][m][0] * sc, v1 = acc[ai][bj][m][1] * sc;
                    u32x4 w; w.x = pk2(v0[0], v0[1]); w.y = pk2(v0[2], v0[3]); w.z = pk2(v1[0], v1[1]); w.w = pk2(v1[2], v1[3]);
                    *(u32x4*)(rowp + bj * HALF) = w; } }
    }
};
struct EpiHP {
    static constexpr bool PERM = false, AFTER_DRAIN = false;
    float* HP;
    __device__ __forceinline__ void operator()(AccT acc, const Unit& u, int wr, int wc, int fr, int fq) const {
        const int row0 = u.pm * BM + wr * 64 + fr, col0 = wc * 32 + 4 * fq; float* base = HP + (size_t)u.z * 1024 * 128;
#pragma unroll
        for (int ai = 0; ai < 2; ++ai)
#pragma unroll
            for (int m = 0; m < 4; ++m) { float* rowp = base + (size_t)(row0 + ai * HALF + m * 16) * 128 + col0;
#pragma unroll
                for (int n = 0; n < 2; ++n) *(f32x4*)(rowp + n * 16) = acc[ai][0][m][n]; }
    }
};
struct CmpFin { const float* HP; const float* b1; const bf16* w2t; const float* gain; bf16* KC; bf16* VCT; };
__device__ __forceinline__ void cmp_finalize(const CmpFin& C_, int z, int pm, LAS unsigned char* lds, int wid, int lane) {
        LAS bf16* H = (LAS bf16*)lds;
        { const int tid = wid * 64 + lane, r = tid >> 1, c0 = (tid & 1) * 64;
#pragma unroll
          for (int j = 0; j < 16; ++j) { const int c = c0 + 4 * j; f32x4 v = *(const f32x4*)(C_.b1 + z * 128 + c);
#pragma unroll
              for (int kp = 0; kp < 4; ++kp) v += *(const f32x4*)(C_.HP + ((size_t)(kp * 2 + z) * 1024 + pm * 256 + r) * 128 + c);
#pragma unroll
              for (int e = 0; e < 4; ++e) { const float x = v[e]; const float t = 0.7978845608f * (x + 0.044715f * x * x * x); const float th = 1.f - 2.f / (__expf(2.f * t) + 1.f); v[e] = 0.5f * x * (1.f + th); }
              u32x2 w; w.x = pk2(v[0], v[1]); w.y = pk2(v[2], v[3]); *(LAS u32x2*)(H + r * 136 + c) = w; } }
        LDS_WAIT(); __syncthreads();
        bf16x8 af[2][4], bfr[4][4];
#pragma unroll
        for (int mt = 0; mt < 2; ++mt)
#pragma unroll
            for (int ks = 0; ks < 4; ++ks) af[mt][ks] = *(const LAS bf16x8*)(H + (wid * 32 + mt * 16 + (lane & 15)) * 136 + ks * 32 + 8 * (lane >> 4));
#pragma unroll
        for (int n = 0; n < 4; ++n)
#pragma unroll
            for (int ks = 0; ks < 4; ++ks) bfr[n][ks] = *(const bf16x8*)(C_.w2t + (size_t)z * 64 * 128 + (16 * n + (lane & 15)) * 128 + ks * 32 + 8 * (lane >> 4));
        asm volatile("s_waitcnt vmcnt(0) lgkmcnt(0)" ::: "memory"); __builtin_amdgcn_sched_barrier(0);
        f32x4 C[2][4];
#pragma unroll
        for (int mt = 0; mt < 2; ++mt)
#pragma unroll
            for (int n = 0; n < 4; ++n) { C[mt][n] = (f32x4){0.f, 0.f, 0.f, 0.f};
#pragma unroll
                for (int ks = 0; ks < 4; ++ks) C[mt][n] = __builtin_amdgcn_mfma_f32_16x16x32_bf16(af[mt][ks], bfr[n][ks], C[mt][n], 0, 0, 0); }
        __builtin_amdgcn_sched_barrier(0);
#pragma unroll
        for (int mt = 0; mt < 2; ++mt)
#pragma unroll
            for (int r = 0; r < 4; ++r) { const int grow = pm * 256 + wid * 32 + mt * 16 + 4 * (lane >> 4) + r;
                const int hh = grow & 1, bc = grow >> 1, b = bc >> 8, c = bc & 255;
                float ss = 0.f;
#pragma unroll
                for (int n = 0; n < 4; ++n) ss += C[mt][n][r] * C[mt][n][r];
                ss = red16_sum(ss);
                if (c < 255) {
                    if (z == 0) { const float rs = 1.0f / sqrtf(ss * (1.f / 64.f) + NORM_EPS); bf16* dst = C_.KC + ((size_t)(b * 2 + hh) * 256 + c) * 64;
#pragma unroll
                        for (int n = 0; n < 4; ++n) { const int d = 16 * n + (lane & 15); dst[d] = (bf16)f2bf(C[mt][n][r] * rs * C_.gain[d]); } }
                    else { bf16* dst = C_.VCT + (size_t)(b * 2 + hh) * 64 * 256 + c;
#pragma unroll
                        for (int n = 0; n < 4; ++n) { const int d = 16 * n + (lane & 15); dst[(size_t)d * 256] = (bf16)f2bf(C[mt][n][r]); } } } }
        __syncthreads();
}

struct Frame {
    LAS unsigned char* lds; int tid, lane, wave, G, bid;
    const float* const* in; unsigned char* ws; unsigned* ctl;
};
__device__ __forceinline__ Frame relaunder(const Frame& F0) { Frame F = F0; int ln = (int)__builtin_amdgcn_mbcnt_hi(~0u, __builtin_amdgcn_mbcnt_lo(~0u, 0u)); asm volatile("" : "+v"(ln)); F.lane = ln; F.wave = F0.wave; F.tid = F0.wave * 64 + ln; return F; }
#define INP(k) (F.in[k])
__device__ __forceinline__ float ldbf(const bf16* p) { return bf2f(*p); }
__device__ __forceinline__ void ld8(const bf16* p, float (&v)[8]) { const u32x4 r = *(const u32x4*)p;
    v[0] = bf2f(r.x & 0xffffu); v[1] = bf2f(r.x >> 16); v[2] = bf2f(r.y & 0xffffu); v[3] = bf2f(r.y >> 16); v[4] = bf2f(r.z & 0xffffu); v[5] = bf2f(r.z >> 16); v[6] = bf2f(r.w & 0xffffu); v[7] = bf2f(r.w >> 16); }
__device__ __forceinline__ void st8(bf16* p, const float (&v)[8]) { u32x4 w; w.x = pk2(v[0], v[1]); w.y = pk2(v[2], v[3]); w.z = pk2(v[4], v[5]); w.w = pk2(v[6], v[7]); *(u32x4*)p = w; }
__device__ __forceinline__ void ldf8(const float* p, float (&v)[8]) { const f32x4 a = *(const f32x4*)p, b = *(const f32x4*)(p + 4); v[0] = a[0]; v[1] = a[1]; v[2] = a[2]; v[3] = a[3]; v[4] = b[0]; v[5] = b[1]; v[6] = b[2]; v[7] = b[3]; }

template <class Fsrc, bool F8 = false>
__device__ __forceinline__ void tr_matrix(const Frame& F, Fsrc f, int nrows, int K, bf16* dst) {
    LAS float* scr = (LAS float*)(F.lds + F.wave * 16384);
    const int gw = F.bid * 8 + F.wave, NGW = F.G * 8, lane = F.lane;
    const int nblk = nrows / 32, nitems = (K / 64) * nblk;
    const int kq = lane >> 3, n4 = (lane & 7) * 4;
    for (int it = gw; it < nitems; it += NGW) {
        const int kb = it / nblk, nb = it % nblk, k0 = 64 * kb, n0 = 32 * nb;
        f32x4 v[8];
#pragma unroll
        for (int i = 0; i < 8; ++i) v[i] = f(n0 + n4, k0 + 8 * i + kq);
#pragma unroll
        for (int i = 0; i < 8; ++i) { LAS float* d = scr + (8 * i + kq) * 33 + n4; d[0] = v[i][0]; d[1] = v[i][1]; d[2] = v[i][2]; d[3] = v[i][3]; }
        LDS_WAIT(); asm volatile("" ::: "memory");
        const int c = lane & 7;
#pragma unroll
        for (int j = 0; j < 4; ++j) { const int n = (lane >> 3) + 8 * j; const LAS float* sp = scr + (8 * c) * 33 + n;
            if constexpr (F8) { u32x2 o; o.x = pk4_fp8(sp[0 * 33], sp[1 * 33], sp[2 * 33], sp[3 * 33]); o.y = pk4_fp8(sp[4 * 33], sp[5 * 33], sp[6 * 33], sp[7 * 33]);
                *(u32x2*)((unsigned char*)dst + (size_t)(n0 + n) * K + k0 + 8 * c) = o; }
            else { u32x4 o; o.x = pk2(sp[0 * 33], sp[1 * 33]); o.y = pk2(sp[2 * 33], sp[3 * 33]); o.z = pk2(sp[4 * 33], sp[5 * 33]); o.w = pk2(sp[6 * 33], sp[7 * 33]);
                *(u32x4*)(dst + (size_t)(n0 + n) * K + k0 + 8 * c) = o; } }
        LDS_WAIT(); asm volatile("" ::: "memory");
    }
}
#define F4Z ((f32x4){0.f, 0.f, 0.f, 0.f})
struct SrcWP { const float* win; const float* vres; const float* gain; int l, NP;
    __device__ __forceinline__ f32x4 operator()(int n, int k) const {
        f32x4 v;
        if (n < 5848) v = *(const f32x4*)(win + (size_t)k * NIN + n);
        else if (n < NP) v = (l == 1 && n < 5912) ? *(const f32x4*)(vres + (size_t)k * 64 + (n - 5848)) : F4Z;
        else v = *(const f32x4*)(win + (size_t)k * NIN + PC_GATE + 4 * 2048 + (n - NP));
        return v * gain[k]; } };
struct SrcWG4 { const float* win; const float* gain;
    __device__ __forceinline__ f32x4 operator()(int n, int k) const { return *(const f32x4*)(win + (size_t)k * NIN + PC_GATE + 4 * 2048 + n) * (gain[k] * W8S); } };
struct SrcWG { const float* win; const float* gain; float sc;
    __device__ __forceinline__ f32x4 operator()(int n, int k) const {
        const int j = n >> 8, rho = n & 255, bj = rho >> 7, wc = (rho >> 5) & 3, nn = (rho >> 4) & 1, q = (rho >> 2) & 3;
        const int br = 2 * bj + nn, c = 64 * j + 16 * wc + 4 * q;
        return *(const f32x4*)(win + (size_t)k * NIN + PC_GATE + br * 2048 + c) * (gain[k] * sc); } };
struct SrcWB { const float* wb; const float* pw; const float* ps;
    __device__ __forceinline__ f32x4 operator()(int n, int k) const {
        if (n < 8192) { const int i = n >> 11, c = n & 2047; return *(const f32x4*)(wb + ((size_t)i * 512 + k) * 2048 + c); }
        const int c = n - 8192, g = c >> 9;
        if ((k >> 7) != g) return F4Z;
        return *(const f32x4*)(pw + ((size_t)g * 128 + (k & 127)) * 512 + (c & 511)) * *(const f32x4*)(ps + c); } };
struct SrcPlain { const float* w; int ldw;
    __device__ __forceinline__ f32x4 operator()(int n, int k) const { return *(const f32x4*)(w + (size_t)k * ldw + n); } };
struct SrcPlainS { const float* w; int ldw; float sc;
    __device__ __forceinline__ f32x4 operator()(int n, int k) const { return *(const f32x4*)(w + (size_t)k * ldw + n) * sc; } };
struct SrcPlainG { const float* w; int ldw; const float* gain;
    __device__ __forceinline__ f32x4 operator()(int n, int k) const { return *(const f32x4*)(w + (size_t)k * ldw + n) * gain[k]; } };
struct SrcLora { const float* w2; const float* a2; const float* g2; const float* vup; int l;
    __device__ __forceinline__ f32x4 operator()(int n, int k) const {
        const int blk = n >> 9, j = n & 511;
        if (blk == 0) return k < 96 ? *(const f32x4*)(w2 + (size_t)k * 512 + j) : F4Z;
        if (blk == 1) return (k >= 96 && k < 192) ? *(const f32x4*)(a2 + (size_t)(k - 96) * 512 + j) : F4Z;
        if (blk == 2) return (k >= 192 && k < 448) ? *(const f32x4*)(g2 + (size_t)(k - 192) * 512 + j) : F4Z;
        return (l == 1 && k >= 448) ? *(const f32x4*)(vup + (size_t)(k - 448) * 512 + j) : F4Z; } };
struct SrcC1 { const float* w1;
    __device__ __forceinline__ f32x4 operator()(int n, int k) const { const int i = n >> 8, c = n & 255; return c < 128 ? *(const f32x4*)(w1 + ((size_t)i * 2048 + k) * 128 + c) : F4Z; } };
struct SrcW13 { const float* w1; const float* w3; const float* gain; int ffw; float sc;
    __device__ __forceinline__ f32x4 operator()(int n, int k) const { const int t = n >> 8, which = (n >> 7) & 1, ff = 128 * t + (n & 127);
        const uintptr_t a = (uintptr_t)w1, dlt = (uintptr_t)w3 - a; const float* p = (const float*)(a + (which ? dlt : (uintptr_t)0));
        return *(const f32x4*)(p + (size_t)k * ffw + ff) * (gain[k] * sc); } };

__device__ __forceinline__ void phase_prologue(const Frame& F0) {
    const Frame F = relaunder(F0);
    unsigned char* ws = F.ws;
    for (int l = 0; l < 2; ++l) {
        const float* win = INP(5) + (size_t)l * D * NIN; const float* gmix = INP(2) + l * D;
        tr_matrix(F, SrcWP{win, INP(17), gmix, l, l ? NP1 : NP0}, (l ? NP1 : NP0), 2048, (bf16*)(ws + (l ? WS_WPT1 : WS_WPT0)));
        tr_matrix<SrcWG4, true>(F, SrcWG4{win, gmix}, 2048, 2048, (bf16*)(ws + (l ? WS_WG4T1 : WS_WG4T0)));
        tr_matrix<SrcWG, F8_G != 0>(F, SrcWG{win, gmix, F8_G ? W8S : 1.f}, 8192, 2048, (bf16*)(ws + (l ? WS_WGT1 : WS_WGT0)));
        tr_matrix(F, SrcWB{INP(31) + (size_t)l * 4 * 512 * 2048, INP(27) + (size_t)l * 4 * 128 * 512, INP(28) + l * D}, 10240, 512, (bf16*)(ws + (l ? WS_WBT1 : WS_WBT0)));
        tr_matrix(F, SrcPlain{INP(32) + (size_t)l * D * D, D}, 2048, 2048, (bf16*)(ws + (l ? WS_WOT1 : WS_WOT0)));
        tr_matrix(F, SrcLora{INP(8) + (size_t)l * 96 * 512, INP(10) + (size_t)l * 96 * 512, INP(11) + (size_t)l * 256 * 512, INP(20), l}, 2048, 512, (bf16*)(ws + (l ? WS_WLT1 : WS_WLT0)));
        tr_matrix(F, SrcPlainG{INP(29) + (size_t)l * D * 1024, 1024, INP(4) + l * D}, 1024, 2048, (bf16*)(ws + (l ? WS_WKVT1 : WS_WKVT0)));
        tr_matrix(F, SrcC1{INP(23) + (size_t)l * 2 * 2048 * 128}, 512, 2048, (bf16*)(ws + (l ? WS_WC1T1 : WS_WC1T0)));
        for (int i = 0; i < 2; ++i) tr_matrix(F, SrcPlain{INP(25) + (size_t)(l * 2 + i) * 128 * 64, 64}, 64, 128, (bf16*)(ws + WS_WC2T) + (size_t)(l * 2 + i) * 64 * 128);
    }
    tr_matrix<SrcW13, F8_F1 != 0>(F, SrcW13{INP(33), INP(34), INP(3), FF, F8_F1 ? W8S : 1.f}, 2 * FF, 2048, (bf16*)(ws + WS_W13T));
    tr_matrix(F, SrcPlain{INP(35), D}, 2048, FF, (bf16*)(ws + WS_W2T));
    for (int e = 0; e < NE; ++e) {
        tr_matrix<SrcW13, F8_M1 != 0>(F, SrcW13{INP(37) + (size_t)e * D * EFF, INP(38) + (size_t)e * D * EFF, INP(3) + D, EFF, F8_M1 ? W8S : 1.f}, 2 * EFF, 2048, (bf16*)(ws + WS_MW13T + (size_t)e * 2 * EFF * 2048 * (F8_M1 ? 1 : 2)));
        tr_matrix<SrcPlainS, F8_M2 != 0>(F, SrcPlainS{INP(39) + (size_t)e * EFF * D, D, F8_M2 ? W8S : 1.f}, 2048, EFF, (bf16*)(ws + WS_MW2T + (size_t)e * 2048 * EFF * (F8_M2 ? 1 : 2)));
    }
    const int gw = F.bid * 8 + F.wave, NGW = F.G * 8;
    u64* ssq = (u64*)(F.ctl + CW_SSQ);
    for (int base = F.bid * 16; base < M + 512; base += F.G * 16) for (int q = 0; q < 2; ++q) { const int m = base + F.wave * 2 + q;
        const bool ismem = m >= M; const float* src = ismem ? INP(1) + (size_t)(m - M) * D : INP(0) + (size_t)m * D;
        const f32x4* xr = (const f32x4*)src + F.lane; f32x4 v[8]; float s = 0.f;
#pragma unroll
        for (int j = 0; j < 8; ++j) { v[j] = xr[64 * j]; s += (v[j][0] * v[j][0] + v[j][1] * v[j][1]) + (v[j][2] * v[j][2] + v[j][3] * v[j][3]); }
        s = wave_sum(s);
        float sc = 1.f;
        if (ismem) sc = 1.0f / sqrtf(s * (1.f / D) + NORM_EPS); else if (F.lane == 0) ssq[m] = ssq_fix(s);
        bf16* dst = ismem ? (bf16*)(ws + WS_MEMN) + (size_t)(m - M) * D : (bf16*)(ws + WS_XH) + (size_t)m * D;
#pragma unroll
        for (int j = 0; j < 8; ++j) { u32x2 w; w.x = pk2(v[j][0] * sc, v[j][1] * sc); w.y = pk2(v[j][2] * sc, v[j][3] * sc); *((u32x2*)dst + F.lane + 64 * j) = w;
            if (!ismem) *((unsigned*)(ws + WS_XH8 + (size_t)m * D) + F.lane + 64 * j) = pk4_fp8(v[j][0], v[j][1], v[j][2], v[j][3]); }
    }
}

__device__ __forceinline__ float shiftP(const bf16* P, int m, int t, int col, float mu) {
    const float u = ldbf(P + (size_t)m * LDP + col); const float pv = t > 0 ? ldbf(P + (size_t)(m - 1) * LDP + col) : 0.f; return u + (pv - u) * mu;
}
__device__ __forceinline__ void phase_prep(const Frame& F0, int l) {
    const Frame F = relaunder(F0);
    unsigned char* ws = F.ws; const bf16* P = (const bf16*)(ws + WS_P);
    const float* mu = INP(6) + l * 1984; const float* vmu = INP(18);
    bf16* AL = (bf16*)(ws + WS_ALORA); bf16* QN = (bf16*)(ws + WS_QN); bf16* QM = (bf16*)(ws + WS_QM); bf16* Y = (bf16*)(ws + WS_Y);
    const float* qkg = INP(21) + l * 4 * 64; const float* mqg = INP(30) + l * 2 * 128;
    const float* cpos = INP(22) + (size_t)l * 2 * 32 * 64; const float* cw = INP(26) + l * 3 * 512;
    const int tid = F.tid, lane = F.lane, wave = F.wave;
    for (int tile = F.bid; tile < M / 32; tile += F.G) {
        const int m0 = tile * 32, b = m0 / T, t0 = m0 % T;
#pragma unroll
        for (int it_ = 0; it_ < 4; ++it_) { const int it = tid + it_ * 512; const int tt = it >> 6, g = it & 63, c = g * 8, m = m0 + tt, t = t0 + tt;
            int pc, kind; const float* mup;
            if (c < 96) { pc = PC_WD + c; kind = 0; mup = mu + pc; } else if (c < 192) { pc = PC_AD + c - 96; kind = 1; mup = mu + pc; }
            else if (c < 448) { pc = PC_GD + c - 192; kind = 2; mup = mu + pc; } else { pc = PC_VRES + c - 448; kind = 3; mup = vmu + (c - 448); }
            float o[8];
            if (kind == 3 && l == 0) {
#pragma unroll
                for (int j = 0; j < 8; ++j) o[j] = 0.f; }
            else { float u[8], pv[8], mm[8]; ld8(P + (size_t)m * LDP + pc, u); ldf8(mup, mm);
                if (t > 0) ld8(P + (size_t)(m - 1) * LDP + pc, pv); else {
#pragma unroll
                    for (int j = 0; j < 8; ++j) pv[j] = 0.f; }
#pragma unroll
                for (int j = 0; j < 8; ++j) { const float x = u[j] + (pv[j] - u[j]) * mm[j]; o[j] = kind == 0 ? tanhf(x) : (kind == 2 ? sigmoidf_(x) : x); } }
            st8(AL + (size_t)m * 512 + c, o); }
        for (int tt = wave; tt < 32; tt += 8) { const int m = m0 + tt;
            { float v[8]; float s = 0.f; const u32x4 raw = *(const u32x4*)(P + (size_t)m * LDP + PC_Q + lane * 8);
              v[0] = bf2f(raw.x & 0xffffu); v[1] = bf2f(raw.x >> 16); v[2] = bf2f(raw.y & 0xffffu); v[3] = bf2f(raw.y >> 16); v[4] = bf2f(raw.z & 0xffffu); v[5] = bf2f(raw.z >> 16); v[6] = bf2f(raw.w & 0xffffu); v[7] = bf2f(raw.w >> 16);
#pragma unroll
              for (int j = 0; j < 8; ++j) s += v[j] * v[j];
              s += __shfl_xor(s, 1); s += __shfl_xor(s, 2); s += __shfl_xor(s, 4);
              const float rs = CQ_NSA / sqrtf(s * (1.f / 64.f) + NORM_EPS); const int d0 = (lane & 7) * 8;
              u32x4 w; w.x = pk2(v[0] * rs * qkg[d0 + 0], v[1] * rs * qkg[d0 + 1]); w.y = pk2(v[2] * rs * qkg[d0 + 2], v[3] * rs * qkg[d0 + 3]); w.z = pk2(v[4] * rs * qkg[d0 + 4], v[5] * rs * qkg[d0 + 5]); w.w = pk2(v[6] * rs * qkg[d0 + 6], v[7] * rs * qkg[d0 + 7]);
              *(u32x4*)(QN + (size_t)m * 512 + lane * 8) = w; }
            { float v[8]; float s = 0.f; const u32x4 raw = *(const u32x4*)(P + (size_t)m * LDP + PC_MEM + lane * 8);
              v[0] = bf2f(raw.x & 0xffffu); v[1] = bf2f(raw.x >> 16); v[2] = bf2f(raw.y & 0xffffu); v[3] = bf2f(raw.y >> 16); v[4] = bf2f(raw.z & 0xffffu); v[5] = bf2f(raw.z >> 16); v[6] = bf2f(raw.w & 0xffffu); v[7] = bf2f(raw.w >> 16);
#pragma unroll
              for (int j = 0; j < 8; ++j) s += v[j] * v[j];
              s += __shfl_xor(s, 1); s += __shfl_xor(s, 2); s += __shfl_xor(s, 4); s += __shfl_xor(s, 8);
              const float rs = CQ_MEM / sqrtf(s * (1.f / 128.f) + NORM_EPS); const int d0 = (lane & 15) * 8;
              u32x4 w; w.x = pk2(v[0] * rs * mqg[d0 + 0], v[1] * rs * mqg[d0 + 1]); w.y = pk2(v[2] * rs * mqg[d0 + 2], v[3] * rs * mqg[d0 + 3]); w.z = pk2(v[4] * rs * mqg[d0 + 4], v[5] * rs * mqg[d0 + 5]); w.w = pk2(v[6] * rs * mqg[d0 + 6], v[7] * rs * mqg[d0 + 7]);
              *(u32x4*)(QM + (size_t)m * 512 + lane * 8) = w; }
            for (int which = 0; which < 2; ++which) { const int pc = which ? PC_KW : PC_KS; const float* gn = qkg + (which ? 3 : 2) * 64;
                const unsigned raw = *(const unsigned*)(P + (size_t)m * LDP + pc + lane * 2); const float a = bf2f(raw & 0xffffu), c2 = bf2f(raw >> 16);
                float s = a * a + c2 * c2; s += __shfl_xor(s, 1); s += __shfl_xor(s, 2); s += __shfl_xor(s, 4); s += __shfl_xor(s, 8); s += __shfl_xor(s, 16);
                const float rs = 1.0f / sqrtf(s * (1.f / 64.f) + NORM_EPS); const int kvh = lane >> 5, d = (lane & 31) * 2;
                bf16* dst = (bf16*)(ws + (which ? WS_KW : WS_KS)) + ((size_t)(b * 2 + kvh) * T + (t0 + tt)) * 64 + d;
                *(unsigned*)dst = pk2(a * rs * gn[d], c2 * rs * gn[d + 1]); }
        }
        if ((tile & 1) == 0) { const int col = tid & 127, tq = tid >> 7, kvh = col >> 6, d = col & 63;
          for (int which = 0; which < 2; ++which) { const int pc = which ? PC_VW : PC_VS;
            for (int q2 = 0; q2 < 2; ++q2) { const int tg = tq + 4 * q2; unsigned short v[8];
#pragma unroll
              for (int i = 0; i < 8; ++i) v[i] = P[(size_t)(m0 + tg * 8 + i) * LDP + pc + col];
              u32x4 w; w.x = v[0] | ((unsigned)v[1] << 16); w.y = v[2] | ((unsigned)v[3] << 16); w.z = v[4] | ((unsigned)v[5] << 16); w.w = v[6] | ((unsigned)v[7] << 16);
              *(u32x4*)((bf16*)(ws + (which ? WS_VWT : WS_VST)) + ((size_t)(b * 2 + kvh) * 64 + d) * T + t0 + tg * 8) = w; } } }
#pragma unroll
        for (int it_ = 0; it_ < 2; ++it_) { const int it = tid + it_ * 512; const int tt = it >> 5, r = (it & 31) * 8, i = r >> 7, h = (r >> 6) & 1, d = r & 63, t = t0 + tt, m = m0 + tt;
            float v[8], p1[8], o[8]; ld8(P + (size_t)m * LDP + PC_KC + r, v);
            bf16* A = (bf16*)(ws + WS_ACMP) + (size_t)i * 1024 * 2048;
            const int c1 = t >> 4, l1 = t & 15;
            if (c1 <= 254) { ldf8(cpos + (i * 32 + l1) * 64 + d, p1);
#pragma unroll
                for (int j = 0; j < 8; ++j) o[j] = v[j] + p1[j];
                st8(A + ((size_t)(b * 256 + c1) * 2 + h) * 2048 + l1 * 64 + d, o); }
            if (c1 >= 1) { ldf8(cpos + (i * 32 + l1 + 16) * 64 + d, p1);
#pragma unroll
                for (int j = 0; j < 8; ++j) o[j] = v[j] + p1[j];
                st8(A + ((size_t)(b * 256 + c1 - 1) * 2 + h) * 2048 + (l1 + 16) * 64 + d, o); } }
#pragma unroll
        for (int it_ = 0; it_ < 4; ++it_) { const int it = tid + it_ * 512; const int tt = it >> 6, c = (it & 63) * 8, m = m0 + tt, t = t0 + tt;
            float acc[8], bg[8];
#pragma unroll
            for (int j = 0; j < 8; ++j) acc[j] = 0.f;
#pragma unroll
            for (int k = 0; k < 3; ++k) { const int dt = 2 - k; if (t - dt >= 0) { float cg[8], xg[8], wv[8]; const size_t o = (size_t)(m - dt) * LDP; ld8(P + o + PC_CC + c, cg); ld8(P + o + PC_CX + c, xg); ldf8(cw + k * 512 + c, wv);
#pragma unroll
                    for (int j = 0; j < 8; ++j) acc[j] += wv[j] * cg[j] * xg[j]; } }
            ld8(P + (size_t)m * LDP + PC_CB + c, bg);
#pragma unroll
            for (int j = 0; j < 8; ++j) acc[j] *= bg[j];
            st8(Y + (size_t)m * 2560 + 1024 + c, acc); }
        { const int cgp = tid & 63, tg = tid >> 6, c = cgp * 8, w = 2 << (cgp >> 4); const int ts = t0 + tg * 4, ms = m0 + tg * 4;
          float sum[8];
#pragma unroll
          for (int j = 0; j < 8; ++j) sum[j] = 0.f;
#pragma unroll
          for (int k = 1; k < 16; ++k) if (k < w && ts - k >= 0) { float u[8]; ld8(P + (size_t)(ms - k) * LDP + PC_POOL + c, u);
#pragma unroll
              for (int j = 0; j < 8; ++j) sum[j] += u[j]; }
          for (int q = 0; q < 4; ++q) { const int t = ts + q, m = ms + q; float u[8], o[8]; ld8(P + (size_t)m * LDP + PC_POOL + c, u);
#pragma unroll
              for (int j = 0; j < 8; ++j) sum[j] += u[j];
              const int cnt = (t + 1) < w ? (t + 1) : w; const float ic = 1.f / (float)cnt;
#pragma unroll
              for (int j = 0; j < 8; ++j) o[j] = sum[j] * ic - u[j];
              st8(Y + (size_t)m * 2560 + 2048 + c, o);
              if (t - w + 1 >= 0) { float ud[8]; ld8(P + (size_t)(m - w + 1) * LDP + PC_POOL + c, ud);
#pragma unroll
                  for (int j = 0; j < 8; ++j) sum[j] -= ud[j]; } } }
    }
    { const float* KV = (const float*)(ws + WS_KVRAW) + l * 1024; bf16* KM = (bf16*)(ws + WS_KMEM); bf16* VM = (bf16*)(ws + WS_VMEMT); const float* kg = mqg + 128;
      for (int r = F.bid * 8 + wave; r < 512; r += F.G * 8) { const int b = r >> 8, j = r & 255;
          for (int h = 0; h < 4; ++h) { const float a = KV[(size_t)r * 2048 + h * 128 + lane], c2 = KV[(size_t)r * 2048 + h * 128 + 64 + lane];
              const float s = wave_sum(a * a + c2 * c2); const float rs = 1.0f / sqrtf(s * (1.f / 128.f) + NORM_EPS);
              bf16* dst = KM + ((size_t)(b * 4 + h) * 256 + j) * 128; dst[lane] = (bf16)f2bf(a * rs * kg[lane]); dst[64 + lane] = (bf16)f2bf(c2 * rs * kg[64 + lane]); } }
      for (int it = F.bid * 8 + wave; it < 1024; it += F.G * 8) { const int b = it >> 9, h = (it >> 7) & 3, d = it & 127;
#pragma unroll
          for (int k = 0; k < 4; ++k) { const int j = lane + 64 * k; VM[((size_t)(b * 4 + h) * 128 + d) * 256 + j] = (bf16)f2bf(KV[(size_t)(b * 256 + j) * 2048 + 512 + h * 128 + d]); } } }
}

template <int DH> struct AttL { static constexpr int KB = 64 * (DH + 8) * 2, VB = DH * 72 * 2, BUF = KB + VB, PW = 2 * BUF, END = PW + 8 * 16 * 72 * 2; };
constexpr int AT_PT = AttL<64>::END, AT_IMP = AT_PT + 32768, AT_SEL = AT_IMP + 8192, AT_UNI = AT_SEL + 256;
static_assert(AttL<128>::END <= RING_BYTES && AT_UNI + 64 <= RING_BYTES, "attention LDS map");
template <int DH, int MODE>
__device__ __forceinline__ void attn_pass(LAS unsigned char* lds, int tid, int lane, int wave, const bf16* Kg, const bf16* VTg, int ldvt, int jlo, int jhi,
                                          const bf16x8 (&qf)[DH / 32], f32x4 (&O)[DH / 16], float (&lsum)[4], int trow, unsigned sel0, unsigned sel1, unsigned uni0, unsigned uni1) {
    typedef AttL<DH> L;
    constexpr int KS = DH + 8;
    LAS bf16* PW = (LAS bf16*)(lds + L::PW) + wave * 16 * 72;
    const unsigned long long um = MODE == 2 ? (((unsigned long long)uni1 << 32) | uni0) : ~0ull;
    auto next_tile = [&](int from) -> int {
        if (from > jhi) return jhi + 1;
        if (MODE != 2) return from;
        const unsigned long long m = um >> from; if (m == 0ull) return jhi + 1;
        const int nx = from + __builtin_ctzll(m); return nx > jhi ? jhi + 1 : nx; };
    u32x4 kreg[DH / 64], vreg[DH / 64];
#define AT_LOADREGS(jt) do { _Pragma("unroll") for (int i = 0; i < DH / 64; ++i) { const int e = tid + i * 512; const int kr = e / (DH / 8), kc = (e % (DH / 8)) * 8; const int vr = e >> 3, vc = (e & 7) * 8; \
        kreg[i] = *(const u32x4*)(Kg + (size_t)(64 * (jt) + kr) * DH + kc); vreg[i] = *(const u32x4*)(VTg + (size_t)vr * ldvt + 64 * (jt) + vc); } } while (0)
#define AT_WRITELDS(bf) do { LAS bf16* KTw = (LAS bf16*)(lds + (bf) * L::BUF); LAS bf16* VTw = (LAS bf16*)(lds + (bf) * L::BUF + L::KB); \
        _Pragma("unroll") for (int i = 0; i < DH / 64; ++i) { const int e = tid + i * 512; const int kr = e / (DH / 8), kc = (e % (DH / 8)) * 8; const int vr = e >> 3, vc = (e & 7) * 8; \
        const int krp = 16 * (2 * (kr >> 5) + (kr & 1)) + ((kr >> 1) & 15); \
        *(LAS u32x4*)(KTw + krp * KS + kc) = kreg[i]; *(LAS u32x4*)(VTw + vr * 72 + vc) = vreg[i]; } } while (0)
    int jc = next_tile(jlo);
    if (jc > jhi) return;
    AT_LOADREGS(jc);
    __syncthreads();
    AT_WRITELDS(0);
    int jn = next_tile(jc + 1);
    if (jn <= jhi) AT_LOADREGS(jn);
    LDS_WAIT(); __syncthreads();
    int cur = 0;
    for (;;) {
        int jnn = jhi + 1;
        if (jn <= jhi) { AT_WRITELDS(cur ^ 1); jnn = next_tile(jn + 1); if (jnn <= jhi) AT_LOADREGS(jnn); }
        const int j = jc;
        const LAS bf16* KT = (const LAS bf16*)(lds + cur * L::BUF); const LAS bf16* VT = (const LAS bf16*)(lds + cur * L::BUF + L::KB);
        bool doit = true;
        if (MODE == 2) { const unsigned sb = j < 32 ? (sel0 >> j) : (sel1 >> (j - 32)); doit = __builtin_amdgcn_ballot_w64((sb & 1u) != 0u) != 0ull; }
        if (doit) {
        f32x4 S[4];
        { bf16x8 kfr[4][DH / 32];
#pragma unroll
          for (int n = 0; n < 4; ++n)
#pragma unroll
              for (int ks = 0; ks < DH / 32; ++ks) kfr[n][ks] = *(const LAS bf16x8*)(KT + (16 * n + (lane & 15)) * KS + ks * 32 + 8 * (lane >> 4));
          LDS_WAIT(); __builtin_amdgcn_sched_barrier(0);
#pragma unroll
          for (int n = 0; n < 4; ++n) { S[n] = (f32x4){0.f, 0.f, 0.f, 0.f};
#pragma unroll
              for (int ks = 0; ks < DH / 32; ++ks) S[n] = __builtin_amdgcn_mfma_f32_16x16x32_bf16(qf[ks], kfr[n][ks], S[n], 0, 0, 0); }
          __builtin_amdgcn_sched_barrier(0); }
        bool valid[4];
#pragma unroll
        for (int n = 0; n < 4; ++n) { const int key = 64 * j + 32 * (n >> 1) + 2 * (lane & 15) + (n & 1);
            if (MODE == 0) valid[n] = true;
            else if (MODE == 1) valid[n] = (key <= 254) && (16 * key + 31 <= trow);
            else if (MODE == 2) { const unsigned sb = j < 32 ? (sel0 >> j) : (sel1 >> (j - 32)); valid[n] = (sb & 1u) && key <= trow; }
            else valid[n] = key <= trow && key > trow - 512; }
#pragma unroll
        for (int a2 = 0; a2 < 2; ++a2)
#pragma unroll
            for (int r = 0; r < 4; ++r) { float p0 = __builtin_amdgcn_exp2f(S[2 * a2][r]), p1 = __builtin_amdgcn_exp2f(S[2 * a2 + 1][r]);
                if (MODE != 0) { p0 = valid[2 * a2] ? p0 : 0.f; p1 = valid[2 * a2 + 1] ? p1 : 0.f; }
                lsum[r] += p0 + p1;
                *(LAS unsigned*)(PW + (4 * (lane >> 4) + r) * 72 + 32 * a2 + 2 * (lane & 15)) = pk2(p0, p1); }
        LDS_WAIT(); asm volatile("" ::: "memory");
        { bf16x8 pfr[2], vfr[2][DH / 16];
#pragma unroll
          for (int ks = 0; ks < 2; ++ks) { pfr[ks] = *(const LAS bf16x8*)(PW + (lane & 15) * 72 + ks * 32 + 8 * (lane >> 4));
#pragma unroll
              for (int nd = 0; nd < DH / 16; ++nd) vfr[ks][nd] = *(const LAS bf16x8*)(VT + (16 * nd + (lane & 15)) * 72 + ks * 32 + 8 * (lane >> 4)); }
          LDS_WAIT(); __builtin_amdgcn_sched_barrier(0);
#pragma unroll
          for (int ks = 0; ks < 2; ++ks)
#pragma unroll
              for (int nd = 0; nd < DH / 16; ++nd) O[nd] = __builtin_amdgcn_mfma_f32_16x16x32_bf16(pfr[ks], vfr[ks][nd], O[nd], 0, 0, 0);
          __builtin_amdgcn_sched_barrier(0); }
        }
        if (jn > jhi) break;
        LDS_WAIT(); __syncthreads();
        cur ^= 1; jc = jn; jn = jnn;
    }
#undef AT_LOADREGS
#undef AT_WRITELDS
}

__device__ __forceinline__ void phase_memattn(const Frame& F0) {
    const Frame F = relaunder(F0);
    unsigned char* ws = F.ws; const bf16* QM = (const bf16*)(ws + WS_QM); const bf16* KM = (const bf16*)(ws + WS_KMEM); const bf16* VM = (const bf16*)(ws + WS_VMEMT); bf16* Y = (bf16*)(ws + WS_Y);
    const int lane = F.lane, wave = F.wave; const float c = 0.08838834764831845f * 1.4426950408889634f;
    for (int u = F.bid; u < 256; u += F.G) { const int b = u >> 7, h = (u >> 5) & 3, tile = u & 31; const int m0 = b * T + tile * 128 + wave * 16;
        bf16x8 qf[4];
#pragma unroll
        for (int ks = 0; ks < 4; ++ks) qf[ks] = *(const bf16x8*)(QM + (size_t)(m0 + (lane & 15)) * 512 + h * 128 + ks * 32 + 8 * (lane >> 4));
        f32x4 O[8]; float ls[4];
#pragma unroll
        for (int i = 0; i < 8; ++i) O[i] = (f32x4){0.f, 0.f, 0.f, 0.f};
#pragma unroll
        for (int r = 0; r < 4; ++r) ls[r] = 0.f;
        attn_pass<128, 0>(F.lds, F.tid, lane, wave, KM + (size_t)(b * 4 + h) * 256 * 128, VM + (size_t)(b * 4 + h) * 128 * 256, 256, 0, 3, qf, O, ls, 0, 0u, 0u, 0u, 0u);
#pragma unroll
        for (int r = 0; r < 4; ++r) { const float lr = red16_sum(ls[r]); const float inv = lr > 0.f ? 1.f / lr : 0.f; const int m = m0 + 4 * (lane >> 4) + r;
#pragma unroll
            for (int nd = 0; nd < 8; ++nd) Y[(size_t)m * 2560 + 1536 + h * 128 + 16 * nd + (lane & 15)] = (bf16)f2bf(O[nd][r] * inv); }
        __syncthreads();
    }
}

__device__ __forceinline__ void phase_nsa(const Frame& F0, unsigned* qctr) {
    const Frame F = relaunder(F0);
    unsigned char* ws = F.ws; const bf16* P = (const bf16*)(ws + WS_P); const bf16* QN = (const bf16*)(ws + WS_QN); bf16* Y = (bf16*)(ws + WS_Y);
    const int lane = F.lane, wave = F.wave, tid = F.tid; const float c = 0.125f * 1.4426950408889634f;
    LAS float* PT = (LAS float*)(F.lds + AT_PT); LAS float* IMP = (LAS float*)(F.lds + AT_IMP); LAS unsigned* SEL = (LAS unsigned*)(F.lds + AT_SEL); LAS unsigned* UNI = (LAS unsigned*)(F.lds + AT_UNI);
    LAS int* UQ = (LAS int*)(F.lds + AT_UNI + 16);
    int nxtq = 0; if (tid == 0) nxtq = (int)atomicAdd(qctr, 1u);
    for (;;) {
        __syncthreads();
        if (tid == 0) UQ[0] = nxtq;
        LDS_WAIT(); __syncthreads();
        const int uq = UQ[0]; if (uq >= 512) break;
        if (tid == 0) nxtq = (int)atomicAdd(qctr, 1u);
        const int tile = 127 - (uq >> 2), b = (uq >> 1) & 1, kvh = uq & 1;
        const int t0 = tile * 32, m0 = b * T + t0; const int cur = t0 >> 6;
        const int tl = wave * 4 + (lane >> 4);
        const int trow = t0 + tl;
        bf16x8 qf[2];
        { const int rho = lane & 15; const int mq = m0 + wave * 4 + (rho >> 2), g = rho & 3;
#pragma unroll
          for (int ks = 0; ks < 2; ++ks) qf[ks] = *(const bf16x8*)(QN + (size_t)mq * 512 + (kvh * 4 + g) * 64 + ks * 32 + 8 * (lane >> 4)); }
        const bf16* KCg = (const bf16*)(ws + WS_KC) + (size_t)(b * 2 + kvh) * 256 * 64; const bf16* VCg = (const bf16*)(ws + WS_VCT) + (size_t)(b * 2 + kvh) * 64 * 256;
        const bf16* KSg = (const bf16*)(ws + WS_KS) + (size_t)(b * 2 + kvh) * T * 64; const bf16* VSg = (const bf16*)(ws + WS_VST) + (size_t)(b * 2 + kvh) * 64 * T;
        const bf16* KWg = (const bf16*)(ws + WS_KW) + (size_t)(b * 2 + kvh) * T * 64; const bf16* VWg = (const bf16*)(ws + WS_VWT) + (size_t)(b * 2 + kvh) * 64 * T;
        f32x4 OF[4];
#pragma unroll
        for (int i = 0; i < 4; ++i) OF[i] = (f32x4){0.f, 0.f, 0.f, 0.f};
        float gate[3][4];
#pragma unroll
        for (int r = 0; r < 4; ++r)
#pragma unroll
            for (int k = 0; k < 3; ++k) gate[k][r] = sigmoidf_(ldbf(P + (size_t)(m0 + tl) * LDP + PC_GL + (kvh * 4 + r) * 3 + k));
        f32x4 O[4]; float lr[4];
#pragma unroll
        for (int i = 0; i < 4; ++i) O[i] = (f32x4){0.f, 0.f, 0.f, 0.f};
#pragma unroll
        for (int r = 0; r < 4; ++r) lr[r] = 0.f;
        attn_pass<64, 1>(F.lds, tid, lane, wave, KCg, VCg, 256, 0, 3, qf, O, lr, trow, 0u, 0u, 0u, 0u);
#pragma unroll
        for (int r = 0; r < 4; ++r) lr[r] = red16_sum(lr[r]);
#pragma unroll
        for (int r = 0; r < 4; ++r) { const float inv = lr[r] > 0.f ? 1.f / lr[r] : 0.f;
#pragma unroll
            for (int nd = 0; nd < 4; ++nd) OF[nd][r] += gate[0][r] * O[nd][r] * inv; }
        { LAS bf16* KT = (LAS bf16*)(F.lds);
          for (int j = 0; j < 4; ++j) {
              __syncthreads();
              { const int kr = tid >> 3, kc = (tid & 7) * 8; *(LAS u32x4*)(KT + kr * 72 + kc) = *(const u32x4*)(KCg + (size_t)(64 * j + kr) * 64 + kc); }
              LDS_WAIT(); __syncthreads();
              bf16x8 kfr[4][2]; f32x4 S4[4];
#pragma unroll
              for (int n = 0; n < 4; ++n)
#pragma unroll
                  for (int ks = 0; ks < 2; ++ks) kfr[n][ks] = *(const LAS bf16x8*)(KT + (16 * n + (lane & 15)) * 72 + ks * 32 + 8 * (lane >> 4));
              LDS_WAIT(); __builtin_amdgcn_sched_barrier(0);
#pragma unroll
              for (int n = 0; n < 4; ++n) { S4[n] = (f32x4){0.f, 0.f, 0.f, 0.f};
#pragma unroll
                  for (int ks = 0; ks < 2; ++ks) S4[n] = __builtin_amdgcn_mfma_f32_16x16x32_bf16(qf[ks], kfr[n][ks], S4[n], 0, 0, 0); }
              __builtin_amdgcn_sched_barrier(0);
#pragma unroll
              for (int n = 0; n < 4; ++n) { const f32x4 S = S4[n];
                  const int key = 64 * j + 16 * n + (lane & 15); const bool valid = (key <= 254) && (16 * key + 31 <= trow); float ps = 0.f;
#pragma unroll
                  for (int r = 0; r < 4; ++r) { const float inv = lr[r] > 0.f ? 1.f / lr[r] : 0.f; ps += valid ? __builtin_amdgcn_exp2f(S[r]) * inv : 0.f; }
                  PT[tl * 256 + key] = ps; } }
          if (tid < 64) SEL[tid] = 0u; if (tid < 2) UNI[tid] = 0u;
          LDS_WAIT(); __syncthreads(); }
        { const int tk = tid >> 4, sg = (tid & 15) * 4;
#pragma unroll
          for (int i = 0; i < 4; ++i) { const int s = sg + i; const LAS float* p = PT + tk * 256 + 4 * s; float v = p[0] + p[1] + p[2] + 0.5f * p[3]; if (s > 0) v += 0.5f * p[-1];
              const bool forced = (s == 0) || (s == cur) || (s == cur - 1); IMP[tk * 64 + s] = forced ? 1e9f : (s <= cur ? v : -1e9f); }
          LDS_WAIT(); __syncthreads();
          float mine[4]; int cnt[4];
#pragma unroll
          for (int i = 0; i < 4; ++i) { mine[i] = IMP[tk * 64 + sg + i]; cnt[i] = 0; }
          for (int s2 = 0; s2 < 64; ++s2) { const float o = IMP[tk * 64 + s2];
#pragma unroll
              for (int i = 0; i < 4; ++i) cnt[i] += (o > mine[i] || (o == mine[i] && s2 < sg + i)) ? 1 : 0; }
          unsigned bits = 0u;
#pragma unroll
          for (int i = 0; i < 4; ++i) if (cnt[i] < 16 && mine[i] > -1e8f) bits |= 1u << ((sg + i) & 31);
          if (bits) { atomicOr((unsigned*)(SEL + tk * 2 + (sg >> 5)), bits); atomicOr((unsigned*)(UNI + (sg >> 5)), bits); }
          LDS_WAIT(); __syncthreads(); }
        const unsigned sel0 = SEL[tl * 2], sel1 = SEL[tl * 2 + 1], uni0 = UNI[0], uni1 = UNI[1];
#pragma unroll
        for (int i = 0; i < 4; ++i) O[i] = (f32x4){0.f, 0.f, 0.f, 0.f};
#pragma unroll
        for (int r = 0; r < 4; ++r) lr[r] = 0.f;
        attn_pass<64, 2>(F.lds, tid, lane, wave, KSg, VSg, T, 0, cur, qf, O, lr, trow, sel0, sel1, uni0, uni1);
#pragma unroll
        for (int r = 0; r < 4; ++r) lr[r] = red16_sum(lr[r]);
#pragma unroll
        for (int r = 0; r < 4; ++r) { const float inv = lr[r] > 0.f ? 1.f / lr[r] : 0.f;
#pragma unroll
            for (int nd = 0; nd < 4; ++nd) OF[nd][r] += gate[1][r] * O[nd][r] * inv; }
#pragma unroll
        for (int i = 0; i < 4; ++i) O[i] = (f32x4){0.f, 0.f, 0.f, 0.f};
#pragma unroll
        for (int r = 0; r < 4; ++r) lr[r] = 0.f;
        { const int lo = t0 - 511; attn_pass<64, 3>(F.lds, tid, lane, wave, KWg, VWg, T, lo > 0 ? (lo >> 6) : 0, cur, qf, O, lr, trow, 0u, 0u, 0u, 0u); }
#pragma unroll
        for (int r = 0; r < 4; ++r) lr[r] = red16_sum(lr[r]);
#pragma unroll
        for (int r = 0; r < 4; ++r) { const float inv = lr[r] > 0.f ? 1.f / lr[r] : 0.f;
#pragma unroll
            for (int nd = 0; nd < 4; ++nd) OF[nd][r] += gate[2][r] * O[nd][r] * inv; }
#pragma unroll
        for (int r = 0; r < 4; ++r)
#pragma unroll
            for (int nd = 0; nd < 4; ++nd) Y[(size_t)(m0 + tl) * 2560 + 512 + (kvh * 4 + r) * 64 + 16 * nd + (lane & 15)] = (bf16)f2bf(OF[nd][r]);
        __syncthreads();
    }
}

constexpr int CL = 32, NCH = T / CL;
constexpr int SC_STEPS = 8;
__device__ __forceinline__ void phase_scan(const Frame& F0, int l) {
    const Frame F = relaunder(F0);
    unsigned char* ws = F.ws; const bf16* P = (const bf16*)(ws + WS_P); const float* LO = (const float*)(ws + WS_LO);
    float* VF = (float*)(ws + WS_VFIRST); float* VC = (float*)(ws + WS_VCUR); float* BON = (float*)(ws + WS_BON);
    float* YL = (float*)(ws + WS_YL); float* ZL = (float*)(ws + WS_ZL); float* QF = (float*)(ws + WS_QF); float* PF = (float*)(ws + WS_PF);
    const float* mu = INP(6) + l * 1984; const float* kk_ = INP(12) + l * 512; const float* ka_ = INP(13) + l * 512; const float* rk_ = INP(14) + l * 512;
    const int wave = F.wave;
    LAS float* ST = (LAS float*)F.lds + wave * (SC_STEPS * 5 * 64 + 64);
    for (int u = F.bid; u < 256; u += F.G) {
        int lane = F.lane; asm volatile("" : "+v"(lane));
        const int b = u >> 7, h = (u >> 4) & 7, cq = u & 15;
        const int jc = h * 64 + lane;
        const float mu_r = mu[PC_R + jc], mu_k = mu[PC_K + jc], mu_v = mu[PC_V + jc], kkw = kk_[jc], kaw = ka_[jc], rkw = rk_[jc];
        const int chunk = cq * 8 + wave;
        f32x2 Sq[32], Sp[32];
#pragma unroll
        for (int k = 0; k < 32; ++k) { Sq[k] = (f32x2){0.f, 0.f}; Sp[k] = (f32x2){(2 * k == lane) ? 1.f : 0.f, (2 * k + 1 == lane) ? 1.f : 0.f}; }
        const int tbase = chunk * CL;
        float gam = 1.f;
        for (int sb = 0; sb < CL / SC_STEPS; ++sb) {
            LDS_WAIT(); asm volatile("" ::: "memory");
#pragma unroll 1
            for (int hb = 0; hb < 2; ++hb) { const int st0 = hb * 4; const int tf = tbase + sb * SC_STEPS + st0, mf = b * T + tf;
              float ur[5], uk[5], uv[5], wv[4], av[4], vgv[4], vfv[4];
#pragma unroll
              for (int i = 0; i < 5; ++i) { const bool ok = (tf - 1 + i) >= 0; const bf16* pr = P + (size_t)(ok ? (mf - 1 + i) : mf) * LDP + h * 64;
                  const float sc = ok ? 1.f : 0.f;
                  ur[i] = ldbf(pr + PC_R + lane) * sc; uk[i] = ldbf(pr + PC_K + lane) * sc; uv[i] = ldbf(pr + PC_V + lane) * sc; }
#pragma unroll
              for (int i = 0; i < 4; ++i) { const float* lr = LO + (size_t)(mf + i) * 2048 + h * 64; wv[i] = lr[lane]; av[i] = lr[512 + lane];
                  vgv[i] = l ? lr[1536 + lane] : 0.f; vfv[i] = l ? (VF + (size_t)(mf + i) * 512 + h * 64)[lane] : 0.f; }
              float rr[4], kv[4], vv4[4], kmod4[4], red[8];
#pragma unroll
              for (int i = 0; i < 4; ++i) { const int m = mf + i;
                  const float r = ur[i + 1] + (ur[i] - ur[i + 1]) * mu_r, k = uk[i + 1] + (uk[i] - uk[i + 1]) * mu_k; float v = uv[i + 1] + (uv[i] - uv[i + 1]) * mu_v;
                  if (l == 0) (VF + (size_t)m * 512 + h * 64)[lane] = v; else v = v + (vfv[i] - v) * vgv[i];
                  (VC + (size_t)m * 512 + h * 64)[lane] = v;
                  const float kkv = k * kkw; const float kmod = k * (1.f + (av[i] - 1.f) * kaw);
                  rr[i] = r; kv[i] = kkv; vv4[i] = v; kmod4[i] = kmod; red[2 * i] = kkv * kkv; red[2 * i + 1] = r * kmod * rkw; }
#pragma unroll
              for (int o = 1; o < 64; o <<= 1) { float t8[8];
#pragma unroll
                  for (int j = 0; j < 8; ++j) t8[j] = __shfl_xor(red[j], o);
#pragma unroll
                  for (int j = 0; j < 8; ++j) red[j] += t8[j]; }
#pragma unroll
              for (int i = 0; i < 4; ++i) { const int m = mf + i; const float w = wv[i], a = av[i];
                  const float kkn = kv[i] * (1.0f / sqrtf(fmaxf(red[2 * i], 1e-24f)));
                  if (lane == 0) __hip_atomic_store((unsigned*)BON + (size_t)m * 8 + h, __builtin_bit_cast(unsigned, red[2 * i + 1]), RLX_AGENT);
                  const float gprev = gam; gam *= w; const float ig = 1.0f / gam;
                  LAS float* dst = ST + ((st0 + i) * 5) * 64 + lane;
                  dst[0] = kkn * gprev; dst[64] = kkn * a * ig; dst[128] = kmod4[i] * ig; dst[192] = rr[i] * gam; dst[256] = vv4[i]; } }
            LDS_WAIT(); asm volatile("" ::: "memory");
            for (int st = 0; st < SC_STEPS; ++st) { const LAS float* sp = ST + (st * 5) * 64; const int t = tbase + sb * SC_STEPS + st;
                const float vv = sp[256 + lane]; const f32x2 vv2 = (f32x2){vv, vv};
                f32x2 qa = (f32x2){0.f, 0.f}, qb = qa, pa = qa, pb = qa;
                { f32x4 buf[2][2];
#pragma unroll
                  for (int i = 0; i < 2; ++i) buf[0][i] = *(const LAS f32x4*)(sp + 4 * i);
#pragma unroll
                  for (int g = 0; g < 8; ++g) {
                      if (g < 7) {
#pragma unroll
                          for (int i = 0; i < 2; ++i) buf[(g + 1) & 1][i] = *(const LAS f32x4*)(sp + 8 * (g + 1) + 4 * i); }
                      asm volatile("" ::: "memory");
#pragma unroll
                      for (int i = 0; i < 2; ++i) { const int k2 = 4 * g + 2 * i; const f32x4 kk4 = buf[g & 1][i]; const f32x2 klo = (f32x2){kk4[0], kk4[1]}, khi = (f32x2){kk4[2], kk4[3]};
                          qa += Sq[k2] * klo; qb += Sq[k2 + 1] * khi; pa += Sp[k2] * klo; pb += Sp[k2 + 1] * khi; } } }
                const f32x2 qs = qa + qb, ps = pa + pb; const float nq = -(qs.x + qs.y), np = -(ps.x + ps.y); const f32x2 nq2 = (f32x2){nq, nq}, np2 = (f32x2){np, np};
                f32x2 ya = (f32x2){0.f, 0.f}, yb = ya, za = ya, zb = ya;
                { f32x4 bb[2], bk[2], br[2];
                  bb[0] = *(const LAS f32x4*)(sp + 64); bk[0] = *(const LAS f32x4*)(sp + 128); br[0] = *(const LAS f32x4*)(sp + 192);
#pragma unroll
                  for (int g = 0; g < 16; ++g) {
                      if (g < 15) { bb[(g + 1) & 1] = *(const LAS f32x4*)(sp + 64 + 4 * (g + 1)); bk[(g + 1) & 1] = *(const LAS f32x4*)(sp + 128 + 4 * (g + 1)); br[(g + 1) & 1] = *(const LAS f32x4*)(sp + 192 + 4 * (g + 1)); }
                      asm volatile("" ::: "memory");
                      { const int k2 = 2 * g; const f32x4 b4 = bb[g & 1], k4 = bk[g & 1], r4 = br[g & 1];
                        const f32x2 blo = (f32x2){b4[0], b4[1]}, bhi = (f32x2){b4[2], b4[3]}, klo = (f32x2){k4[0], k4[1]}, khi = (f32x2){k4[2], k4[3]}, rlo = (f32x2){r4[0], r4[1]}, rhi = (f32x2){r4[2], r4[3]};
                        Sq[k2] += vv2 * klo + nq2 * blo; Sq[k2 + 1] += vv2 * khi + nq2 * bhi; Sp[k2] += np2 * blo; Sp[k2 + 1] += np2 * bhi;
                        ya += Sq[k2] * rlo; yb += Sq[k2 + 1] * rhi; za += Sp[k2] * rlo; zb += Sp[k2 + 1] * rhi; } } }
                const f32x2 ys = ya + yb, zs = za + zb;
                const size_t o = (size_t)(b * T + t) * 512 + h * 64 + lane;
                YL[o] = ys.x + ys.y; ZL[o] = zs.x + zs.y; }
        }
        { LAS float* GL = ST + SC_STEPS * 5 * 64; LDS_WAIT(); asm volatile("" ::: "memory"); GL[lane] = gam; LDS_WAIT(); asm volatile("" ::: "memory");
#pragma unroll
          for (int k = 0; k < 32; k += 2) { const f32x4 g4 = *(const LAS f32x4*)(GL + 2 * k); const f32x2 glo = (f32x2){g4[0], g4[1]}, ghi = (f32x2){g4[2], g4[3]};
              Sq[k] *= glo; Sq[k + 1] *= ghi; Sp[k] *= glo; Sp[k + 1] *= ghi; } }
        { const size_t un = ((size_t)(b * 8 + h) * NCH + chunk) * 4096;
#pragma unroll
          for (int k = 0; k < 32; k += 4) { u32x4 w; w.x = pk2(Sq[k].x, Sq[k].y); w.y = pk2(Sq[k + 1].x, Sq[k + 1].y); w.z = pk2(Sq[k + 2].x, Sq[k + 2].y); w.w = pk2(Sq[k + 3].x, Sq[k + 3].y);
              *(u32x4*)((bf16*)QF + un + lane * 64 + 2 * k) = w; }
          { unsigned short* pf = (unsigned short*)PF + un + ((lane >> 2) & 3) * 16 + (lane >> 4) * 4 + (lane & 3);
#pragma unroll
            for (int k = 0; k < 32; ++k) { const unsigned w = pk2(Sp[k].x, Sp[k].y); pf[(2 * k) * 64] = (unsigned short)w; pf[(2 * k + 1) * 64] = (unsigned short)(w >> 16); } } }
    }
}
constexpr int CPF = 8;
__device__ __forceinline__ void phase_carry(const Frame& F0, unsigned* flags) {
    const Frame F = relaunder(F0);
    unsigned char* ws = F.ws; const unsigned char* QFb = ws + WS_QF; const unsigned char* PFb = ws + WS_PF; float* SI = (float*)(ws + WS_SINIT);
    const int lane = F.lane, wave = F.wave;
    LAS unsigned char* ring = F.lds;
    for (int chain = F.bid; chain < 16; chain += F.G) {
        const size_t cb = (size_t)chain * NCH * 8192;
        if (wave >= 4) {
            const int pt = (wave - 4) * 64 + lane;
            u32x4 rt[CPF][2], rq[CPF][2];
#pragma unroll
            for (int d = 0; d < CPF; ++d) { const size_t o = cb + (size_t)d * 8192 + pt * 16;
                rt[d][0] = *(const u32x4*)(PFb + o); rt[d][1] = *(const u32x4*)(PFb + o + 4096); rq[d][0] = *(const u32x4*)(QFb + o); rq[d][1] = *(const u32x4*)(QFb + o + 4096); }
            asm volatile("s_waitcnt vmcnt(%0)" :: "n"(4 * (CPF - 1)) : "memory");
            { LAS unsigned char* sl = ring + pt * 16; *(LAS u32x4*)(sl) = rt[0][0]; *(LAS u32x4*)(sl + 4096) = rt[0][1]; *(LAS u32x4*)(sl + 8192) = rq[0][0]; *(LAS u32x4*)(sl + 12288) = rq[0][1]; }
            { const size_t o = cb + (size_t)CPF * 8192 + pt * 16;
              rt[0][0] = *(const u32x4*)(PFb + o); rt[0][1] = *(const u32x4*)(PFb + o + 4096); rq[0][0] = *(const u32x4*)(QFb + o); rq[0][1] = *(const u32x4*)(QFb + o + 4096); }
            LDS_WAIT(); __syncthreads();
            for (int c0 = 0; c0 < NCH; c0 += CPF) {
#pragma unroll
                for (int d = 0; d < CPF; ++d) { const int c = c0 + d;
                    constexpr int DUMMY = 0; (void)DUMMY;
                    const int e = (d + 1) % CPF;
                    if (c + 1 < NCH) {
                        asm volatile("s_waitcnt vmcnt(%0)" :: "n"(4 * (CPF - 1)) : "memory");
                        LAS unsigned char* sl = ring + ((c + 1) & 1) * 16384 + pt * 16;
                        *(LAS u32x4*)(sl) = rt[e][0]; *(LAS u32x4*)(sl + 4096) = rt[e][1]; *(LAS u32x4*)(sl + 8192) = rq[e][0]; *(LAS u32x4*)(sl + 12288) = rq[e][1];
                        const int cn = c + 1 + CPF < NCH ? c + 1 + CPF : NCH - 1;
                        const size_t o = cb + (size_t)cn * 8192 + pt * 16;
                        rt[e][0] = *(const u32x4*)(PFb + o); rt[e][1] = *(const u32x4*)(PFb + o + 4096); rq[e][0] = *(const u32x4*)(QFb + o); rq[e][1] = *(const u32x4*)(QFb + o + 4096);
                    }
                    LDS_WAIT(); __syncthreads();
                }
            }
            asm volatile("s_waitcnt vmcnt(0)" ::: "memory");
        } else {
            const int row = wave * 16 + (lane & 15), g = lane >> 4;
            const int aoff = ((lane & 15) * 64 + g * 16) * 2, qoff = (row * 64 + 4 * g) * 2;
            f32x4 S[4];
#pragma unroll
            for (int mt = 0; mt < 4; ++mt) S[mt] = (f32x4){0.f, 0.f, 0.f, 0.f};
            u32x4 a[4][2]; u32x2 q[4];
            __syncthreads();
#pragma unroll
            for (int mt = 0; mt < 4; ++mt) { a[mt][0] = *(const LAS u32x4*)(ring + mt * 2048 + aoff); a[mt][1] = *(const LAS u32x4*)(ring + mt * 2048 + aoff + 16); q[mt] = *(const LAS u32x2*)(ring + 8192 + qoff + 32 * mt); }
            LDS_WAIT(); __builtin_amdgcn_sched_barrier(0);
            for (int c = 0; c < NCH; ++c) { const size_t un = ((size_t)chain * NCH + c) * 4096;
#pragma unroll
                for (int mt = 0; mt < 4; ++mt) *(f32x4*)(SI + un + (qoff >> 1) + 16 * mt) = S[mt];
                bf16x8 bh[2], bl[2];
#pragma unroll
                for (int ks = 0; ks < 2; ++ks) { u32x4 wh, wl; const f32x4 s0 = S[2 * ks], s1 = S[2 * ks + 1];
                    wh.x = pk2(s0[0], s0[1]); wh.y = pk2(s0[2], s0[3]); wh.z = pk2(s1[0], s1[1]); wh.w = pk2(s1[2], s1[3]);
                    wl.x = pk2(s0[0] - bf2f(wh.x & 0xffffu), s0[1] - bf2f(wh.x >> 16)); wl.y = pk2(s0[2] - bf2f(wh.y & 0xffffu), s0[3] - bf2f(wh.y >> 16));
                    wl.z = pk2(s1[0] - bf2f(wh.z & 0xffffu), s1[1] - bf2f(wh.z >> 16)); wl.w = pk2(s1[2] - bf2f(wh.w & 0xffffu), s1[3] - bf2f(wh.w >> 16));
                    bh[ks] = __builtin_bit_cast(bf16x8, wh); bl[ks] = __builtin_bit_cast(bf16x8, wl); }
                __builtin_amdgcn_sched_barrier(0);
#pragma unroll
                for (int mt = 0; mt < 4; ++mt) { f32x4 d = (f32x4){bf2f(q[mt].x & 0xffffu), bf2f(q[mt].x >> 16), bf2f(q[mt].y & 0xffffu), bf2f(q[mt].y >> 16)};
#pragma unroll
                    for (int ks = 0; ks < 2; ++ks) { const bf16x8 af = __builtin_bit_cast(bf16x8, a[mt][ks]);
                        d = __builtin_amdgcn_mfma_f32_16x16x32_bf16(af, bh[ks], d, 0, 0, 0); d = __builtin_amdgcn_mfma_f32_16x16x32_bf16(af, bl[ks], d, 0, 0, 0); }
                    S[mt] = d; }
                asm volatile("s_nop 7\n\ts_nop 7" ::: "memory");
                __builtin_amdgcn_sched_barrier(0);
                __syncthreads();
                if (c + 1 < NCH) { LAS unsigned char* sl = ring + ((c + 1) & 1) * 16384;
#pragma unroll
                    for (int mt = 0; mt < 4; ++mt) { a[mt][0] = *(const LAS u32x4*)(sl + mt * 2048 + aoff); a[mt][1] = *(const LAS u32x4*)(sl + mt * 2048 + aoff + 16); q[mt] = *(const LAS u32x2*)(sl + 8192 + qoff + 32 * mt); } }
                LDS_WAIT(); __builtin_amdgcn_sched_barrier(0);
            }
        }
        asm volatile("s_waitcnt vmcnt(0)" ::: "memory");
        __syncthreads();
        if (xb_t0(wave)) { __builtin_amdgcn_fence(__ATOMIC_RELEASE, "agent"); asm volatile("s_waitcnt vmcnt(0)" ::: "memory"); __hip_atomic_store(flags + chain, 1u, __ATOMIC_RELAXED, __HIP_MEMORY_SCOPE_AGENT); }
    }
}
__device__ __forceinline__ void phase_rwkv_fin(const Frame& F0, int l, unsigned* flags, unsigned* qctr) {
    const Frame F = relaunder(F0);
    unsigned char* ws = F.ws; const float* SI = (const float*)(ws + WS_SINIT); const float* YL = (const float*)(ws + WS_YL); const float* ZL = (const float*)(ws + WS_ZL);
    const float* LO = (const float*)(ws + WS_LO); const float* VC = (const float*)(ws + WS_VCUR); const float* BON = (const float*)(ws + WS_BON); bf16* Y = (bf16*)(ws + WS_Y);
    const float* lnw = INP(15) + l * 512; const float* lnb = INP(16) + l * 512;
    const int lane = F.lane, wave = F.wave;
    (void)qctr;
    __syncthreads();
    if (xb_t0(wave)) {
        for (int u = F.bid; u < 16 * (NCH / 4); u += F.G) { unsigned* fl = flags + u / (NCH / 4); unsigned sp = 0u;
            while (xb_ld(fl) == 0u && ++sp < (1u << 22)) __builtin_amdgcn_s_sleep(1); }
        __builtin_amdgcn_fence(__ATOMIC_ACQUIRE, "agent"); asm volatile("s_waitcnt vmcnt(0)" ::: "memory"); }
    __syncthreads();
    for (int u = F.bid; u < 16 * (NCH / 4); u += F.G) {
        const int chain = u / (NCH / 4), c = (u % (NCH / 4)) * 4 + (wave >> 1), b = chain >> 3, h = chain & 7; const size_t un = ((size_t)chain * NCH + c) * 4096;
        const int m0 = b * T + c * CL + (wave & 1) * 16;
        bf16x8 af[2], bfr[4][2];
#pragma unroll
        for (int ks = 0; ks < 2; ++ks) { float t8[8]; ldf8(ZL + (size_t)(m0 + (lane & 15)) * 512 + h * 64 + ks * 32 + 8 * (lane >> 4), t8);
            u32x4 w; w.x = pk2(t8[0], t8[1]); w.y = pk2(t8[2], t8[3]); w.z = pk2(t8[4], t8[5]); w.w = pk2(t8[6], t8[7]); af[ks] = __builtin_bit_cast(bf16x8, w); }
#pragma unroll
        for (int n = 0; n < 4; ++n)
#pragma unroll
            for (int ks = 0; ks < 2; ++ks) { float t8[8]; ldf8(SI + un + (size_t)(16 * n + (lane & 15)) * 64 + ks * 32 + 8 * (lane >> 4), t8);
                u32x4 w; w.x = pk2(t8[0], t8[1]); w.y = pk2(t8[2], t8[3]); w.z = pk2(t8[4], t8[5]); w.w = pk2(t8[6], t8[7]); bfr[n][ks] = __builtin_bit_cast(bf16x8, w); }
        float yl[4][4], vc[4][4], gg[4][4], bn[4];
#pragma unroll
        for (int r = 0; r < 4; ++r) { const int m = m0 + 4 * (lane >> 4) + r; bn[r] = BON[(size_t)m * 8 + h];
#pragma unroll
            for (int n = 0; n < 4; ++n) { const int j = h * 64 + 16 * n + (lane & 15); yl[n][r] = YL[(size_t)m * 512 + j]; vc[n][r] = VC[(size_t)m * 512 + j]; gg[n][r] = LO[(size_t)m * 2048 + 1024 + j]; } }
        asm volatile("s_waitcnt vmcnt(0)" ::: "memory"); __builtin_amdgcn_sched_barrier(0);
        f32x4 C[4];
#pragma unroll
        for (int n = 0; n < 4; ++n) { C[n] = (f32x4){yl[n][0], yl[n][1], yl[n][2], yl[n][3]};
#pragma unroll
            for (int ks = 0; ks < 2; ++ks) C[n] = __builtin_amdgcn_mfma_f32_16x16x32_bf16(af[ks], bfr[n][ks], C[n], 0, 0, 0); }
        __builtin_amdgcn_sched_barrier(0);
#pragma unroll
        for (int r = 0; r < 4; ++r) { const int m = m0 + 4 * (lane >> 4) + r;
            float sm = (C[0][r] + C[1][r]) + (C[2][r] + C[3][r]); sm = red16_sum(sm); const float mean = sm * (1.f / 64.f);
            float d[4], sv = 0.f;
#pragma unroll
            for (int n = 0; n < 4; ++n) { d[n] = C[n][r] - mean; sv += d[n] * d[n]; }
            sv = red16_sum(sv); const float rs = 1.0f / sqrtf(sv * (1.f / 64.f) + 64e-5f);
#pragma unroll
            for (int n = 0; n < 4; ++n) { const int j = h * 64 + 16 * n + (lane & 15); const float yn = d[n] * rs * lnw[j] + lnb[j];
                Y[(size_t)m * 2560 + j] = (bf16)f2bf((yn + bn[r] * vc[n][r]) * gg[n][r]); } }
    }
}

__device__ __forceinline__ void phase_route(const Frame& F0, const float* X) {
    const Frame F = relaunder(F0);
    const float* R = INP(36); const float* gain = INP(3) + D; const u64* ssq = (const u64*)(F.ctl + CW_SSQ) + 3 * 8192;
    unsigned* cnt = F.ctl + CW_CNT; unsigned* route = F.ctl + CW_ROUTE;
    const int lane = F.lane;
    for (int m = F.bid * 8 + F.wave; m < M; m += F.G * 8) {
        float acc[8];
#pragma unroll
        for (int e = 0; e < 8; ++e) acc[e] = 0.f;
#pragma unroll 8
        for (int i = 0; i < 32; ++i) { const int k = lane + 64 * i; const float xv = X[(size_t)m * D + k] * gain[k]; const f32x4 r0 = *(const f32x4*)(R + k * 8), r1 = *(const f32x4*)(R + k * 8 + 4);
            acc[0] += xv * r0[0]; acc[1] += xv * r0[1]; acc[2] += xv * r0[2]; acc[3] += xv * r0[3]; acc[4] += xv * r1[0]; acc[5] += xv * r1[1]; acc[6] += xv * r1[2]; acc[7] += xv * r1[3]; }
        const float rs = rstd_of(ssq, m);
#pragma unroll
        for (int e = 0; e < 8; ++e) acc[e] = wave_sum(acc[e]) * rs;
        if (lane == 0) {
            int e0 = 0; float v0 = acc[0];
#pragma unroll
            for (int e = 1; e < 8; ++e) if (acc[e] > v0) { v0 = acc[e]; e0 = e; }
            int e1 = -1; float v1 = -3.0e38f;
#pragma unroll
            for (int e = 0; e < 8; ++e) if (e != e0 && acc[e] > v1) { v1 = acc[e]; e1 = e; }
            const float p1 = __expf(v1 - v0); const float w0 = 1.f / (1.f + p1), w1 = p1 / (1.f + p1);
            const unsigned pos0 = atomicAdd(cnt + 64 * e0, 1u), pos1 = atomicAdd(cnt + 64 * e1, 1u);
            unsigned* rr = route + (size_t)m * 8; rr[0] = (unsigned)e0; rr[1] = (unsigned)e1; rr[2] = __builtin_bit_cast(unsigned, w0); rr[3] = __builtin_bit_cast(unsigned, w1); rr[4] = pos0; rr[5] = pos1; rr[6] = __builtin_bit_cast(unsigned, rs); }
    }
}
__device__ __forceinline__ void moe_tiles(const Frame& F, int (&ts)[9]) {
    ts[0] = 0;
#pragma unroll
    for (int e = 0; e < 8; ++e) { const unsigned c = __hip_atomic_load(F.ctl + CW_CNT + 64 * e, RLX_AGENT); ts[e + 1] = ts[e] + (int)((c + 255u) >> 8); }
}
__device__ __forceinline__ void phase_gather(const Frame& F0, float* RSS) {
    const Frame F = relaunder(F0);
    constexpr int RB = F8_M1 ? D : 2 * D;
    unsigned char* ws = F.ws; const unsigned char* XH = ws + (F8_M1 ? WS_XH8 : WS_XH); unsigned char* XG = ws + WS_XG; const unsigned* route = F.ctl + CW_ROUTE;
    int ts[9]; moe_tiles(F, ts);
    for (int m = F.bid * 8 + F.wave; m < M; m += F.G * 8) { const unsigned* rr = route + (size_t)m * 8;
        const u32x4* src = (const u32x4*)(XH + (size_t)m * RB);
#pragma unroll
        for (int s = 0; s < 2; ++s) { const int e = (int)rr[s]; int base = 0;
#pragma unroll
            for (int j = 0; j < 8; ++j) base = (j == e) ? ts[j] : base;
            const int slot = base * 256 + (int)rr[4 + s]; u32x4* dst = (u32x4*)(XG + (size_t)slot * RB);
#pragma unroll
            for (int i = 0; i < RB / 1024; ++i) dst[F.lane + 64 * i] = src[F.lane + 64 * i];
            if (F.lane == 0) __hip_atomic_store((unsigned*)RSS + slot, rr[6], RLX_AGENT); } }
}
__device__ __forceinline__ void phase_combine(const Frame& F0, const float* X, float* out) {
    const Frame F = relaunder(F0);
    unsigned char* ws = F.ws; const bf16* YS = (const bf16*)(ws + WS_YS); const unsigned* route = F.ctl + CW_ROUTE;
    int ts[9]; moe_tiles(F, ts);
    for (int m = F.bid * 8 + F.wave; m < M; m += F.G * 8) { const unsigned* rr = route + (size_t)m * 8; int slot[2]; float w[2];
#pragma unroll
        for (int s = 0; s < 2; ++s) { const int e = (int)rr[s]; int base = 0;
#pragma unroll
            for (int j = 0; j < 8; ++j) base = (j == e) ? ts[j] : base;
            slot[s] = base * 256 + (int)rr[4 + s]; w[s] = __builtin_bit_cast(float, rr[2 + s]); }
#pragma unroll
        for (int i = 0; i < 8; ++i) { const int c = (F.lane + 64 * i) * 4; f32x4 v = *(const f32x4*)(X + (size_t)m * D + c);
            const u32x2 a = *(const u32x2*)(YS + (size_t)slot[0] * D + c), b2 = *(const u32x2*)(YS + (size_t)slot[1] * D + c);
            v[0] += w[0] * bf2f(a.x & 0xffffu) + w[1] * bf2f(b2.x & 0xffffu); v[1] += w[0] * bf2f(a.x >> 16) + w[1] * bf2f(b2.x >> 16);
            v[2] += w[0] * bf2f(a.y & 0xffffu) + w[1] * bf2f(b2.y & 0xffffu); v[3] += w[0] * bf2f(a.y >> 16) + w[1] * bf2f(b2.y >> 16);
            *(f32x4*)(out + (size_t)m * D + c) = v; } }
}

constexpr int PH_PER_LAYER = 14, N_PHASES = 1 + 2 * PH_PER_LAYER;
struct Args { const float* in[40]; float* out; unsigned char* ws; int ph_lo, ph_hi; };
__global__ void __launch_bounds__(512, 2) mega_fwd(Args args) {
    extern __shared__ __attribute__((aligned(16))) unsigned char lds_raw[];
    Frame F; F.lds = (LAS unsigned char*)lds_raw; F.tid = threadIdx.x; F.lane = F.tid & 63; F.wave = __builtin_amdgcn_readfirstlane(F.tid >> 6); F.G = gridDim.x; F.bid = blockIdx.x;
    F.in = args.in; F.ws = args.ws; F.ctl = (unsigned*)(args.ws + WS_CTL);
    volatile LAS unsigned* MISC = (volatile LAS unsigned*)(F.lds + MISC_OFF);
    for (int u = F.tid; u < (LDS_BYTES - RING_BYTES) / 4; u += 512) ((LAS unsigned*)(F.lds + RING_BYTES))[u] = 0u;
    __syncthreads();
    const int lo = args.ph_lo, hi = args.ph_hi;
    XcdBarrier bar; bar.bar = F.ctl + CW_BAR; bar.x = 0; bar.st = nullptr; bar.wave = F.wave;
    if (hi - lo > 1) bar = xcd_barrier_post(F.ctl + CW_BAR, MISC + 8, F.wave);
#ifndef PHMASK
#define PHMASK 0xFFFFFFFFu
#endif
#define KD(j) (((PHMASK) >> (j)) & 1u)
#define IN(k) (lo <= (k) && (k) < hi)
#define SEAM(k) do { if (IN((k) + 1)) xcd_barrier(bar); } while (0)
    unsigned char* ws = args.ws;
    u64* ssq_all = (u64*)(F.ctl + CW_SSQ);
    LAS unsigned char* lds = F.lds;

    if (KD(0) && IN(0)) { phase_prologue(F); SEAM(0); }

    auto run_layer = [&](auto LC) __attribute__((always_inline)) {
        constexpr int l = decltype(LC)::value;
        const int pb = 1 + l * PH_PER_LAYER;
        const u64* ssq_mix = ssq_all + (2 * l) * 8192; u64* ssq_ffn = ssq_all + (2 * l + 1) * 8192;
        bf16* XH = (bf16*)(ws + WS_XH);
        const float* xin = l == 0 ? args.in[0] : args.out; float* xmid = (float*)(ws + WS_XA); float* xout = args.out;
        if (KD(1) && IN(pb + 0)) {
            const int nNP = (l ? NP1 : NP0) / 256;
            { pg8::Gemm g{XH, (const bf16*)(ws + (l ? WS_WPT1 : WS_WPT0)), D, D, D, 0, 0}; pg8::GridOrder S; S.init(M / 256, nNP, 1, F.G, F.bid);
              EpiP E{(bf16*)(ws + WS_P), (bf16*)(ws + WS_G4), ssq_mix, nNP}; pg8::gemm_phase<EpiP, pg8::GridOrder>(lds, g, S, E, F.wave); }
            if (l == 0 && F.G >= 16 && F.bid >= F.G - 16) { pg8::Gemm g{(const bf16*)(ws + WS_MEMN), (const bf16*)(ws + WS_WKVT0), D, D, D, 0, 0}; pg8::GridOrder S; S.init(2, 8, 1, 16, F.bid - (F.G - 16));
              EpiF32 E{(float*)(ws + WS_KVRAW), 2048}; pg8::gemm_phase<EpiF32, pg8::GridOrder>(lds, g, S, E, F.wave); }
            SEAM(pb + 0);
        }
        if (KD(2) && IN(pb + 1)) { phase_prep(F, l); SEAM(pb + 1); }
        if (KD(3) && IN(pb + 2)) {
            if (KD(17)) { pg8::Gemm g{(const bf16*)(ws + WS_ALORA), (const bf16*)(ws + (l ? WS_WLT1 : WS_WLT0)), 512, 512, 512, 0, 0}; pg8::GridOrder S; S.init(M / 256, 8, 1, F.G, F.bid);
              EpiLora E{(float*)(ws + WS_LO), args.in[7] + l * 512, args.in[9] + l * 512, args.in[19], l}; pg8::gemm_phase<EpiLora, pg8::GridOrder>(lds, g, S, E, F.wave); }
            if (KD(18) && F.bid < 32) { const int kp = F.bid >> 3;
              pg8::Gemm g{(const bf16*)(ws + WS_ACMP) + kp * 512, (const bf16*)(ws + (l ? WS_WC1T1 : WS_WC1T0)) + kp * 512, 2048, 2048, 512, (size_t)1024 * 2048 * 2, (size_t)256 * 2048 * 2}; pg8::GridOrder S; S.init(4, 1, 2, 8, F.bid & 7);
              EpiHP E{(float*)(ws + WS_HP) + (size_t)kp * 2 * 1024 * 128}; pg8::gemm_phase<EpiHP, pg8::GridOrder>(lds, g, S, E, F.wave); }
            __syncthreads();
            if (KD(19)) phase_memattn(F);
            SEAM(pb + 2);
        }
        if (KD(4) && IN(pb + 3)) {
            if (F.bid < 8) { const CmpFin CF{(const float*)(ws + WS_HP), args.in[24] + l * 256, (const bf16*)(ws + WS_WC2T) + (size_t)l * 2 * 64 * 128, args.in[21] + l * 256 + 64, (bf16*)(ws + WS_KC), (bf16*)(ws + WS_VCT)};
                cmp_finalize(CF, F.bid >> 2, F.bid & 3, lds, F.wave, F.lane); }
            phase_scan(F, l); SEAM(pb + 3); }
        if (KD(5) && IN(pb + 4)) { unsigned* cflags = F.ctl + CW_QCTR + 256 + 64 * l; phase_carry(F, cflags); phase_nsa(F, F.ctl + CW_QCTR + 64 * l); phase_rwkv_fin(F, l, cflags, F.ctl + CW_QCTR + 128 + 64 * l); SEAM(pb + 4); }
        if (KD(7) && IN(pb + 6)) {
            pg8::Gemm g{(const bf16*)(ws + WS_Y), (const bf16*)(ws + (l ? WS_WBT1 : WS_WBT0)), 2560, 512, 512, (size_t)512 * 2, (size_t)2048 * 512 * 2}; pg8::GridOrder S; S.init(M / 256, 8, 5, F.G, F.bid);
            EpiZ E{(bf16*)(ws + WS_ZB)}; pg8::gemm_phase<EpiZ, pg8::GridOrder>(lds, g, S, E, F.wave);
            { pg8::Gemm g4{(const bf16*)(ws + WS_XH8), (const bf16*)(ws + (l ? WS_WG4T1 : WS_WG4T0)), D / 2, D / 2, D / 2, 0, 0}; pg8::GridOrder S4; S4.init(M / 256, 8, 1, F.G, F.bid);
              EpiGate4 E4{(bf16*)(ws + WS_G4), ssq_mix}; pg8::gemm_phase<EpiGate4, pg8::GridOrder, true, true>(lds, g4, S4, E4, F.wave); }
            SEAM(pb + 6);
        }
        if (KD(8) && IN(pb + 7)) {
            constexpr int KD2 = F8_G ? D / 2 : D; pg8::Gemm g{F8_G ? (const bf16*)(ws + WS_XH8) : (const bf16*)XH, (const bf16*)(ws + (l ? WS_WGT1 : WS_WGT0)), KD2, KD2, KD2, 0, 0}; pg8::GridOrder S; S.init(M / 256, 32, 1, F.G, F.bid);
            EpiG E{(const bf16*)(ws + WS_ZB), (const bf16*)(ws + WS_G4), (bf16*)(ws + WS_MG), ssq_mix, F8_G ? W8SI : 1.f}; pg8::gemm_phase<EpiG, pg8::GridOrder, true, F8_G != 0>(lds, g, S, E, F.wave);
            SEAM(pb + 7);
        }
        if (KD(9) && IN(pb + 8)) {
            pg8::Gemm g{(const bf16*)(ws + WS_MG), (const bf16*)(ws + (l ? WS_WOT1 : WS_WOT0)), D, D, D, 0, 0}; pg8::GridOrder S; S.init(M / 256, 8, 1, F.G, F.bid);
            EpiRes E{xin, xmid, XH, ssq_ffn, ws + WS_XH8}; pg8::gemm_phase<EpiRes, pg8::GridOrder>(lds, g, S, E, F.wave);
            SEAM(pb + 8);
        }
        if (l == 0) {
            if (KD(10) && IN(pb + 9)) {
                constexpr int KD2 = F8_F1 ? D / 2 : D; pg8::Gemm g{F8_F1 ? (const bf16*)(ws + WS_XH8) : (const bf16*)XH, (const bf16*)(ws + WS_W13T), KD2, KD2, KD2, 0, 0}; pg8::GridOrder S; S.init(M / 256, 2 * FF / 256, 1, F.G, F.bid);
                EpiSwiglu<false> E{(bf16*)(ws + WS_ACT), FF, ssq_ffn, nullptr, F8_F1 ? W8SI : 1.f, 1.f}; pg8::gemm_phase<EpiSwiglu<false>, pg8::GridOrder, true, F8_F1 != 0>(lds, g, S, E, F.wave);
                SEAM(pb + 9);
            }
            if (KD(11) && IN(pb + 10)) {
                pg8::Gemm g{(const bf16*)(ws + WS_ACT), (const bf16*)(ws + WS_W2T), FF, FF, FF, 0, 0}; pg8::GridOrder S; S.init(M / 256, 8, 1, F.G, F.bid);
                EpiRes E{xmid, xout, XH, ssq_all + 2 * 8192, ws + WS_XH8}; pg8::gemm_phase<EpiRes, pg8::GridOrder>(lds, g, S, E, F.wave);
                SEAM(pb + 13);
            }
        } else {
            float* RSS = (float*)(ws + WS_RSS);
            if (KD(12) && IN(pb + 9)) { phase_route(F, xmid); SEAM(pb + 9); }
            if (KD(13) && IN(pb + 10)) { phase_gather(F, RSS); SEAM(pb + 10); }
            if (KD(14) && IN(pb + 11)) {
                pg8::MoeOrder S; moe_tiles(F, S.ts); S.nN = 2 * EFF / 256; S.G = F.G; S.c = F.bid;
                constexpr int KD2 = F8_M1 ? D / 2 : D; pg8::Gemm g{(const bf16*)(ws + WS_XG), (const bf16*)(ws + WS_MW13T), KD2, KD2, KD2, 0, (size_t)2 * EFF * 2048 * (F8_M1 ? 1 : 2)};
                EpiSwiglu<F8_M2 != 0> E{(bf16*)(ws + WS_ACTM), EFF, nullptr, RSS, F8_M1 ? W8SI : 1.f, 8.f}; pg8::gemm_phase<EpiSwiglu<F8_M2 != 0>, pg8::MoeOrder, true, F8_M1 != 0>(lds, g, S, E, F.wave);
                SEAM(pb + 11);
            }
            if (KD(15) && IN(pb + 12)) {
                pg8::MoeOrder S; moe_tiles(F, S.ts); S.nN = 8; S.G = F.G; S.c = F.bid;
                constexpr int KE2 = F8_M2 ? EFF / 2 : EFF; pg8::Gemm g{(const bf16*)(ws + WS_ACTM), (const bf16*)(ws + WS_MW2T), KE2, KE2, KE2, 0, (size_t)2048 * EFF * (F8_M2 ? 1 : 2)};
                EpiBf E{(bf16*)(ws + WS_YS), D, F8_M2 ? W8SI / 8.f : 1.f}; pg8::gemm_phase<EpiBf, pg8::MoeOrder, true, F8_M2 != 0>(lds, g, S, E, F.wave);
                SEAM(pb + 12);
            }
            if (KD(16) && IN(pb + 13)) { phase_combine(F, xmid, xout); }
        }
    };
    run_layer(std::integral_constant<int, 0>{});
    run_layer(std::integral_constant<int, 1>{});
#undef IN
#undef SEAM
}

#ifdef DBG_STOP
__global__ void dbg_dump(const unsigned char* buf, size_t nelem, int is_bf16, float* out, int nout) {
    for (int i = blockIdx.x * blockDim.x + threadIdx.x; i < nout; i += gridDim.x * blockDim.x) { float s = 0.f;
        for (size_t j = (size_t)i; j < nelem; j += (size_t)nout) s += is_bf16 ? bf2f(((const bf16*)buf)[j]) : ((const float*)buf)[j];
        out[i] = s; }
}
__global__ void dbg_cols(const bf16* buf, int ld, int c0, int w, float* out) {
    for (int i = blockIdx.x * blockDim.x + threadIdx.x; i < M * D; i += gridDim.x * blockDim.x) { const int row = i >> 11, c = i & 2047; out[i] = bf2f(buf[(size_t)row * ld + c0 + (c % w)]); }
}
#endif
extern "C" void kernel_launch(void* const* d_in, const int* in_sizes, int n_in, void* d_out, int out_size, void* d_ws, size_t ws_size, hipStream_t stream) {
    static int grid = 0;
    if (grid == 0) {
        if (n_in != 40 || out_size != M * D || ws_size < WS_END) { fprintf(stderr, "kernel_launch: unexpected shapes (n_in %d out %d ws %zu need %zu)\n", n_in, out_size, ws_size, (size_t)WS_END); grid = -1; return; }
        int dev = 0, cus = 0, per_cu = 0;
        if (hipGetDevice(&dev) != hipSuccess || hipDeviceGetAttribute(&cus, hipDeviceAttributeMultiprocessorCount, dev) != hipSuccess) { grid = -1; return; }
        if (hipFuncSetAttribute((const void*)mega_fwd, hipFuncAttributeMaxDynamicSharedMemorySize, LDS_BYTES) != hipSuccess) { fprintf(stderr, "kernel_launch: hipFuncSetAttribute failed\n"); grid = -1; return; }
        if (hipOccupancyMaxActiveBlocksPerMultiprocessor(&per_cu, (const void*)mega_fwd, 512, LDS_BYTES) != hipSuccess || per_cu < 1) fprintf(stderr, "kernel_launch: occupancy query reports %d\n", per_cu);
        (void)hipGetLastError();
        grid = cus;
    }
    if (grid < 0) return;
    if (hipMemsetAsync((char*)d_ws + WS_CTL, 0, CTL_BYTES, stream) != hipSuccess) return;
    Args a{};
    for (int i = 0; i < 40; ++i) a.in[i] = (const float*)d_in[i];
    a.out = (float*)d_out; a.ws = (unsigned char*)d_ws;
#if MK_ONE_LAUNCH
    a.ph_lo = 0; a.ph_hi = N_PHASES;
    hipLaunchKernelGGL(mega_fwd, dim3(grid), dim3(512), LDS_BYTES, stream, a);
#else
    for (int p = 0; p < N_PHASES; ++p) {
        if (p >= 1 + 11 && p < 1 + PH_PER_LAYER) continue;
#ifdef DBG_STOP
        if (p > DBG_STOP) break;
#endif
        a.ph_lo = p; a.ph_hi = p + 1;
        hipLaunchKernelGGL(mega_fwd, dim3(grid), dim3(512), LDS_BYTES, stream, a);
    }
#ifdef DBG_STOP
#ifdef DBG_C0
    hipLaunchKernelGGL(dbg_cols, dim3(2048), dim3(256), 0, stream, (const bf16*)((const unsigned char*)d_ws + (size_t)(DBG_OFF)), (int)(DBG_LD), (int)(DBG_C0), (int)(DBG_W), (float*)d_out);
#else
    hipLaunchKernelGGL(dbg_dump, dim3(2048), dim3(256), 0, stream, (const unsigned char*)d_ws + (size_t)(DBG_OFF), (size_t)(DBG_NELEM), (int)(DBG_BF16), (float*)d_out, M * D);
#endif
#endif
#endif
}
```

```cpp
#include <hip/hip_runtime.h>
#include <cstdio>
#include <cstdint>
#include <type_traits>

#ifndef F8_G
#define F8_G 1
#endif
#ifndef F8_F1
#define F8_F1 0
#endif
#ifndef F8_M1
#define F8_M1 1
#endif
#ifndef F8_M2
#define F8_M2 1
#endif
#ifndef MK_ONE_LAUNCH
#define MK_ONE_LAUNCH 1
#endif

#define GAS __attribute__((address_space(1)))
#define LAS __attribute__((address_space(3)))
typedef unsigned short bf16;
typedef short bf16x8 __attribute__((ext_vector_type(8)));
typedef float f32x4 __attribute__((ext_vector_type(4)));
typedef float f32x2 __attribute__((ext_vector_type(2)));
typedef unsigned u32x4 __attribute__((ext_vector_type(4)));
typedef unsigned u32x2 __attribute__((ext_vector_type(2)));

constexpr int M = 8192, T = 4096, D = 2048;
constexpr int LDP = 6144;
constexpr int NP0 = 5888, NP1 = 6144;
constexpr int PC_R = 0, PC_K = 512, PC_V = 1024, PC_WD = 1536, PC_AD = 1632, PC_GD = 1728;
constexpr int PC_Q = 1984, PC_KC = 2496, PC_VC = 2624, PC_KS = 2752, PC_VS = 2880, PC_KW = 3008, PC_VW = 3136, PC_GL = 3264;
constexpr int PC_CB = 3288, PC_CC = 3800, PC_CX = 4312, PC_POOL = 4824, PC_MEM = 5336, PC_GATE = 5848, PC_VRES = 5848;
constexpr int NIN = 16088;
constexpr int FF = 5632, EFF = 2816, NE = 8;
constexpr float NORM_EPS = 1e-6f;
constexpr float CQ_NSA = 0.125f * 1.4426950408889634f, CQ_MEM = 0.08838834764831845f * 1.4426950408889634f;
constexpr int SLOTS = 18432;

constexpr size_t al4k(size_t x) { return (x + 4095) & ~(size_t)4095; }
constexpr size_t MiB = 1u << 20;
constexpr size_t WS_CTL = 0, CTL_BYTES = MiB;
constexpr size_t SZ_WPT0 = (size_t)NP0 * 2048 * 2, SZ_WPT1 = (size_t)NP1 * 2048 * 2;
constexpr size_t SZ_WGT = (size_t)8192 * 2048 * 2, SZ_WBT = (size_t)5 * 2048 * 512 * 2, SZ_WOT = (size_t)2048 * 2048 * 2, SZ_WLT = (size_t)2048 * 512 * 2;
constexpr size_t SZ_WKVT = (size_t)1024 * 2048 * 2, SZ_WC1T = (size_t)2 * 256 * 2048 * 2;
constexpr size_t WS_WPT0 = WS_CTL + CTL_BYTES;
constexpr size_t WS_WPT1 = WS_WPT0 + SZ_WPT0;
constexpr size_t WS_WGT0 = WS_WPT1 + SZ_WPT1, WS_WGT1 = WS_WGT0 + SZ_WGT;
constexpr size_t WS_WG4T0 = WS_WGT1 + SZ_WGT, WS_WG4T1 = WS_WG4T0 + (size_t)2048 * 2048;
constexpr size_t WS_WBT0 = WS_WG4T1 + (size_t)2048 * 2048, WS_WBT1 = WS_WBT0 + SZ_WBT;
constexpr size_t WS_WOT0 = WS_WBT1 + SZ_WBT, WS_WOT1 = WS_WOT0 + SZ_WOT;
constexpr size_t WS_WLT0 = WS_WOT1 + SZ_WOT, WS_WLT1 = WS_WLT0 + SZ_WLT;
constexpr size_t WS_WKVT0 = WS_WLT1 + SZ_WLT, WS_WKVT1 = WS_WKVT0 + SZ_WKVT;
constexpr size_t WS_WC1T0 = WS_WKVT1 + SZ_WKVT, WS_WC1T1 = WS_WC1T0 + SZ_WC1T;
constexpr size_t WS_WC2T = WS_WC1T1 + SZ_WC1T;
constexpr size_t WS_W13T = WS_WC2T + (size_t)65536;
constexpr size_t WS_W2T = WS_W13T + (size_t)2 * FF * 2048 * 2;
constexpr size_t WS_MW13T = WS_W2T + (size_t)2048 * FF * 2;
constexpr size_t WS_MW2T = WS_MW13T + (size_t)NE * 2 * EFF * 2048 * 2;
constexpr size_t WS_XA = WS_MW2T + (size_t)NE * 2048 * EFF * 2;
constexpr size_t WS_XH = WS_XA + (size_t)M * D * 4;
constexpr size_t WS_MEMN = WS_XH + (size_t)M * D * 2;
constexpr size_t WS_G4 = WS_MEMN + (size_t)512 * 2048 * 2;
constexpr size_t WS_Y = WS_G4 + (size_t)M * D * 2;
constexpr size_t WS_VFIRST = WS_Y + (size_t)M * 2560 * 2;
constexpr size_t WS_KVRAW = WS_VFIRST + (size_t)M * 512 * 4;
constexpr size_t WS_XH8 = WS_KVRAW + (size_t)512 * 2048 * 4;
constexpr size_t WS_OV = WS_XH8 + (size_t)M * D;
constexpr size_t WS_P = WS_OV;
constexpr size_t WS_ALORA = WS_P + (size_t)M * LDP * 2;
constexpr size_t WS_LO = WS_ALORA + (size_t)M * 512 * 2;
constexpr size_t WS_YL = WS_LO + (size_t)M * 2048 * 4;
constexpr size_t WS_ZL = WS_YL + (size_t)M * 512 * 4;
constexpr size_t WS_QF = WS_ZL + (size_t)M * 512 * 4;
constexpr size_t WS_PF = WS_QF + (size_t)2048 * 4096 * 4;
constexpr size_t WS_SINIT = WS_PF + (size_t)2048 * 4096 * 4;
constexpr size_t WS_VCUR = WS_SINIT + (size_t)2048 * 4096 * 4;
constexpr size_t WS_BON = WS_VCUR + (size_t)M * 512 * 4;
constexpr size_t WS_QN = WS_BON + (size_t)M * 8 * 4;
constexpr size_t WS_KS = WS_QN + (size_t)M * 512 * 2;
constexpr size_t WS_KW = WS_KS + (size_t)M * 128 * 2;
constexpr size_t WS_VST = WS_KW + (size_t)M * 128 * 2;
constexpr size_t WS_VWT = WS_VST + (size_t)M * 128 * 2;
constexpr size_t WS_ACMP = WS_VWT + (size_t)M * 128 * 2;
constexpr size_t WS_KC = WS_ACMP + (size_t)2 * 1024 * 2048 * 2;
constexpr size_t WS_VCT = WS_KC + (size_t)4 * 256 * 64 * 2;
constexpr size_t WS_QM = WS_VCT + (size_t)4 * 256 * 64 * 2;
constexpr size_t WS_KMEM = WS_QM + (size_t)M * 512 * 2;
constexpr size_t WS_VMEMT = WS_KMEM + (size_t)8 * 256 * 128 * 2;
constexpr size_t WS_HP = WS_VMEMT + (size_t)8 * 256 * 128 * 2;
constexpr size_t WS_MIX_END = WS_HP + (size_t)4 * 2 * 1024 * 128 * 4;
constexpr size_t WS_ZB = WS_OV;
constexpr size_t WS_MG = WS_ZB + (size_t)5 * M * D * 2;
constexpr size_t WS_ACT = WS_OV;
constexpr size_t WS_XG = WS_OV;
constexpr size_t WS_ACTM = WS_XG + (size_t)SLOTS * 2048 * 2;
constexpr size_t WS_YS = WS_ACTM + (size_t)SLOTS * EFF * 2;
constexpr size_t WS_RSS = WS_YS + (size_t)SLOTS * 2048 * 2;
constexpr size_t WS_MOE_END = WS_RSS + (size_t)SLOTS * 4;
constexpr size_t WS_END = WS_MIX_END > WS_MOE_END ? WS_MIX_END : WS_MOE_END;
static_assert(WS_END <= (size_t)1119977216, "workspace map exceeds the guaranteed d_ws size");
static_assert(WS_MG + (size_t)M * D * 2 <= WS_MIX_END, "Z view inside overlay");

constexpr int CW_BAR = 4096;
constexpr int CW_SSQ = 16384;
constexpr int CW_CNT = CW_SSQ + 4 * 8192 * 2;
constexpr int CW_QCTR = CW_CNT + 512;
constexpr int CW_ROUTE = CW_CNT + 1024;
static_assert((CW_ROUTE + 8 * 8192) * 4 <= (int)CTL_BYTES, "CTL map");

constexpr int RING_BYTES = 131072;
constexpr int MISC_OFF = RING_BYTES + 320;
constexpr int LDS_BYTES = 147456;

#define RLX_AGENT __ATOMIC_RELAXED, __HIP_MEMORY_SCOPE_AGENT
#define LDS_WAIT() asm volatile("s_waitcnt lgkmcnt(0)" ::: "memory")
#define VM_WAIT() asm volatile("s_waitcnt vmcnt(0)" ::: "memory")
__device__ __forceinline__ unsigned f2bf(float f) { unsigned u = __builtin_bit_cast(unsigned, f); return (u + 0x7fffu + ((u >> 16) & 1u)) >> 16; }
__device__ __forceinline__ float bf2f(unsigned b) { return __builtin_bit_cast(float, b << 16); }
typedef __bf16 bf16x2_t __attribute__((ext_vector_type(2)));
__device__ __forceinline__ unsigned pk2(float lo, float hi) { const bf16x2_t b = __builtin_convertvector((f32x2){lo, hi}, bf16x2_t); return __builtin_bit_cast(unsigned, b); }
__device__ __forceinline__ unsigned pk4_fp8(float a, float b, float c, float d) { unsigned w = 0u; w = (unsigned)__builtin_amdgcn_cvt_pk_fp8_f32(a, b, (int)w, false); w = (unsigned)__builtin_amdgcn_cvt_pk_fp8_f32(c, d, (int)w, true); return w; }
constexpr float W8S = 64.0f, W8SI = 1.0f / 64.0f;
__device__ __forceinline__ float sigmoidf_(float x) { return __builtin_amdgcn_rcpf(1.f + __builtin_amdgcn_exp2f(x * -1.4426950408889634f)); }
#define DPPF(v, ctrl) __builtin_bit_cast(float, __builtin_amdgcn_update_dpp(0, __builtin_bit_cast(int, (v)), (ctrl), 0xf, 0xf, true))
__device__ __forceinline__ float red16_max(float v) { v = fmaxf(v, DPPF(v, 0xB1)); v = fmaxf(v, DPPF(v, 0x4E)); v = fmaxf(v, DPPF(v, 0x141)); v = fmaxf(v, DPPF(v, 0x140)); return v; }
__device__ __forceinline__ float red16_sum(float v) { v += DPPF(v, 0xB1); v += DPPF(v, 0x4E); v += DPPF(v, 0x141); v += DPPF(v, 0x140); return v; }
__device__ __forceinline__ float wave_sum(float v) {
#pragma unroll
    for (int o = 1; o < 64; o <<= 1) v += __shfl_xor(v, o);
    return v;
}

#define XB_TMO      128
#define XB_XCNT(j)  (256  + 64 * (j))
#define XB_XSUB(j)  (1280 + 64 * (j))
#define XB_XGEN(j)  (2304 + 64 * (j))
#define XB_TOP      3328
#define XB_TOPGEN   3392
#define XCD_BAR_WORDS 3456
#define XB_SPIN_CAP (1u << 18)
__device__ __forceinline__ unsigned xb_ld(unsigned* p)              { return __hip_atomic_load(p, __ATOMIC_RELAXED, __HIP_MEMORY_SCOPE_AGENT); }
__device__ __forceinline__ unsigned xb_add(unsigned* p, unsigned v) { return __hip_atomic_fetch_add(p, v, __ATOMIC_RELAXED, __HIP_MEMORY_SCOPE_AGENT); }
__device__ __forceinline__ unsigned xb_xcc_id() { return (unsigned)__builtin_amdgcn_s_getreg((3 << 11) | 20) & 0xFu; }
#define XB_SPIN(cond, bar) do { unsigned _sp = 0; while (cond) { __builtin_amdgcn_s_sleep(1); \
    if ((++_sp & 255u) == 0u) { if (xb_ld(&(bar)[XB_TMO])) break; if (_sp > XB_SPIN_CAP) { atomicAdd(&(bar)[XB_TMO], 1u); break; } } } } while (0)
struct XcdBarrier { unsigned* bar; unsigned x; volatile LAS unsigned* st; int wave; };
__device__ __forceinline__ bool xb_t0(int wave) { return wave == 0 && __builtin_amdgcn_mbcnt_hi(~0u, __builtin_amdgcn_mbcnt_lo(~0u, 0u)) == 0u; }
__device__ __forceinline__ XcdBarrier xcd_barrier_post(unsigned* bar, volatile LAS unsigned* st, int wave) {
    XcdBarrier b; b.bar = bar; b.x = xb_xcc_id(); b.st = st; b.wave = wave;
    if (xb_t0(wave)) (void)xb_add(&bar[XB_XCNT(b.x)], 1u);
    return b;
}
__device__ __forceinline__ void xcd_barrier_complete(unsigned* bar, unsigned x, unsigned& nloc, unsigned& nx) {
    const unsigned G = gridDim.x * gridDim.y * gridDim.z;
    unsigned sum, cnt, mine, sp = 0u;
    for (;;) {
        sum = 0u; cnt = 0u; mine = 0u;
#pragma unroll
        for (unsigned j = 0; j < 16; ++j) { const unsigned c = xb_ld(&bar[XB_XCNT(j)]); sum += c; cnt += (c > 0u) ? 1u : 0u; mine = (j == x) ? c : mine; }
        if (sum == G) break;
        __builtin_amdgcn_s_sleep(1);
        if ((++sp & 255u) == 0u) { if (xb_ld(&bar[XB_TMO])) break; if (sp > XB_SPIN_CAP) { atomicAdd(&bar[XB_TMO], 1u); break; } }
    }
    nloc = mine > 0u ? mine : 1u; nx = cnt > 0u ? cnt : 1u;
}
__device__ __forceinline__ void xcd_barrier(const XcdBarrier& b) {
    asm volatile("s_waitcnt vmcnt(0)" ::: "memory");
    __syncthreads();
    if (xb_t0(b.wave)) {
        unsigned* bar = b.bar;
        __builtin_amdgcn_s_waitcnt(0);
        unsigned nloc = b.st[0], nx = b.st[1];
        if (nloc == 0u) { xcd_barrier_complete(bar, b.x, nloc, nx); b.st[0] = nloc; b.st[1] = nx; }
        const unsigned old = xb_add(&bar[XB_XSUB(b.x)], 1u);
        const unsigned gen = old / nloc;
        if (old + 1u == (gen + 1u) * nloc) {
            __builtin_amdgcn_fence(__ATOMIC_RELEASE, "agent");
            asm volatile("s_waitcnt vmcnt(0)" ::: "memory");
            const unsigned og = xb_add(&bar[XB_TOP], 1u);
            const unsigned tg = og / nx;
            if (og + 1u == (tg + 1u) * nx) xb_add(&bar[XB_TOPGEN], 1u);
            else XB_SPIN(xb_ld(&bar[XB_TOPGEN]) == tg, bar);
            __builtin_amdgcn_fence(__ATOMIC_ACQUIRE, "agent");
            xb_add(&bar[XB_XGEN(b.x)], 1u);
            asm volatile("s_waitcnt vmcnt(0)" ::: "memory");
        } else {
            XB_SPIN(xb_ld(&bar[XB_XGEN(b.x)]) == gen, bar);
            __builtin_amdgcn_fence(__ATOMIC_ACQUIRE, "agent");
            asm volatile("s_waitcnt vmcnt(0)" ::: "memory");
        }
    }
    __syncthreads();
}

namespace pg8 {
typedef int v4i_t __attribute__((ext_vector_type(4)));
typedef int v8i_t __attribute__((ext_vector_type(8)));
constexpr int BM = 256, BK = 64, HALF = 128, HTB = HALF * BK * 2, STAGE_BYTES = 8 * HTB, NXCD = 8, WGM = 8;
__host__ __device__ __forceinline__ int lds_byte(int r, int c) { const int st = (r >> 4) * 2 + (c >> 5), rr = r & 15, cc = c & 31, ob = rr * 64 + cc * 2; return st * 1024 + (ob ^ (((ob >> 9) & 1) << 5)); }
__host__ __device__ __forceinline__ void stage_rc(int b, int& R, int& C) { const int st = b / 1024, sb = b % 1024, swz = sb ^ (((sb >> 9) & 1) << 5); R = (st >> 1) * 16 + swz / 64; C = (st & 1) * 32 + (swz % 64) / 2; }
__host__ __device__ __forceinline__ int perm32(int rho) { const int n = rho >> 4, i = rho & 15; return 8 * (i >> 2) + 4 * n + (i & 3); }
struct Unit { int pm, pn, z; };
struct Gemm { const bf16* A; const bf16* Bt; int lda, ldb, K; size_t az, bz; };

struct GridOrder {
    int nM, nN, nZ, G, c;
    __device__ void init(int nM_, int nN_, int nZ_, int G_, int c_) { nM = nM_; nN = nN_; nZ = nZ_; G = G_; c = c_; }
    __device__ bool next(int i, Unit& u) const {
        const long L = (long)i * G + c; const int nwg = nM * nN; if (L >= (long)nwg * nZ) return false;
        u.z = (int)(L / nwg); int wgid = (int)(L % nwg);
        { const int q = nwg / NXCD, r = nwg % NXCD, xcd = wgid % NXCD, off = wgid / NXCD; wgid = (xcd < r ? xcd * (q + 1) : r * (q + 1) + (xcd - r) * q) + off; }
        const int nig = WGM * nN, gid = wgid / nig, fm = gid * WGM, gsz = (nM - fm) < WGM ? (nM - fm) : WGM;
        u.pm = fm + ((wgid % nig) % gsz); u.pn = (wgid % nig) / gsz; return true;
    }
    __device__ __forceinline__ void a_ready(const Unit&) const {}
    __device__ __forceinline__ void done(const Unit&) const {}
};
struct PBOrder {
    GridOrder base; int nP, nX;
    __device__ bool next(int i, Unit& u) const {
        const long L = (long)i * base.G + base.c;
        if (L < nP) return base.next(i, u);
        const int e = (int)(L - nP); if (e >= nX) return false;
        u.z = 1; u.pm = e & 1; u.pn = e >> 1; return true; }
    __device__ __forceinline__ void a_ready(const Unit&) const {}
    __device__ __forceinline__ void done(const Unit&) const {}
};
struct MoeOrder {
    int ts[9]; int nN, G, c;
    __device__ bool next(int i, Unit& u) const {
        const long L = (long)i * G + c; const int rt = (int)(L / nN); if (rt >= ts[8]) return false;
        u.pn = (int)(L % nN); u.pm = rt; int e = 0;
#pragma unroll
        for (int j = 1; j < 8; ++j) e += (rt >= ts[j]) ? 1 : 0;
        u.z = e; return true;
    }
    __device__ __forceinline__ void a_ready(const Unit&) const {}
    __device__ __forceinline__ void done(const Unit&) const {}
};

template <class Epi, class Sched, bool ALIGN_EPI = true, bool F8 = false>
__device__ __forceinline__ void gemm_phase(LAS unsigned char* lds, const Gemm g, const Sched& S, const Epi& E, int wave0) {
    int lane_ = (int)__builtin_amdgcn_mbcnt_hi(~0u, __builtin_amdgcn_mbcnt_lo(~0u, 0u)); asm volatile("" : "+v"(lane_));
    const int wid = wave0, lane = lane_, tid = wid * 64 + lane, wr = wid >> 2, wc = wid & 3, fr = lane & 15, fq = lane >> 4;
    const int K = g.K, nt = K / BK;
    unsigned voffA[2], voffB[2];
#pragma unroll
    for (int i = 0; i < 2; ++i) { int R, C; stage_rc(tid * 16 + i * 8192, R, C); const int Rb = Epi::PERM ? ((R & ~31) + perm32(R & 31)) : R;
        voffA[i] = (unsigned)(R * g.lda + C) * 2u; voffB[i] = (unsigned)(Rb * g.ldb + C) * 2u; }
    const size_t kstep = (size_t)(BK * 2);
    const size_t hA = (size_t)HALF * g.lda * 2, hB = (size_t)HALF * g.ldb * 2;
    const unsigned ldsw = (unsigned)wid * 1024u;
    const int aoff = lds_byte(wr * 64 + fr, fq * 8), boff = lds_byte(wc * 32 + fr, fq * 8);
#define PG8_SA(b, h) (((b) * 2 + (h)) * HTB)
#define PG8_SB(b, h) ((4 + (b) * 2 + (h)) * HTB)
#define PG8_STAGE(bufoff, gbase, voff) do { _Pragma("unroll") for (int _i = 0; _i < 2; ++_i) \
        __builtin_amdgcn_global_load_lds((const unsigned*)((const char*)(gbase) + (voff)[_i]), (LAS unsigned*)(lds + (bufoff) + ldsw + _i * 8192), 16, 0, 0); } while (0)
#define PG8_LDA(dst, b, h) do { _Pragma("unroll") for (int m = 0; m < 4; ++m) _Pragma("unroll") for (int k = 0; k < 2; ++k) dst[m][k] = *(const LAS bf16x8*)(lds + PG8_SA(b, h) + aoff + m * 2048 + k * 1024); } while (0)
#define PG8_LDB(dst, b, h) do { _Pragma("unroll") for (int n = 0; n < 2; ++n) _Pragma("unroll") for (int k = 0; k < 2; ++k) dst[n][k] = *(const LAS bf16x8*)(lds + PG8_SB(b, h) + boff + n * 2048 + k * 1024); } while (0)
#define PG8_MMA(ai, bj, At, Bt) do { __builtin_amdgcn_s_setprio(1); \
        if constexpr (F8) { _Pragma("unroll") for (int m = 0; m < 4; ++m) _Pragma("unroll") for (int n = 0; n < 2; ++n) { \
            const v4i_t b0 = __builtin_bit_cast(v4i_t, Bt[n][0]), b1 = __builtin_bit_cast(v4i_t, Bt[n][1]), a0 = __builtin_bit_cast(v4i_t, At[m][0]), a1 = __builtin_bit_cast(v4i_t, At[m][1]); \
            const v8i_t b8 = __builtin_shufflevector(b0, b1, 0, 1, 2, 3, 4, 5, 6, 7), a8 = __builtin_shufflevector(a0, a1, 0, 1, 2, 3, 4, 5, 6, 7); \
            asm volatile("v_mfma_f32_16x16x128_f8f6f4 %0, %1, %2, %0" : "+v"(acc[ai][bj][m][n]) : "v"(b8), "v"(a8)); } }     \
        else { _Pragma("unroll") for (int m = 0; m < 4; ++m) _Pragma("unroll") for (int n = 0; n < 2; ++n) _Pragma("unroll") for (int k = 0; k < 2; ++k) \
            acc[ai][bj][m][n] = __builtin_amdgcn_mfma_f32_16x16x32_bf16(Bt[n][k], At[m][k], acc[ai][bj][m][n], 0, 0, 0); } \
        __builtin_amdgcn_s_setprio(0); } while (0)
#define PG8_WAIT_V(n) asm volatile("s_waitcnt vmcnt(" #n ")" ::: "memory")
#define PG8_WAIT_L(n) asm volatile("s_waitcnt lgkmcnt(" #n ")" ::: "memory")
#define PG8_BAR __builtin_amdgcn_s_barrier()
#define PG8_SCHED __builtin_amdgcn_sched_barrier(0)
    Unit cur, nxt; int ui = 0;
    if (!S.next(0, cur)) return;
    f32x4 acc[2][2][4][2];
#pragma unroll
    for (int a = 0; a < 2; ++a)
#pragma unroll
        for (int b = 0; b < 2; ++b)
#pragma unroll
            for (int m = 0; m < 4; ++m)
#pragma unroll
                for (int n = 0; n < 2; ++n) acc[a][b][m][n] = (f32x4){0.f, 0.f, 0.f, 0.f};
    bf16x8 At[4][2], B0[2][2], B1[2][2];
    const char* cA = (const char*)g.A + (size_t)cur.z * g.az + (size_t)cur.pm * 2 * hA; const char* cB = (const char*)g.Bt + (size_t)cur.z * g.bz + (size_t)cur.pn * 2 * hB;
    S.a_ready(cur);
    PG8_STAGE(PG8_SB(0, 0), cB, voffB); PG8_STAGE(PG8_SB(0, 1), cB + hB, voffB); PG8_STAGE(PG8_SA(0, 0), cA, voffA); PG8_STAGE(PG8_SA(0, 1), cA + hA, voffA);
    if (wr == 1) PG8_BAR;
    PG8_WAIT_V(2); PG8_BAR;
    PG8_STAGE(PG8_SB(1, 0), cB + kstep, voffB); PG8_STAGE(PG8_SA(1, 0), cA + kstep, voffA); PG8_STAGE(PG8_SB(1, 1), cB + hB + kstep, voffB);
    PG8_WAIT_V(6); PG8_BAR;
    for (;;) {
        const bool has_next = S.next(ui + 1, nxt);
        const char* nA = has_next ? (const char*)g.A + (size_t)nxt.z * g.az + (size_t)nxt.pm * 2 * hA : cA; const char* nB = has_next ? (const char*)g.Bt + (size_t)nxt.z * g.bz + (size_t)nxt.pn * 2 * hB : cB;
        for (int t = 0; t < nt; t += 2) {
            const bool last = (t == nt - 2);
            const char* a1 = cA + (size_t)(t + 1) * kstep;
            const char* a2 = last ? nA : cA + (size_t)(t + 2) * kstep; const char* b2 = last ? nB : cB + (size_t)(t + 2) * kstep;
            const char* a3 = a2 + kstep; const char* b3 = b2 + kstep;
            if (last && has_next) S.a_ready(nxt);
            PG8_LDB(B0, 0, 0); PG8_LDB(B1, 0, 1); PG8_SCHED; PG8_LDA(At, 0, 0); PG8_STAGE(PG8_SA(1, 1), a1 + hA, voffA);
            PG8_WAIT_V(8); PG8_WAIT_L(0); PG8_BAR; PG8_MMA(0, 0, At, B0); PG8_MMA(0, 1, At, B1); PG8_BAR; PG8_SCHED;
            PG8_LDA(At, 0, 1); PG8_STAGE(PG8_SB(0, 0), b2, voffB); PG8_STAGE(PG8_SB(0, 1), b2 + hB, voffB); PG8_STAGE(PG8_SA(0, 0), a2, voffA);
            PG8_WAIT_V(8); PG8_WAIT_L(0); PG8_BAR; PG8_MMA(1, 0, At, B0); PG8_MMA(1, 1, At, B1); PG8_BAR; PG8_SCHED;
            PG8_LDB(B0, 1, 0); PG8_LDB(B1, 1, 1); PG8_SCHED; PG8_LDA(At, 1, 0); PG8_STAGE(PG8_SA(0, 1), a2 + hA, voffA);
            PG8_WAIT_V(8); PG8_WAIT_L(0); PG8_BAR; PG8_MMA(0, 0, At, B0); PG8_MMA(0, 1, At, B1); PG8_BAR; PG8_SCHED;
            PG8_LDA(At, 1, 1); PG8_STAGE(PG8_SB(1, 0), b3, voffB); PG8_STAGE(PG8_SB(1, 1), b3 + hB, voffB); PG8_STAGE(PG8_SA(1, 0), a3, voffA);
            PG8_WAIT_V(8); PG8_WAIT_L(0); PG8_BAR; PG8_MMA(1, 0, At, B0); PG8_MMA(1, 1, At, B1); PG8_BAR; PG8_SCHED;
        }
        if constexpr (ALIGN_EPI) { if (wr == 0) PG8_BAR; }
        if constexpr (F8) asm volatile("s_nop 15\n\ts_nop 15\n\ts_nop 15\n\ts_nop 15" ::: "memory");
        if constexpr (!Epi::AFTER_DRAIN) { E(acc, cur, wr, wc, fr, fq); S.done(cur); }
        if (!has_next) break;
#pragma unroll
        for (int a = 0; a < 2; ++a)
#pragma unroll
            for (int b = 0; b < 2; ++b)
#pragma unroll
                for (int m = 0; m < 4; ++m)
#pragma unroll
                    for (int n = 0; n < 2; ++n) acc[a][b][m][n] = (f32x4){0.f, 0.f, 0.f, 0.f};
        cur = nxt; cA = nA; cB = nB; ++ui;
        if constexpr (ALIGN_EPI) { if (wr == 1) PG8_BAR; }
    }
    PG8_WAIT_V(0);
    if constexpr (!ALIGN_EPI) { if (wr == 0) PG8_BAR; }
    PG8_BAR;
    if constexpr (Epi::AFTER_DRAIN) { E.fused(acc, cur, wr, wc, fr, fq, lds, wid, lane); S.done(cur); }
#undef PG8_SA
#undef PG8_SB
#undef PG8_STAGE
#undef PG8_LDA
#undef PG8_LDB
#undef PG8_MMA
#undef PG8_WAIT_V
#undef PG8_WAIT_L
#undef PG8_BAR
#undef PG8_SCHED
}
}
using pg8::Unit; using pg8::HALF; using pg8::BM;
typedef const f32x4 (&AccT)[2][2][4][2];

typedef unsigned long long u64;
__device__ __forceinline__ float rstd_of(const u64* ssq, int row) { return 1.0f / sqrtf((float)ssq[row] * (1.0f / 4294967296.0f) * (1.0f / D) + NORM_EPS); }
__device__ __forceinline__ size_t zblk(int row, int col) { return ((size_t)(row >> 4) * (D / 16) + (col >> 4)) * 256 + (row & 15) * 16 + (col & 15); }
__device__ __forceinline__ float rstd_raw(u64 q) { return 1.0f / sqrtf((float)q * (1.0f / 4294967296.0f) * (1.0f / D) + NORM_EPS); }
__device__ __forceinline__ u64 ssq_fix(float s) { return (u64)(s * 4294967296.0f); }

struct EpiP {
    static constexpr bool PERM = true, AFTER_DRAIN = false;
    bf16* P; bf16* G4; const u64* ssq; int nNP;
    __device__ __forceinline__ void operator()(AccT acc, const Unit& u, int wr, int wc, int fr, int fq) const {
        const int row0 = u.pm * BM + wr * 64 + fr; const bool gate = u.pn >= nNP;
        bf16* base = gate ? G4 : P; const int ld = gate ? D : LDP; const int col0 = (gate ? (u.pn - nNP) : u.pn) * BM + wc * 32 + 8 * fq;
        float rs8[2][4];
#pragma unroll
        for (int ai = 0; ai < 2; ++ai)
#pragma unroll
            for (int m = 0; m < 4; ++m) rs8[ai][m] = rstd_of(ssq, row0 + ai * HALF + m * 16);
#pragma unroll
        for (int ai = 0; ai < 2; ++ai)
#pragma unroll
            for (int m = 0; m < 4; ++m) { const int row = row0 + ai * HALF + m * 16; const float rs = rs8[ai][m]; bf16* rowp = base + (size_t)row * ld + col0;
#pragma unroll
                for (int bj = 0; bj < 2; ++bj) { f32x4 v0 = acc[ai][bj][m][0] * rs, v1 = acc[ai][bj][m][1] * rs;
                    if (gate) {
#pragma unroll
                        for (int j = 0; j < 4; ++j) { v0[j] = sigmoidf_(v0[j]); v1[j] = sigmoidf_(v1[j]); } }
                    u32x4 w; w.x = pk2(v0[0], v0[1]); w.y = pk2(v0[2], v0[3]); w.z = pk2(v1[0], v1[1]); w.w = pk2(v1[2], v1[3]);
                    *(u32x4*)(rowp + bj * HALF) = w; } }
    }
};
struct EpiGate4 {
    static constexpr bool PERM = true, AFTER_DRAIN = false;
    bf16* G4; const u64* ssq;
    __device__ __forceinline__ void operator()(AccT acc, const Unit& u, int wr, int wc, int fr, int fq) const {
        const int row0 = u.pm * BM + wr * 64 + fr, col0 = u.pn * BM + wc * 32 + 8 * fq;
        float rs8[2][4];
#pragma unroll
        for (int ai = 0; ai < 2; ++ai)
#pragma unroll
            for (int m = 0; m < 4; ++m) rs8[ai][m] = rstd_of(ssq, row0 + ai * HALF + m * 16) * W8SI;
#pragma unroll
        for (int ai = 0; ai < 2; ++ai)
#pragma unroll
            for (int m = 0; m < 4; ++m) { const int row = row0 + ai * HALF + m * 16; const float rs = rs8[ai][m];
#pragma unroll
                for (int bj = 0; bj < 2; ++bj) { f32x4 v0 = acc[ai][bj][m][0] * rs, v1 = acc[ai][bj][m][1] * rs;
#pragma unroll
                    for (int j = 0; j < 4; ++j) { v0[j] = sigmoidf_(v0[j]); v1[j] = sigmoidf_(v1[j]); }
                    u32x4 w; w.x = pk2(v0[0], v0[1]); w.y = pk2(v0[2], v0[3]); w.z = pk2(v1[0], v1[1]); w.w = pk2(v1[2], v1[3]);
                    *(u32x4*)(G4 + zblk(row, col0 + bj * HALF)) = w; } }
    }
};
struct EpiF32 {
    static constexpr bool PERM = false, AFTER_DRAIN = false;
    float* C; int ldc;
    __device__ __forceinline__ void operator()(AccT acc, const Unit& u, int wr, int wc, int fr, int fq) const {
        const int row0 = u.pm * BM + wr * 64 + fr, col0 = u.pn * BM + wc * 32 + 4 * fq;
#pragma unroll
        for (int ai = 0; ai < 2; ++ai)
#pragma unroll
            for (int m = 0; m < 4; ++m) { float* rowp = C + (size_t)(row0 + ai * HALF + m * 16) * ldc + col0;
#pragma unroll
                for (int bj = 0; bj < 2; ++bj)
#pragma unroll
                    for (int n = 0; n < 2; ++n) *(f32x4*)(rowp + bj * HALF + n * 16) = acc[ai][bj][m][n]; }
    }
};
struct EpiLora {
    static constexpr bool PERM = false, AFTER_DRAIN = false;
    float* LO; const float* w0; const float* a0; const float* v0; int has_v;
    __device__ __forceinline__ void operator()(AccT acc, const Unit& u, int wr, int wc, int fr, int fq) const {
        const int row0 = u.pm * BM + wr * 64 + fr, col0 = u.pn * BM + wc * 32 + 4 * fq; const int blk = u.pn >> 1;
        f32x4 bias4[2][2];
#pragma unroll
        for (int bj = 0; bj < 2; ++bj)
#pragma unroll
            for (int n = 0; n < 2; ++n) { const int j = (col0 + bj * HALF + n * 16) & 511; f32x4 bb = (f32x4){0.f, 0.f, 0.f, 0.f};
                if (blk == 0) bb = *(const f32x4*)(w0 + j); else if (blk == 1) bb = *(const f32x4*)(a0 + j); else if (blk == 3 && has_v) bb = *(const f32x4*)(v0 + j);
                bias4[bj][n] = bb; }
#pragma unroll
        for (int bj = 0; bj < 2; ++bj)
#pragma unroll
            for (int n = 0; n < 2; ++n) { const int col = col0 + bj * HALF + n * 16; const f32x4 bias = bias4[bj][n];
#pragma unroll
                for (int ai = 0; ai < 2; ++ai)
#pragma unroll
                    for (int m = 0; m < 4; ++m) { f32x4 v = acc[ai][bj][m][n] + bias;
                        if (blk == 0) {
#pragma unroll
                            for (int e = 0; e < 4; ++e) { const float x = v[e]; const float sp = fmaxf(-x, 0.f) + log1pf(__expf(-fabsf(x)));
                                v[e] = __expf(-__expf(-sp - 0.5f)); } }
                        else if (blk != 2) {
#pragma unroll
                            for (int e = 0; e < 4; ++e) v[e] = sigmoidf_(v[e]); }
                        *(f32x4*)(LO + (size_t)(row0 + ai * HALF + m * 16) * 2048 + col) = v; } }
    }
};
struct EpiZ {
    static constexpr bool PERM = true, AFTER_DRAIN = false;
    bf16* ZB;
    __device__ __forceinline__ void operator()(AccT acc, const Unit& u, int wr, int wc, int fr, int fq) const {
        const int row0 = u.pm * BM + wr * 64 + fr, col0 = u.pn * BM + wc * 32 + 8 * fq; bf16* base = ZB + (size_t)u.z * M * D;
#pragma unroll
        for (int ai = 0; ai < 2; ++ai)
#pragma unroll
            for (int m = 0; m < 4; ++m) { const int row = row0 + ai * HALF + m * 16;
#pragma unroll
                for (int bj = 0; bj < 2; ++bj) { const f32x4 v0 = acc[ai][bj][m][0], v1 = acc[ai][bj][m][1];
                    u32x4 w; w.x = pk2(v0[0], v0[1]); w.y = pk2(v0[2], v0[3]); w.z = pk2(v1[0], v1[1]); w.w = pk2(v1[2], v1[3]);
                    *(u32x4*)(base + zblk(row, col0 + bj * HALF)) = w; } }
    }
};
struct EpiG {
    static constexpr bool PERM = false, AFTER_DRAIN = false;
    const bf16* ZB; const bf16* G4; bf16* MG; const u64* ssq; float wsi;
    struct Bat { u64 q[2]; u32x2 g4[2], z4[2], zz[2][4]; };
    __device__ __forceinline__ void load(Bat& B, int k, int row0, int c0) const {
#pragma unroll
        for (int mm = 0; mm < 2; ++mm) { const int row = row0 + (k >> 1) * HALF + (2 * (k & 1) + mm) * 16; const size_t off = zblk(row, c0);
            B.q[mm] = ssq[row]; B.g4[mm] = *(const u32x2*)(G4 + off); B.z4[mm] = *(const u32x2*)(ZB + (size_t)4 * M * D + off);
#pragma unroll
            for (int br = 0; br < 4; ++br) B.zz[mm][br] = *(const u32x2*)(ZB + (size_t)br * M * D + off); }
    }
    __device__ __forceinline__ void operator()(AccT acc, const Unit& u, int wr, int wc, int fr, int fq) const {
        const int row0 = u.pm * BM + wr * 64 + fr, c0 = u.pn * 64 + wc * 16 + 4 * fq;
        Bat b[2]; load(b[0], 0, row0, c0);
#pragma unroll
        for (int k = 0; k < 4; ++k) { const int ai = k >> 1;
            if (k < 3) load(b[(k + 1) & 1], k + 1, row0, c0);
            const Bat& B = b[k & 1];
#pragma unroll
            for (int mm = 0; mm < 2; ++mm) { const int m = 2 * (k & 1) + mm, row = row0 + ai * HALF + m * 16; const float rs = rstd_raw(B.q[mm]) * wsi;
                f32x4 s;
                s[0] = bf2f(B.g4[mm].x & 0xffffu) * bf2f(B.z4[mm].x & 0xffffu); s[1] = bf2f(B.g4[mm].x >> 16) * bf2f(B.z4[mm].x >> 16);
                s[2] = bf2f(B.g4[mm].y & 0xffffu) * bf2f(B.z4[mm].y & 0xffffu); s[3] = bf2f(B.g4[mm].y >> 16) * bf2f(B.z4[mm].y >> 16);
#pragma unroll
                for (int bj = 0; bj < 2; ++bj)
#pragma unroll
                    for (int n = 0; n < 2; ++n) { const int br = 2 * bj + n; const u32x2 z = B.zz[mm][br]; const f32x4 a = acc[ai][bj][m][n] * rs;
                        s[0] += sigmoidf_(a[0]) * bf2f(z.x & 0xffffu); s[1] += sigmoidf_(a[1]) * bf2f(z.x >> 16);
                        s[2] += sigmoidf_(a[2]) * bf2f(z.y & 0xffffu); s[3] += sigmoidf_(a[3]) * bf2f(z.y >> 16); }
                u32x2 w; w.x = pk2(s[0], s[1]); w.y = pk2(s[2], s[3]); *(u32x2*)(MG + (size_t)row * D + c0) = w; } }
    }
};
struct EpiRes {
    static constexpr bool PERM = true, AFTER_DRAIN = false;
    bf16* XH; u64* ssq; unsigned char* XH8;
    __device__ __forceinline__ void operator()(AccT acc, const Unit& u, int wr, int wc, int fr, int fq) const {
        const int row0 = u.pm * BM + wr * 64 + fr, col0 = u.pn * BM + wc * 32 + 8 * fq;
#pragma unroll
        for (int ai = 0; ai < 2; ++ai) {
            u32x4 rv[4][2];
#pragma unroll
            for (int m = 0; m < 4; ++m) { const size_t off = (size_t)(row0 + ai * HALF + m * 16) * D + col0;
#pragma unroll
                for (int bj = 0; bj < 2; ++bj) rv[m][bj] = *(const u32x4*)(XH + off + bj * HALF); }
#pragma unroll
            for (int m = 0; m < 4; ++m) { const int row = row0 + ai * HALF + m * 16; const size_t off = (size_t)row * D + col0; float sq = 0.f;
#pragma unroll
                for (int bj = 0; bj < 2; ++bj) { const size_t o = off + bj * HALF; const u32x4 r = rv[m][bj];
                    const f32x4 v0 = (f32x4){bf2f(r.x & 0xffffu), bf2f(r.x >> 16), bf2f(r.y & 0xffffu), bf2f(r.y >> 16)} + acc[ai][bj][m][0];
                    const f32x4 v1 = (f32x4){bf2f(r.z & 0xffffu), bf2f(r.z >> 16), bf2f(r.w & 0xffffu), bf2f(r.w >> 16)} + acc[ai][bj][m][1];
                    sq += ((v0[0] * v0[0] + v0[1] * v0[1]) + (v0[2] * v0[2] + v0[3] * v0[3])) + ((v1[0] * v1[0] + v1[1] * v1[1]) + (v1[2] * v1[2] + v1[3] * v1[3]));
                    u32x4 w; w.x = pk2(v0[0], v0[1]); w.y = pk2(v0[2], v0[3]); w.z = pk2(v1[0], v1[1]); w.w = pk2(v1[2], v1[3]); *(u32x4*)(XH + o) = w;
                    u32x2 w8; w8.x = pk4_fp8(v0[0], v0[1], v0[2], v0[3]); w8.y = pk4_fp8(v1[0], v1[1], v1[2], v1[3]); *(u32x2*)(XH8 + o) = w8; }
                sq += __shfl_xor(sq, 16); sq += __shfl_xor(sq, 32);
                if (fq == 0) atomicAdd(ssq + row, ssq_fix(sq)); }
            asm volatile("" ::: "memory"); }
    }
};
template <bool OUT8> struct EpiSwiglu {
    static constexpr bool PERM = true, AFTER_DRAIN = false;
    bf16* ACT; int ldc; const u64* ssq; const float* rss; float wsi; float osc;
    __device__ __forceinline__ void operator()(AccT acc, const Unit& u, int wr, int wc, int fr, int fq) const {
        const int row0 = u.pm * BM + wr * 64 + fr, col0 = u.pn * HALF + wc * 32 + 8 * fq;
        float rs8[2][4];
#pragma unroll
        for (int ai = 0; ai < 2; ++ai)
#pragma unroll
            for (int m = 0; m < 4; ++m) { const int row = row0 + ai * HALF + m * 16; rs8[ai][m] = (rss ? rss[row] : rstd_of(ssq, row)) * wsi; }
#pragma unroll
        for (int ai = 0; ai < 2; ++ai)
#pragma unroll
            for (int m = 0; m < 4; ++m) { const int row = row0 + ai * HALF + m * 16; const float rs = rs8[ai][m];
                float o[8];
#pragma unroll
                for (int n = 0; n < 2; ++n)
#pragma unroll
                    for (int e = 0; e < 4; ++e) { const float a = acc[ai][0][m][n][e] * rs, b = acc[ai][1][m][n][e] * rs; o[4 * n + e] = a * sigmoidf_(a) * b; }
                if constexpr (OUT8) { u32x2 w; w.x = pk4_fp8(o[0] * osc, o[1] * osc, o[2] * osc, o[3] * osc); w.y = pk4_fp8(o[4] * osc, o[5] * osc, o[6] * osc, o[7] * osc);
                    *(u32x2*)((unsigned char*)ACT + (size_t)row * ldc + col0) = w; }
                else { u32x4 w; w.x = pk2(o[0], o[1]); w.y = pk2(o[2], o[3]); w.z = pk2(o[4], o[5]); w.w = pk2(o[6], o[7]);
                    *(u32x4*)(ACT + (size_t)row * ldc + col0) = w; } }
    }
};
struct EpiBf {
    static constexpr bool PERM = true, AFTER_DRAIN = false;
    bf16* O; int ldc; float sc;
    __device__ __forceinline__ void operator()(AccT acc, const Unit& u, int wr, int wc, int fr, int fq) const {
        const int row0 = u.pm * BM + wr * 64 + fr, col0 = u.pn * BM + wc * 32 + 8 * fq;
#pragma unroll
        for (int ai = 0; ai < 2; ++ai)
#pragma unroll
            for (int m = 0; m < 4; ++m) { bf16* rowp = O + (size_t)(row0 + ai * HALF + m * 16) * ldc + col0;
#pragma unroll
                for (int bj = 0; bj < 2; ++bj) { const f32x4 v0 = acc[ai][bj][m][0] * sc, v1 = acc[ai][bj][m][1] * sc;
                    u32x4 w; w.x = pk2(v0[0], v0[1]); w.y = pk2(v0[2], v0[3]); w.z = pk2(v1[0], v1[1]); w.w = pk2(v1[2], v1[3]);
                    *(u32x4*)(rowp + bj * HALF) = w; } }
    }
};
struct EpiHP {
    static constexpr bool PERM = false, AFTER_DRAIN = false;
    float* HP;
    __device__ __forceinline__ void operator()(AccT acc, const Unit& u, int wr, int wc, int fr, int fq) const {
        const int row0 = u.pm * BM + wr * 64 + fr, col0 = wc * 32 + 4 * fq; float* base = HP + (size_t)u.z * 1024 * 128;
#pragma unroll
        for (int ai = 0; ai < 2; ++ai)
#pragma unroll
            for (int m = 0; m < 4; ++m) { float* rowp = base + (size_t)(row0 + ai * HALF + m * 16) * 128 + col0;
#pragma unroll
                for (int n = 0; n < 2; ++n) *(f32x4*)(rowp + n * 16) = acc[ai][0][m][n]; }
    }
};
struct CmpFin { const float* HP; const float* b1; const bf16* w2t; const float* gain; bf16* KC; bf16* VCT; };
__device__ __forceinline__ void cmp_finalize(const CmpFin& C_, int z, int pm, LAS unsigned char* lds, int wid, int lane) {
        LAS bf16* H = (LAS bf16*)lds;
        { const int tid = wid * 64 + lane, r = tid >> 1, c0 = (tid & 1) * 64;
#pragma unroll
          for (int j = 0; j < 16; ++j) { const int c = c0 + 4 * j; f32x4 v = *(const f32x4*)(C_.b1 + z * 128 + c);
#pragma unroll
              for (int kp = 0; kp < 4; ++kp) v += *(const f32x4*)(C_.HP + ((size_t)(kp * 2 + z) * 1024 + pm * 256 + r) * 128 + c);
#pragma unroll
              for (int e = 0; e < 4; ++e) { const float x = v[e]; const float t = 0.7978845608f * (x + 0.044715f * x * x * x); const float th = 1.f - 2.f / (__expf(2.f * t) + 1.f); v[e] = 0.5f * x * (1.f + th); }
              u32x2 w; w.x = pk2(v[0], v[1]); w.y = pk2(v[2], v[3]); *(LAS u32x2*)(H + r * 136 + c) = w; } }
        LDS_WAIT(); __syncthreads();
        bf16x8 af[2][4], bfr[4][4];
#pragma unroll
        for (int mt = 0; mt < 2; ++mt)
#pragma unroll
            for (int ks = 0; ks < 4; ++ks) af[mt][ks] = *(const LAS bf16x8*)(H + (wid * 32 + mt * 16 + (lane & 15)) * 136 + ks * 32 + 8 * (lane >> 4));
#pragma unroll
        for (int n = 0; n < 4; ++n)
#pragma unroll
            for (int ks = 0; ks < 4; ++ks) bfr[n][ks] = *(const bf16x8*)(C_.w2t + (size_t)z * 64 * 128 + (16 * n + (lane & 15)) * 128 + ks * 32 + 8 * (lane >> 4));
        asm volatile("s_waitcnt vmcnt(0) lgkmcnt(0)" ::: "memory"); __builtin_amdgcn_sched_barrier(0);
        f32x4 C[2][4];
#pragma unroll
        for (int mt = 0; mt < 2; ++mt)
#pragma unroll
            for (int n = 0; n < 4; ++n) { C[mt][n] = (f32x4){0.f, 0.f, 0.f, 0.f};
#pragma unroll
                for (int ks = 0; ks < 4; ++ks) C[mt][n] = __builtin_amdgcn_mfma_f32_16x16x32_bf16(af[mt][ks], bfr[n][ks], C[mt][n], 0, 0, 0); }
        __builtin_amdgcn_sched_barrier(0);
#pragma unroll
        for (int mt = 0; mt < 2; ++mt)
#pragma unroll
            for (int r = 0; r < 4; ++r) { const int grow = pm * 256 + wid * 32 + mt * 16 + 4 * (lane >> 4) + r;
                const int hh = grow & 1, bc = grow >> 1, b = bc >> 8, c = bc & 255;
                float ss = 0.f;
#pragma unroll
                for (int n = 0; n < 4; ++n) ss += C[mt][n][r] * C[mt][n][r];
                ss = red16_sum(ss);
                if (c < 255) {
                    if (z == 0) { const float rs = 1.0f / sqrtf(ss * (1.f / 64.f) + NORM_EPS); bf16* dst = C_.KC + ((size_t)(b * 2 + hh) * 256 + c) * 64;
#pragma unroll
                        for (int n = 0; n < 4; ++n) { const int d = 16 * n + (lane & 15); dst[d] = (bf16)f2bf(C[mt][n][r] * rs * C_.gain[d]); } }
                    else { bf16* dst = C_.VCT + (size_t)(b * 2 + hh) * 64 * 256 + c;
#pragma unroll
                        for (int n = 0; n < 4; ++n) { const int d = 16 * n + (lane & 15); dst[(size_t)d * 256] = (bf16)f2bf(C[mt][n][r]); } } } }
        __syncthreads();
}

struct Frame {
    LAS unsigned char* lds; int tid, lane, wave, G, bid;
    const float* const* in; unsigned char* ws; unsigned* ctl;
};
__device__ __forceinline__ Frame relaunder(const Frame& F0) { Frame F = F0; int ln = (int)__builtin_amdgcn_mbcnt_hi(~0u, __builtin_amdgcn_mbcnt_lo(~0u, 0u)); asm volatile("" : "+v"(ln)); F.lane = ln; F.wave = F0.wave; F.tid = F0.wave * 64 + ln; return F; }
#define INP(k) (F.in[k])
__device__ __forceinline__ float ldbf(const bf16* p) { return bf2f(*p); }
__device__ __forceinline__ void ld8(const bf16* p, float (&v)[8]) { const u32x4 r = *(const u32x4*)p;
    v[0] = bf2f(r.x & 0xffffu); v[1] = bf2f(r.x >> 16); v[2] = bf2f(r.y & 0xffffu); v[3] = bf2f(r.y >> 16); v[4] = bf2f(r.z & 0xffffu); v[5] = bf2f(r.z >> 16); v[6] = bf2f(r.w & 0xffffu); v[7] = bf2f(r.w >> 16); }
__device__ __forceinline__ void st8(bf16* p, const float (&v)[8]) { u32x4 w; w.x = pk2(v[0], v[1]); w.y = pk2(v[2], v[3]); w.z = pk2(v[4], v[5]); w.w = pk2(v[6], v[7]); *(u32x4*)p = w; }
__device__ __forceinline__ void ldf8(const float* p, float (&v)[8]) { const f32x4 a = *(const f32x4*)p, b = *(const f32x4*)(p + 4); v[0] = a[0]; v[1] = a[1]; v[2] = a[2]; v[3] = a[3]; v[4] = b[0]; v[5] = b[1]; v[6] = b[2]; v[7] = b[3]; }

template <class Fsrc, bool F8 = false>
__device__ __forceinline__ void tr_matrix(const Frame& F, Fsrc f, int nrows, int K, bf16* dst) {
    LAS float* scr = (LAS float*)(F.lds + F.wave * 16384);
    const int gw = F.bid * 8 + F.wave, NGW = F.G * 8, lane = F.lane;
    const int nblk = nrows / 32, nitems = (K / 64) * nblk;
    const int kq = lane >> 3, n4 = (lane & 7) * 4;
    for (int it = gw; it < nitems; it += NGW) {
        const int kb = it / nblk, nb = it % nblk, k0 = 64 * kb, n0 = 32 * nb;
        f32x4 v[8];
#pragma unroll
        for (int i = 0; i < 8; ++i) v[i] = f(n0 + n4, k0 + 8 * i + kq);
#pragma unroll
        for (int i = 0; i < 8; ++i) { LAS float* d = scr + (8 * i + kq) * 33 + n4; d[0] = v[i][0]; d[1] = v[i][1]; d[2] = v[i][2]; d[3] = v[i][3]; }
        LDS_WAIT(); asm volatile("" ::: "memory");
        const int c = lane & 7;
#pragma unroll
        for (int j = 0; j < 4; ++j) { const int n = (lane >> 3) + 8 * j; const LAS float* sp = scr + (8 * c) * 33 + n;
            if constexpr (F8) { u32x2 o; o.x = pk4_fp8(sp[0 * 33], sp[1 * 33], sp[2 * 33], sp[3 * 33]); o.y = pk4_fp8(sp[4 * 33], sp[5 * 33], sp[6 * 33], sp[7 * 33]);
                *(u32x2*)((unsigned char*)dst + (size_t)(n0 + n) * K + k0 + 8 * c) = o; }
            else { u32x4 o; o.x = pk2(sp[0 * 33], sp[1 * 33]); o.y = pk2(sp[2 * 33], sp[3 * 33]); o.z = pk2(sp[4 * 33], sp[5 * 33]); o.w = pk2(sp[6 * 33], sp[7 * 33]);
                *(u32x4*)(dst + (size_t)(n0 + n) * K + k0 + 8 * c) = o; } }
        LDS_WAIT(); asm volatile("" ::: "memory");
    }
}
#define F4Z ((f32x4){0.f, 0.f, 0.f, 0.f})
struct SrcWP { const float* win; const float* vres; const float* gain; int l, NP;
    __device__ __forceinline__ f32x4 operator()(int n, int k) const {
        f32x4 v;
        if (n < 5848) v = *(const f32x4*)(win + (size_t)k * NIN + n);
        else if (n < NP) v = (l == 1 && n < 5912) ? *(const f32x4*)(vres + (size_t)k * 64 + (n - 5848)) : F4Z;
        else v = *(const f32x4*)(win + (size_t)k * NIN + PC_GATE + 4 * 2048 + (n - NP));
        return v * gain[k]; } };
struct SrcWG4 { const float* win; const float* gain;
    __device__ __forceinline__ f32x4 operator()(int n, int k) const { return *(const f32x4*)(win + (size_t)k * NIN + PC_GATE + 4 * 2048 + n) * (gain[k] * W8S); } };
struct SrcWG { const float* win; const float* gain; float sc;
    __device__ __forceinline__ f32x4 operator()(int n, int k) const {
        const int j = n >> 8, rho = n & 255, bj = rho >> 7, wc = (rho >> 5) & 3, nn = (rho >> 4) & 1, q = (rho >> 2) & 3;
        const int br = 2 * bj + nn, c = 64 * j + 16 * wc + 4 * q;
        return *(const f32x4*)(win + (size_t)k * NIN + PC_GATE + br * 2048 + c) * (gain[k] * sc); } };
struct SrcWB { const float* wb; const float* pw; const float* ps;
    __device__ __forceinline__ f32x4 operator()(int n, int k) const {
        if (n < 8192) { const int i = n >> 11, c = n & 2047; return *(const f32x4*)(wb + ((size_t)i * 512 + k) * 2048 + c); }
        const int c = n - 8192, g = c >> 9;
        if ((k >> 7) != g) return F4Z;
        return *(const f32x4*)(pw + ((size_t)g * 128 + (k & 127)) * 512 + (c & 511)) * *(const f32x4*)(ps + c); } };
struct SrcPlain { const float* w; int ldw;
    __device__ __forceinline__ f32x4 operator()(int n, int k) const { return *(const f32x4*)(w + (size_t)k * ldw + n); } };
struct SrcPlainS { const float* w; int ldw; float sc;
    __device__ __forceinline__ f32x4 operator()(int n, int k) const { return *(const f32x4*)(w + (size_t)k * ldw + n) * sc; } };
struct SrcPlainG { const float* w; int ldw; const float* gain;
    __device__ __forceinline__ f32x4 operator()(int n, int k) const { return *(const f32x4*)(w + (size_t)k * ldw + n) * gain[k]; } };
struct SrcLora { const float* w2; const float* a2; const float* g2; const float* vup; int l;
    __device__ __forceinline__ f32x4 operator()(int n, int k) const {
        const int blk = n >> 9, j = n & 511;
        if (blk == 0) return k < 96 ? *(const f32x4*)(w2 + (size_t)k * 512 + j) : F4Z;
        if (blk == 1) return (k >= 96 && k < 192) ? *(const f32x4*)(a2 + (size_t)(k - 96) * 512 + j) : F4Z;
        if (blk == 2) return (k >= 192 && k < 448) ? *(const f32x4*)(g2 + (size_t)(k - 192) * 512 + j) : F4Z;
        return (l == 1 && k >= 448) ? *(const f32x4*)(vup + (size_t)(k - 448) * 512 + j) : F4Z; } };
struct SrcC1 { const float* w1;
    __device__ __forceinline__ f32x4 operator()(int n, int k) const { const int i = n >> 8, c = n & 255; return c < 128 ? *(const f32x4*)(w1 + ((size_t)i * 2048 + k) * 128 + c) : F4Z; } };
struct SrcW13 { const float* w1; const float* w3; const float* gain; int ffw; float sc;
    __device__ __forceinline__ f32x4 operator()(int n, int k) const { const int t = n >> 8, which = (n >> 7) & 1, ff = 128 * t + (n & 127);
        const uintptr_t a = (uintptr_t)w1, dlt = (uintptr_t)w3 - a; const float* p = (const float*)(a + (which ? dlt : (uintptr_t)0));
        return *(const f32x4*)(p + (size_t)k * ffw + ff) * (gain[k] * sc); } };

__device__ __forceinline__ void phase_prologue(const Frame& F0) {
    const Frame F = relaunder(F0);
    unsigned char* ws = F.ws;
    for (int l = 0; l < 2; ++l) {
        const float* win = INP(5) + (size_t)l * D * NIN; const float* gmix = INP(2) + l * D;
        tr_matrix(F, SrcWP{win, INP(17), gmix, l, l ? NP1 : NP0}, (l ? NP1 : NP0), 2048, (bf16*)(ws + (l ? WS_WPT1 : WS_WPT0)));
        tr_matrix<SrcWG4, true>(F, SrcWG4{win, gmix}, 2048, 2048, (bf16*)(ws + (l ? WS_WG4T1 : WS_WG4T0)));
        tr_matrix<SrcWG, F8_G != 0>(F, SrcWG{win, gmix, F8_G ? W8S : 1.f}, 8192, 2048, (bf16*)(ws + (l ? WS_WGT1 : WS_WGT0)));
        tr_matrix(F, SrcWB{INP(31) + (size_t)l * 4 * 512 * 2048, INP(27) + (size_t)l * 4 * 128 * 512, INP(28) + l * D}, 10240, 512, (bf16*)(ws + (l ? WS_WBT1 : WS_WBT0)));
        tr_matrix(F, SrcPlain{INP(32) + (size_t)l * D * D, D}, 2048, 2048, (bf16*)(ws + (l ? WS_WOT1 : WS_WOT0)));
        tr_matrix(F, SrcLora{INP(8) + (size_t)l * 96 * 512, INP(10) + (size_t)l * 96 * 512, INP(11) + (size_t)l * 256 * 512, INP(20), l}, 2048, 512, (bf16*)(ws + (l ? WS_WLT1 : WS_WLT0)));
        tr_matrix(F, SrcPlainG{INP(29) + (size_t)l * D * 1024, 1024, INP(4) + l * D}, 1024, 2048, (bf16*)(ws + (l ? WS_WKVT1 : WS_WKVT0)));
        tr_matrix(F, SrcC1{INP(23) + (size_t)l * 2 * 2048 * 128}, 512, 2048, (bf16*)(ws + (l ? WS_WC1T1 : WS_WC1T0)));
        for (int i = 0; i < 2; ++i) tr_matrix(F, SrcPlain{INP(25) + (size_t)(l * 2 + i) * 128 * 64, 64}, 64, 128, (bf16*)(ws + WS_WC2T) + (size_t)(l * 2 + i) * 64 * 128);
    }
    tr_matrix<SrcW13, F8_F1 != 0>(F, SrcW13{INP(33), INP(34), INP(3), FF, F8_F1 ? W8S : 1.f}, 2 * FF, 2048, (bf16*)(ws + WS_W13T));
    tr_matrix(F, SrcPlain{INP(35), D}, 2048, FF, (bf16*)(ws + WS_W2T));
    for (int e = 0; e < NE; ++e) {
        tr_matrix<SrcW13, F8_M1 != 0>(F, SrcW13{INP(37) + (size_t)e * D * EFF, INP(38) + (size_t)e * D * EFF, INP(3) + D, EFF, F8_M1 ? W8S : 1.f}, 2 * EFF, 2048, (bf16*)(ws + WS_MW13T + (size_t)e * 2 * EFF * 2048 * (F8_M1 ? 1 : 2)));
        tr_matrix<SrcPlainS, F8_M2 != 0>(F, SrcPlainS{INP(39) + (size_t)e * EFF * D, D, F8_M2 ? W8S : 1.f}, 2048, EFF, (bf16*)(ws + WS_MW2T + (size_t)e * 2048 * EFF * (F8_M2 ? 1 : 2)));
    }
    const int gw = F.bid * 8 + F.wave, NGW = F.G * 8;
    u64* ssq = (u64*)(F.ctl + CW_SSQ);
    for (int base = F.bid * 16; base < M + 512; base += F.G * 16) for (int q = 0; q < 2; ++q) { const int m = base + F.wave * 2 + q;
        const bool ismem = m >= M; const float* src = ismem ? INP(1) + (size_t)(m - M) * D : INP(0) + (size_t)m * D;
        const f32x4* xr = (const f32x4*)src + F.lane; f32x4 v[8]; float s = 0.f;
#pragma unroll
        for (int j = 0; j < 8; ++j) { v[j] = xr[64 * j]; s += (v[j][0] * v[j][0] + v[j][1] * v[j][1]) + (v[j][2] * v[j][2] + v[j][3] * v[j][3]); }
        s = wave_sum(s);
        float sc = 1.f;
        if (ismem) sc = 1.0f / sqrtf(s * (1.f / D) + NORM_EPS); else if (F.lane == 0) ssq[m] = ssq_fix(s);
        bf16* dst = ismem ? (bf16*)(ws + WS_MEMN) + (size_t)(m - M) * D : (bf16*)(ws + WS_XH) + (size_t)m * D;
#pragma unroll
        for (int j = 0; j < 8; ++j) { u32x2 w; w.x = pk2(v[j][0] * sc, v[j][1] * sc); w.y = pk2(v[j][2] * sc, v[j][3] * sc); *((u32x2*)dst + F.lane + 64 * j) = w;
            if (!ismem) *((unsigned*)(ws + WS_XH8 + (size_t)m * D) + F.lane + 64 * j) = pk4_fp8(v[j][0], v[j][1], v[j][2], v[j][3]); }
    }
}

__device__ __forceinline__ float shiftP(const bf16* P, int m, int t, int col, float mu) {
    const float u = ldbf(P + (size_t)m * LDP + col); const float pv = t > 0 ? ldbf(P + (size_t)(m - 1) * LDP + col) : 0.f; return u + (pv - u) * mu;
}
__device__ __forceinline__ void phase_prep(const Frame& F0, int l) {
    const Frame F = relaunder(F0);
    unsigned char* ws = F.ws; const bf16* P = (const bf16*)(ws + WS_P);
    const float* mu = INP(6) + l * 1984; const float* vmu = INP(18);
    bf16* AL = (bf16*)(ws + WS_ALORA); bf16* QN = (bf16*)(ws + WS_QN); bf16* QM = (bf16*)(ws + WS_QM); bf16* Y = (bf16*)(ws + WS_Y);
    const float* qkg = INP(21) + l * 4 * 64; const float* mqg = INP(30) + l * 2 * 128;
    const float* cpos = INP(22) + (size_t)l * 2 * 32 * 64; const float* cw = INP(26) + l * 3 * 512;
    const int tid = F.tid, lane = F.lane, wave = F.wave;
    for (int tile = F.bid; tile < M / 32; tile += F.G) {
        const int m0 = tile * 32, b = m0 / T, t0 = m0 % T;
#pragma unroll
        for (int it_ = 0; it_ < 4; ++it_) { const int it = tid + it_ * 512; const int tt = it >> 6, g = it & 63, c = g * 8, m = m0 + tt, t = t0 + tt;
            int pc, kind; const float* mup;
            if (c < 96) { pc = PC_WD + c; kind = 0; mup = mu + pc; } else if (c < 192) { pc = PC_AD + c - 96; kind = 1; mup = mu + pc; }
            else if (c < 448) { pc = PC_GD + c - 192; kind = 2; mup = mu + pc; } else { pc = PC_VRES + c - 448; kind = 3; mup = vmu + (c - 448); }
            float o[8];
            if (kind == 3 && l == 0) {
#pragma unroll
                for (int j = 0; j < 8; ++j) o[j] = 0.f; }
            else { float u[8], pv[8], mm[8]; ld8(P + (size_t)m * LDP + pc, u); ldf8(mup, mm);
                if (t > 0) ld8(P + (size_t)(m - 1) * LDP + pc, pv); else {
#pragma unroll
                    for (int j = 0; j < 8; ++j) pv[j] = 0.f; }
#pragma unroll
                for (int j = 0; j < 8; ++j) { const float x = u[j] + (pv[j] - u[j]) * mm[j]; o[j] = kind == 0 ? tanhf(x) : (kind == 2 ? sigmoidf_(x) : x); } }
            st8(AL + (size_t)m * 512 + c, o); }
        for (int tt = wave; tt < 32; tt += 8) { const int m = m0 + tt;
            { float v[8]; float s = 0.f; const u32x4 raw = *(const u32x4*)(P + (size_t)m * LDP + PC_Q + lane * 8);
              v[0] = bf2f(raw.x & 0xffffu); v[1] = bf2f(raw.x >> 16); v[2] = bf2f(raw.y & 0xffffu); v[3] = bf2f(raw.y >> 16); v[4] = bf2f(raw.z & 0xffffu); v[5] = bf2f(raw.z >> 16); v[6] = bf2f(raw.w & 0xffffu); v[7] = bf2f(raw.w >> 16);
#pragma unroll
              for (int j = 0; j < 8; ++j) s += v[j] * v[j];
              s += __shfl_xor(s, 1); s += __shfl_xor(s, 2); s += __shfl_xor(s, 4);
              const float rs = CQ_NSA / sqrtf(s * (1.f / 64.f) + NORM_EPS); const int d0 = (lane & 7) * 8;
              u32x4 w; w.x = pk2(v[0] * rs * qkg[d0 + 0], v[1] * rs * qkg[d0 + 1]); w.y = pk2(v[2] * rs * qkg[d0 + 2], v[3] * rs * qkg[d0 + 3]); w.z = pk2(v[4] * rs * qkg[d0 + 4], v[5] * rs * qkg[d0 + 5]); w.w = pk2(v[6] * rs * qkg[d0 + 6], v[7] * rs * qkg[d0 + 7]);
              *(u32x4*)(QN + (size_t)m * 512 + lane * 8) = w; }
            { float v[8]; float s = 0.f; const u32x4 raw = *(const u32x4*)(P + (size_t)m * LDP + PC_MEM + lane * 8);
              v[0] = bf2f(raw.x & 0xffffu); v[1] = bf2f(raw.x >> 16); v[2] = bf2f(raw.y & 0xffffu); v[3] = bf2f(raw.y >> 16); v[4] = bf2f(raw.z & 0xffffu); v[5] = bf2f(raw.z >> 16); v[6] = bf2f(raw.w & 0xffffu); v[7] = bf2f(raw.w >> 16);
#pragma unroll
              for (int j = 0; j < 8; ++j) s += v[j] * v[j];
              s += __shfl_xor(s, 1); s += __shfl_xor(s, 2); s += __shfl_xor(s, 4); s += __shfl_xor(s, 8);
              const float rs = CQ_MEM / sqrtf(s * (1.f / 128.f) + NORM_EPS); const int d0 = (lane & 15) * 8;
              u32x4 w; w.x = pk2(v[0] * rs * mqg[d0 + 0], v[1] * rs * mqg[d0 + 1]); w.y = pk2(v[2] * rs * mqg[d0 + 2], v[3] * rs * mqg[d0 + 3]); w.z = pk2(v[4] * rs * mqg[d0 + 4], v[5] * rs * mqg[d0 + 5]); w.w = pk2(v[6] * rs * mqg[d0 + 6], v[7] * rs * mqg[d0 + 7]);
              *(u32x4*)(QM + (size_t)m * 512 + lane * 8) = w; }
            for (int which = 0; which < 2; ++which) { const int pc = which ? PC_KW : PC_KS; const float* gn = qkg + (which ? 3 : 2) * 64;
                const unsigned raw = *(const unsigned*)(P + (size_t)m * LDP + pc + lane * 2); const float a = bf2f(raw & 0xffffu), c2 = bf2f(raw >> 16);
                float s = a * a + c2 * c2; s += __shfl_xor(s, 1); s += __shfl_xor(s, 2); s += __shfl_xor(s, 4); s += __shfl_xor(s, 8); s += __shfl_xor(s, 16);
                const float rs = 1.0f / sqrtf(s * (1.f / 64.f) + NORM_EPS); const int kvh = lane >> 5, d = (lane & 31) * 2;
                bf16* dst = (bf16*)(ws + (which ? WS_KW : WS_KS)) + ((size_t)(b * 2 + kvh) * T + (t0 + tt)) * 64 + d;
                *(unsigned*)dst = pk2(a * rs * gn[d], c2 * rs * gn[d + 1]); }
        }
        if ((tile & 1) == 0) { const int col = tid & 127, tq = tid >> 7, kvh = col >> 6, d = col & 63;
          for (int which = 0; which < 2; ++which) { const int pc = which ? PC_VW : PC_VS;
            for (int q2 = 0; q2 < 2; ++q2) { const int tg = tq + 4 * q2; unsigned short v[8];
#pragma unroll
              for (int i = 0; i < 8; ++i) v[i] = P[(size_t)(m0 + tg * 8 + i) * LDP + pc + col];
              u32x4 w; w.x = v[0] | ((unsigned)v[1] << 16); w.y = v[2] | ((unsigned)v[3] << 16); w.z = v[4] | ((unsigned)v[5] << 16); w.w = v[6] | ((unsigned)v[7] << 16);
              *(u32x4*)((bf16*)(ws + (which ? WS_VWT : WS_VST)) + ((size_t)(b * 2 + kvh) * 64 + d) * T + t0 + tg * 8) = w; } } }
#pragma unroll
        for (int it_ = 0; it_ < 2; ++it_) { const int it = tid + it_ * 512; const int tt = it >> 5, r = (it & 31) * 8, i = r >> 7, h = (r >> 6) & 1, d = r & 63, t = t0 + tt, m = m0 + tt;
            float v[8], p1[8], o[8]; ld8(P + (size_t)m * LDP + PC_KC + r, v);
            bf16* A = (bf16*)(ws + WS_ACMP) + (size_t)i * 1024 * 2048;
            const int c1 = t >> 4, l1 = t & 15;
            if (c1 <= 254) { ldf8(cpos + (i * 32 + l1) * 64 + d, p1);
#pragma unroll
                for (int j = 0; j < 8; ++j) o[j] = v[j] + p1[j];
                st8(A + ((size_t)(b * 256 + c1) * 2 + h) * 2048 + l1 * 64 + d, o); }
            if (c1 >= 1) { ldf8(cpos + (i * 32 + l1 + 16) * 64 + d, p1);
#pragma unroll
                for (int j = 0; j < 8; ++j) o[j] = v[j] + p1[j];
                st8(A + ((size_t)(b * 256 + c1 - 1) * 2 + h) * 2048 + (l1 + 16) * 64 + d, o); } }
#pragma unroll
        for (int it_ = 0; it_ < 4; ++it_) { const int it = tid + it_ * 512; const int tt = it >> 6, c = (it & 63) * 8, m = m0 + tt, t = t0 + tt;
            float acc[8], bg[8];
#pragma unroll
            for (int j = 0; j < 8; ++j) acc[j] = 0.f;
#pragma unroll
            for (int k = 0; k < 3; ++k) { const int dt = 2 - k; if (t - dt >= 0) { float cg[8], xg[8], wv[8]; const size_t o = (size_t)(m - dt) * LDP; ld8(P + o + PC_CC + c, cg); ld8(P + o + PC_CX + c, xg); ldf8(cw + k * 512 + c, wv);
#pragma unroll
                    for (int j = 0; j < 8; ++j) acc[j] += wv[j] * cg[j] * xg[j]; } }
            ld8(P + (size_t)m * LDP + PC_CB + c, bg);
#pragma unroll
            for (int j = 0; j < 8; ++j) acc[j] *= bg[j];
            st8(Y + (size_t)m * 2560 + 1024 + c, acc); }
        { const int cgp = tid & 63, tg = tid >> 6, c = cgp * 8, w = 2 << (cgp >> 4); const int ts = t0 + tg * 4, ms = m0 + tg * 4;
          float sum[8];
#pragma unroll
          for (int j = 0; j < 8; ++j) sum[j] = 0.f;
#pragma unroll
          for (int k = 1; k < 16; ++k) if (k < w && ts - k >= 0) { float u[8]; ld8(P + (size_t)(ms - k) * LDP + PC_POOL + c, u);
#pragma unroll
              for (int j = 0; j < 8; ++j) sum[j] += u[j]; }
          for (int q = 0; q < 4; ++q) { const int t = ts + q, m = ms + q; float u[8], o[8]; ld8(P + (size_t)m * LDP + PC_POOL + c, u);
#pragma unroll
              for (int j = 0; j < 8; ++j) sum[j] += u[j];
              const int cnt = (t + 1) < w ? (t + 1) : w; const float ic = 1.f / (float)cnt;
#pragma unroll
              for (int j = 0; j < 8; ++j) o[j] = sum[j] * ic - u[j];
              st8(Y + (size_t)m * 2560 + 2048 + c, o);
              if (t - w + 1 >= 0) { float ud[8]; ld8(P + (size_t)(m - w + 1) * LDP + PC_POOL + c, ud);
#pragma unroll
                  for (int j = 0; j < 8; ++j) sum[j] -= ud[j]; } } }
    }
    { const float* KV = (const float*)(ws + WS_KVRAW) + l * 1024; bf16* KM = (bf16*)(ws + WS_KMEM); bf16* VM = (bf16*)(ws + WS_VMEMT); const float* kg = mqg + 128;
      for (int r = F.bid * 8 + wave; r < 512; r += F.G * 8) { const int b = r >> 8, j = r & 255;
          for (int h = 0; h < 4; ++h) { const float a = KV[(size_t)r * 2048 + h * 128 + lane], c2 = KV[(size_t)r * 2048 + h * 128 + 64 + lane];
              const float s = wave_sum(a * a + c2 * c2); const float rs = 1.0f / sqrtf(s * (1.f / 128.f) + NORM_EPS);
              bf16* dst = KM + ((size_t)(b * 4 + h) * 256 + j) * 128; dst[lane] = (bf16)f2bf(a * rs * kg[lane]); dst[64 + lane] = (bf16)f2bf(c2 * rs * kg[64 + lane]); } }
      for (int it = F.bid * 8 + wave; it < 1024; it += F.G * 8) { const int b = it >> 9, h = (it >> 7) & 3, d = it & 127;
#pragma unroll
          for (int k = 0; k < 4; ++k) { const int j = lane + 64 * k; VM[((size_t)(b * 4 + h) * 128 + d) * 256 + j] = (bf16)f2bf(KV[(size_t)(b * 256 + j) * 2048 + 512 + h * 128 + d]); } } }
}

template <int DH> struct AttL { static constexpr int KB = 64 * (DH + 8) * 2, VB = DH * 72 * 2, BUF = KB + VB, PW = 2 * BUF, END = PW + 8 * 16 * 72 * 2; };
constexpr int AT_PT = AttL<64>::END, AT_IMP = AT_PT + 32768, AT_SEL = AT_IMP + 8192, AT_UNI = AT_SEL + 256;
static_assert(AttL<128>::END <= RING_BYTES && AT_UNI + 64 <= RING_BYTES, "attention LDS map");
template <int DH, int MODE>
__device__ __forceinline__ void attn_pass(LAS unsigned char* lds, int tid, int lane, int wave, const bf16* Kg, const bf16* VTg, int ldvt, int jlo, int jhi,
                                          const bf16x8 (&qf)[DH / 32], f32x4 (&O)[DH / 16], float (&lsum)[4], int trow, unsigned sel0, unsigned sel1, unsigned uni0, unsigned uni1) {
    typedef AttL<DH> L;
    constexpr int KS = DH + 8;
    LAS bf16* PW = (LAS bf16*)(lds + L::PW) + wave * 16 * 72;
    const unsigned long long um = MODE == 2 ? (((unsigned long long)uni1 << 32) | uni0) : ~0ull;
    auto next_tile = [&](int from) -> int {
        if (from > jhi) return jhi + 1;
        if (MODE != 2) return from;
        const unsigned long long m = um >> from; if (m == 0ull) return jhi + 1;
        const int nx = from + __builtin_ctzll(m); return nx > jhi ? jhi + 1 : nx; };
    u32x4 kreg[DH / 64], vreg[DH / 64];
#define AT_LOADREGS(jt) do { _Pragma("unroll") for (int i = 0; i < DH / 64; ++i) { const int e = tid + i * 512; const int kr = e / (DH / 8), kc = (e % (DH / 8)) * 8; const int vr = e >> 3, vc = (e & 7) * 8; \
        kreg[i] = *(const u32x4*)(Kg + (size_t)(64 * (jt) + kr) * DH + kc); vreg[i] = *(const u32x4*)(VTg + (size_t)vr * ldvt + 64 * (jt) + vc); } } while (0)
#define AT_WRITELDS(bf) do { LAS bf16* KTw = (LAS bf16*)(lds + (bf) * L::BUF); LAS bf16* VTw = (LAS bf16*)(lds + (bf) * L::BUF + L::KB); \
        _Pragma("unroll") for (int i = 0; i < DH / 64; ++i) { const int e = tid + i * 512; const int kr = e / (DH / 8), kc = (e % (DH / 8)) * 8; const int vr = e >> 3, vc = (e & 7) * 8; \
        const int krp = 16 * (2 * (kr >> 5) + (kr & 1)) + ((kr >> 1) & 15); \
        *(LAS u32x4*)(KTw + krp * KS + kc) = kreg[i]; *(LAS u32x4*)(VTw + vr * 72 + vc) = vreg[i]; } } while (0)
    int jc = next_tile(jlo);
    if (jc > jhi) return;
    AT_LOADREGS(jc);
    __syncthreads();
    AT_WRITELDS(0);
    int jn = next_tile(jc + 1);
    if (jn <= jhi) AT_LOADREGS(jn);
    LDS_WAIT(); __syncthreads();
    int cur = 0;
    for (;;) {
        int jnn = jhi + 1;
        if (jn <= jhi) { AT_WRITELDS(cur ^ 1); jnn = next_tile(jn + 1); if (jnn <= jhi) AT_LOADREGS(jnn); }
        const int j = jc;
        const LAS bf16* KT = (const LAS bf16*)(lds + cur * L::BUF); const LAS bf16* VT = (const LAS bf16*)(lds + cur * L::BUF + L::KB);
        bool doit = true;
        if (MODE == 2) { const unsigned sb = j < 32 ? (sel0 >> j) : (sel1 >> (j - 32)); doit = __builtin_amdgcn_ballot_w64((sb & 1u) != 0u) != 0ull; }
        if (doit) {
        f32x4 S[4];
        { bf16x8 kfr[4][DH / 32];
#pragma unroll
          for (int n = 0; n < 4; ++n)
#pragma unroll
              for (int ks = 0; ks < DH / 32; ++ks) kfr[n][ks] = *(const LAS bf16x8*)(KT + (16 * n + (lane & 15)) * KS + ks * 32 + 8 * (lane >> 4));
          LDS_WAIT(); __builtin_amdgcn_sched_barrier(0);
#pragma unroll
          for (int n = 0; n < 4; ++n) { S[n] = (f32x4){0.f, 0.f, 0.f, 0.f};
#pragma unroll
              for (int ks = 0; ks < DH / 32; ++ks) S[n] = __builtin_amdgcn_mfma_f32_16x16x32_bf16(qf[ks], kfr[n][ks], S[n], 0, 0, 0); }
          __builtin_amdgcn_sched_barrier(0); }
        bool valid[4];
#pragma unroll
        for (int n = 0; n < 4; ++n) { const int key = 64 * j + 32 * (n >> 1) + 2 * (lane & 15) + (n & 1);
            if (MODE == 0) valid[n] = true;
            else if (MODE == 1) valid[n] = (key <= 254) && (16 * key + 31 <= trow);
            else if (MODE == 2) { const unsigned sb = j < 32 ? (sel0 >> j) : (sel1 >> (j - 32)); valid[n] = (sb & 1u) && key <= trow; }
            else valid[n] = key <= trow && key > trow - 512; }
#pragma unroll
        for (int a2 = 0; a2 < 2; ++a2)
#pragma unroll
            for (int r = 0; r < 4; ++r) { float p0 = __builtin_amdgcn_exp2f(S[2 * a2][r]), p1 = __builtin_amdgcn_exp2f(S[2 * a2 + 1][r]);
                if (MODE != 0) { p0 = valid[2 * a2] ? p0 : 0.f; p1 = valid[2 * a2 + 1] ? p1 : 0.f; }
                lsum[r] += p0 + p1;
                *(LAS unsigned*)(PW + (4 * (lane >> 4) + r) * 72 + 32 * a2 + 2 * (lane & 15)) = pk2(p0, p1); }
        LDS_WAIT(); asm volatile("" ::: "memory");
        { bf16x8 pfr[2], vfr[2][DH / 16];
#pragma unroll
          for (int ks = 0; ks < 2; ++ks) { pfr[ks] = *(const LAS bf16x8*)(PW + (lane & 15) * 72 + ks * 32 + 8 * (lane >> 4));
#pragma unroll
              for (int nd = 0; nd < DH / 16; ++nd) vfr[ks][nd] = *(const LAS bf16x8*)(VT + (16 * nd + (lane & 15)) * 72 + ks * 32 + 8 * (lane >> 4)); }
          LDS_WAIT(); __builtin_amdgcn_sched_barrier(0);
#pragma unroll
          for (int ks = 0; ks < 2; ++ks)
#pragma unroll
              for (int nd = 0; nd < DH / 16; ++nd) O[nd] = __builtin_amdgcn_mfma_f32_16x16x32_bf16(pfr[ks], vfr[ks][nd], O[nd], 0, 0, 0);
          __builtin_amdgcn_sched_barrier(0); }
        }
        if (jn > jhi) break;
        LDS_WAIT(); __syncthreads();
        cur ^= 1; jc = jn; jn = jnn;
    }
#undef AT_LOADREGS
#undef AT_WRITELDS
}

__device__ __forceinline__ void phase_memattn(const Frame& F0) {
    const Frame F = relaunder(F0);
    unsigned char* ws = F.ws; const bf16* QM = (const bf16*)(ws + WS_QM); const bf16* KM = (const bf16*)(ws + WS_KMEM); const bf16* VM = (const bf16*)(ws + WS_VMEMT); bf16* Y = (bf16*)(ws + WS_Y);
    const int lane = F.lane, wave = F.wave; const float c = 0.08838834764831845f * 1.4426950408889634f;
    for (int u = F.bid; u < 256; u += F.G) { const int b = u >> 7, h = (u >> 5) & 3, tile = u & 31; const int m0 = b * T + tile * 128 + wave * 16;
        bf16x8 qf[4];
#pragma unroll
        for (int ks = 0; ks < 4; ++ks) qf[ks] = *(const bf16x8*)(QM + (size_t)(m0 + (lane & 15)) * 512 + h * 128 + ks * 32 + 8 * (lane >> 4));
        f32x4 O[8]; float ls[4];
#pragma unroll
        for (int i = 0; i < 8; ++i) O[i] = (f32x4){0.f, 0.f, 0.f, 0.f};
#pragma unroll
        for (int r = 0; r < 4; ++r) ls[r] = 0.f;
        attn_pass<128, 0>(F.lds, F.tid, lane, wave, KM + (size_t)(b * 4 + h) * 256 * 128, VM + (size_t)(b * 4 + h) * 128 * 256, 256, 0, 3, qf, O, ls, 0, 0u, 0u, 0u, 0u);
#pragma unroll
        for (int r = 0; r < 4; ++r) { const float lr = red16_sum(ls[r]); const float inv = lr > 0.f ? 1.f / lr : 0.f; const int m = m0 + 4 * (lane >> 4) + r;
#pragma unroll
            for (int nd = 0; nd < 8; ++nd) Y[(size_t)m * 2560 + 1536 + h * 128 + 16 * nd + (lane & 15)] = (bf16)f2bf(O[nd][r] * inv); }
        __syncthreads();
    }
}

__device__ __forceinline__ void phase_nsa(const Frame& F0, unsigned* qctr) {
    const Frame F = relaunder(F0);
    unsigned char* ws = F.ws; const bf16* P = (const bf16*)(ws + WS_P); const bf16* QN = (const bf16*)(ws + WS_QN); bf16* Y = (bf16*)(ws + WS_Y);
    const int lane = F.lane, wave = F.wave, tid = F.tid; const float c = 0.125f * 1.4426950408889634f;
    LAS float* PT = (LAS float*)(F.lds + AT_PT); LAS float* IMP = (LAS float*)(F.lds + AT_IMP); LAS unsigned* SEL = (LAS unsigned*)(F.lds + AT_SEL); LAS unsigned* UNI = (LAS unsigned*)(F.lds + AT_UNI);
    LAS int* UQ = (LAS int*)(F.lds + AT_UNI + 16);
    int nxtq = 0; if (tid == 0) nxtq = (int)atomicAdd(qctr, 1u);
    for (;;) {
        __syncthreads();
        if (tid == 0) UQ[0] = nxtq;
        LDS_WAIT(); __syncthreads();
        const int uq = UQ[0]; if (uq >= 512) break;
        if (tid == 0) nxtq = (int)atomicAdd(qctr, 1u);
        const int tile = 127 - (uq >> 2), b = (uq >> 1) & 1, kvh = uq & 1;
        const int t0 = tile * 32, m0 = b * T + t0; const int cur = t0 >> 6;
        const int tl = wave * 4 + (lane >> 4);
        const int trow = t0 + tl;
        bf16x8 qf[2];
        { const int rho = lane & 15; const int mq = m0 + wave * 4 + (rho >> 2), g = rho & 3;
#pragma unroll
          for (int ks = 0; ks < 2; ++ks) qf[ks] = *(const bf16x8*)(QN + (size_t)mq * 512 + (kvh * 4 + g) * 64 + ks * 32 + 8 * (lane >> 4)); }
        const bf16* KCg = (const bf16*)(ws + WS_KC) + (size_t)(b * 2 + kvh) * 256 * 64; const bf16* VCg = (const bf16*)(ws + WS_VCT) + (size_t)(b * 2 + kvh) * 64 * 256;
        const bf16* KSg = (const bf16*)(ws + WS_KS) + (size_t)(b * 2 + kvh) * T * 64; const bf16* VSg = (const bf16*)(ws + WS_VST) + (size_t)(b * 2 + kvh) * 64 * T;
        const bf16* KWg = (const bf16*)(ws + WS_KW) + (size_t)(b * 2 + kvh) * T * 64; const bf16* VWg = (const bf16*)(ws + WS_VWT) + (size_t)(b * 2 + kvh) * 64 * T;
        f32x4 OF[4];
#pragma unroll
        for (int i = 0; i < 4; ++i) OF[i] = (f32x4){0.f, 0.f, 0.f, 0.f};
        float gate[3][4];
#pragma unroll
        for (int r = 0; r < 4; ++r)
#pragma unroll
            for (int k = 0; k < 3; ++k) gate[k][r] = sigmoidf_(ldbf(P + (size_t)(m0 + tl) * LDP + PC_GL + (kvh * 4 + r) * 3 + k));
        f32x4 O[4]; float lr[4];
#pragma unroll
        for (int i = 0; i < 4; ++i) O[i] = (f32x4){0.f, 0.f, 0.f, 0.f};
#pragma unroll
        for (int r = 0; r < 4; ++r) lr[r] = 0.f;
        attn_pass<64, 1>(F.lds, tid, lane, wave, KCg, VCg, 256, 0, 3, qf, O, lr, trow, 0u, 0u, 0u, 0u);
#pragma unroll
        for (int r = 0; r < 4; ++r) lr[r] = red16_sum(lr[r]);
#pragma unroll
        for (int r = 0; r < 4; ++r) { const float inv = lr[r] > 0.f ? 1.f / lr[r] : 0.f;
#pragma unroll
            for (int nd = 0; nd < 4; ++nd) OF[nd][r] += gate[0][r] * O[nd][r] * inv; }
        { LAS bf16* KT = (LAS bf16*)(F.lds);
          for (int j = 0; j < 4; ++j) {
              __syncthreads();
              { const int kr = tid >> 3, kc = (tid & 7) * 8; *(LAS u32x4*)(KT + kr * 72 + kc) = *(const u32x4*)(KCg + (size_t)(64 * j + kr) * 64 + kc); }
              LDS_WAIT(); __syncthreads();
              bf16x8 kfr[4][2]; f32x4 S4[4];
#pragma unroll
              for (int n = 0; n < 4; ++n)
#pragma unroll
                  for (int ks = 0; ks < 2; ++ks) kfr[n][ks] = *(const LAS bf16x8*)(KT + (16 * n + (lane & 15)) * 72 + ks * 32 + 8 * (lane >> 4));
              LDS_WAIT(); __builtin_amdgcn_sched_barrier(0);
#pragma unroll
              for (int n = 0; n < 4; ++n) { S4[n] = (f32x4){0.f, 0.f, 0.f, 0.f};
#pragma unroll
                  for (int ks = 0; ks < 2; ++ks) S4[n] = __builtin_amdgcn_mfma_f32_16x16x32_bf16(qf[ks], kfr[n][ks], S4[n], 0, 0, 0); }
              __builtin_amdgcn_sched_barrier(0);
#pragma unroll
              for (int n = 0; n < 4; ++n) { const f32x4 S = S4[n];
                  const int key = 64 * j + 16 * n + (lane & 15); const bool valid = (key <= 254) && (16 * key + 31 <= trow); float ps = 0.f;
#pragma unroll
                  for (int r = 0; r < 4; ++r) { const float inv = lr[r] > 0.f ? 1.f / lr[r] : 0.f; ps += valid ? __builtin_amdgcn_exp2f(S[r]) * inv : 0.f; }
                  PT[tl * 256 + key] = ps; } }
          if (tid < 64) SEL[tid] = 0u; if (tid < 2) UNI[tid] = 0u;
          LDS_WAIT(); __syncthreads(); }
        { const int tk = tid >> 4, sg = (tid & 15) * 4;
#pragma unroll
          for (int i = 0; i < 4; ++i) { const int s = sg + i; const LAS float* p = PT + tk * 256 + 4 * s; float v = p[0] + p[1] + p[2] + 0.5f * p[3]; if (s > 0) v += 0.5f * p[-1];
              const bool forced = (s == 0) || (s == cur) || (s == cur - 1); IMP[tk * 64 + s] = forced ? 1e9f : (s <= cur ? v : -1e9f); }
          LDS_WAIT(); __syncthreads();
          float mine[4]; int cnt[4];
#pragma unroll
          for (int i = 0; i < 4; ++i) { mine[i] = IMP[tk * 64 + sg + i]; cnt[i] = 0; }
          for (int s2 = 0; s2 < 64; ++s2) { const float o = IMP[tk * 64 + s2];
#pragma unroll
              for (int i = 0; i < 4; ++i) cnt[i] += (o > mine[i] || (o == mine[i] && s2 < sg + i)) ? 1 : 0; }
          unsigned bits = 0u;
#pragma unroll
          for (int i = 0; i < 4; ++i) if (cnt[i] < 16 && mine[i] > -1e8f) bits |= 1u << ((sg + i) & 31);
          if (bits) { atomicOr((unsigned*)(SEL + tk * 2 + (sg >> 5)), bits); atomicOr((unsigned*)(UNI + (sg >> 5)), bits); }
          LDS_WAIT(); __syncthreads(); }
        const unsigned sel0 = SEL[tl * 2], sel1 = SEL[tl * 2 + 1], uni0 = UNI[0], uni1 = UNI[1];
#pragma unroll
        for (int i = 0; i < 4; ++i) O[i] = (f32x4){0.f, 0.f, 0.f, 0.f};
#pragma unroll
        for (int r = 0; r < 4; ++r) lr[r] = 0.f;
        attn_pass<64, 2>(F.lds, tid, lane, wave, KSg, VSg, T, 0, cur, qf, O, lr, trow, sel0, sel1, uni0, uni1);
#pragma unroll
        for (int r = 0; r < 4; ++r) lr[r] = red16_sum(lr[r]);
#pragma unroll
        for (int r = 0; r < 4; ++r) { const float inv = lr[r] > 0.f ? 1.f / lr[r] : 0.f;
#pragma unroll
            for (int nd = 0; nd < 4; ++nd) OF[nd][r] += gate[1][r] * O[nd][r] * inv; }
#pragma unroll
        for (int i = 0; i < 4; ++i) O[i] = (f32x4){0.f, 0.f, 0.f, 0.f};
#pragma unroll
        for (int r = 0; r < 4; ++r) lr[r] = 0.f;
        { const int lo = t0 - 511; attn_pass<64, 3>(F.lds, tid, lane, wave, KWg, VWg, T, lo > 0 ? (lo >> 6) : 0, cur, qf, O, lr, trow, 0u, 0u, 0u, 0u); }
#pragma unroll
        for (int r = 0; r < 4; ++r) lr[r] = red16_sum(lr[r]);
#pragma unroll
        for (int r = 0; r < 4; ++r) { const float inv = lr[r] > 0.f ? 1.f / lr[r] : 0.f;
#pragma unroll
            for (int nd = 0; nd < 4; ++nd) OF[nd][r] += gate[2][r] * O[nd][r] * inv; }
#pragma unroll
        for (int r = 0; r < 4; ++r)
#pragma unroll
            for (int nd = 0; nd < 4; ++nd) Y[(size_t)(m0 + tl) * 2560 + 512 + (kvh * 4 + r) * 64 + 16 * nd + (lane & 15)] = (bf16)f2bf(OF[nd][r]);
        __syncthreads();
    }
}

constexpr int CL = 32, NCH = T / CL;
constexpr int SC_STEPS = 8;
__device__ __forceinline__ void phase_scan(const Frame& F0, int l) {
    const Frame F = relaunder(F0);
    unsigned char* ws = F.ws; const bf16* P = (const bf16*)(ws + WS_P); const float* LO = (const float*)(ws + WS_LO);
    float* VF = (float*)(ws + WS_VFIRST); float* VC = (float*)(ws + WS_VCUR); float* BON = (float*)(ws + WS_BON);
    float* YL = (float*)(ws + WS_YL); float* ZL = (float*)(ws + WS_ZL); float* QF = (float*)(ws + WS_QF); float* PF = (float*)(ws + WS_PF);
    const float* mu = INP(6) + l * 1984; const float* kk_ = INP(12) + l * 512; const float* ka_ = INP(13) + l * 512; const float* rk_ = INP(14) + l * 512;
    const int wave = F.wave;
    LAS float* ST = (LAS float*)F.lds + wave * (SC_STEPS * 5 * 64 + 64);
    for (int u = F.bid; u < 256; u += F.G) {
        int lane = F.lane; asm volatile("" : "+v"(lane));
        const int b = u >> 7, h = (u >> 4) & 7, cq = u & 15;
        const int jc = h * 64 + lane;
        const float mu_r = mu[PC_R + jc], mu_k = mu[PC_K + jc], mu_v = mu[PC_V + jc], kkw = kk_[jc], kaw = ka_[jc], rkw = rk_[jc];
        const int chunk = cq * 8 + wave;
        f32x2 Sq[32], Sp[32];
#pragma unroll
        for (int k = 0; k < 32; ++k) { Sq[k] = (f32x2){0.f, 0.f}; Sp[k] = (f32x2){(2 * k == lane) ? 1.f : 0.f, (2 * k + 1 == lane) ? 1.f : 0.f}; }
        const int tbase = chunk * CL;
        float gam = 1.f;
        for (int sb = 0; sb < CL / SC_STEPS; ++sb) {
            LDS_WAIT(); asm volatile("" ::: "memory");
#pragma unroll 1
            for (int hb = 0; hb < 2; ++hb) { const int st0 = hb * 4; const int tf = tbase + sb * SC_STEPS + st0, mf = b * T + tf;
              float ur[5], uk[5], uv[5], wv[4], av[4], vgv[4], vfv[4];
#pragma unroll
              for (int i = 0; i < 5; ++i) { const bool ok = (tf - 1 + i) >= 0; const bf16* pr = P + (size_t)(ok ? (mf - 1 + i) : mf) * LDP + h * 64;
                  const float sc = ok ? 1.f : 0.f;
                  ur[i] = ldbf(pr + PC_R + lane) * sc; uk[i] = ldbf(pr + PC_K + lane) * sc; uv[i] = ldbf(pr + PC_V + lane) * sc; }
#pragma unroll
              for (int i = 0; i < 4; ++i) { const float* lr = LO + (size_t)(mf + i) * 2048 + h * 64; wv[i] = lr[lane]; av[i] = lr[512 + lane];
                  vgv[i] = l ? lr[1536 + lane] : 0.f; vfv[i] = l ? (VF + (size_t)(mf + i) * 512 + h * 64)[lane] : 0.f; }
              float rr[4], kv[4], vv4[4], kmod4[4], red[8];
#pragma unroll
              for (int i = 0; i < 4; ++i) { const int m = mf + i;
                  const float r = ur[i + 1] + (ur[i] - ur[i + 1]) * mu_r, k = uk[i + 1] + (uk[i] - uk[i + 1]) * mu_k; float v = uv[i + 1] + (uv[i] - uv[i + 1]) * mu_v;
                  if (l == 0) (VF + (size_t)m * 512 + h * 64)[lane] = v; else v = v + (vfv[i] - v) * vgv[i];
                  (VC + (size_t)m * 512 + h * 64)[lane] = v;
                  const float kkv = k * kkw; const float kmod = k * (1.f + (av[i] - 1.f) * kaw);
                  rr[i] = r; kv[i] = kkv; vv4[i] = v; kmod4[i] = kmod; red[2 * i] = kkv * kkv; red[2 * i + 1] = r * kmod * rkw; }
#pragma unroll
              for (int o = 1; o < 64; o <<= 1) { float t8[8];
#pragma unroll
                  for (int j = 0; j < 8; ++j) t8[j] = __shfl_xor(red[j], o);
#pragma unroll
                  for (int j = 0; j < 8; ++j) red[j] += t8[j]; }
#pragma unroll
              for (int i = 0; i < 4; ++i) { const int m = mf + i; const float w = wv[i], a = av[i];
                  const float kkn = kv[i] * (1.0f / sqrtf(fmaxf(red[2 * i], 1e-24f)));
                  if (lane == 0) __hip_atomic_store((unsigned*)BON + (size_t)m * 8 + h, __builtin_bit_cast(unsigned, red[2 * i + 1]), RLX_AGENT);
                  const float gprev = gam; gam *= w; const float ig = 1.0f / gam;
                  LAS float* dst = ST + ((st0 + i) * 5) * 64 + lane;
                  dst[0] = kkn * gprev; dst[64] = kkn * a * ig; dst[128] = kmod4[i] * ig; dst[192] = rr[i] * gam; dst[256] = vv4[i]; } }
            LDS_WAIT(); asm volatile("" ::: "memory");
            for (int st = 0; st < SC_STEPS; ++st) { const LAS float* sp = ST + (st * 5) * 64; const int t = tbase + sb * SC_STEPS + st;
                const float vv = sp[256 + lane]; const f32x2 vv2 = (f32x2){vv, vv};
                f32x2 qa = (f32x2){0.f, 0.f}, qb = qa, pa = qa, pb = qa;
                { f32x4 buf[2][2];
#pragma unroll
                  for (int i = 0; i < 2; ++i) buf[0][i] = *(const LAS f32x4*)(sp + 4 * i);
#pragma unroll
                  for (int g = 0; g < 8; ++g) {
                      if (g < 7) {
#pragma unroll
                          for (int i = 0; i < 2; ++i) buf[(g + 1) & 1][i] = *(const LAS f32x4*)(sp + 8 * (g + 1) + 4 * i); }
                      asm volatile("" ::: "memory");
#pragma unroll
                      for (int i = 0; i < 2; ++i) { const int k2 = 4 * g + 2 * i; const f32x4 kk4 = buf[g & 1][i]; const f32x2 klo = (f32x2){kk4[0], kk4[1]}, khi = (f32x2){kk4[2], kk4[3]};
                          qa += Sq[k2] * klo; qb += Sq[k2 + 1] * khi; pa += Sp[k2] * klo; pb += Sp[k2 + 1] * khi; } } }
                const f32x2 qs = qa + qb, ps = pa + pb; const float nq = -(qs.x + qs.y), np = -(ps.x + ps.y); const f32x2 nq2 = (f32x2){nq, nq}, np2 = (f32x2){np, np};
                f32x2 ya = (f32x2){0.f, 0.f}, yb = ya, za = ya, zb = ya;
                { f32x4 bb[2], bk[2], br[2];
                  bb[0] = *(const LAS f32x4*)(sp + 64); bk[0] = *(const LAS f32x4*)(sp + 128); br[0] = *(const LAS f32x4*)(sp + 192);
#pragma unroll
                  for (int g = 0; g < 16; ++g) {
                      if (g < 15) { bb[(g + 1) & 1] = *(const LAS f32x4*)(sp + 64 + 4 * (g + 1)); bk[(g + 1) & 1] = *(const LAS f32x4*)(sp + 128 + 4 * (g + 1)); br[(g + 1) & 1] = *(const LAS f32x4*)(sp + 192 + 4 * (g + 1)); }
                      asm volatile("" ::: "memory");
                      { const int k2 = 2 * g; const f32x4 b4 = bb[g & 1], k4 = bk[g & 1], r4 = br[g & 1];
                        const f32x2 blo = (f32x2){b4[0], b4[1]}, bhi = (f32x2){b4[2], b4[3]}, klo = (f32x2){k4[0], k4[1]}, khi = (f32x2){k4[2], k4[3]}, rlo = (f32x2){r4[0], r4[1]}, rhi = (f32x2){r4[2], r4[3]};
                        Sq[k2] += vv2 * klo + nq2 * blo; Sq[k2 + 1] += vv2 * khi + nq2 * bhi; Sp[k2] += np2 * blo; Sp[k2 + 1] += np2 * bhi;
                        ya += Sq[k2] * rlo; yb += Sq[k2 + 1] * rhi; za += Sp[k2] * rlo; zb += Sp[k2 + 1] * rhi; } } }
                const f32x2 ys = ya + yb, zs = za + zb;
                const size_t o = (size_t)(b * T + t) * 512 + h * 64 + lane;
                YL[o] = ys.x + ys.y; ZL[o] = zs.x + zs.y; }
        }
        { LAS float* GL = ST + SC_STEPS * 5 * 64; LDS_WAIT(); asm volatile("" ::: "memory"); GL[lane] = gam; LDS_WAIT(); asm volatile("" ::: "memory");
#pragma unroll
          for (int k = 0; k < 32; k += 2) { const f32x4 g4 = *(const LAS f32x4*)(GL + 2 * k); const f32x2 glo = (f32x2){g4[0], g4[1]}, ghi = (f32x2){g4[2], g4[3]};
              Sq[k] *= glo; Sq[k + 1] *= ghi; Sp[k] *= glo; Sp[k + 1] *= ghi; } }
        { const size_t un = ((size_t)(b * 8 + h) * NCH + chunk) * 4096;
#pragma unroll
          for (int k = 0; k < 32; k += 4) { u32x4 w; w.x = pk2(Sq[k].x, Sq[k].y); w.y = pk2(Sq[k + 1].x, Sq[k + 1].y); w.z = pk2(Sq[k + 2].x, Sq[k + 2].y); w.w = pk2(Sq[k + 3].x, Sq[k + 3].y);
              *(u32x4*)((bf16*)QF + un + lane * 64 + 2 * k) = w; }
          { unsigned short* pf = (unsigned short*)PF + un + ((lane >> 2) & 3) * 16 + (lane >> 4) * 4 + (lane & 3);
#pragma unroll
            for (int k = 0; k < 32; ++k) { const unsigned w = pk2(Sp[k].x, Sp[k].y); pf[(2 * k) * 64] = (unsigned short)w; pf[(2 * k + 1) * 64] = (unsigned short)(w >> 16); } } }
    }
}
constexpr int CPF = 8;
__device__ __forceinline__ void phase_carry(const Frame& F0, unsigned* flags) {
    const Frame F = relaunder(F0);
    unsigned char* ws = F.ws; const unsigned char* QFb = ws + WS_QF; const unsigned char* PFb = ws + WS_PF; float* SI = (float*)(ws + WS_SINIT);
    const int lane = F.lane, wave = F.wave;
    LAS unsigned char* ring = F.lds;
    for (int chain = F.bid; chain < 16; chain += F.G) {
        const size_t cb = (size_t)chain * NCH * 8192;
        if (wave >= 4) {
            const int pt = (wave - 4) * 64 + lane;
            u32x4 rt[CPF][2], rq[CPF][2];
#pragma unroll
            for (int d = 0; d < CPF; ++d) { const size_t o = cb + (size_t)d * 8192 + pt * 16;
                rt[d][0] = *(const u32x4*)(PFb + o); rt[d][1] = *(const u32x4*)(PFb + o + 4096); rq[d][0] = *(const u32x4*)(QFb + o); rq[d][1] = *(const u32x4*)(QFb + o + 4096); }
            asm volatile("s_waitcnt vmcnt(%0)" :: "n"(4 * (CPF - 1)) : "memory");
            { LAS unsigned char* sl = ring + pt * 16; *(LAS u32x4*)(sl) = rt[0][0]; *(LAS u32x4*)(sl + 4096) = rt[0][1]; *(LAS u32x4*)(sl + 8192) = rq[0][0]; *(LAS u32x4*)(sl + 12288) = rq[0][1]; }
            { const size_t o = cb + (size_t)CPF * 8192 + pt * 16;
              rt[0][0] = *(const u32x4*)(PFb + o); rt[0][1] = *(const u32x4*)(PFb + o + 4096); rq[0][0] = *(const u32x4*)(QFb + o); rq[0][1] = *(const u32x4*)(QFb + o + 4096); }
            LDS_WAIT(); __syncthreads();
            for (int c0 = 0; c0 < NCH; c0 += CPF) {
#pragma unroll
                for (int d = 0; d < CPF; ++d) { const int c = c0 + d;
                    constexpr int DUMMY = 0; (void)DUMMY;
                    const int e = (d + 1) % CPF;
                    if (c + 1 < NCH) {
                        asm volatile("s_waitcnt vmcnt(%0)" :: "n"(4 * (CPF - 1)) : "memory");
                        LAS unsigned char* sl = ring + ((c + 1) & 1) * 16384 + pt * 16;
                        *(LAS u32x4*)(sl) = rt[e][0]; *(LAS u32x4*)(sl + 4096) = rt[e][1]; *(LAS u32x4*)(sl + 8192) = rq[e][0]; *(LAS u32x4*)(sl + 12288) = rq[e][1];
                        const int cn = c + 1 + CPF < NCH ? c + 1 + CPF : NCH - 1;
                        const size_t o = cb + (size_t)cn * 8192 + pt * 16;
                        rt[e][0] = *(const u32x4*)(PFb + o); rt[e][1] = *(const u32x4*)(PFb + o + 4096); rq[e][0] = *(const u32x4*)(QFb + o); rq[e][1] = *(const u32x4*)(QFb + o + 4096);
                    }
                    LDS_WAIT(); __syncthreads();
                }
            }
            asm volatile("s_waitcnt vmcnt(0)" ::: "memory");
        } else {
            const int row = wave * 16 + (lane & 15), g = lane >> 4;
            const int aoff = ((lane & 15) * 64 + g * 16) * 2, qoff = (row * 64 + 4 * g) * 2;
            f32x4 S[4];
#pragma unroll
            for (int mt = 0; mt < 4; ++mt) S[mt] = (f32x4){0.f, 0.f, 0.f, 0.f};
            u32x4 a[4][2]; u32x2 q[4];
            __syncthreads();
#pragma unroll
            for (int mt = 0; mt < 4; ++mt) { a[mt][0] = *(const LAS u32x4*)(ring + mt * 2048 + aoff); a[mt][1] = *(const LAS u32x4*)(ring + mt * 2048 + aoff + 16); q[mt] = *(const LAS u32x2*)(ring + 8192 + qoff + 32 * mt); }
            LDS_WAIT(); __builtin_amdgcn_sched_barrier(0);
            for (int c = 0; c < NCH; ++c) { const size_t un = ((size_t)chain * NCH + c) * 4096;
#pragma unroll
                for (int mt = 0; mt < 4; ++mt) *(f32x4*)(SI + un + (qoff >> 1) + 16 * mt) = S[mt];
                bf16x8 bh[2], bl[2];
#pragma unroll
                for (int ks = 0; ks < 2; ++ks) { u32x4 wh, wl; const f32x4 s0 = S[2 * ks], s1 = S[2 * ks + 1];
                    wh.x = pk2(s0[0], s0[1]); wh.y = pk2(s0[2], s0[3]); wh.z = pk2(s1[0], s1[1]); wh.w = pk2(s1[2], s1[3]);
                    wl.x = pk2(s0[0] - bf2f(wh.x & 0xffffu), s0[1] - bf2f(wh.x >> 16)); wl.y = pk2(s0[2] - bf2f(wh.y & 0xffffu), s0[3] - bf2f(wh.y >> 16));
                    wl.z = pk2(s1[0] - bf2f(wh.z & 0xffffu), s1[1] - bf2f(wh.z >> 16)); wl.w = pk2(s1[2] - bf2f(wh.w & 0xffffu), s1[3] - bf2f(wh.w >> 16));
                    bh[ks] = __builtin_bit_cast(bf16x8, wh); bl[ks] = __builtin_bit_cast(bf16x8, wl); }
                __builtin_amdgcn_sched_barrier(0);
#pragma unroll
                for (int mt = 0; mt < 4; ++mt) { f32x4 d = (f32x4){bf2f(q[mt].x & 0xffffu), bf2f(q[mt].x >> 16), bf2f(q[mt].y & 0xffffu), bf2f(q[mt].y >> 16)};
#pragma unroll
                    for (int ks = 0; ks < 2; ++ks) { const bf16x8 af = __builtin_bit_cast(bf16x8, a[mt][ks]);
                        d = __builtin_amdgcn_mfma_f32_16x16x32_bf16(af, bh[ks], d, 0, 0, 0); d = __builtin_amdgcn_mfma_f32_16x16x32_bf16(af, bl[ks], d, 0, 0, 0); }
                    S[mt] = d; }
                asm volatile("s_nop 7\n\ts_nop 7" ::: "memory");
                __builtin_amdgcn_sched_barrier(0);
                __syncthreads();
                if (c + 1 < NCH) { LAS unsigned char* sl = ring + ((c + 1) & 1) * 16384;
#pragma unroll
                    for (int mt = 0; mt < 4; ++mt) { a[mt][0] = *(const LAS u32x4*)(sl + mt * 2048 + aoff); a[mt][1] = *(const LAS u32x4*)(sl + mt * 2048 + aoff + 16); q[mt] = *(const LAS u32x2*)(sl + 8192 + qoff + 32 * mt); } }
                LDS_WAIT(); __builtin_amdgcn_sched_barrier(0);
            }
        }
        asm volatile("s_waitcnt vmcnt(0)" ::: "memory");
        __syncthreads();
        if (xb_t0(wave)) { __builtin_amdgcn_fence(__ATOMIC_RELEASE, "agent"); asm volatile("s_waitcnt vmcnt(0)" ::: "memory"); __hip_atomic_store(flags + chain, 1u, __ATOMIC_RELAXED, __HIP_MEMORY_SCOPE_AGENT); }
    }
}
__device__ __forceinline__ void phase_rwkv_fin(const Frame& F0, int l, unsigned* flags, unsigned* qctr) {
    const Frame F = relaunder(F0);
    unsigned char* ws = F.ws; const float* SI = (const float*)(ws + WS_SINIT); const float* YL = (const float*)(ws + WS_YL); const float* ZL = (const float*)(ws + WS_ZL);
    const float* LO = (const float*)(ws + WS_LO); const float* VC = (const float*)(ws + WS_VCUR); const float* BON = (const float*)(ws + WS_BON); bf16* Y = (bf16*)(ws + WS_Y);
    const float* lnw = INP(15) + l * 512; const float* lnb = INP(16) + l * 512;
    const int lane = F.lane, wave = F.wave;
    (void)qctr;
    __syncthreads();
    if (xb_t0(wave)) {
        for (int u = F.bid; u < 16 * (NCH / 4); u += F.G) { unsigned* fl = flags + u / (NCH / 4); unsigned sp = 0u;
            while (xb_ld(fl) == 0u && ++sp < (1u << 22)) __builtin_amdgcn_s_sleep(1); }
        __builtin_amdgcn_fence(__ATOMIC_ACQUIRE, "agent"); asm volatile("s_waitcnt vmcnt(0)" ::: "memory"); }
    __syncthreads();
    for (int u = F.bid; u < 16 * (NCH / 4); u += F.G) {
        const int chain = u / (NCH / 4), c = (u % (NCH / 4)) * 4 + (wave >> 1), b = chain >> 3, h = chain & 7; const size_t un = ((size_t)chain * NCH + c) * 4096;
        const int m0 = b * T + c * CL + (wave & 1) * 16;
        bf16x8 af[2], bfr[4][2];
#pragma unroll
        for (int ks = 0; ks < 2; ++ks) { float t8[8]; ldf8(ZL + (size_t)(m0 + (lane & 15)) * 512 + h * 64 + ks * 32 + 8 * (lane >> 4), t8);
            u32x4 w; w.x = pk2(t8[0], t8[1]); w.y = pk2(t8[2], t8[3]); w.z = pk2(t8[4], t8[5]); w.w = pk2(t8[6], t8[7]); af[ks] = __builtin_bit_cast(bf16x8, w); }
#pragma unroll
        for (int n = 0; n < 4; ++n)
#pragma unroll
            for (int ks = 0; ks < 2; ++ks) { float t8[8]; ldf8(SI + un + (size_t)(16 * n + (lane & 15)) * 64 + ks * 32 + 8 * (lane >> 4), t8);
                u32x4 w; w.x = pk2(t8[0], t8[1]); w.y = pk2(t8[2], t8[3]); w.z = pk2(t8[4], t8[5]); w.w = pk2(t8[6], t8[7]); bfr[n][ks] = __builtin_bit_cast(bf16x8, w); }
        float yl[4][4], vc[4][4], gg[4][4], bn[4];
#pragma unroll
        for (int r = 0; r < 4; ++r) { const int m = m0 + 4 * (lane >> 4) + r; bn[r] = BON[(size_t)m * 8 + h];
#pragma unroll
            for (int n = 0; n < 4; ++n) { const int j = h * 64 + 16 * n + (lane & 15); yl[n][r] = YL[(size_t)m * 512 + j]; vc[n][r] = VC[(size_t)m * 512 + j]; gg[n][r] = LO[(size_t)m * 2048 + 1024 + j]; } }
        asm volatile("s_waitcnt vmcnt(0)" ::: "memory"); __builtin_amdgcn_sched_barrier(0);
        f32x4 C[4];
#pragma unroll
        for (int n = 0; n < 4; ++n) { C[n] = (f32x4){yl[n][0], yl[n][1], yl[n][2], yl[n][3]};
#pragma unroll
            for (int ks = 0; ks < 2; ++ks) C[n] = __builtin_amdgcn_mfma_f32_16x16x32_bf16(af[ks], bfr[n][ks], C[n], 0, 0, 0); }
        __builtin_amdgcn_sched_barrier(0);
#pragma unroll
        for (int r = 0; r < 4; ++r) { const int m = m0 + 4 * (lane >> 4) + r;
            float sm = (C[0][r] + C[1][r]) + (C[2][r] + C[3][r]); sm = red16_sum(sm); const float mean = sm * (1.f / 64.f);
            float d[4], sv = 0.f;
#pragma unroll
            for (int n = 0; n < 4; ++n) { d[n] = C[n][r] - mean; sv += d[n] * d[n]; }
            sv = red16_sum(sv); const float rs = 1.0f / sqrtf(sv * (1.f / 64.f) + 64e-5f);
#pragma unroll
            for (int n = 0; n < 4; ++n) { const int j = h * 64 + 16 * n + (lane & 15); const float yn = d[n] * rs * lnw[j] + lnb[j];
                Y[(size_t)m * 2560 + j] = (bf16)f2bf((yn + bn[r] * vc[n][r]) * gg[n][r]); } }
    }
}

__device__ __forceinline__ void phase_route(const Frame& F0, const bf16* X) {
    const Frame F = relaunder(F0);
    const float* R = INP(36); const float* gain = INP(3) + D; const u64* ssq = (const u64*)(F.ctl + CW_SSQ) + 3 * 8192;
    unsigned* cnt = F.ctl + CW_CNT; unsigned* route = F.ctl + CW_ROUTE;
    const int lane = F.lane;
    for (int m = F.bid * 8 + F.wave; m < M; m += F.G * 8) {
        float acc[8];
#pragma unroll
        for (int e = 0; e < 8; ++e) acc[e] = 0.f;
#pragma unroll 8
        for (int i = 0; i < 32; ++i) { const int k = lane + 64 * i; const float xv = ldbf(X + (size_t)m * D + k) * gain[k]; const f32x4 r0 = *(const f32x4*)(R + k * 8), r1 = *(const f32x4*)(R + k * 8 + 4);
            acc[0] += xv * r0[0]; acc[1] += xv * r0[1]; acc[2] += xv * r0[2]; acc[3] += xv * r0[3]; acc[4] += xv * r1[0]; acc[5] += xv * r1[1]; acc[6] += xv * r1[2]; acc[7] += xv * r1[3]; }
        const float rs = rstd_of(ssq, m);
#pragma unroll
        for (int e = 0; e < 8; ++e) acc[e] = wave_sum(acc[e]) * rs;
        if (lane == 0) {
            int e0 = 0; float v0 = acc[0];
#pragma unroll
            for (int e = 1; e < 8; ++e) if (acc[e] > v0) { v0 = acc[e]; e0 = e; }
            int e1 = -1; float v1 = -3.0e38f;
#pragma unroll
            for (int e = 0; e < 8; ++e) if (e != e0 && acc[e] > v1) { v1 = acc[e]; e1 = e; }
            const float p1 = __expf(v1 - v0); const float w0 = 1.f / (1.f + p1), w1 = p1 / (1.f + p1);
            const unsigned pos0 = atomicAdd(cnt + 64 * e0, 1u), pos1 = atomicAdd(cnt + 64 * e1, 1u);
            unsigned* rr = route + (size_t)m * 8; rr[0] = (unsigned)e0; rr[1] = (unsigned)e1; rr[2] = __builtin_bit_cast(unsigned, w0); rr[3] = __builtin_bit_cast(unsigned, w1); rr[4] = pos0; rr[5] = pos1; rr[6] = __builtin_bit_cast(unsigned, rs); }
    }
}
__device__ __forceinline__ void moe_tiles(const Frame& F, int (&ts)[9]) {
    ts[0] = 0;
#pragma unroll
    for (int e = 0; e < 8; ++e) { const unsigned c = __hip_atomic_load(F.ctl + CW_CNT + 64 * e, RLX_AGENT); ts[e + 1] = ts[e] + (int)((c + 255u) >> 8); }
}
__device__ __forceinline__ void phase_gather(const Frame& F0, float* RSS) {
    const Frame F = relaunder(F0);
    constexpr int RB = F8_M1 ? D : 2 * D;
    unsigned char* ws = F.ws; const unsigned char* XH = ws + (F8_M1 ? WS_XH8 : WS_XH); unsigned char* XG = ws + WS_XG; const unsigned* route = F.ctl + CW_ROUTE;
    int ts[9]; moe_tiles(F, ts);
    for (int m = F.bid * 8 + F.wave; m < M; m += F.G * 8) { const unsigned* rr = route + (size_t)m * 8;
        const u32x4* src = (const u32x4*)(XH + (size_t)m * RB);
#pragma unroll
        for (int s = 0; s < 2; ++s) { const int e = (int)rr[s]; int base = 0;
#pragma unroll
            for (int j = 0; j < 8; ++j) base = (j == e) ? ts[j] : base;
            const int slot = base * 256 + (int)rr[4 + s]; u32x4* dst = (u32x4*)(XG + (size_t)slot * RB);
#pragma unroll
            for (int i = 0; i < RB / 1024; ++i) dst[F.lane + 64 * i] = src[F.lane + 64 * i];
            if (F.lane == 0) __hip_atomic_store((unsigned*)RSS + slot, rr[6], RLX_AGENT); } }
}
__device__ __forceinline__ void phase_combine(const Frame& F0, const bf16* X, float* out) {
    const Frame F = relaunder(F0);
    unsigned char* ws = F.ws; const bf16* YS = (const bf16*)(ws + WS_YS); const unsigned* route = F.ctl + CW_ROUTE;
    int ts[9]; moe_tiles(F, ts);
    for (int m = F.bid * 8 + F.wave; m < M; m += F.G * 8) { const unsigned* rr = route + (size_t)m * 8; int slot[2]; float w[2];
#pragma unroll
        for (int s = 0; s < 2; ++s) { const int e = (int)rr[s]; int base = 0;
#pragma unroll
            for (int j = 0; j < 8; ++j) base = (j == e) ? ts[j] : base;
            slot[s] = base * 256 + (int)rr[4 + s]; w[s] = __builtin_bit_cast(float, rr[2 + s]); }
#pragma unroll
        for (int i = 0; i < 8; ++i) { const int c = (F.lane + 64 * i) * 4; const u32x2 xr = *(const u32x2*)(X + (size_t)m * D + c); f32x4 v = (f32x4){bf2f(xr.x & 0xffffu), bf2f(xr.x >> 16), bf2f(xr.y & 0xffffu), bf2f(xr.y >> 16)};
            const u32x2 a = *(const u32x2*)(YS + (size_t)slot[0] * D + c), b2 = *(const u32x2*)(YS + (size_t)slot[1] * D + c);
            v[0] += w[0] * bf2f(a.x & 0xffffu) + w[1] * bf2f(b2.x & 0xffffu); v[1] += w[0] * bf2f(a.x >> 16) + w[1] * bf2f(b2.x >> 16);
            v[2] += w[0] * bf2f(a.y & 0xffffu) + w[1] * bf2f(b2.y & 0xffffu); v[3] += w[0] * bf2f(a.y >> 16) + w[1] * bf2f(b2.y >> 16);
            *(f32x4*)(out + (size_t)m * D + c) = v; } }
}

constexpr int PH_PER_LAYER = 14, N_PHASES = 1 + 2 * PH_PER_LAYER;
struct Args { const float* in[40]; float* out; unsigned char* ws; int ph_lo, ph_hi; };
__global__ void __launch_bounds__(512, 2) mega_fwd(Args args) {
    extern __shared__ __attribute__((aligned(16))) unsigned char lds_raw[];
    Frame F; F.lds = (LAS unsigned char*)lds_raw; F.tid = threadIdx.x; F.lane = F.tid & 63; F.wave = __builtin_amdgcn_readfirstlane(F.tid >> 6); F.G = gridDim.x; F.bid = blockIdx.x;
    F.in = args.in; F.ws = args.ws; F.ctl = (unsigned*)(args.ws + WS_CTL);
    volatile LAS unsigned* MISC = (volatile LAS unsigned*)(F.lds + MISC_OFF);
    for (int u = F.tid; u < (LDS_BYTES - RING_BYTES) / 4; u += 512) ((LAS unsigned*)(F.lds + RING_BYTES))[u] = 0u;
    __syncthreads();
    const int lo = args.ph_lo, hi = args.ph_hi;
    XcdBarrier bar; bar.bar = F.ctl + CW_BAR; bar.x = 0; bar.st = nullptr; bar.wave = F.wave;
    if (hi - lo > 1) bar = xcd_barrier_post(F.ctl + CW_BAR, MISC + 8, F.wave);
#ifndef PHMASK
#define PHMASK 0xFFFFFFFFu
#endif
#define KD(j) (((PHMASK) >> (j)) & 1u)
#define IN(k) (lo <= (k) && (k) < hi)
#define SEAM(k) do { if (IN((k) + 1)) xcd_barrier(bar); } while (0)
    unsigned char* ws = args.ws;
    u64* ssq_all = (u64*)(F.ctl + CW_SSQ);
    LAS unsigned char* lds = F.lds;

    if (KD(0) && IN(0)) { phase_prologue(F); SEAM(0); }

    auto run_layer = [&](auto LC) __attribute__((always_inline)) {
        constexpr int l = decltype(LC)::value;
        const int pb = 1 + l * PH_PER_LAYER;
        const u64* ssq_mix = ssq_all + (2 * l) * 8192; u64* ssq_ffn = ssq_all + (2 * l + 1) * 8192;
        bf16* XH = (bf16*)(ws + WS_XH);
        const float* xin = l == 0 ? args.in[0] : args.out; float* xmid = (float*)(ws + WS_XA); float* xout = args.out;
        if (KD(1) && IN(pb + 0)) {
            const int nNP = (l ? NP1 : NP0) / 256;
            { pg8::Gemm g{XH, (const bf16*)(ws + (l ? WS_WPT1 : WS_WPT0)), D, D, D, 0, 0}; pg8::GridOrder S; S.init(M / 256, nNP, 1, F.G, F.bid);
              EpiP E{(bf16*)(ws + WS_P), (bf16*)(ws + WS_G4), ssq_mix, nNP}; pg8::gemm_phase<EpiP, pg8::GridOrder>(lds, g, S, E, F.wave); }
            if (l == 0 && F.G >= 16 && F.bid >= F.G - 16) { pg8::Gemm g{(const bf16*)(ws + WS_MEMN), (const bf16*)(ws + WS_WKVT0), D, D, D, 0, 0}; pg8::GridOrder S; S.init(2, 8, 1, 16, F.bid - (F.G - 16));
              EpiF32 E{(float*)(ws + WS_KVRAW), 2048}; pg8::gemm_phase<EpiF32, pg8::GridOrder>(lds, g, S, E, F.wave); }
            SEAM(pb + 0);
        }
        if (KD(2) && IN(pb + 1)) { phase_prep(F, l); SEAM(pb + 1); }
        if (KD(3) && IN(pb + 2)) {
            if (KD(17)) { pg8::Gemm g{(const bf16*)(ws + WS_ALORA), (const bf16*)(ws + (l ? WS_WLT1 : WS_WLT0)), 512, 512, 512, 0, 0}; pg8::GridOrder S; S.init(M / 256, 8, 1, F.G, F.bid);
              EpiLora E{(float*)(ws + WS_LO), args.in[7] + l * 512, args.in[9] + l * 512, args.in[19], l}; pg8::gemm_phase<EpiLora, pg8::GridOrder>(lds, g, S, E, F.wave); }
            if (KD(18) && F.bid < 32) { const int kp = F.bid >> 3;
              pg8::Gemm g{(const bf16*)(ws + WS_ACMP) + kp * 512, (const bf16*)(ws + (l ? WS_WC1T1 : WS_WC1T0)) + kp * 512, 2048, 2048, 512, (size_t)1024 * 2048 * 2, (size_t)256 * 2048 * 2}; pg8::GridOrder S; S.init(4, 1, 2, 8, F.bid & 7);
              EpiHP E{(float*)(ws + WS_HP) + (size_t)kp * 2 * 1024 * 128}; pg8::gemm_phase<EpiHP, pg8::GridOrder>(lds, g, S, E, F.wave); }
            __syncthreads();
            if (KD(19)) phase_memattn(F);
            SEAM(pb + 2);
        }
        if (KD(4) && IN(pb + 3)) {
            if (F.bid < 8) { const CmpFin CF{(const float*)(ws + WS_HP), args.in[24] + l * 256, (const bf16*)(ws + WS_WC2T) + (size_t)l * 2 * 64 * 128, args.in[21] + l * 256 + 64, (bf16*)(ws + WS_KC), (bf16*)(ws + WS_VCT)};
                cmp_finalize(CF, F.bid >> 2, F.bid & 3, lds, F.wave, F.lane); }
            phase_scan(F, l); SEAM(pb + 3); }
        if (KD(5) && IN(pb + 4)) { unsigned* cflags = F.ctl + CW_QCTR + 256 + 64 * l; phase_carry(F, cflags); phase_nsa(F, F.ctl + CW_QCTR + 64 * l); phase_rwkv_fin(F, l, cflags, F.ctl + CW_QCTR + 128 + 64 * l); SEAM(pb + 4); }
        if (KD(7) && IN(pb + 6)) {
            pg8::Gemm g{(const bf16*)(ws + WS_Y), (const bf16*)(ws + (l ? WS_WBT1 : WS_WBT0)), 2560, 512, 512, (size_t)512 * 2, (size_t)2048 * 512 * 2}; pg8::GridOrder S; S.init(M / 256, 8, 5, F.G, F.bid);
            EpiZ E{(bf16*)(ws + WS_ZB)}; pg8::gemm_phase<EpiZ, pg8::GridOrder>(lds, g, S, E, F.wave);
            { pg8::Gemm g4{(const bf16*)(ws + WS_XH8), (const bf16*)(ws + (l ? WS_WG4T1 : WS_WG4T0)), D / 2, D / 2, D / 2, 0, 0}; pg8::GridOrder S4; S4.init(M / 256, 8, 1, F.G, F.bid);
              EpiGate4 E4{(bf16*)(ws + WS_G4), ssq_mix}; pg8::gemm_phase<EpiGate4, pg8::GridOrder, true, true>(lds, g4, S4, E4, F.wave); }
            SEAM(pb + 6);
        }
        if (KD(8) && IN(pb + 7)) {
            constexpr int KD2 = F8_G ? D / 2 : D; pg8::Gemm g{F8_G ? (const bf16*)(ws + WS_XH8) : (const bf16*)XH, (const bf16*)(ws + (l ? WS_WGT1 : WS_WGT0)), KD2, KD2, KD2, 0, 0}; pg8::GridOrder S; S.init(M / 256, 32, 1, F.G, F.bid);
            { const int sg = (F.bid >> 3) & 3; for (int i = 0; i < sg; ++i) __builtin_amdgcn_s_sleep(127); }
            EpiG E{(const bf16*)(ws + WS_ZB), (const bf16*)(ws + WS_G4), (bf16*)(ws + WS_MG), ssq_mix, F8_G ? W8SI : 1.f}; pg8::gemm_phase<EpiG, pg8::GridOrder, true, F8_G != 0>(lds, g, S, E, F.wave);
            SEAM(pb + 7);
        }
        if (KD(9) && IN(pb + 8)) {
            pg8::Gemm g{(const bf16*)(ws + WS_MG), (const bf16*)(ws + (l ? WS_WOT1 : WS_WOT0)), D, D, D, 0, 0}; pg8::GridOrder S; S.init(M / 256, 8, 1, F.G, F.bid);
            EpiRes E{XH, ssq_ffn, ws + WS_XH8}; pg8::gemm_phase<EpiRes, pg8::GridOrder>(lds, g, S, E, F.wave);
            SEAM(pb + 8);
        }
        if (l == 0) {
            if (KD(10) && IN(pb + 9)) {
                constexpr int KD2 = F8_F1 ? D / 2 : D; pg8::Gemm g{F8_F1 ? (const bf16*)(ws + WS_XH8) : (const bf16*)XH, (const bf16*)(ws + WS_W13T), KD2, KD2, KD2, 0, 0}; pg8::GridOrder S; S.init(M / 256, 2 * FF / 256, 1, F.G, F.bid);
                EpiSwiglu<false> E{(bf16*)(ws + WS_ACT), FF, ssq_ffn, nullptr, F8_F1 ? W8SI : 1.f, 1.f}; pg8::gemm_phase<EpiSwiglu<false>, pg8::GridOrder, true, F8_F1 != 0>(lds, g, S, E, F.wave);
                SEAM(pb + 9);
            }
            if (KD(11) && IN(pb + 10)) {
                pg8::Gemm g{(const bf16*)(ws + WS_ACT), (const bf16*)(ws + WS_W2T), FF, FF, FF, 0, 0}; pg8::GridOrder S; S.init(M / 256, 8, 1, F.G, F.bid);
                EpiRes E{XH, ssq_all + 2 * 8192, ws + WS_XH8}; pg8::gemm_phase<EpiRes, pg8::GridOrder>(lds, g, S, E, F.wave);
                SEAM(pb + 13);
            }
        } else {
            float* RSS = (float*)(ws + WS_RSS);
            if (KD(12) && IN(pb + 9)) { phase_route(F, XH); SEAM(pb + 9); }
            if (KD(13) && IN(pb + 10)) { phase_gather(F, RSS); SEAM(pb + 10); }
            if (KD(14) && IN(pb + 11)) {
                pg8::MoeOrder S; moe_tiles(F, S.ts); S.nN = 2 * EFF / 256; S.G = F.G; S.c = F.bid;
                constexpr int KD2 = F8_M1 ? D / 2 : D; pg8::Gemm g{(const bf16*)(ws + WS_XG), (const bf16*)(ws + WS_MW13T), KD2, KD2, KD2, 0, (size_t)2 * EFF * 2048 * (F8_M1 ? 1 : 2)};
                EpiSwiglu<F8_M2 != 0> E{(bf16*)(ws + WS_ACTM), EFF, nullptr, RSS, F8_M1 ? W8SI : 1.f, 8.f}; pg8::gemm_phase<EpiSwiglu<F8_M2 != 0>, pg8::MoeOrder, true, F8_M1 != 0>(lds, g, S, E, F.wave);
                SEAM(pb + 11);
            }
            if (KD(15) && IN(pb + 12)) {
                pg8::MoeOrder S; moe_tiles(F, S.ts); S.nN = 8; S.G = F.G; S.c = F.bid;
                constexpr int KE2 = F8_M2 ? EFF / 2 : EFF; pg8::Gemm g{(const bf16*)(ws + WS_ACTM), (const bf16*)(ws + WS_MW2T), KE2, KE2, KE2, 0, (size_t)2048 * EFF * (F8_M2 ? 1 : 2)};
                EpiBf E{(bf16*)(ws + WS_YS), D, F8_M2 ? W8SI / 8.f : 1.f}; pg8::gemm_phase<EpiBf, pg8::MoeOrder, true, F8_M2 != 0>(lds, g, S, E, F.wave);
                SEAM(pb + 12);
            }
            if (KD(16) && IN(pb + 13)) { phase_combine(F, XH, xout); }
        }
    };
    run_layer(std::integral_constant<int, 0>{});
    run_layer(std::integral_constant<int, 1>{});
#undef IN
#undef SEAM
}

#ifdef DBG_STOP
__global__ void dbg_dump(const unsigned char* buf, size_t nelem, int is_bf16, float* out, int nout) {
    for (int i = blockIdx.x * blockDim.x + threadIdx.x; i < nout; i += gridDim.x * blockDim.x) { float s = 0.f;
        for (size_t j = (size_t)i; j < nelem; j += (size_t)nout) s += is_bf16 ? bf2f(((const bf16*)buf)[j]) : ((const float*)buf)[j];
        out[i] = s; }
}
__global__ void dbg_cols(const bf16* buf, int ld, int c0, int w, float* out) {
    for (int i = blockIdx.x * blockDim.x + threadIdx.x; i < M * D; i += gridDim.x * blockDim.x) { const int row = i >> 11, c = i & 2047; out[i] = bf2f(buf[(size_t)row * ld + c0 + (c % w)]); }
}
#endif
extern "C" void kernel_launch(void* const* d_in, const int* in_sizes, int n_in, void* d_out, int out_size, void* d_ws, size_t ws_size, hipStream_t stream) {
    static int grid = 0;
    if (grid == 0) {
        if (n_in != 40 || out_size != M * D || ws_size < WS_END) { fprintf(stderr, "kernel_launch: unexpected shapes (n_in %d out %d ws %zu need %zu)\n", n_in, out_size, ws_size, (size_t)WS_END); grid = -1; return; }
        int dev = 0, cus = 0, per_cu = 0;
        if (hipGetDevice(&dev) != hipSuccess || hipDeviceGetAttribute(&cus, hipDeviceAttributeMultiprocessorCount, dev) != hipSuccess) { grid = -1; return; }
        if (hipFuncSetAttribute((const void*)mega_fwd, hipFuncAttributeMaxDynamicSharedMemorySize, LDS_BYTES) != hipSuccess) { fprintf(stderr, "kernel_launch: hipFuncSetAttribute failed\n"); grid = -1; return; }
        if (hipOccupancyMaxActiveBlocksPerMultiprocessor(&per_cu, (const void*)mega_fwd, 512, LDS_BYTES) != hipSuccess || per_cu < 1) fprintf(stderr, "kernel_launch: occupancy query reports %d\n", per_cu);
        (void)hipGetLastError();
        grid = cus;
    }
    if (grid < 0) return;
    if (hipMemsetAsync((char*)d_ws + WS_CTL, 0, CTL_BYTES, stream) != hipSuccess) return;
    Args a{};
    for (int i = 0; i < 40; ++i) a.in[i] = (const float*)d_in[i];
    a.out = (float*)d_out; a.ws = (unsigned char*)d_ws;
#if MK_ONE_LAUNCH
    a.ph_lo = 0; a.ph_hi = N_PHASES;
    hipLaunchKernelGGL(mega_fwd, dim3(grid), dim3(512), LDS_BYTES, stream, a);
#else
    for (int p = 0; p < N_PHASES; ++p) {
        if (p >= 1 + 11 && p < 1 + PH_PER_LAYER) continue;
#ifdef DBG_STOP
        if (p > DBG_STOP) break;
#endif
        a.ph_lo = p; a.ph_hi = p + 1;
        hipLaunchKernelGGL(mega_fwd, dim3(grid), dim3(512), LDS_BYTES, stream, a);
    }
#ifdef DBG_STOP
#ifdef DBG_C0
    hipLaunchKernelGGL(dbg_cols, dim3(2048), dim3(256), 0, stream, (const bf16*)((const unsigned char*)d_ws + (size_t)(DBG_OFF)), (int)(DBG_LD), (int)(DBG_C0), (int)(DBG_W), (float*)d_out);
#else
    hipLaunchKernelGGL(dbg_dump, dim3(2048), dim3(256), 0, stream, (const unsigned char*)d_ws + (size_t)(DBG_OFF), (size_t)(DBG_NELEM), (int)(DBG_BF16), (float*)d_out, M * D);
#endif
#endif
#endif
}
```

```cpp
#include <hip/hip_runtime.h>
#include <cstdio>
#include <cstdint>
#include <type_traits>

#ifndef F8_G
#define F8_G 1
#endif
#ifndef F8_F1
#define F8_F1 0
#endif
#ifndef F8_M1
#define F8_M1 1
#endif
#ifndef F8_M2
#define F8_M2 1
#endif
#ifndef MK_ONE_LAUNCH
#define MK_ONE_LAUNCH 1
#endif

#define GAS __attribute__((address_space(1)))
#define LAS __attribute__((address_space(3)))
typedef unsigned short bf16;
typedef short bf16x8 __attribute__((ext_vector_type(8)));
typedef float f32x4 __attribute__((ext_vector_type(4)));
typedef float f32x2 __attribute__((ext_vector_type(2)));
typedef unsigned u32x4 __attribute__((ext_vector_type(4)));
typedef unsigned u32x2 __attribute__((ext_vector_type(2)));

constexpr int M = 8192, T = 4096, D = 2048;
constexpr int LDP = 6144;
constexpr int NP0 = 5888, NP1 = 6144;
constexpr int PC_R = 0, PC_K = 512, PC_V = 1024, PC_WD = 1536, PC_AD = 1632, PC_GD = 1728;
constexpr int PC_Q = 1984, PC_KC = 2496, PC_VC = 2624, PC_KS = 2752, PC_VS = 2880, PC_KW = 3008, PC_VW = 3136, PC_GL = 3264;
constexpr int PC_CB = 3288, PC_CC = 3800, PC_CX = 4312, PC_POOL = 4824, PC_MEM = 5336, PC_GATE = 5848, PC_VRES = 5848;
constexpr int NIN = 16088;
constexpr int FF = 5632, EFF = 2816, NE = 8;
constexpr float NORM_EPS = 1e-6f;
constexpr float CQ_NSA = 0.125f * 1.4426950408889634f, CQ_MEM = 0.08838834764831845f * 1.4426950408889634f;
constexpr int SLOTS = 18432;

constexpr size_t al4k(size_t x) { return (x + 4095) & ~(size_t)4095; }
constexpr size_t MiB = 1u << 20;
constexpr size_t WS_CTL = 0, CTL_BYTES = MiB;
constexpr size_t SZ_WPT0 = (size_t)NP0 * 2048 * 2, SZ_WPT1 = (size_t)NP1 * 2048 * 2;
constexpr size_t SZ_WGT = (size_t)8192 * 2048 * 2, SZ_WBT = (size_t)5 * 2048 * 512 * 2, SZ_WOT = (size_t)2048 * 2048 * 2, SZ_WLT = (size_t)2048 * 512 * 2;
constexpr size_t SZ_WKVT = (size_t)1024 * 2048 * 2, SZ_WC1T = (size_t)2 * 256 * 2048 * 2;
constexpr size_t WS_WPT0 = WS_CTL + CTL_BYTES;
constexpr size_t WS_WPT1 = WS_WPT0 + SZ_WPT0;
constexpr size_t WS_WGT0 = WS_WPT1 + SZ_WPT1, WS_WGT1 = WS_WGT0 + SZ_WGT;
constexpr size_t WS_WG4T0 = WS_WGT1 + SZ_WGT, WS_WG4T1 = WS_WG4T0 + (size_t)2048 * 2048;
constexpr size_t WS_WBT0 = WS_WG4T1 + (size_t)2048 * 2048, WS_WBT1 = WS_WBT0 + SZ_WBT;
constexpr size_t WS_WOT0 = WS_WBT1 + SZ_WBT, WS_WOT1 = WS_WOT0 + SZ_WOT;
constexpr size_t WS_WLT0 = WS_WOT1 + SZ_WOT, WS_WLT1 = WS_WLT0 + SZ_WLT;
constexpr size_t WS_WKVT0 = WS_WLT1 + SZ_WLT, WS_WKVT1 = WS_WKVT0 + SZ_WKVT;
constexpr size_t WS_WC1T0 = WS_WKVT1 + SZ_WKVT, WS_WC1T1 = WS_WC1T0 + SZ_WC1T;
constexpr size_t WS_WC2T = WS_WC1T1 + SZ_WC1T;
constexpr size_t WS_W13T = WS_WC2T + (size_t)65536;
constexpr size_t WS_W2T = WS_W13T + (size_t)2 * FF * 2048 * 2;
constexpr size_t WS_MW13T = WS_W2T + (size_t)2048 * FF * 2;
constexpr size_t WS_MW2T = WS_MW13T + (size_t)NE * 2 * EFF * 2048 * 2;
constexpr size_t WS_XA = WS_MW2T + (size_t)NE * 2048 * EFF * 2;
constexpr size_t WS_XH = WS_XA + (size_t)M * D * 4;
constexpr size_t WS_MEMN = WS_XH + (size_t)M * D * 2;
constexpr size_t WS_G4 = WS_MEMN + (size_t)512 * 2048 * 2;
constexpr size_t WS_Y = WS_G4 + (size_t)M * D * 2;
constexpr size_t WS_VFIRST = WS_Y + (size_t)M * 2560 * 2;
constexpr size_t WS_KVRAW = WS_VFIRST + (size_t)M * 512 * 4;
constexpr size_t WS_XH8 = WS_KVRAW + (size_t)512 * 2048 * 4;
constexpr size_t WS_OV = WS_XH8 + (size_t)M * D;
constexpr size_t WS_P = WS_OV;
constexpr size_t WS_ALORA = WS_P + (size_t)M * LDP * 2;
constexpr size_t WS_LO = WS_ALORA + (size_t)M * 512 * 2;
constexpr size_t WS_YL = WS_LO + (size_t)M * 2048 * 4;
constexpr size_t WS_ZL = WS_YL + (size_t)M * 512 * 4;
constexpr size_t WS_QF = WS_ZL + (size_t)M * 512 * 4;
constexpr size_t WS_PF = WS_QF + (size_t)2048 * 4096 * 4;
constexpr size_t WS_SINIT = WS_PF + (size_t)2048 * 4096 * 4;
constexpr size_t WS_VCUR = WS_SINIT + (size_t)2048 * 4096 * 4;
constexpr size_t WS_BON = WS_VCUR + (size_t)M * 512 * 4;
constexpr size_t WS_QN = WS_BON + (size_t)M * 8 * 4;
constexpr size_t WS_KS = WS_QN + (size_t)M * 512 * 2;
constexpr size_t WS_KW = WS_KS + (size_t)M * 128 * 2;
constexpr size_t WS_VST = WS_KW + (size_t)M * 128 * 2;
constexpr size_t WS_VWT = WS_VST + (size_t)M * 128 * 2;
constexpr size_t WS_ACMP = WS_VWT + (size_t)M * 128 * 2;
constexpr size_t WS_KC = WS_ACMP + (size_t)2 * 1024 * 2048 * 2;
constexpr size_t WS_VCT = WS_KC + (size_t)4 * 256 * 64 * 2;
constexpr size_t WS_QM = WS_VCT + (size_t)4 * 256 * 64 * 2;
constexpr size_t WS_KMEM = WS_QM + (size_t)M * 512 * 2;
constexpr size_t WS_VMEMT = WS_KMEM + (size_t)8 * 256 * 128 * 2;
constexpr size_t WS_HP = WS_VMEMT + (size_t)8 * 256 * 128 * 2;
constexpr size_t WS_MIX_END = WS_HP + (size_t)4 * 2 * 1024 * 128 * 4;
constexpr size_t WS_ZB = WS_OV;
constexpr size_t WS_MG = WS_ZB + (size_t)5 * M * D * 2;
constexpr size_t WS_ACT = WS_OV;
constexpr size_t WS_XG = WS_OV;
constexpr size_t WS_ACTM = WS_XG + (size_t)SLOTS * 2048 * 2;
constexpr size_t WS_YS = WS_ACTM + (size_t)SLOTS * EFF * 2;
constexpr size_t WS_RSS = WS_YS + (size_t)SLOTS * 2048 * 2;
constexpr size_t WS_MOE_END = WS_RSS + (size_t)SLOTS * 4;
constexpr size_t WS_END = WS_MIX_END > WS_MOE_END ? WS_MIX_END : WS_MOE_END;
static_assert(WS_END <= (size_t)1119977216, "workspace map exceeds the guaranteed d_ws size");
static_assert(WS_MG + (size_t)M * D * 2 <= WS_MIX_END, "Z view inside overlay");

constexpr int CW_BAR = 4096;
constexpr int CW_SSQ = 16384;
constexpr int CW_CNT = CW_SSQ + 4 * 8192 * 2;
constexpr int CW_QCTR = CW_CNT + 512;
constexpr int CW_ROUTE = CW_CNT + 1024;
static_assert((CW_ROUTE + 8 * 8192) * 4 <= (int)CTL_BYTES, "CTL map");

constexpr int RING_BYTES = 131072;
constexpr int MISC_OFF = RING_BYTES + 320;
constexpr int LDS_BYTES = 147456;

#define RLX_AGENT __ATOMIC_RELAXED, __HIP_MEMORY_SCOPE_AGENT
#define LDS_WAIT() asm volatile("s_waitcnt lgkmcnt(0)" ::: "memory")
#define VM_WAIT() asm volatile("s_waitcnt vmcnt(0)" ::: "memory")
__device__ __forceinline__ unsigned f2bf(float f) { unsigned u = __builtin_bit_cast(unsigned, f); return (u + 0x7fffu + ((u >> 16) & 1u)) >> 16; }
__device__ __forceinline__ float bf2f(unsigned b) { return __builtin_bit_cast(float, b << 16); }
typedef __bf16 bf16x2_t __attribute__((ext_vector_type(2)));
__device__ __forceinline__ unsigned pk2(float lo, float hi) { const bf16x2_t b = __builtin_convertvector((f32x2){lo, hi}, bf16x2_t); return __builtin_bit_cast(unsigned, b); }
__device__ __forceinline__ unsigned pk4_fp8(float a, float b, float c, float d) { unsigned w = 0u; w = (unsigned)__builtin_amdgcn_cvt_pk_fp8_f32(a, b, (int)w, false); w = (unsigned)__builtin_amdgcn_cvt_pk_fp8_f32(c, d, (int)w, true); return w; }
constexpr float W8S = 64.0f, W8SI = 1.0f / 64.0f;
__device__ __forceinline__ float sigmoidf_(float x) { return __builtin_amdgcn_rcpf(1.f + __builtin_amdgcn_exp2f(x * -1.4426950408889634f)); }
#define DPPF(v, ctrl) __builtin_bit_cast(float, __builtin_amdgcn_update_dpp(0, __builtin_bit_cast(int, (v)), (ctrl), 0xf, 0xf, true))
__device__ __forceinline__ float red16_max(float v) { v = fmaxf(v, DPPF(v, 0xB1)); v = fmaxf(v, DPPF(v, 0x4E)); v = fmaxf(v, DPPF(v, 0x141)); v = fmaxf(v, DPPF(v, 0x140)); return v; }
__device__ __forceinline__ float red16_sum(float v) { v += DPPF(v, 0xB1); v += DPPF(v, 0x4E); v += DPPF(v, 0x141); v += DPPF(v, 0x140); return v; }
__device__ __forceinline__ float wave_sum(float v) {
#pragma unroll
    for (int o = 1; o < 64; o <<= 1) v += __shfl_xor(v, o);
    return v;
}

#define XB_TMO      128
#define XB_XCNT(j)  (256  + 64 * (j))
#define XB_XSUB(j)  (1280 + 64 * (j))
#define XB_XGEN(j)  (2304 + 64 * (j))
#define XB_TOP      3328
#define XB_TOPGEN   3392
#define XCD_BAR_WORDS 3456
#define XB_SPIN_CAP (1u << 18)
__device__ __forceinline__ unsigned xb_ld(unsigned* p)              { return __hip_atomic_load(p, __ATOMIC_RELAXED, __HIP_MEMORY_SCOPE_AGENT); }
__device__ __forceinline__ unsigned xb_add(unsigned* p, unsigned v) { return __hip_atomic_fetch_add(p, v, __ATOMIC_RELAXED, __HIP_MEMORY_SCOPE_AGENT); }
__device__ __forceinline__ unsigned xb_xcc_id() { return (unsigned)__builtin_amdgcn_s_getreg((3 << 11) | 20) & 0xFu; }
#define XB_SPIN(cond, bar) do { unsigned _sp = 0; while (cond) { __builtin_amdgcn_s_sleep(1); \
    if ((++_sp & 255u) == 0u) { if (xb_ld(&(bar)[XB_TMO])) break; if (_sp > XB_SPIN_CAP) { atomicAdd(&(bar)[XB_TMO], 1u); break; } } } } while (0)
struct XcdBarrier { unsigned* bar; unsigned x; volatile LAS unsigned* st; int wave; };
__device__ __forceinline__ bool xb_t0(int wave) { return wave == 0 && __builtin_amdgcn_mbcnt_hi(~0u, __builtin_amdgcn_mbcnt_lo(~0u, 0u)) == 0u; }
__device__ __forceinline__ XcdBarrier xcd_barrier_post(unsigned* bar, volatile LAS unsigned* st, int wave) {
    XcdBarrier b; b.bar = bar; b.x = xb_xcc_id(); b.st = st; b.wave = wave;
    if (xb_t0(wave)) (void)xb_add(&bar[XB_XCNT(b.x)], 1u);
    return b;
}
__device__ __forceinline__ void xcd_barrier_complete(unsigned* bar, unsigned x, unsigned& nloc, unsigned& nx) {
    const unsigned G = gridDim.x * gridDim.y * gridDim.z;
    unsigned sum, cnt, mine, sp = 0u;
    for (;;) {
        sum = 0u; cnt = 0u; mine = 0u;
#pragma unroll
        for (unsigned j = 0; j < 16; ++j) { const unsigned c = xb_ld(&bar[XB_XCNT(j)]); sum += c; cnt += (c > 0u) ? 1u : 0u; mine = (j == x) ? c : mine; }
        if (sum == G) break;
        __builtin_amdgcn_s_sleep(1);
        if ((++sp & 255u) == 0u) { if (xb_ld(&bar[XB_TMO])) break; if (sp > XB_SPIN_CAP) { atomicAdd(&bar[XB_TMO], 1u); break; } }
    }
    nloc = mine > 0u ? mine : 1u; nx = cnt > 0u ? cnt : 1u;
}
__device__ __forceinline__ void xcd_barrier(const XcdBarrier& b) {
    asm volatile("s_waitcnt vmcnt(0)" ::: "memory");
    __syncthreads();
    if (xb_t0(b.wave)) {
        unsigned* bar = b.bar;
        __builtin_amdgcn_s_waitcnt(0);
        unsigned nloc = b.st[0], nx = b.st[1];
        if (nloc == 0u) { xcd_barrier_complete(bar, b.x, nloc, nx); b.st[0] = nloc; b.st[1] = nx; }
        const unsigned old = xb_add(&bar[XB_XSUB(b.x)], 1u);
        const unsigned gen = old / nloc;
        if (old + 1u == (gen + 1u) * nloc) {
            __builtin_amdgcn_fence(__ATOMIC_RELEASE, "agent");
            asm volatile("s_waitcnt vmcnt(0)" ::: "memory");
            const unsigned og = xb_add(&bar[XB_TOP], 1u);
            const unsigned tg = og / nx;
            if (og + 1u == (tg + 1u) * nx) xb_add(&bar[XB_TOPGEN], 1u);
            else XB_SPIN(xb_ld(&bar[XB_TOPGEN]) == tg, bar);
            __builtin_amdgcn_fence(__ATOMIC_ACQUIRE, "agent");
            xb_add(&bar[XB_XGEN(b.x)], 1u);
            asm volatile("s_waitcnt vmcnt(0)" ::: "memory");
        } else {
            XB_SPIN(xb_ld(&bar[XB_XGEN(b.x)]) == gen, bar);
            __builtin_amdgcn_fence(__ATOMIC_ACQUIRE, "agent");
            asm volatile("s_waitcnt vmcnt(0)" ::: "memory");
        }
    }
    __syncthreads();
}

namespace pg8 {
typedef int v4i_t __attribute__((ext_vector_type(4)));
typedef int v8i_t __attribute__((ext_vector_type(8)));
constexpr int BM = 256, BK = 64, HALF = 128, HTB = HALF * BK * 2, STAGE_BYTES = 8 * HTB, NXCD = 8, WGM = 8;
__host__ __device__ __forceinline__ int lds_byte(int r, int c) { const int st = (r >> 4) * 2 + (c >> 5), rr = r & 15, cc = c & 31, ob = rr * 64 + cc * 2; return st * 1024 + (ob ^ (((ob >> 9) & 1) << 5)); }
__host__ __device__ __forceinline__ void stage_rc(int b, int& R, int& C) { const int st = b / 1024, sb = b % 1024, swz = sb ^ (((sb >> 9) & 1) << 5); R = (st >> 1) * 16 + swz / 64; C = (st & 1) * 32 + (swz % 64) / 2; }
__host__ __device__ __forceinline__ int perm32(int rho) { const int n = rho >> 4, i = rho & 15; return 8 * (i >> 2) + 4 * n + (i & 3); }
struct Unit { int pm, pn, z; };
struct Gemm { const bf16* A; const bf16* Bt; int lda, ldb, K; size_t az, bz; };

struct GridOrder {
    int nM, nN, nZ, G, c;
    __device__ void init(int nM_, int nN_, int nZ_, int G_, int c_) { nM = nM_; nN = nN_; nZ = nZ_; G = G_; c = c_; }
    __device__ bool next(int i, Unit& u) const {
        const long L = (long)i * G + c; const int nwg = nM * nN; if (L >= (long)nwg * nZ) return false;
        u.z = (int)(L / nwg); int wgid = (int)(L % nwg);
        { const int q = nwg / NXCD, r = nwg % NXCD, xcd = wgid % NXCD, off = wgid / NXCD; wgid = (xcd < r ? xcd * (q + 1) : r * (q + 1) + (xcd - r) * q) + off; }
        const int nig = WGM * nN, gid = wgid / nig, fm = gid * WGM, gsz = (nM - fm) < WGM ? (nM - fm) : WGM;
        u.pm = fm + ((wgid % nig) % gsz); u.pn = (wgid % nig) / gsz; return true;
    }
    __device__ __forceinline__ void a_ready(const Unit&) const {}
    __device__ __forceinline__ void done(const Unit&) const {}
};
struct PBOrder {
    GridOrder base; int nP, nX;
    __device__ bool next(int i, Unit& u) const {
        const long L = (long)i * base.G + base.c;
        if (L < nP) return base.next(i, u);
        const int e = (int)(L - nP); if (e >= nX) return false;
        u.z = 1; u.pm = e & 1; u.pn = e >> 1; return true; }
    __device__ __forceinline__ void a_ready(const Unit&) const {}
    __device__ __forceinline__ void done(const Unit&) const {}
};
struct MoeOrder {
    int ts[9]; int nN, G, c;
    __device__ bool next(int i, Unit& u) const {
        const long L = (long)i * G + c; const int rt = (int)(L / nN); if (rt >= ts[8]) return false;
        u.pn = (int)(L % nN); u.pm = rt; int e = 0;
#pragma unroll
        for (int j = 1; j < 8; ++j) e += (rt >= ts[j]) ? 1 : 0;
        u.z = e; return true;
    }
    __device__ __forceinline__ void a_ready(const Unit&) const {}
    __device__ __forceinline__ void done(const Unit&) const {}
};

template <class Epi, class Sched, bool ALIGN_EPI = true, bool F8 = false>
__device__ __forceinline__ void gemm_phase(LAS unsigned char* lds, const Gemm g, const Sched& S, const Epi& E, int wave0) {
    int lane_ = (int)__builtin_amdgcn_mbcnt_hi(~0u, __builtin_amdgcn_mbcnt_lo(~0u, 0u)); asm volatile("" : "+v"(lane_));
    const int wid = wave0, lane = lane_, tid = wid * 64 + lane, wr = wid >> 2, wc = wid & 3, fr = lane & 15, fq = lane >> 4;
    const int K = g.K, nt = K / BK;
    unsigned voffA[2], voffB[2];
#pragma unroll
    for (int i = 0; i < 2; ++i) { int R, C; stage_rc(tid * 16 + i * 8192, R, C); const int Rb = Epi::PERM ? ((R & ~31) + perm32(R & 31)) : R;
        voffA[i] = (unsigned)(R * g.lda + C) * 2u; voffB[i] = (unsigned)(Rb * g.ldb + C) * 2u; }
    const size_t kstep = (size_t)(BK * 2);
    const size_t hA = (size_t)HALF * g.lda * 2, hB = (size_t)HALF * g.ldb * 2;
    const unsigned ldsw = (unsigned)wid * 1024u;
    const int aoff = lds_byte(wr * 64 + fr, fq * 8), boff = lds_byte(wc * 32 + fr, fq * 8);
#define PG8_SA(b, h) (((b) * 2 + (h)) * HTB)
#define PG8_SB(b, h) ((4 + (b) * 2 + (h)) * HTB)
#define PG8_STAGE(bufoff, gbase, voff) do { _Pragma("unroll") for (int _i = 0; _i < 2; ++_i) \
        __builtin_amdgcn_global_load_lds((const unsigned*)((const char*)(gbase) + (voff)[_i]), (LAS unsigned*)(lds + (bufoff) + ldsw + _i * 8192), 16, 0, 0); } while (0)
#define PG8_LDA(dst, b, h) do { _Pragma("unroll") for (int m = 0; m < 4; ++m) _Pragma("unroll") for (int k = 0; k < 2; ++k) dst[m][k] = *(const LAS bf16x8*)(lds + PG8_SA(b, h) + aoff + m * 2048 + k * 1024); } while (0)
#define PG8_LDB(dst, b, h) do { _Pragma("unroll") for (int n = 0; n < 2; ++n) _Pragma("unroll") for (int k = 0; k < 2; ++k) dst[n][k] = *(const LAS bf16x8*)(lds + PG8_SB(b, h) + boff + n * 2048 + k * 1024); } while (0)
#define PG8_MMA(ai, bj, At, Bt) do { __builtin_amdgcn_s_setprio(1); \
        if constexpr (F8) { _Pragma("unroll") for (int m = 0; m < 4; ++m) _Pragma("unroll") for (int n = 0; n < 2; ++n) { \
            const v4i_t b0 = __builtin_bit_cast(v4i_t, Bt[n][0]), b1 = __builtin_bit_cast(v4i_t, Bt[n][1]), a0 = __builtin_bit_cast(v4i_t, At[m][0]), a1 = __builtin_bit_cast(v4i_t, At[m][1]); \
            const v8i_t b8 = __builtin_shufflevector(b0, b1, 0, 1, 2, 3, 4, 5, 6, 7), a8 = __builtin_shufflevector(a0, a1, 0, 1, 2, 3, 4, 5, 6, 7); \
            asm volatile("v_mfma_f32_16x16x128_f8f6f4 %0, %1, %2, %0" : "+v"(acc[ai][bj][m][n]) : "v"(b8), "v"(a8)); } }     \
        else { _Pragma("unroll") for (int m = 0; m < 4; ++m) _Pragma("unroll") for (int n = 0; n < 2; ++n) _Pragma("unroll") for (int k = 0; k < 2; ++k) \
            acc[ai][bj][m][n] = __builtin_amdgcn_mfma_f32_16x16x32_bf16(Bt[n][k], At[m][k], acc[ai][bj][m][n], 0, 0, 0); } \
        __builtin_amdgcn_s_setprio(0); } while (0)
#define PG8_WAIT_V(n) asm volatile("s_waitcnt vmcnt(" #n ")" ::: "memory")
#define PG8_WAIT_L(n) asm volatile("s_waitcnt lgkmcnt(" #n ")" ::: "memory")
#define PG8_BAR __builtin_amdgcn_s_barrier()
#define PG8_SCHED __builtin_amdgcn_sched_barrier(0)
    Unit cur, nxt; int ui = 0;
    if (!S.next(0, cur)) return;
    f32x4 acc[2][2][4][2];
#pragma unroll
    for (int a = 0; a < 2; ++a)
#pragma unroll
        for (int b = 0; b < 2; ++b)
#pragma unroll
            for (int m = 0; m < 4; ++m)
#pragma unroll
                for (int n = 0; n < 2; ++n) acc[a][b][m][n] = (f32x4){0.f, 0.f, 0.f, 0.f};
    bf16x8 At[4][2], B0[2][2], B1[2][2];
    const char* cA = (const char*)g.A + (size_t)cur.z * g.az + (size_t)cur.pm * 2 * hA; const char* cB = (const char*)g.Bt + (size_t)cur.z * g.bz + (size_t)cur.pn * 2 * hB;
    S.a_ready(cur);
    PG8_STAGE(PG8_SB(0, 0), cB, voffB); PG8_STAGE(PG8_SB(0, 1), cB + hB, voffB); PG8_STAGE(PG8_SA(0, 0), cA, voffA); PG8_STAGE(PG8_SA(0, 1), cA + hA, voffA);
    if (wr == 1) PG8_BAR;
    PG8_WAIT_V(2); PG8_BAR;
    PG8_STAGE(PG8_SB(1, 0), cB + kstep, voffB); PG8_STAGE(PG8_SA(1, 0), cA + kstep, voffA); PG8_STAGE(PG8_SB(1, 1), cB + hB + kstep, voffB);
    PG8_WAIT_V(6); PG8_BAR;
    for (;;) {
        const bool has_next = S.next(ui + 1, nxt);
        const char* nA = has_next ? (const char*)g.A + (size_t)nxt.z * g.az + (size_t)nxt.pm * 2 * hA : cA; const char* nB = has_next ? (const char*)g.Bt + (size_t)nxt.z * g.bz + (size_t)nxt.pn * 2 * hB : cB;
        for (int t = 0; t < nt; t += 2) {
            const bool last = (t == nt - 2);
            const char* a1 = cA + (size_t)(t + 1) * kstep;
            const char* a2 = last ? nA : cA + (size_t)(t + 2) * kstep; const char* b2 = last ? nB : cB + (size_t)(t + 2) * kstep;
            const char* a3 = a2 + kstep; const char* b3 = b2 + kstep;
            if (last && has_next) S.a_ready(nxt);
            PG8_LDB(B0, 0, 0); PG8_LDB(B1, 0, 1); PG8_SCHED; PG8_LDA(At, 0, 0); PG8_STAGE(PG8_SA(1, 1), a1 + hA, voffA);
            PG8_WAIT_V(8); PG8_WAIT_L(0); PG8_BAR; PG8_MMA(0, 0, At, B0); PG8_MMA(0, 1, At, B1); PG8_BAR; PG8_SCHED;
            PG8_LDA(At, 0, 1); PG8_STAGE(PG8_SB(0, 0), b2, voffB); PG8_STAGE(PG8_SB(0, 1), b2 + hB, voffB); PG8_STAGE(PG8_SA(0, 0), a2, voffA);
            PG8_WAIT_V(8); PG8_WAIT_L(0); PG8_BAR; PG8_MMA(1, 0, At, B0); PG8_MMA(1, 1, At, B1); PG8_BAR; PG8_SCHED;
            PG8_LDB(B0, 1, 0); PG8_LDB(B1, 1, 1); PG8_SCHED; PG8_LDA(At, 1, 0); PG8_STAGE(PG8_SA(0, 1), a2 + hA, voffA);
            PG8_WAIT_V(8); PG8_WAIT_L(0); PG8_BAR; PG8_MMA(0, 0, At, B0); PG8_MMA(0, 1, At, B1); PG8_BAR; PG8_SCHED;
            PG8_LDA(At, 1, 1); PG8_STAGE(PG8_SB(1, 0), b3, voffB); PG8_STAGE(PG8_SB(1, 1), b3 + hB, voffB); PG8_STAGE(PG8_SA(1, 0), a3, voffA);
            PG8_WAIT_V(8); PG8_WAIT_L(0); PG8_BAR; PG8_MMA(1, 0, At, B0); PG8_MMA(1, 1, At, B1); PG8_BAR; PG8_SCHED;
        }
        if constexpr (ALIGN_EPI) { if (wr == 0) PG8_BAR; }
        if constexpr (F8) asm volatile("s_nop 15\n\ts_nop 15\n\ts_nop 15\n\ts_nop 15" ::: "memory");
        if constexpr (!Epi::AFTER_DRAIN) { E(acc, cur, wr, wc, fr, fq); S.done(cur); }
        if (!has_next) break;
#pragma unroll
        for (int a = 0; a < 2; ++a)
#pragma unroll
            for (int b = 0; b < 2; ++b)
#pragma unroll
                for (int m = 0; m < 4; ++m)
#pragma unroll
                    for (int n = 0; n < 2; ++n) acc[a][b][m][n] = (f32x4){0.f, 0.f, 0.f, 0.f};
        cur = nxt; cA = nA; cB = nB; ++ui;
        if constexpr (ALIGN_EPI) { if (wr == 1) PG8_BAR; }
    }
    PG8_WAIT_V(0);
    if constexpr (!ALIGN_EPI) { if (wr == 0) PG8_BAR; }
    PG8_BAR;
    if constexpr (Epi::AFTER_DRAIN) { E.fused(acc, cur, wr, wc, fr, fq, lds, wid, lane); S.done(cur); }
#undef PG8_SA
#undef PG8_SB
#undef PG8_STAGE
#undef PG8_LDA
#undef PG8_LDB
#undef PG8_MMA
#undef PG8_WAIT_V
#undef PG8_WAIT_L
#undef PG8_BAR
#undef PG8_SCHED
}
}
using pg8::Unit; using pg8::HALF; using pg8::BM;
typedef const f32x4 (&AccT)[2][2][4][2];

typedef unsigned long long u64;
__device__ __forceinline__ float rstd_of(const u64* ssq, int row) { return 1.0f / sqrtf((float)ssq[row] * (1.0f / 4294967296.0f) * (1.0f / D) + NORM_EPS); }
__device__ __forceinline__ size_t zblk(int row, int col) { return ((size_t)(row >> 4) * (D / 16) + (col >> 4)) * 256 + (row & 15) * 16 + (col & 15); }
__device__ __forceinline__ float rstd_raw(u64 q) { return 1.0f / sqrtf((float)q * (1.0f / 4294967296.0f) * (1.0f / D) + NORM_EPS); }
__device__ __forceinline__ u64 ssq_fix(float s) { return (u64)(s * 4294967296.0f); }

struct EpiP {
    static constexpr bool PERM = true, AFTER_DRAIN = false;
    bf16* P; bf16* G4; const u64* ssq; int nNP;
    __device__ __forceinline__ void operator()(AccT acc, const Unit& u, int wr, int wc, int fr, int fq) const {
        const int row0 = u.pm * BM + wr * 64 + fr; const bool gate = u.pn >= nNP;
        bf16* base = gate ? G4 : P; const int ld = gate ? D : LDP; const int col0 = (gate ? (u.pn - nNP) : u.pn) * BM + wc * 32 + 8 * fq;
        float rs8[2][4];
#pragma unroll
        for (int ai = 0; ai < 2; ++ai)
#pragma unroll
            for (int m = 0; m < 4; ++m) rs8[ai][m] = rstd_of(ssq, row0 + ai * HALF + m * 16);
#pragma unroll
        for (int ai = 0; ai < 2; ++ai)
#pragma unroll
            for (int m = 0; m < 4; ++m) { const int row = row0 + ai * HALF + m * 16; const float rs = rs8[ai][m]; bf16* rowp = base + (size_t)row * ld + col0;
#pragma unroll
                for (int bj = 0; bj < 2; ++bj) { f32x4 v0 = acc[ai][bj][m][0] * rs, v1 = acc[ai][bj][m][1] * rs;
                    if (gate) {
#pragma unroll
                        for (int j = 0; j < 4; ++j) { v0[j] = sigmoidf_(v0[j]); v1[j] = sigmoidf_(v1[j]); } }
                    u32x4 w; w.x = pk2(v0[0], v0[1]); w.y = pk2(v0[2], v0[3]); w.z = pk2(v1[0], v1[1]); w.w = pk2(v1[2], v1[3]);
                    *(u32x4*)(rowp + bj * HALF) = w; } }
    }
};
struct EpiGate4 {
    static constexpr bool PERM = true, AFTER_DRAIN = false;
    bf16* G4; const u64* ssq;
    __device__ __forceinline__ void operator()(AccT acc, const Unit& u, int wr, int wc, int fr, int fq) const {
        const int row0 = u.pm * BM + wr * 64 + fr, col0 = u.pn * BM + wc * 32 + 8 * fq;
        float rs8[2][4];
#pragma unroll
        for (int ai = 0; ai < 2; ++ai)
#pragma unroll
            for (int m = 0; m < 4; ++m) rs8[ai][m] = rstd_of(ssq, row0 + ai * HALF + m * 16) * W8SI;
#pragma unroll
        for (int ai = 0; ai < 2; ++ai)
#pragma unroll
            for (int m = 0; m < 4; ++m) { const int row = row0 + ai * HALF + m * 16; const float rs = rs8[ai][m];
#pragma unroll
                for (int bj = 0; bj < 2; ++bj) { f32x4 v0 = acc[ai][bj][m][0] * rs, v1 = acc[ai][bj][m][1] * rs;
#pragma unroll
                    for (int j = 0; j < 4; ++j) { v0[j] = sigmoidf_(v0[j]); v1[j] = sigmoidf_(v1[j]); }
                    u32x4 w; w.x = pk2(v0[0], v0[1]); w.y = pk2(v0[2], v0[3]); w.z = pk2(v1[0], v1[1]); w.w = pk2(v1[2], v1[3]);
                    *(u32x4*)(G4 + zblk(row, col0 + bj * HALF)) = w; } }
    }
};
struct EpiF32 {
    static constexpr bool PERM = false, AFTER_DRAIN = false;
    float* C; int ldc;
    __device__ __forceinline__ void operator()(AccT acc, const Unit& u, int wr, int wc, int fr, int fq) const {
        const int row0 = u.pm * BM + wr * 64 + fr, col0 = u.pn * BM + wc * 32 + 4 * fq;
#pragma unroll
        for (int ai = 0; ai < 2; ++ai)
#pragma unroll
            for (int m = 0; m < 4; ++m) { float* rowp = C + (size_t)(row0 + ai * HALF + m * 16) * ldc + col0;
#pragma unroll
                for (int bj = 0; bj < 2; ++bj)
#pragma unroll
                    for (int n = 0; n < 2; ++n) *(f32x4*)(rowp + bj * HALF + n * 16) = acc[ai][bj][m][n]; }
    }
};
struct EpiLora {
    static constexpr bool PERM = false, AFTER_DRAIN = false;
    float* LO; const float* w0; const float* a0; const float* v0; int has_v;
    __device__ __forceinline__ void operator()(AccT acc, const Unit& u, int wr, int wc, int fr, int fq) const {
        const int row0 = u.pm * BM + wr * 64 + fr, col0 = u.pn * BM + wc * 32 + 4 * fq; const int blk = u.pn >> 1;
        f32x4 bias4[2][2];
#pragma unroll
        for (int bj = 0; bj < 2; ++bj)
#pragma unroll
            for (int n = 0; n < 2; ++n) { const int j = (col0 + bj * HALF + n * 16) & 511; f32x4 bb = (f32x4){0.f, 0.f, 0.f, 0.f};
                if (blk == 0) bb = *(const f32x4*)(w0 + j); else if (blk == 1) bb = *(const f32x4*)(a0 + j); else if (blk == 3 && has_v) bb = *(const f32x4*)(v0 + j);
                bias4[bj][n] = bb; }
#pragma unroll
        for (int bj = 0; bj < 2; ++bj)
#pragma unroll
            for (int n = 0; n < 2; ++n) { const int col = col0 + bj * HALF + n * 16; const f32x4 bias = bias4[bj][n];
#pragma unroll
                for (int ai = 0; ai < 2; ++ai)
#pragma unroll
                    for (int m = 0; m < 4; ++m) { f32x4 v = acc[ai][bj][m][n] + bias;
                        if (blk == 0) {
#pragma unroll
                            for (int e = 0; e < 4; ++e) { const float x = v[e]; const float sp = fmaxf(-x, 0.f) + log1pf(__expf(-fabsf(x)));
                                v[e] = __expf(-__expf(-sp - 0.5f)); } }
                        else if (blk != 2) {
#pragma unroll
                            for (int e = 0; e < 4; ++e) v[e] = sigmoidf_(v[e]); }
                        *(f32x4*)(LO + (size_t)(row0 + ai * HALF + m * 16) * 2048 + col) = v; } }
    }
};
struct EpiZ {
    static constexpr bool PERM = true, AFTER_DRAIN = false;
    bf16* ZB;
    __device__ __forceinline__ void operator()(AccT acc, const Unit& u, int wr, int wc, int fr, int fq) const {
        const int row0 = u.pm * BM + wr * 64 + fr, col0 = u.pn * BM + wc * 32 + 8 * fq; bf16* base = ZB + (size_t)u.z * M * D;
#pragma unroll
        for (int ai = 0; ai < 2; ++ai)
#pragma unroll
            for (int m = 0; m < 4; ++m) { const int row = row0 + ai * HALF + m * 16;
#pragma unroll
                for (int bj = 0; bj < 2; ++bj) { const f32x4 v0 = acc[ai][bj][m][0], v1 = acc[ai][bj][m][1];
                    u32x4 w; w.x = pk2(v0[0], v0[1]); w.y = pk2(v0[2], v0[3]); w.z = pk2(v1[0], v1[1]); w.w = pk2(v1[2], v1[3]);
                    *(u32x4*)(base + zblk(row, col0 + bj * HALF)) = w; } }
    }
};
struct EpiG {
    static constexpr bool PERM = false, AFTER_DRAIN = false;
    const bf16* ZB; const bf16* G4; bf16* MG; const u64* ssq; float wsi;
    struct Bat { u64 q[2]; u32x2 g4[2], z4[2], zz[2][4]; };
    __device__ __forceinline__ void load(Bat& B, int k, int row0, int c0) const {
#pragma unroll
        for (int mm = 0; mm < 2; ++mm) { const int row = row0 + (k >> 1) * HALF + (2 * (k & 1) + mm) * 16; const size_t off = zblk(row, c0);
            B.q[mm] = ssq[row]; B.g4[mm] = *(const u32x2*)(G4 + off); B.z4[mm] = *(const u32x2*)(ZB + (size_t)4 * M * D + off);
#pragma unroll
            for (int br = 0; br < 4; ++br) B.zz[mm][br] = *(const u32x2*)(ZB + (size_t)br * M * D + off); }
    }
    __device__ __forceinline__ void operator()(AccT acc, const Unit& u, int wr, int wc, int fr, int fq) const {
        const int row0 = u.pm * BM + wr * 64 + fr, c0 = u.pn * 64 + wc * 16 + 4 * fq;
        Bat b[2]; load(b[0], 0, row0, c0);
#pragma unroll
        for (int k = 0; k < 4; ++k) { const int ai = k >> 1;
            if (k < 3) load(b[(k + 1) & 1], k + 1, row0, c0);
            const Bat& B = b[k & 1];
#pragma unroll
            for (int mm = 0; mm < 2; ++mm) { const int m = 2 * (k & 1) + mm, row = row0 + ai * HALF + m * 16; const float rs = rstd_raw(B.q[mm]) * wsi;
                f32x4 s;
                s[0] = bf2f(B.g4[mm].x & 0xffffu) * bf2f(B.z4[mm].x & 0xffffu); s[1] = bf2f(B.g4[mm].x >> 16) * bf2f(B.z4[mm].x >> 16);
                s[2] = bf2f(B.g4[mm].y & 0xffffu) * bf2f(B.z4[mm].y & 0xffffu); s[3] = bf2f(B.g4[mm].y >> 16) * bf2f(B.z4[mm].y >> 16);
#pragma unroll
                for (int bj = 0; bj < 2; ++bj)
#pragma unroll
                    for (int n = 0; n < 2; ++n) { const int br = 2 * bj + n; const u32x2 z = B.zz[mm][br]; const f32x4 a = acc[ai][bj][m][n] * rs;
                        s[0] += sigmoidf_(a[0]) * bf2f(z.x & 0xffffu); s[1] += sigmoidf_(a[1]) * bf2f(z.x >> 16);
                        s[2] += sigmoidf_(a[2]) * bf2f(z.y & 0xffffu); s[3] += sigmoidf_(a[3]) * bf2f(z.y >> 16); }
                u32x2 w; w.x = pk2(s[0], s[1]); w.y = pk2(s[2], s[3]); *(u32x2*)(MG + (size_t)row * D + c0) = w; } }
    }
};
struct EpiRes {
    static constexpr bool PERM = true, AFTER_DRAIN = false;
    bf16* XH; u64* ssq; unsigned char* XH8;
    __device__ __forceinline__ void operator()(AccT acc, const Unit& u, int wr, int wc, int fr, int fq) const {
        const int row0 = u.pm * BM + wr * 64 + fr, col0 = u.pn * BM + wc * 32 + 8 * fq;
#pragma unroll
        for (int ai = 0; ai < 2; ++ai) {
            u32x4 rv[4][2];
#pragma unroll
            for (int m = 0; m < 4; ++m) { const size_t off = (size_t)(row0 + ai * HALF + m * 16) * D + col0;
#pragma unroll
                for (int bj = 0; bj < 2; ++bj) rv[m][bj] = *(const u32x4*)(XH + off + bj * HALF); }
#pragma unroll
            for (int m = 0; m < 4; ++m) { const int row = row0 + ai * HALF + m * 16; const size_t off = (size_t)row * D + col0; float sq = 0.f;
#pragma unroll
                for (int bj = 0; bj < 2; ++bj) { const size_t o = off + bj * HALF; const u32x4 r = rv[m][bj];
                    const f32x4 v0 = (f32x4){bf2f(r.x & 0xffffu), bf2f(r.x >> 16), bf2f(r.y & 0xffffu), bf2f(r.y >> 16)} + acc[ai][bj][m][0];
                    const f32x4 v1 = (f32x4){bf2f(r.z & 0xffffu), bf2f(r.z >> 16), bf2f(r.w & 0xffffu), bf2f(r.w >> 16)} + acc[ai][bj][m][1];
                    sq += ((v0[0] * v0[0] + v0[1] * v0[1]) + (v0[2] * v0[2] + v0[3] * v0[3])) + ((v1[0] * v1[0] + v1[1] * v1[1]) + (v1[2] * v1[2] + v1[3] * v1[3]));
                    u32x4 w; w.x = pk2(v0[0], v0[1]); w.y = pk2(v0[2], v0[3]); w.z = pk2(v1[0], v1[1]); w.w = pk2(v1[2], v1[3]); *(u32x4*)(XH + o) = w;
                    u32x2 w8; w8.x = pk4_fp8(v0[0], v0[1], v0[2], v0[3]); w8.y = pk4_fp8(v1[0], v1[1], v1[2], v1[3]); *(u32x2*)(XH8 + o) = w8; }
                sq += __shfl_xor(sq, 16); sq += __shfl_xor(sq, 32);
                if (fq == 0) atomicAdd(ssq + row, ssq_fix(sq)); }
            asm volatile("" ::: "memory"); }
    }
};
template <bool OUT8> struct EpiSwiglu {
    static constexpr bool PERM = true, AFTER_DRAIN = false;
    bf16* ACT; int ldc; const u64* ssq; const float* rss; float wsi; float osc;
    __device__ __forceinline__ void operator()(AccT acc, const Unit& u, int wr, int wc, int fr, int fq) const {
        const int row0 = u.pm * BM + wr * 64 + fr, col0 = u.pn * HALF + wc * 32 + 8 * fq;
        float rs8[2][4];
#pragma unroll
        for (int ai = 0; ai < 2; ++ai)
#pragma unroll
            for (int m = 0; m < 4; ++m) { const int row = row0 + ai * HALF + m * 16; rs8[ai][m] = (rss ? rss[row] : rstd_of(ssq, row)) * wsi; }
#pragma unroll
        for (int ai = 0; ai < 2; ++ai)
#pragma unroll
            for (int m = 0; m < 4; ++m) { const int row = row0 + ai * HALF + m * 16; const float rs = rs8[ai][m];
                float o[8];
#pragma unroll
                for (int n = 0; n < 2; ++n)
#pragma unroll
                    for (int e = 0; e < 4; ++e) { const float a = acc[ai][0][m][n][e] * rs, b = acc[ai][1][m][n][e] * rs; o[4 * n + e] = a * sigmoidf_(a) * b; }
                if constexpr (OUT8) { u32x2 w; w.x = pk4_fp8(o[0] * osc, o[1] * osc, o[2] * osc, o[3] * osc); w.y = pk4_fp8(o[4] * osc, o[5] * osc, o[6] * osc, o[7] * osc);
                    *(u32x2*)((unsigned char*)ACT + (size_t)row * ldc + col0) = w; }
                else { u32x4 w; w.x = pk2(o[0], o[1]); w.y = pk2(o[2], o[3]); w.z = pk2(o[4], o[5]); w.w = pk2(o[6], o[7]);
                    *(u32x4*)(ACT + (size_t)row * ldc + col0) = w; } }
    }
};
struct EpiBf {
    static constexpr bool PERM = true, AFTER_DRAIN = false;
    bf16* O; int ldc; float sc;
    __device__ __forceinline__ void operator()(AccT acc, const Unit& u, int wr, int wc, int fr, int fq) const {
        const int row0 = u.pm * BM + wr * 64 + fr, col0 = u.pn * BM + wc * 32 + 8 * fq;
#pragma unroll
        for (int ai = 0; ai < 2; ++ai)
#pragma unroll
            for (int m = 0; m < 4; ++m) { bf16* rowp = O + (size_t)(row0 + ai * HALF + m * 16) * ldc + col0;
#pragma unroll
                for (int bj = 0; bj < 2; ++bj) { const f32x4 v0 = acc[ai][bj][m][0] * sc, v1 = acc[ai][bj][m][1] * sc;
                    u32x4 w; w.x = pk2(v0[0], v0[1]); w.y = pk2(v0[2], v0[3]); w.z = pk2(v1[0], v1[1]); w.w = pk2(v1[2], v1[3]);
                    *(u32x4*)(rowp + bj * HALF) = w; } }
    }
};
struct EpiHP {
    static constexpr bool PERM = false, AFTER_DRAIN = false;
    float* HP;
    __device__ __forceinline__ void operator()(AccT acc, const Unit& u, int wr, int wc, int fr, int fq) const {
        const int row0 = u.pm * BM + wr * 64 + fr, col0 = wc * 32 + 4 * fq; float* base = HP + (size_t)u.z * 1024 * 128;
#pragma unroll
        for (int ai = 0; ai < 2; ++ai)
#pragma unroll
            for (int m = 0; m < 4; ++m) { float* rowp = base + (size_t)(row0 + ai * HALF + m * 16) * 128 + col0;
#pragma unroll
                for (int n = 0; n < 2; ++n) *(f32x4*)(rowp + n * 16) = acc[ai][0][m][n]; }
    }
};
struct CmpFin { const float* HP; const float* b1; const bf16* w2t; const float* gain; bf16* KC; bf16* VCT; };
__device__ __forceinline__ void cmp_finalize(const CmpFin& C_, int z, int pm, LAS unsigned char* lds, int wid, int lane) {
        LAS bf16* H = (LAS bf16*)lds;
        { const int tid = wid * 64 + lane, r = tid >> 1, c0 = (tid & 1) * 64;
#pragma unroll
          for (int j = 0; j < 16; ++j) { const int c = c0 + 4 * j; f32x4 v = *(const f32x4*)(C_.b1 + z * 128 + c);
#pragma unroll
              for (int kp = 0; kp < 4; ++kp) v += *(const f32x4*)(C_.HP + ((size_t)(kp * 2 + z) * 1024 + pm * 256 + r) * 128 + c);
#pragma unroll
              for (int e = 0; e < 4; ++e) { const float x = v[e]; const float t = 0.7978845608f * (x + 0.044715f * x * x * x); const float th = 1.f - 2.f / (__expf(2.f * t) + 1.f); v[e] = 0.5f * x * (1.f + th); }
              u32x2 w; w.x = pk2(v[0], v[1]); w.y = pk2(v[2], v[3]); *(LAS u32x2*)(H + r * 136 + c) = w; } }
        LDS_WAIT(); __syncthreads();
        bf16x8 af[2][4], bfr[4][4];
#pragma unroll
        for (int mt = 0; mt < 2; ++mt)
#pragma unroll
            for (int ks = 0; ks < 4; ++ks) af[mt][ks] = *(const LAS bf16x8*)(H + (wid * 32 + mt * 16 + (lane & 15)) * 136 + ks * 32 + 8 * (lane >> 4));
#pragma unroll
        for (int n = 0; n < 4; ++n)
#pragma unroll
            for (int ks = 0; ks < 4; ++ks) bfr[n][ks] = *(const bf16x8*)(C_.w2t + (size_t)z * 64 * 128 + (16 * n + (lane & 15)) * 128 + ks * 32 + 8 * (lane >> 4));
        asm volatile("s_waitcnt vmcnt(0) lgkmcnt(0)" ::: "memory"); __builtin_amdgcn_sched_barrier(0);
        f32x4 C[2][4];
#pragma unroll
        for (int mt = 0; mt < 2; ++mt)
#pragma unroll
            for (int n = 0; n < 4; ++n) { C[mt][n] = (f32x4){0.f, 0.f, 0.f, 0.f};
#pragma unroll
                for (int ks = 0; ks < 4; ++ks) C[mt][n] = __builtin_amdgcn_mfma_f32_16x16x32_bf16(af[mt][ks], bfr[n][ks], C[mt][n], 0, 0, 0); }
        __builtin_amdgcn_sched_barrier(0);
#pragma unroll
        for (int mt = 0; mt < 2; ++mt)
#pragma unroll
            for (int r = 0; r < 4; ++r) { const int grow = pm * 256 + wid * 32 + mt * 16 + 4 * (lane >> 4) + r;
                const int hh = grow & 1, bc = grow >> 1, b = bc >> 8, c = bc & 255;
                float ss = 0.f;
#pragma unroll
                for (int n = 0; n < 4; ++n) ss += C[mt][n][r] * C[mt][n][r];
                ss = red16_sum(ss);
                if (c < 255) {
                    if (z == 0) { const float rs = 1.0f / sqrtf(ss * (1.f / 64.f) + NORM_EPS); bf16* dst = C_.KC + ((size_t)(b * 2 + hh) * 256 + c) * 64;
#pragma unroll
                        for (int n = 0; n < 4; ++n) { const int d = 16 * n + (lane & 15); dst[d] = (bf16)f2bf(C[mt][n][r] * rs * C_.gain[d]); } }
                    else { bf16* dst = C_.VCT + (size_t)(b * 2 + hh) * 64 * 256 + c;
#pragma unroll
                        for (int n = 0; n < 4; ++n) { const int d = 16 * n + (lane & 15); dst[(size_t)d * 256] = (bf16)f2bf(C[mt][n][r]); } } } }
        __syncthreads();
}

struct Frame {
    LAS unsigned char* lds; int tid, lane, wave, G, bid;
    const float* const* in; unsigned char* ws; unsigned* ctl;
};
__device__ __forceinline__ Frame relaunder(const Frame& F0) { Frame F = F0; int ln = (int)__builtin_amdgcn_mbcnt_hi(~0u, __builtin_amdgcn_mbcnt_lo(~0u, 0u)); asm volatile("" : "+v"(ln)); F.lane = ln; F.wave = F0.wave; F.tid = F0.wave * 64 + ln; return F; }
#define INP(k) (F.in[k])
__device__ __forceinline__ float ldbf(const bf16* p) { return bf2f(*p); }
__device__ __forceinline__ void ld8(const bf16* p, float (&v)[8]) { const u32x4 r = *(const u32x4*)p;
    v[0] = bf2f(r.x & 0xffffu); v[1] = bf2f(r.x >> 16); v[2] = bf2f(r.y & 0xffffu); v[3] = bf2f(r.y >> 16); v[4] = bf2f(r.z & 0xffffu); v[5] = bf2f(r.z >> 16); v[6] = bf2f(r.w & 0xffffu); v[7] = bf2f(r.w >> 16); }
__device__ __forceinline__ void st8(bf16* p, const float (&v)[8]) { u32x4 w; w.x = pk2(v[0], v[1]); w.y = pk2(v[2], v[3]); w.z = pk2(v[4], v[5]); w.w = pk2(v[6], v[7]); *(u32x4*)p = w; }
__device__ __forceinline__ void ldf8(const float* p, float (&v)[8]) { const f32x4 a = *(const f32x4*)p, b = *(const f32x4*)(p + 4); v[0] = a[0]; v[1] = a[1]; v[2] = a[2]; v[3] = a[3]; v[4] = b[0]; v[5] = b[1]; v[6] = b[2]; v[7] = b[3]; }

template <class Fsrc, bool F8 = false>
__device__ __forceinline__ void tr_matrix(const Frame& F, Fsrc f, int nrows, int K, bf16* dst) {
    LAS float* scr = (LAS float*)(F.lds + F.wave * 16384);
    const int gw = F.bid * 8 + F.wave, NGW = F.G * 8, lane = F.lane;
    const int nblk = nrows / 32, nitems = (K / 64) * nblk;
    const int kq = lane >> 3, n4 = (lane & 7) * 4;
    for (int it = gw; it < nitems; it += NGW) {
        const int kb = it / nblk, nb = it % nblk, k0 = 64 * kb, n0 = 32 * nb;
        f32x4 v[8];
#pragma unroll
        for (int i = 0; i < 8; ++i) v[i] = f(n0 + n4, k0 + 8 * i + kq);
#pragma unroll
        for (int i = 0; i < 8; ++i) { LAS float* d = scr + (8 * i + kq) * 33 + n4; d[0] = v[i][0]; d[1] = v[i][1]; d[2] = v[i][2]; d[3] = v[i][3]; }
        LDS_WAIT(); asm volatile("" ::: "memory");
        const int c = lane & 7;
#pragma unroll
        for (int j = 0; j < 4; ++j) { const int n = (lane >> 3) + 8 * j; const LAS float* sp = scr + (8 * c) * 33 + n;
            if constexpr (F8) { u32x2 o; o.x = pk4_fp8(sp[0 * 33], sp[1 * 33], sp[2 * 33], sp[3 * 33]); o.y = pk4_fp8(sp[4 * 33], sp[5 * 33], sp[6 * 33], sp[7 * 33]);
                *(u32x2*)((unsigned char*)dst + (size_t)(n0 + n) * K + k0 + 8 * c) = o; }
            else { u32x4 o; o.x = pk2(sp[0 * 33], sp[1 * 33]); o.y = pk2(sp[2 * 33], sp[3 * 33]); o.z = pk2(sp[4 * 33], sp[5 * 33]); o.w = pk2(sp[6 * 33], sp[7 * 33]);
                *(u32x4*)(dst + (size_t)(n0 + n) * K + k0 + 8 * c) = o; } }
        LDS_WAIT(); asm volatile("" ::: "memory");
    }
}
#define F4Z ((f32x4){0.f, 0.f, 0.f, 0.f})
struct SrcWP { const float* win; const float* vres; const float* gain; int l, NP;
    __device__ __forceinline__ f32x4 operator()(int n, int k) const {
        f32x4 v;
        if (n < 5848) v = *(const f32x4*)(win + (size_t)k * NIN + n);
        else if (n < NP) v = (l == 1 && n < 5912) ? *(const f32x4*)(vres + (size_t)k * 64 + (n - 5848)) : F4Z;
        else v = *(const f32x4*)(win + (size_t)k * NIN + PC_GATE + 4 * 2048 + (n - NP));
        return v * gain[k]; } };
struct SrcWG4 { const float* win; const float* gain;
    __device__ __forceinline__ f32x4 operator()(int n, int k) const { return *(const f32x4*)(win + (size_t)k * NIN + PC_GATE + 4 * 2048 + n) * (gain[k] * W8S); } };
struct SrcWG { const float* win; const float* gain; float sc;
    __device__ __forceinline__ f32x4 operator()(int n, int k) const {
        const int j = n >> 8, rho = n & 255, bj = rho >> 7, wc = (rho >> 5) & 3, nn = (rho >> 4) & 1, q = (rho >> 2) & 3;
        const int br = 2 * bj + nn, c = 64 * j + 16 * wc + 4 * q;
        return *(const f32x4*)(win + (size_t)k * NIN + PC_GATE + br * 2048 + c) * (gain[k] * sc); } };
struct SrcWB { const float* wb; const float* pw; const float* ps;
    __device__ __forceinline__ f32x4 operator()(int n, int k) const {
        if (n < 8192) { const int i = n >> 11, c = n & 2047; return *(const f32x4*)(wb + ((size_t)i * 512 + k) * 2048 + c); }
        const int c = n - 8192, g = c >> 9;
        if ((k >> 7) != g) return F4Z;
        return *(const f32x4*)(pw + ((size_t)g * 128 + (k & 127)) * 512 + (c & 511)) * *(const f32x4*)(ps + c); } };
struct SrcPlain { const float* w; int ldw;
    __device__ __forceinline__ f32x4 operator()(int n, int k) const { return *(const f32x4*)(w + (size_t)k * ldw + n); } };
struct SrcPlainS { const float* w; int ldw; float sc;
    __device__ __forceinline__ f32x4 operator()(int n, int k) const { return *(const f32x4*)(w + (size_t)k * ldw + n) * sc; } };
struct SrcPlainG { const float* w; int ldw; const float* gain;
    __device__ __forceinline__ f32x4 operator()(int n, int k) const { return *(const f32x4*)(w + (size_t)k * ldw + n) * gain[k]; } };
struct SrcLora { const float* w2; const float* a2; const float* g2; const float* vup; int l;
    __device__ __forceinline__ f32x4 operator()(int n, int k) const {
        const int blk = n >> 9, j = n & 511;
        if (blk == 0) return k < 96 ? *(const f32x4*)(w2 + (size_t)k * 512 + j) : F4Z;
        if (blk == 1) return (k >= 96 && k < 192) ? *(const f32x4*)(a2 + (size_t)(k - 96) * 512 + j) : F4Z;
        if (blk == 2) return (k >= 192 && k < 448) ? *(const f32x4*)(g2 + (size_t)(k - 192) * 512 + j) : F4Z;
        return (l == 1 && k >= 448) ? *(const f32x4*)(vup + (size_t)(k - 448) * 512 + j) : F4Z; } };
struct SrcC1 { const float* w1;
    __device__ __forceinline__ f32x4 operator()(int n, int k) const { const int i = n >> 8, c = n & 255; return c < 128 ? *(const f32x4*)(w1 + ((size_t)i * 2048 + k) * 128 + c) : F4Z; } };
struct SrcW13 { const float* w1; const float* w3; const float* gain; int ffw; float sc;
    __device__ __forceinline__ f32x4 operator()(int n, int k) const { const int t = n >> 8, which = (n >> 7) & 1, ff = 128 * t + (n & 127);
        const uintptr_t a = (uintptr_t)w1, dlt = (uintptr_t)w3 - a; const float* p = (const float*)(a + (which ? dlt : (uintptr_t)0));
        return *(const f32x4*)(p + (size_t)k * ffw + ff) * (gain[k] * sc); } };

constexpr int N_LATE_CHUNKS = 512;
__device__ __forceinline__ void convert_late(const Frame& F) {
    unsigned char* ws = F.ws;
    tr_matrix<SrcW13, F8_F1 != 0>(F, SrcW13{INP(33), INP(34), INP(3), FF, F8_F1 ? W8S : 1.f}, 2 * FF, 2048, (bf16*)(ws + WS_W13T));
    tr_matrix(F, SrcPlain{INP(35), D}, 2048, FF, (bf16*)(ws + WS_W2T));
    for (int e = 0; e < NE; ++e) {
        tr_matrix<SrcW13, F8_M1 != 0>(F, SrcW13{INP(37) + (size_t)e * D * EFF, INP(38) + (size_t)e * D * EFF, INP(3) + D, EFF, F8_M1 ? W8S : 1.f}, 2 * EFF, 2048, (bf16*)(ws + WS_MW13T + (size_t)e * 2 * EFF * 2048 * (F8_M1 ? 1 : 2)));
        tr_matrix<SrcPlainS, F8_M2 != 0>(F, SrcPlainS{INP(39) + (size_t)e * EFF * D, D, F8_M2 ? W8S : 1.f}, 2048, EFF, (bf16*)(ws + WS_MW2T + (size_t)e * 2048 * EFF * (F8_M2 ? 1 : 2)));
    }
}
__device__ __forceinline__ void convert_late_loop(const Frame& F0, unsigned* cq) {
    Frame F = relaunder(F0);
    LAS int* UQ = (LAS int*)(F.lds + 131072 + 64);
    for (;;) {
        __syncthreads();
        if (F.tid == 0) UQ[0] = (int)atomicAdd(cq, 1u);
        LDS_WAIT(); __syncthreads();
        const int c = UQ[0]; if (c >= N_LATE_CHUNKS) break;
        Frame Fc = F; Fc.bid = c; Fc.G = N_LATE_CHUNKS; convert_late(Fc);
    }
}
__device__ __forceinline__ void phase_prologue(const Frame& F0) {
    const Frame F = relaunder(F0);
    unsigned char* ws = F.ws;
    for (int l = 0; l < 2; ++l) {
        const float* win = INP(5) + (size_t)l * D * NIN; const float* gmix = INP(2) + l * D;
        tr_matrix(F, SrcWP{win, INP(17), gmix, l, l ? NP1 : NP0}, (l ? NP1 : NP0), 2048, (bf16*)(ws + (l ? WS_WPT1 : WS_WPT0)));
        tr_matrix<SrcWG4, true>(F, SrcWG4{win, gmix}, 2048, 2048, (bf16*)(ws + (l ? WS_WG4T1 : WS_WG4T0)));
        tr_matrix<SrcWG, F8_G != 0>(F, SrcWG{win, gmix, F8_G ? W8S : 1.f}, 8192, 2048, (bf16*)(ws + (l ? WS_WGT1 : WS_WGT0)));
        tr_matrix(F, SrcWB{INP(31) + (size_t)l * 4 * 512 * 2048, INP(27) + (size_t)l * 4 * 128 * 512, INP(28) + l * D}, 10240, 512, (bf16*)(ws + (l ? WS_WBT1 : WS_WBT0)));
        tr_matrix(F, SrcPlain{INP(32) + (size_t)l * D * D, D}, 2048, 2048, (bf16*)(ws + (l ? WS_WOT1 : WS_WOT0)));
        tr_matrix(F, SrcLora{INP(8) + (size_t)l * 96 * 512, INP(10) + (size_t)l * 96 * 512, INP(11) + (size_t)l * 256 * 512, INP(20), l}, 2048, 512, (bf16*)(ws + (l ? WS_WLT1 : WS_WLT0)));
        tr_matrix(F, SrcPlainG{INP(29) + (size_t)l * D * 1024, 1024, INP(4) + l * D}, 1024, 2048, (bf16*)(ws + (l ? WS_WKVT1 : WS_WKVT0)));
        tr_matrix(F, SrcC1{INP(23) + (size_t)l * 2 * 2048 * 128}, 512, 2048, (bf16*)(ws + (l ? WS_WC1T1 : WS_WC1T0)));
        for (int i = 0; i < 2; ++i) tr_matrix(F, SrcPlain{INP(25) + (size_t)(l * 2 + i) * 128 * 64, 64}, 64, 128, (bf16*)(ws + WS_WC2T) + (size_t)(l * 2 + i) * 64 * 128);
    }
    const int gw = F.bid * 8 + F.wave, NGW = F.G * 8;
    u64* ssq = (u64*)(F.ctl + CW_SSQ);
    for (int base = F.bid * 16; base < M + 512; base += F.G * 16) for (int q = 0; q < 2; ++q) { const int m = base + F.wave * 2 + q;
        const bool ismem = m >= M; const float* src = ismem ? INP(1) + (size_t)(m - M) * D : INP(0) + (size_t)m * D;
        const f32x4* xr = (const f32x4*)src + F.lane; f32x4 v[8]; float s = 0.f;
#pragma unroll
        for (int j = 0; j < 8; ++j) { v[j] = xr[64 * j]; s += (v[j][0] * v[j][0] + v[j][1] * v[j][1]) + (v[j][2] * v[j][2] + v[j][3] * v[j][3]); }
        s = wave_sum(s);
        float sc = 1.f;
        if (ismem) sc = 1.0f / sqrtf(s * (1.f / D) + NORM_EPS); else if (F.lane == 0) ssq[m] = ssq_fix(s);
        bf16* dst = ismem ? (bf16*)(ws + WS_MEMN) + (size_t)(m - M) * D : (bf16*)(ws + WS_XH) + (size_t)m * D;
#pragma unroll
        for (int j = 0; j < 8; ++j) { u32x2 w; w.x = pk2(v[j][0] * sc, v[j][1] * sc); w.y = pk2(v[j][2] * sc, v[j][3] * sc); *((u32x2*)dst + F.lane + 64 * j) = w;
            if (!ismem) *((unsigned*)(ws + WS_XH8 + (size_t)m * D) + F.lane + 64 * j) = pk4_fp8(v[j][0], v[j][1], v[j][2], v[j][3]); }
    }
}

__device__ __forceinline__ float shiftP(const bf16* P, int m, int t, int col, float mu) {
    const float u = ldbf(P + (size_t)m * LDP + col); const float pv = t > 0 ? ldbf(P + (size_t)(m - 1) * LDP + col) : 0.f; return u + (pv - u) * mu;
}
__device__ __forceinline__ void phase_prep(const Frame& F0, int l) {
    const Frame F = relaunder(F0);
    unsigned char* ws = F.ws; const bf16* P = (const bf16*)(ws + WS_P);
    const float* mu = INP(6) + l * 1984; const float* vmu = INP(18);
    bf16* AL = (bf16*)(ws + WS_ALORA); bf16* QN = (bf16*)(ws + WS_QN); bf16* QM = (bf16*)(ws + WS_QM); bf16* Y = (bf16*)(ws + WS_Y);
    const float* qkg = INP(21) + l * 4 * 64; const float* mqg = INP(30) + l * 2 * 128;
    const float* cpos = INP(22) + (size_t)l * 2 * 32 * 64; const float* cw = INP(26) + l * 3 * 512;
    const int tid = F.tid, lane = F.lane, wave = F.wave;
    for (int tile = F.bid; tile < M / 32; tile += F.G) {
        const int m0 = tile * 32, b = m0 / T, t0 = m0 % T;
#pragma unroll
        for (int it_ = 0; it_ < 4; ++it_) { const int it = tid + it_ * 512; const int tt = it >> 6, g = it & 63, c = g * 8, m = m0 + tt, t = t0 + tt;
            int pc, kind; const float* mup;
            if (c < 96) { pc = PC_WD + c; kind = 0; mup = mu + pc; } else if (c < 192) { pc = PC_AD + c - 96; kind = 1; mup = mu + pc; }
            else if (c < 448) { pc = PC_GD + c - 192; kind = 2; mup = mu + pc; } else { pc = PC_VRES + c - 448; kind = 3; mup = vmu + (c - 448); }
            float o[8];
            if (kind == 3 && l == 0) {
#pragma unroll
                for (int j = 0; j < 8; ++j) o[j] = 0.f; }
            else { float u[8], pv[8], mm[8]; ld8(P + (size_t)m * LDP + pc, u); ldf8(mup, mm);
                if (t > 0) ld8(P + (size_t)(m - 1) * LDP + pc, pv); else {
#pragma unroll
                    for (int j = 0; j < 8; ++j) pv[j] = 0.f; }
#pragma unroll
                for (int j = 0; j < 8; ++j) { const float x = u[j] + (pv[j] - u[j]) * mm[j]; o[j] = kind == 0 ? tanhf(x) : (kind == 2 ? sigmoidf_(x) : x); } }
            st8(AL + (size_t)m * 512 + c, o); }
        for (int tt = wave; tt < 32; tt += 8) { const int m = m0 + tt;
            { float v[8]; float s = 0.f; const u32x4 raw = *(const u32x4*)(P + (size_t)m * LDP + PC_Q + lane * 8);
              v[0] = bf2f(raw.x & 0xffffu); v[1] = bf2f(raw.x >> 16); v[2] = bf2f(raw.y & 0xffffu); v[3] = bf2f(raw.y >> 16); v[4] = bf2f(raw.z & 0xffffu); v[5] = bf2f(raw.z >> 16); v[6] = bf2f(raw.w & 0xffffu); v[7] = bf2f(raw.w >> 16);
#pragma unroll
              for (int j = 0; j < 8; ++j) s += v[j] * v[j];
              s += __shfl_xor(s, 1); s += __shfl_xor(s, 2); s += __shfl_xor(s, 4);
              const float rs = CQ_NSA / sqrtf(s * (1.f / 64.f) + NORM_EPS); const int d0 = (lane & 7) * 8;
              u32x4 w; w.x = pk2(v[0] * rs * qkg[d0 + 0], v[1] * rs * qkg[d0 + 1]); w.y = pk2(v[2] * rs * qkg[d0 + 2], v[3] * rs * qkg[d0 + 3]); w.z = pk2(v[4] * rs * qkg[d0 + 4], v[5] * rs * qkg[d0 + 5]); w.w = pk2(v[6] * rs * qkg[d0 + 6], v[7] * rs * qkg[d0 + 7]);
              *(u32x4*)(QN + (size_t)m * 512 + lane * 8) = w; }
            { float v[8]; float s = 0.f; const u32x4 raw = *(const u32x4*)(P + (size_t)m * LDP + PC_MEM + lane * 8);
              v[0] = bf2f(raw.x & 0xffffu); v[1] = bf2f(raw.x >> 16); v[2] = bf2f(raw.y & 0xffffu); v[3] = bf2f(raw.y >> 16); v[4] = bf2f(raw.z & 0xffffu); v[5] = bf2f(raw.z >> 16); v[6] = bf2f(raw.w & 0xffffu); v[7] = bf2f(raw.w >> 16);
#pragma unroll
              for (int j = 0; j < 8; ++j) s += v[j] * v[j];
              s += __shfl_xor(s, 1); s += __shfl_xor(s, 2); s += __shfl_xor(s, 4); s += __shfl_xor(s, 8);
              const float rs = CQ_MEM / sqrtf(s * (1.f / 128.f) + NORM_EPS); const int d0 = (lane & 15) * 8;
              u32x4 w; w.x = pk2(v[0] * rs * mqg[d0 + 0], v[1] * rs * mqg[d0 + 1]); w.y = pk2(v[2] * rs * mqg[d0 + 2], v[3] * rs * mqg[d0 + 3]); w.z = pk2(v[4] * rs * mqg[d0 + 4], v[5] * rs * mqg[d0 + 5]); w.w = pk2(v[6] * rs * mqg[d0 + 6], v[7] * rs * mqg[d0 + 7]);
              *(u32x4*)(QM + (size_t)m * 512 + lane * 8) = w; }
            for (int which = 0; which < 2; ++which) { const int pc = which ? PC_KW : PC_KS; const float* gn = qkg + (which ? 3 : 2) * 64;
                const unsigned raw = *(const unsigned*)(P + (size_t)m * LDP + pc + lane * 2); const float a = bf2f(raw & 0xffffu), c2 = bf2f(raw >> 16);
                float s = a * a + c2 * c2; s += __shfl_xor(s, 1); s += __shfl_xor(s, 2); s += __shfl_xor(s, 4); s += __shfl_xor(s, 8); s += __shfl_xor(s, 16);
                const float rs = 1.0f / sqrtf(s * (1.f / 64.f) + NORM_EPS); const int kvh = lane >> 5, d = (lane & 31) * 2;
                bf16* dst = (bf16*)(ws + (which ? WS_KW : WS_KS)) + ((size_t)(b * 2 + kvh) * T + (t0 + tt)) * 64 + d;
                *(unsigned*)dst = pk2(a * rs * gn[d], c2 * rs * gn[d + 1]); }
        }
        if ((tile & 1) == 0) { const int col = tid & 127, tq = tid >> 7, kvh = col >> 6, d = col & 63;
          for (int which = 0; which < 2; ++which) { const int pc = which ? PC_VW : PC_VS;
            for (int q2 = 0; q2 < 2; ++q2) { const int tg = tq + 4 * q2; unsigned short v[8];
#pragma unroll
              for (int i = 0; i < 8; ++i) v[i] = P[(size_t)(m0 + tg * 8 + i) * LDP + pc + col];
              u32x4 w; w.x = v[0] | ((unsigned)v[1] << 16); w.y = v[2] | ((unsigned)v[3] << 16); w.z = v[4] | ((unsigned)v[5] << 16); w.w = v[6] | ((unsigned)v[7] << 16);
              *(u32x4*)((bf16*)(ws + (which ? WS_VWT : WS_VST)) + ((size_t)(b * 2 + kvh) * 64 + d) * T + t0 + tg * 8) = w; } } }
#pragma unroll
        for (int it_ = 0; it_ < 2; ++it_) { const int it = tid + it_ * 512; const int tt = it >> 5, r = (it & 31) * 8, i = r >> 7, h = (r >> 6) & 1, d = r & 63, t = t0 + tt, m = m0 + tt;
            float v[8], p1[8], o[8]; ld8(P + (size_t)m * LDP + PC_KC + r, v);
            bf16* A = (bf16*)(ws + WS_ACMP) + (size_t)i * 1024 * 2048;
            const int c1 = t >> 4, l1 = t & 15;
            if (c1 <= 254) { ldf8(cpos + (i * 32 + l1) * 64 + d, p1);
#pragma unroll
                for (int j = 0; j < 8; ++j) o[j] = v[j] + p1[j];
                st8(A + ((size_t)(b * 256 + c1) * 2 + h) * 2048 + l1 * 64 + d, o); }
            if (c1 >= 1) { ldf8(cpos + (i * 32 + l1 + 16) * 64 + d, p1);
#pragma unroll
                for (int j = 0; j < 8; ++j) o[j] = v[j] + p1[j];
                st8(A + ((size_t)(b * 256 + c1 - 1) * 2 + h) * 2048 + (l1 + 16) * 64 + d, o); } }
#pragma unroll
        for (int it_ = 0; it_ < 4; ++it_) { const int it = tid + it_ * 512; const int tt = it >> 6, c = (it & 63) * 8, m = m0 + tt, t = t0 + tt;
            float acc[8], bg[8];
#pragma unroll
            for (int j = 0; j < 8; ++j) acc[j] = 0.f;
#pragma unroll
            for (int k = 0; k < 3; ++k) { const int dt = 2 - k; if (t - dt >= 0) { float cg[8], xg[8], wv[8]; const size_t o = (size_t)(m - dt) * LDP; ld8(P + o + PC_CC + c, cg); ld8(P + o + PC_CX + c, xg); ldf8(cw + k * 512 + c, wv);
#pragma unroll
                    for (int j = 0; j < 8; ++j) acc[j] += wv[j] * cg[j] * xg[j]; } }
            ld8(P + (size_t)m * LDP + PC_CB + c, bg);
#pragma unroll
            for (int j = 0; j < 8; ++j) acc[j] *= bg[j];
            st8(Y + (size_t)m * 2560 + 1024 + c, acc); }
        { const int cgp = tid & 63, tg = tid >> 6, c = cgp * 8, w = 2 << (cgp >> 4); const int ts = t0 + tg * 4, ms = m0 + tg * 4;
          float sum[8];
#pragma unroll
          for (int j = 0; j < 8; ++j) sum[j] = 0.f;
#pragma unroll
          for (int k = 1; k < 16; ++k) if (k < w && ts - k >= 0) { float u[8]; ld8(P + (size_t)(ms - k) * LDP + PC_POOL + c, u);
#pragma unroll
              for (int j = 0; j < 8; ++j) sum[j] += u[j]; }
          for (int q = 0; q < 4; ++q) { const int t = ts + q, m = ms + q; float u[8], o[8]; ld8(P + (size_t)m * LDP + PC_POOL + c, u);
#pragma unroll
              for (int j = 0; j < 8; ++j) sum[j] += u[j];
              const int cnt = (t + 1) < w ? (t + 1) : w; const float ic = 1.f / (float)cnt;
#pragma unroll
              for (int j = 0; j < 8; ++j) o[j] = sum[j] * ic - u[j];
              st8(Y + (size_t)m * 2560 + 2048 + c, o);
              if (t - w + 1 >= 0) { float ud[8]; ld8(P + (size_t)(m - w + 1) * LDP + PC_POOL + c, ud);
#pragma unroll
                  for (int j = 0; j < 8; ++j) sum[j] -= ud[j]; } } }
    }
    { const float* KV = (const float*)(ws + WS_KVRAW) + l * 1024; bf16* KM = (bf16*)(ws + WS_KMEM); bf16* VM = (bf16*)(ws + WS_VMEMT); const float* kg = mqg + 128;
      for (int r = F.bid * 8 + wave; r < 512; r += F.G * 8) { const int b = r >> 8, j = r & 255;
          for (int h = 0; h < 4; ++h) { const float a = KV[(size_t)r * 2048 + h * 128 + lane], c2 = KV[(size_t)r * 2048 + h * 128 + 64 + lane];
              const float s = wave_sum(a * a + c2 * c2); const float rs = 1.0f / sqrtf(s * (1.f / 128.f) + NORM_EPS);
              bf16* dst = KM + ((size_t)(b * 4 + h) * 256 + j) * 128; dst[lane] = (bf16)f2bf(a * rs * kg[lane]); dst[64 + lane] = (bf16)f2bf(c2 * rs * kg[64 + lane]); } }
      for (int it = F.bid * 8 + wave; it < 1024; it += F.G * 8) { const int b = it >> 9, h = (it >> 7) & 3, d = it & 127;
#pragma unroll
          for (int k = 0; k < 4; ++k) { const int j = lane + 64 * k; VM[((size_t)(b * 4 + h) * 128 + d) * 256 + j] = (bf16)f2bf(KV[(size_t)(b * 256 + j) * 2048 + 512 + h * 128 + d]); } } }
}

template <int DH> struct AttL { static constexpr int KB = 64 * (DH + 8) * 2, VB = DH * 72 * 2, BUF = KB + VB, PW = 2 * BUF, END = PW + 8 * 16 * 72 * 2; };
constexpr int AT_PT = AttL<64>::END, AT_IMP = AT_PT + 32768, AT_SEL = AT_IMP + 8192, AT_UNI = AT_SEL + 256;
static_assert(AttL<128>::END <= RING_BYTES && AT_UNI + 64 <= RING_BYTES, "attention LDS map");
template <int DH, int MODE>
__device__ __forceinline__ void attn_pass(LAS unsigned char* lds, int tid, int lane, int wave, const bf16* Kg, const bf16* VTg, int ldvt, int jlo, int jhi,
                                          const bf16x8 (&qf)[DH / 32], f32x4 (&O)[DH / 16], float (&lsum)[4], int trow, unsigned sel0, unsigned sel1, unsigned uni0, unsigned uni1) {
    typedef AttL<DH> L;
    constexpr int KS = DH + 8;
    LAS bf16* PW = (LAS bf16*)(lds + L::PW) + wave * 16 * 72;
    const unsigned long long um = MODE == 2 ? (((unsigned long long)uni1 << 32) | uni0) : ~0ull;
    auto next_tile = [&](int from) -> int {
        if (from > jhi) return jhi + 1;
        if (MODE != 2) return from;
        const unsigned long long m = um >> from; if (m == 0ull) return jhi + 1;
        const int nx = from + __builtin_ctzll(m); return nx > jhi ? jhi + 1 : nx; };
    u32x4 kreg[DH / 64], vreg[DH / 64];
#define AT_LOADREGS(jt) do { _Pragma("unroll") for (int i = 0; i < DH / 64; ++i) { const int e = tid + i * 512; const int kr = e / (DH / 8), kc = (e % (DH / 8)) * 8; const int vr = e >> 3, vc = (e & 7) * 8; \
        kreg[i] = *(const u32x4*)(Kg + (size_t)(64 * (jt) + kr) * DH + kc); vreg[i] = *(const u32x4*)(VTg + (size_t)vr * ldvt + 64 * (jt) + vc); } } while (0)
#define AT_WRITELDS(bf) do { LAS bf16* KTw = (LAS bf16*)(lds + (bf) * L::BUF); LAS bf16* VTw = (LAS bf16*)(lds + (bf) * L::BUF + L::KB); \
        _Pragma("unroll") for (int i = 0; i < DH / 64; ++i) { const int e = tid + i * 512; const int kr = e / (DH / 8), kc = (e % (DH / 8)) * 8; const int vr = e >> 3, vc = (e & 7) * 8; \
        const int krp = 16 * (2 * (kr >> 5) + (kr & 1)) + ((kr >> 1) & 15); \
        *(LAS u32x4*)(KTw + krp * KS + kc) = kreg[i]; *(LAS u32x4*)(VTw + vr * 72 + vc) = vreg[i]; } } while (0)
    int jc = next_tile(jlo);
    if (jc > jhi) return;
    AT_LOADREGS(jc);
    __syncthreads();
    AT_WRITELDS(0);
    int jn = next_tile(jc + 1);
    if (jn <= jhi) AT_LOADREGS(jn);
    LDS_WAIT(); __syncthreads();
    int cur = 0;
    for (;;) {
        int jnn = jhi + 1;
        if (jn <= jhi) { AT_WRITELDS(cur ^ 1); jnn = next_tile(jn + 1); if (jnn <= jhi) AT_LOADREGS(jnn); }
        const int j = jc;
        const LAS bf16* KT = (const LAS bf16*)(lds + cur * L::BUF); const LAS bf16* VT = (const LAS bf16*)(lds + cur * L::BUF + L::KB);
        bool doit = true;
        if (MODE == 2) { const unsigned sb = j < 32 ? (sel0 >> j) : (sel1 >> (j - 32)); doit = __builtin_amdgcn_ballot_w64((sb & 1u) != 0u) != 0ull; }
        if (doit) {
        f32x4 S[4];
        { bf16x8 kfr[4][DH / 32];
#pragma unroll
          for (int n = 0; n < 4; ++n)
#pragma unroll
              for (int ks = 0; ks < DH / 32; ++ks) kfr[n][ks] = *(const LAS bf16x8*)(KT + (16 * n + (lane & 15)) * KS + ks * 32 + 8 * (lane >> 4));
          LDS_WAIT(); __builtin_amdgcn_sched_barrier(0);
#pragma unroll
          for (int n = 0; n < 4; ++n) { S[n] = (f32x4){0.f, 0.f, 0.f, 0.f};
#pragma unroll
              for (int ks = 0; ks < DH / 32; ++ks) S[n] = __builtin_amdgcn_mfma_f32_16x16x32_bf16(qf[ks], kfr[n][ks], S[n], 0, 0, 0); }
          __builtin_amdgcn_sched_barrier(0); }
        bool valid[4];
#pragma unroll
        for (int n = 0; n < 4; ++n) { const int key = 64 * j + 32 * (n >> 1) + 2 * (lane & 15) + (n & 1);
            if (MODE == 0) valid[n] = true;
            else if (MODE == 1) valid[n] = (key <= 254) && (16 * key + 31 <= trow);
            else if (MODE == 2) { const unsigned sb = j < 32 ? (sel0 >> j) : (sel1 >> (j - 32)); valid[n] = (sb & 1u) && key <= trow; }
            else valid[n] = key <= trow && key > trow - 512; }
#pragma unroll
        for (int a2 = 0; a2 < 2; ++a2)
#pragma unroll
            for (int r = 0; r < 4; ++r) { float p0 = __builtin_amdgcn_exp2f(S[2 * a2][r]), p1 = __builtin_amdgcn_exp2f(S[2 * a2 + 1][r]);
                if (MODE != 0) { p0 = valid[2 * a2] ? p0 : 0.f; p1 = valid[2 * a2 + 1] ? p1 : 0.f; }
                lsum[r] += p0 + p1;
                *(LAS unsigned*)(PW + (4 * (lane >> 4) + r) * 72 + 32 * a2 + 2 * (lane & 15)) = pk2(p0, p1); }
        LDS_WAIT(); asm volatile("" ::: "memory");
        { bf16x8 pfr[2], vfr[2][DH / 16];
#pragma unroll
          for (int ks = 0; ks < 2; ++ks) { pfr[ks] = *(const LAS bf16x8*)(PW + (lane & 15) * 72 + ks * 32 + 8 * (lane >> 4));
#pragma unroll
              for (int nd = 0; nd < DH / 16; ++nd) vfr[ks][nd] = *(const LAS bf16x8*)(VT + (16 * nd + (lane & 15)) * 72 + ks * 32 + 8 * (lane >> 4)); }
          LDS_WAIT(); __builtin_amdgcn_sched_barrier(0);
#pragma unroll
          for (int ks = 0; ks < 2; ++ks)
#pragma unroll
              for (int nd = 0; nd < DH / 16; ++nd) O[nd] = __builtin_amdgcn_mfma_f32_16x16x32_bf16(pfr[ks], vfr[ks][nd], O[nd], 0, 0, 0);
          __builtin_amdgcn_sched_barrier(0); }
        }
        if (jn > jhi) break;
        LDS_WAIT(); __syncthreads();
        cur ^= 1; jc = jn; jn = jnn;
    }
#undef AT_LOADREGS
#undef AT_WRITELDS
}

__device__ __forceinline__ void phase_memattn(const Frame& F0) {
    const Frame F = relaunder(F0);
    unsigned char* ws = F.ws; const bf16* QM = (const bf16*)(ws + WS_QM); const bf16* KM = (const bf16*)(ws + WS_KMEM); const bf16* VM = (const bf16*)(ws + WS_VMEMT); bf16* Y = (bf16*)(ws + WS_Y);
    const int lane = F.lane, wave = F.wave; const float c = 0.08838834764831845f * 1.4426950408889634f;
    for (int u = F.bid; u < 256; u += F.G) { const int b = u >> 7, h = (u >> 5) & 3, tile = u & 31; const int m0 = b * T + tile * 128 + wave * 16;
        bf16x8 qf[4];
#pragma unroll
        for (int ks = 0; ks < 4; ++ks) qf[ks] = *(const bf16x8*)(QM + (size_t)(m0 + (lane & 15)) * 512 + h * 128 + ks * 32 + 8 * (lane >> 4));
        f32x4 O[8]; float ls[4];
#pragma unroll
        for (int i = 0; i < 8; ++i) O[i] = (f32x4){0.f, 0.f, 0.f, 0.f};
#pragma unroll
        for (int r = 0; r < 4; ++r) ls[r] = 0.f;
        attn_pass<128, 0>(F.lds, F.tid, lane, wave, KM + (size_t)(b * 4 + h) * 256 * 128, VM + (size_t)(b * 4 + h) * 128 * 256, 256, 0, 3, qf, O, ls, 0, 0u, 0u, 0u, 0u);
#pragma unroll
        for (int r = 0; r < 4; ++r) { const float lr = red16_sum(ls[r]); const float inv = lr > 0.f ? 1.f / lr : 0.f; const int m = m0 + 4 * (lane >> 4) + r;
#pragma unroll
            for (int nd = 0; nd < 8; ++nd) Y[(size_t)m * 2560 + 1536 + h * 128 + 16 * nd + (lane & 15)] = (bf16)f2bf(O[nd][r] * inv); }
        __syncthreads();
    }
}

__device__ __forceinline__ void phase_nsa(const Frame& F0, unsigned* qctr) {
    const Frame F = relaunder(F0);
    unsigned char* ws = F.ws; const bf16* P = (const bf16*)(ws + WS_P); const bf16* QN = (const bf16*)(ws + WS_QN); bf16* Y = (bf16*)(ws + WS_Y);
    const int lane = F.lane, wave = F.wave, tid = F.tid; const float c = 0.125f * 1.4426950408889634f;
    LAS float* PT = (LAS float*)(F.lds + AT_PT); LAS float* IMP = (LAS float*)(F.lds + AT_IMP); LAS unsigned* SEL = (LAS unsigned*)(F.lds + AT_SEL); LAS unsigned* UNI = (LAS unsigned*)(F.lds + AT_UNI);
    LAS int* UQ = (LAS int*)(F.lds + AT_UNI + 16);
    int nxtq = 0; if (tid == 0) nxtq = (int)atomicAdd(qctr, 1u);
    for (;;) {
        __syncthreads();
        if (tid == 0) UQ[0] = nxtq;
        LDS_WAIT(); __syncthreads();
        const int uq = UQ[0]; if (uq >= 512) break;
        if (tid == 0) nxtq = (int)atomicAdd(qctr, 1u);
        const int tile = 127 - (uq >> 2), b = (uq >> 1) & 1, kvh = uq & 1;
        const int t0 = tile * 32, m0 = b * T + t0; const int cur = t0 >> 6;
        const int tl = wave * 4 + (lane >> 4);
        const int trow = t0 + tl;
        bf16x8 qf[2];
        { const int rho = lane & 15; const int mq = m0 + wave * 4 + (rho >> 2), g = rho & 3;
#pragma unroll
          for (int ks = 0; ks < 2; ++ks) qf[ks] = *(const bf16x8*)(QN + (size_t)mq * 512 + (kvh * 4 + g) * 64 + ks * 32 + 8 * (lane >> 4)); }
        const bf16* KCg = (const bf16*)(ws + WS_KC) + (size_t)(b * 2 + kvh) * 256 * 64; const bf16* VCg = (const bf16*)(ws + WS_VCT) + (size_t)(b * 2 + kvh) * 64 * 256;
        const bf16* KSg = (const bf16*)(ws + WS_KS) + (size_t)(b * 2 + kvh) * T * 64; const bf16* VSg = (const bf16*)(ws + WS_VST) + (size_t)(b * 2 + kvh) * 64 * T;
        const bf16* KWg = (const bf16*)(ws + WS_KW) + (size_t)(b * 2 + kvh) * T * 64; const bf16* VWg = (const bf16*)(ws + WS_VWT) + (size_t)(b * 2 + kvh) * 64 * T;
        f32x4 OF[4];
#pragma unroll
        for (int i = 0; i < 4; ++i) OF[i] = (f32x4){0.f, 0.f, 0.f, 0.f};
        float gate[3][4];
#pragma unroll
        for (int r = 0; r < 4; ++r)
#pragma unroll
            for (int k = 0; k < 3; ++k) gate[k][r] = sigmoidf_(ldbf(P + (size_t)(m0 + tl) * LDP + PC_GL + (kvh * 4 + r) * 3 + k));
        f32x4 O[4]; float lr[4];
#pragma unroll
        for (int i = 0; i < 4; ++i) O[i] = (f32x4){0.f, 0.f, 0.f, 0.f};
#pragma unroll
        for (int r = 0; r < 4; ++r) lr[r] = 0.f;
        attn_pass<64, 1>(F.lds, tid, lane, wave, KCg, VCg, 256, 0, 3, qf, O, lr, trow, 0u, 0u, 0u, 0u);
#pragma unroll
        for (int r = 0; r < 4; ++r) lr[r] = red16_sum(lr[r]);
#pragma unroll
        for (int r = 0; r < 4; ++r) { const float inv = lr[r] > 0.f ? 1.f / lr[r] : 0.f;
#pragma unroll
            for (int nd = 0; nd < 4; ++nd) OF[nd][r] += gate[0][r] * O[nd][r] * inv; }
        { LAS bf16* KT = (LAS bf16*)(F.lds);
          for (int j = 0; j < 4; ++j) {
              __syncthreads();
              { const int kr = tid >> 3, kc = (tid & 7) * 8; *(LAS u32x4*)(KT + kr * 72 + kc) = *(const u32x4*)(KCg + (size_t)(64 * j + kr) * 64 + kc); }
              LDS_WAIT(); __syncthreads();
              bf16x8 kfr[4][2]; f32x4 S4[4];
#pragma unroll
              for (int n = 0; n < 4; ++n)
#pragma unroll
                  for (int ks = 0; ks < 2; ++ks) kfr[n][ks] = *(const LAS bf16x8*)(KT + (16 * n + (lane & 15)) * 72 + ks * 32 + 8 * (lane >> 4));
              LDS_WAIT(); __builtin_amdgcn_sched_barrier(0);
#pragma unroll
              for (int n = 0; n < 4; ++n) { S4[n] = (f32x4){0.f, 0.f, 0.f, 0.f};
#pragma unroll
                  for (int ks = 0; ks < 2; ++ks) S4[n] = __builtin_amdgcn_mfma_f32_16x16x32_bf16(qf[ks], kfr[n][ks], S4[n], 0, 0, 0); }
              __builtin_amdgcn_sched_barrier(0);
#pragma unroll
              for (int n = 0; n < 4; ++n) { const f32x4 S = S4[n];
                  const int key = 64 * j + 16 * n + (lane & 15); const bool valid = (key <= 254) && (16 * key + 31 <= trow); float ps = 0.f;
#pragma unroll
                  for (int r = 0; r < 4; ++r) { const float inv = lr[r] > 0.f ? 1.f / lr[r] : 0.f; ps += valid ? __builtin_amdgcn_exp2f(S[r]) * inv : 0.f; }
                  PT[tl * 256 + key] = ps; } }
          if (tid < 64) SEL[tid] = 0u; if (tid < 2) UNI[tid] = 0u;
          LDS_WAIT(); __syncthreads(); }
        { const int tk = tid >> 4, sg = (tid & 15) * 4;
#pragma unroll
          for (int i = 0; i < 4; ++i) { const int s = sg + i; const LAS float* p = PT + tk * 256 + 4 * s; float v = p[0] + p[1] + p[2] + 0.5f * p[3]; if (s > 0) v += 0.5f * p[-1];
              const bool forced = (s == 0) || (s == cur) || (s == cur - 1); IMP[tk * 64 + s] = forced ? 1e9f : (s <= cur ? v : -1e9f); }
          LDS_WAIT(); __syncthreads();
          float mine[4]; int cnt[4];
#pragma unroll
          for (int i = 0; i < 4; ++i) { mine[i] = IMP[tk * 64 + sg + i]; cnt[i] = 0; }
          for (int s2 = 0; s2 < 64; ++s2) { const float o = IMP[tk * 64 + s2];
#pragma unroll
              for (int i = 0; i < 4; ++i) cnt[i] += (o > mine[i] || (o == mine[i] && s2 < sg + i)) ? 1 : 0; }
          unsigned bits = 0u;
#pragma unroll
          for (int i = 0; i < 4; ++i) if (cnt[i] < 16 && mine[i] > -1e8f) bits |= 1u << ((sg + i) & 31);
          if (bits) { atomicOr((unsigned*)(SEL + tk * 2 + (sg >> 5)), bits); atomicOr((unsigned*)(UNI + (sg >> 5)), bits); }
          LDS_WAIT(); __syncthreads(); }
        const unsigned sel0 = SEL[tl * 2], sel1 = SEL[tl * 2 + 1], uni0 = UNI[0], uni1 = UNI[1];
#pragma unroll
        for (int i = 0; i < 4; ++i) O[i] = (f32x4){0.f, 0.f, 0.f, 0.f};
#pragma unroll
        for (int r = 0; r < 4; ++r) lr[r] = 0.f;
        attn_pass<64, 2>(F.lds, tid, lane, wave, KSg, VSg, T, 0, cur, qf, O, lr, trow, sel0, sel1, uni0, uni1);
#pragma unroll
        for (int r = 0; r < 4; ++r) lr[r] = red16_sum(lr[r]);
#pragma unroll
        for (int r = 0; r < 4; ++r) { const float inv = lr[r] > 0.f ? 1.f / lr[r] : 0.f;
#pragma unroll
            for (int nd = 0; nd < 4; ++nd) OF[nd][r] += gate[1][r] * O[nd][r] * inv; }
#pragma unroll
        for (int i = 0; i < 4; ++i) O[i] = (f32x4){0.f, 0.f, 0.f, 0.f};
#pragma unroll
        for (int r = 0; r < 4; ++r) lr[r] = 0.f;
        { const int lo = t0 - 511; attn_pass<64, 3>(F.lds, tid, lane, wave, KWg, VWg, T, lo > 0 ? (lo >> 6) : 0, cur, qf, O, lr, trow, 0u, 0u, 0u, 0u); }
#pragma unroll
        for (int r = 0; r < 4; ++r) lr[r] = red16_sum(lr[r]);
#pragma unroll
        for (int r = 0; r < 4; ++r) { const float inv = lr[r] > 0.f ? 1.f / lr[r] : 0.f;
#pragma unroll
            for (int nd = 0; nd < 4; ++nd) OF[nd][r] += gate[2][r] * O[nd][r] * inv; }
#pragma unroll
        for (int r = 0; r < 4; ++r)
#pragma unroll
            for (int nd = 0; nd < 4; ++nd) Y[(size_t)(m0 + tl) * 2560 + 512 + (kvh * 4 + r) * 64 + 16 * nd + (lane & 15)] = (bf16)f2bf(OF[nd][r]);
        __syncthreads();
    }
}

constexpr int CL = 32, NCH = T / CL;
constexpr int SC_STEPS = 8;
__device__ __forceinline__ void phase_scan(const Frame& F0, int l) {
    const Frame F = relaunder(F0);
    unsigned char* ws = F.ws; const bf16* P = (const bf16*)(ws + WS_P); const float* LO = (const float*)(ws + WS_LO);
    float* VF = (float*)(ws + WS_VFIRST); float* VC = (float*)(ws + WS_VCUR); float* BON = (float*)(ws + WS_BON);
    float* YL = (float*)(ws + WS_YL); float* ZL = (float*)(ws + WS_ZL); float* QF = (float*)(ws + WS_QF); float* PF = (float*)(ws + WS_PF);
    const float* mu = INP(6) + l * 1984; const float* kk_ = INP(12) + l * 512; const float* ka_ = INP(13) + l * 512; const float* rk_ = INP(14) + l * 512;
    const int wave = F.wave;
    LAS float* ST = (LAS float*)F.lds + wave * (SC_STEPS * 5 * 64 + 64);
    for (int u = F.bid; u < 256; u += F.G) {
        int lane = F.lane; asm volatile("" : "+v"(lane));
        const int b = u >> 7, h = (u >> 4) & 7, cq = u & 15;
        const int jc = h * 64 + lane;
        const float mu_r = mu[PC_R + jc], mu_k = mu[PC_K + jc], mu_v = mu[PC_V + jc], kkw = kk_[jc], kaw = ka_[jc], rkw = rk_[jc];
        const int chunk = cq * 8 + wave;
        f32x2 Sq[32], Sp[32];
#pragma unroll
        for (int k = 0; k < 32; ++k) { Sq[k] = (f32x2){0.f, 0.f}; Sp[k] = (f32x2){(2 * k == lane) ? 1.f : 0.f, (2 * k + 1 == lane) ? 1.f : 0.f}; }
        const int tbase = chunk * CL;
        float gam = 1.f;
        for (int sb = 0; sb < CL / SC_STEPS; ++sb) {
            LDS_WAIT(); asm volatile("" ::: "memory");
#pragma unroll 1
            for (int hb = 0; hb < 2; ++hb) { const int st0 = hb * 4; const int tf = tbase + sb * SC_STEPS + st0, mf = b * T + tf;
              float ur[5], uk[5], uv[5], wv[4], av[4], vgv[4], vfv[4];
#pragma unroll
              for (int i = 0; i < 5; ++i) { const bool ok = (tf - 1 + i) >= 0; const bf16* pr = P + (size_t)(ok ? (mf - 1 + i) : mf) * LDP + h * 64;
                  const float sc = ok ? 1.f : 0.f;
                  ur[i] = ldbf(pr + PC_R + lane) * sc; uk[i] = ldbf(pr + PC_K + lane) * sc; uv[i] = ldbf(pr + PC_V + lane) * sc; }
#pragma unroll
              for (int i = 0; i < 4; ++i) { const float* lr = LO + (size_t)(mf + i) * 2048 + h * 64; wv[i] = lr[lane]; av[i] = lr[512 + lane];
                  vgv[i] = l ? lr[1536 + lane] : 0.f; vfv[i] = l ? (VF + (size_t)(mf + i) * 512 + h * 64)[lane] : 0.f; }
              float rr[4], kv[4], vv4[4], kmod4[4], red[8];
#pragma unroll
              for (int i = 0; i < 4; ++i) { const int m = mf + i;
                  const float r = ur[i + 1] + (ur[i] - ur[i + 1]) * mu_r, k = uk[i + 1] + (uk[i] - uk[i + 1]) * mu_k; float v = uv[i + 1] + (uv[i] - uv[i + 1]) * mu_v;
                  if (l == 0) (VF + (size_t)m * 512 + h * 64)[lane] = v; else v = v + (vfv[i] - v) * vgv[i];
                  (VC + (size_t)m * 512 + h * 64)[lane] = v;
                  const float kkv = k * kkw; const float kmod = k * (1.f + (av[i] - 1.f) * kaw);
                  rr[i] = r; kv[i] = kkv; vv4[i] = v; kmod4[i] = kmod; red[2 * i] = kkv * kkv; red[2 * i + 1] = r * kmod * rkw; }
#pragma unroll
              for (int o = 1; o < 64; o <<= 1) { float t8[8];
#pragma unroll
                  for (int j = 0; j < 8; ++j) t8[j] = __shfl_xor(red[j], o);
#pragma unroll
                  for (int j = 0; j < 8; ++j) red[j] += t8[j]; }
#pragma unroll
              for (int i = 0; i < 4; ++i) { const int m = mf + i; const float w = wv[i], a = av[i];
                  const float kkn = kv[i] * (1.0f / sqrtf(fmaxf(red[2 * i], 1e-24f)));
                  if (lane == 0) __hip_atomic_store((unsigned*)BON + (size_t)m * 8 + h, __builtin_bit_cast(unsigned, red[2 * i + 1]), RLX_AGENT);
                  const float gprev = gam; gam *= w; const float ig = 1.0f / gam;
                  LAS float* dst = ST + ((st0 + i) * 5) * 64 + lane;
                  dst[0] = kkn * gprev; dst[64] = kkn * a * ig; dst[128] = kmod4[i] * ig; dst[192] = rr[i] * gam; dst[256] = vv4[i]; } }
            LDS_WAIT(); asm volatile("" ::: "memory");
            for (int st = 0; st < SC_STEPS; ++st) { const LAS float* sp = ST + (st * 5) * 64; const int t = tbase + sb * SC_STEPS + st;
                const float vv = sp[256 + lane]; const f32x2 vv2 = (f32x2){vv, vv};
                f32x2 qa = (f32x2){0.f, 0.f}, qb = qa, pa = qa, pb = qa;
                { f32x4 buf[2][2];
#pragma unroll
                  for (int i = 0; i < 2; ++i) buf[0][i] = *(const LAS f32x4*)(sp + 4 * i);
#pragma unroll
                  for (int g = 0; g < 8; ++g) {
                      if (g < 7) {
#pragma unroll
                          for (int i = 0; i < 2; ++i) buf[(g + 1) & 1][i] = *(const LAS f32x4*)(sp + 8 * (g + 1) + 4 * i); }
                      asm volatile("" ::: "memory");
#pragma unroll
                      for (int i = 0; i < 2; ++i) { const int k2 = 4 * g + 2 * i; const f32x4 kk4 = buf[g & 1][i]; const f32x2 klo = (f32x2){kk4[0], kk4[1]}, khi = (f32x2){kk4[2], kk4[3]};
                          qa += Sq[k2] * klo; qb += Sq[k2 + 1] * khi; pa += Sp[k2] * klo; pb += Sp[k2 + 1] * khi; } } }
                const f32x2 qs = qa + qb, ps = pa + pb; const float nq = -(qs.x + qs.y), np = -(ps.x + ps.y); const f32x2 nq2 = (f32x2){nq, nq}, np2 = (f32x2){np, np};
                f32x2 ya = (f32x2){0.f, 0.f}, yb = ya, za = ya, zb = ya;
                { f32x4 bb[2], bk[2], br[2];
                  bb[0] = *(const LAS f32x4*)(sp + 64); bk[0] = *(const LAS f32x4*)(sp + 128); br[0] = *(const LAS f32x4*)(sp + 192);
#pragma unroll
                  for (int g = 0; g < 16; ++g) {
                      if (g < 15) { bb[(g + 1) & 1] = *(const LAS f32x4*)(sp + 64 + 4 * (g + 1)); bk[(g + 1) & 1] = *(const LAS f32x4*)(sp + 128 + 4 * (g + 1)); br[(g + 1) & 1] = *(const LAS f32x4*)(sp + 192 + 4 * (g + 1)); }
                      asm volatile("" ::: "memory");
                      { const int k2 = 2 * g; const f32x4 b4 = bb[g & 1], k4 = bk[g & 1], r4 = br[g & 1];
                        const f32x2 blo = (f32x2){b4[0], b4[1]}, bhi = (f32x2){b4[2], b4[3]}, klo = (f32x2){k4[0], k4[1]}, khi = (f32x2){k4[2], k4[3]}, rlo = (f32x2){r4[0], r4[1]}, rhi = (f32x2){r4[2], r4[3]};
                        Sq[k2] += vv2 * klo + nq2 * blo; Sq[k2 + 1] += vv2 * khi + nq2 * bhi; Sp[k2] += np2 * blo; Sp[k2 + 1] += np2 * bhi;
                        ya += Sq[k2] * rlo; yb += Sq[k2 + 1] * rhi; za += Sp[k2] * rlo; zb += Sp[k2 + 1] * rhi; } } }
                const f32x2 ys = ya + yb, zs = za + zb;
                const size_t o = (size_t)(b * T + t) * 512 + h * 64 + lane;
                YL[o] = ys.x + ys.y; ZL[o] = zs.x + zs.y; }
        }
        { LAS float* GL = ST + SC_STEPS * 5 * 64; LDS_WAIT(); asm volatile("" ::: "memory"); GL[lane] = gam; LDS_WAIT(); asm volatile("" ::: "memory");
#pragma unroll
          for (int k = 0; k < 32; k += 2) { const f32x4 g4 = *(const LAS f32x4*)(GL + 2 * k); const f32x2 glo = (f32x2){g4[0], g4[1]}, ghi = (f32x2){g4[2], g4[3]};
              Sq[k] *= glo; Sq[k + 1] *= ghi; Sp[k] *= glo; Sp[k + 1] *= ghi; } }
        { const size_t un = ((size_t)(b * 8 + h) * NCH + chunk) * 4096;
#pragma unroll
          for (int k = 0; k < 32; k += 4) { u32x4 w; w.x = pk2(Sq[k].x, Sq[k].y); w.y = pk2(Sq[k + 1].x, Sq[k + 1].y); w.z = pk2(Sq[k + 2].x, Sq[k + 2].y); w.w = pk2(Sq[k + 3].x, Sq[k + 3].y);
              *(u32x4*)((bf16*)QF + un + lane * 64 + 2 * k) = w; }
          { unsigned short* pf = (unsigned short*)PF + un + ((lane >> 2) & 3) * 16 + (lane >> 4) * 4 + (lane & 3);
#pragma unroll
            for (int k = 0; k < 32; ++k) { const unsigned w = pk2(Sp[k].x, Sp[k].y); pf[(2 * k) * 64] = (unsigned short)w; pf[(2 * k + 1) * 64] = (unsigned short)(w >> 16); } } }
    }
}
constexpr int CPF = 8;
__device__ __forceinline__ void phase_carry(const Frame& F0, unsigned* flags) {
    const Frame F = relaunder(F0);
    unsigned char* ws = F.ws; const unsigned char* QFb = ws + WS_QF; const unsigned char* PFb = ws + WS_PF; float* SI = (float*)(ws + WS_SINIT);
    const int lane = F.lane, wave = F.wave;
    LAS unsigned char* ring = F.lds;
    for (int chain = F.bid; chain < 16; chain += F.G) {
        const size_t cb = (size_t)chain * NCH * 8192;
        if (wave >= 4) {
            const int pt = (wave - 4) * 64 + lane;
            u32x4 rt[CPF][2], rq[CPF][2];
#pragma unroll
            for (int d = 0; d < CPF; ++d) { const size_t o = cb + (size_t)d * 8192 + pt * 16;
                rt[d][0] = *(const u32x4*)(PFb + o); rt[d][1] = *(const u32x4*)(PFb + o + 4096); rq[d][0] = *(const u32x4*)(QFb + o); rq[d][1] = *(const u32x4*)(QFb + o + 4096); }
            asm volatile("s_waitcnt vmcnt(%0)" :: "n"(4 * (CPF - 1)) : "memory");
            { LAS unsigned char* sl = ring + pt * 16; *(LAS u32x4*)(sl) = rt[0][0]; *(LAS u32x4*)(sl + 4096) = rt[0][1]; *(LAS u32x4*)(sl + 8192) = rq[0][0]; *(LAS u32x4*)(sl + 12288) = rq[0][1]; }
            { const size_t o = cb + (size_t)CPF * 8192 + pt * 16;
              rt[0][0] = *(const u32x4*)(PFb + o); rt[0][1] = *(const u32x4*)(PFb + o + 4096); rq[0][0] = *(const u32x4*)(QFb + o); rq[0][1] = *(const u32x4*)(QFb + o + 4096); }
            LDS_WAIT(); __syncthreads();
            for (int c0 = 0; c0 < NCH; c0 += CPF) {
#pragma unroll
                for (int d = 0; d < CPF; ++d) { const int c = c0 + d;
                    constexpr int DUMMY = 0; (void)DUMMY;
                    const int e = (d + 1) % CPF;
                    if (c + 1 < NCH) {
                        asm volatile("s_waitcnt vmcnt(%0)" :: "n"(4 * (CPF - 1)) : "memory");
                        LAS unsigned char* sl = ring + ((c + 1) & 1) * 16384 + pt * 16;
                        *(LAS u32x4*)(sl) = rt[e][0]; *(LAS u32x4*)(sl + 4096) = rt[e][1]; *(LAS u32x4*)(sl + 8192) = rq[e][0]; *(LAS u32x4*)(sl + 12288) = rq[e][1];
                        const int cn = c + 1 + CPF < NCH ? c + 1 + CPF : NCH - 1;
                        const size_t o = cb + (size_t)cn * 8192 + pt * 16;
                        rt[e][0] = *(const u32x4*)(PFb + o); rt[e][1] = *(const u32x4*)(PFb + o + 4096); rq[e][0] = *(const u32x4*)(QFb + o); rq[e][1] = *(const u32x4*)(QFb + o + 4096);
                    }
                    LDS_WAIT(); __syncthreads();
                }
            }
            asm volatile("s_waitcnt vmcnt(0)" ::: "memory");
        } else {
            const int row = wave * 16 + (lane & 15), g = lane >> 4;
            const int aoff = ((lane & 15) * 64 + g * 16) * 2, qoff = (row * 64 + 4 * g) * 2;
            f32x4 S[4];
#pragma unroll
            for (int mt = 0; mt < 4; ++mt) S[mt] = (f32x4){0.f, 0.f, 0.f, 0.f};
            u32x4 a[4][2]; u32x2 q[4];
            __syncthreads();
#pragma unroll
            for (int mt = 0; mt < 4; ++mt) { a[mt][0] = *(const LAS u32x4*)(ring + mt * 2048 + aoff); a[mt][1] = *(const LAS u32x4*)(ring + mt * 2048 + aoff + 16); q[mt] = *(const LAS u32x2*)(ring + 8192 + qoff + 32 * mt); }
            LDS_WAIT(); __builtin_amdgcn_sched_barrier(0);
            for (int c = 0; c < NCH; ++c) { const size_t un = ((size_t)chain * NCH + c) * 4096;
#pragma unroll
                for (int mt = 0; mt < 4; ++mt) *(f32x4*)(SI + un + (qoff >> 1) + 16 * mt) = S[mt];
                bf16x8 bh[2], bl[2];
#pragma unroll
                for (int ks = 0; ks < 2; ++ks) { u32x4 wh, wl; const f32x4 s0 = S[2 * ks], s1 = S[2 * ks + 1];
                    wh.x = pk2(s0[0], s0[1]); wh.y = pk2(s0[2], s0[3]); wh.z = pk2(s1[0], s1[1]); wh.w = pk2(s1[2], s1[3]);
                    wl.x = pk2(s0[0] - bf2f(wh.x & 0xffffu), s0[1] - bf2f(wh.x >> 16)); wl.y = pk2(s0[2] - bf2f(wh.y & 0xffffu), s0[3] - bf2f(wh.y >> 16));
                    wl.z = pk2(s1[0] - bf2f(wh.z & 0xffffu), s1[1] - bf2f(wh.z >> 16)); wl.w = pk2(s1[2] - bf2f(wh.w & 0xffffu), s1[3] - bf2f(wh.w >> 16));
                    bh[ks] = __builtin_bit_cast(bf16x8, wh); bl[ks] = __builtin_bit_cast(bf16x8, wl); }
                __builtin_amdgcn_sched_barrier(0);
#pragma unroll
                for (int mt = 0; mt < 4; ++mt) { f32x4 d = (f32x4){bf2f(q[mt].x & 0xffffu), bf2f(q[mt].x >> 16), bf2f(q[mt].y & 0xffffu), bf2f(q[mt].y >> 16)};
#pragma unroll
                    for (int ks = 0; ks < 2; ++ks) { const bf16x8 af = __builtin_bit_cast(bf16x8, a[mt][ks]);
                        d = __builtin_amdgcn_mfma_f32_16x16x32_bf16(af, bh[ks], d, 0, 0, 0); d = __builtin_amdgcn_mfma_f32_16x16x32_bf16(af, bl[ks], d, 0, 0, 0); }
                    S[mt] = d; }
                asm volatile("s_nop 7\n\ts_nop 7" ::: "memory");
                __builtin_amdgcn_sched_barrier(0);
                __syncthreads();
                if (c + 1 < NCH) { LAS unsigned char* sl = ring + ((c + 1) & 1) * 16384;
#pragma unroll
                    for (int mt = 0; mt < 4; ++mt) { a[mt][0] = *(const LAS u32x4*)(sl + mt * 2048 + aoff); a[mt][1] = *(const LAS u32x4*)(sl + mt * 2048 + aoff + 16); q[mt] = *(const LAS u32x2*)(sl + 8192 + qoff + 32 * mt); } }
                LDS_WAIT(); __builtin_amdgcn_sched_barrier(0);
            }
        }
        asm volatile("s_waitcnt vmcnt(0)" ::: "memory");
        __syncthreads();
        if (xb_t0(wave)) { __builtin_amdgcn_fence(__ATOMIC_RELEASE, "agent"); asm volatile("s_waitcnt vmcnt(0)" ::: "memory"); __hip_atomic_store(flags + chain, 1u, __ATOMIC_RELAXED, __HIP_MEMORY_SCOPE_AGENT); }
    }
}
__device__ __forceinline__ void phase_rwkv_fin(const Frame& F0, int l, unsigned* flags, unsigned* qctr) {
    const Frame F = relaunder(F0);
    unsigned char* ws = F.ws; const float* SI = (const float*)(ws + WS_SINIT); const float* YL = (const float*)(ws + WS_YL); const float* ZL = (const float*)(ws + WS_ZL);
    const float* LO = (const float*)(ws + WS_LO); const float* VC = (const float*)(ws + WS_VCUR); const float* BON = (const float*)(ws + WS_BON); bf16* Y = (bf16*)(ws + WS_Y);
    const float* lnw = INP(15) + l * 512; const float* lnb = INP(16) + l * 512;
    const int lane = F.lane, wave = F.wave;
    (void)qctr;
    __syncthreads();
    if (xb_t0(wave)) {
        for (int u = F.bid; u < 16 * (NCH / 4); u += F.G) { unsigned* fl = flags + u / (NCH / 4); unsigned sp = 0u;
            while (xb_ld(fl) == 0u && ++sp < (1u << 22)) __builtin_amdgcn_s_sleep(1); }
        __builtin_amdgcn_fence(__ATOMIC_ACQUIRE, "agent"); asm volatile("s_waitcnt vmcnt(0)" ::: "memory"); }
    __syncthreads();
    for (int u = F.bid; u < 16 * (NCH / 4); u += F.G) {
        const int chain = u / (NCH / 4), c = (u % (NCH / 4)) * 4 + (wave >> 1), b = chain >> 3, h = chain & 7; const size_t un = ((size_t)chain * NCH + c) * 4096;
        const int m0 = b * T + c * CL + (wave & 1) * 16;
        bf16x8 af[2], bfr[4][2];
#pragma unroll
        for (int ks = 0; ks < 2; ++ks) { float t8[8]; ldf8(ZL + (size_t)(m0 + (lane & 15)) * 512 + h * 64 + ks * 32 + 8 * (lane >> 4), t8);
            u32x4 w; w.x = pk2(t8[0], t8[1]); w.y = pk2(t8[2], t8[3]); w.z = pk2(t8[4], t8[5]); w.w = pk2(t8[6], t8[7]); af[ks] = __builtin_bit_cast(bf16x8, w); }
#pragma unroll
        for (int n = 0; n < 4; ++n)
#pragma unroll
            for (int ks = 0; ks < 2; ++ks) { float t8[8]; ldf8(SI + un + (size_t)(16 * n + (lane & 15)) * 64 + ks * 32 + 8 * (lane >> 4), t8);
                u32x4 w; w.x = pk2(t8[0], t8[1]); w.y = pk2(t8[2], t8[3]); w.z = pk2(t8[4], t8[5]); w.w = pk2(t8[6], t8[7]); bfr[n][ks] = __builtin_bit_cast(bf16x8, w); }
        float yl[4][4], vc[4][4], gg[4][4], bn[4];
#pragma unroll
        for (int r = 0; r < 4; ++r) { const int m = m0 + 4 * (lane >> 4) + r; bn[r] = BON[(size_t)m * 8 + h];
#pragma unroll
            for (int n = 0; n < 4; ++n) { const int j = h * 64 + 16 * n + (lane & 15); yl[n][r] = YL[(size_t)m * 512 + j]; vc[n][r] = VC[(size_t)m * 512 + j]; gg[n][r] = LO[(size_t)m * 2048 + 1024 + j]; } }
        asm volatile("s_waitcnt vmcnt(0)" ::: "memory"); __builtin_amdgcn_sched_barrier(0);
        f32x4 C[4];
#pragma unroll
        for (int n = 0; n < 4; ++n) { C[n] = (f32x4){yl[n][0], yl[n][1], yl[n][2], yl[n][3]};
#pragma unroll
            for (int ks = 0; ks < 2; ++ks) C[n] = __builtin_amdgcn_mfma_f32_16x16x32_bf16(af[ks], bfr[n][ks], C[n], 0, 0, 0); }
        __builtin_amdgcn_sched_barrier(0);
#pragma unroll
        for (int r = 0; r < 4; ++r) { const int m = m0 + 4 * (lane >> 4) + r;
            float sm = (C[0][r] + C[1][r]) + (C[2][r] + C[3][r]); sm = red16_sum(sm); const float mean = sm * (1.f / 64.f);
            float d[4], sv = 0.f;
#pragma unroll
            for (int n = 0; n < 4; ++n) { d[n] = C[n][r] - mean; sv += d[n] * d[n]; }
            sv = red16_sum(sv); const float rs = 1.0f / sqrtf(sv * (1.f / 64.f) + 64e-5f);
#pragma unroll
            for (int n = 0; n < 4; ++n) { const int j = h * 64 + 16 * n + (lane & 15); const float yn = d[n] * rs * lnw[j] + lnb[j];
                Y[(size_t)m * 2560 + j] = (bf16)f2bf((yn + bn[r] * vc[n][r]) * gg[n][r]); } }
    }
}

__device__ __forceinline__ void phase_route(const Frame& F0, const bf16* X) {
    const Frame F = relaunder(F0);
    const float* R = INP(36); const float* gain = INP(3) + D; const u64* ssq = (const u64*)(F.ctl + CW_SSQ) + 3 * 8192;
    unsigned* cnt = F.ctl + CW_CNT; unsigned* route = F.ctl + CW_ROUTE;
    const int lane = F.lane;
    for (int m = F.bid * 8 + F.wave; m < M; m += F.G * 8) {
        float acc[8];
#pragma unroll
        for (int e = 0; e < 8; ++e) acc[e] = 0.f;
#pragma unroll 8
        for (int i = 0; i < 32; ++i) { const int k = lane + 64 * i; const float xv = ldbf(X + (size_t)m * D + k) * gain[k]; const f32x4 r0 = *(const f32x4*)(R + k * 8), r1 = *(const f32x4*)(R + k * 8 + 4);
            acc[0] += xv * r0[0]; acc[1] += xv * r0[1]; acc[2] += xv * r0[2]; acc[3] += xv * r0[3]; acc[4] += xv * r1[0]; acc[5] += xv * r1[1]; acc[6] += xv * r1[2]; acc[7] += xv * r1[3]; }
        const float rs = rstd_of(ssq, m);
#pragma unroll
        for (int e = 0; e < 8; ++e) acc[e] = wave_sum(acc[e]) * rs;
        if (lane == 0) {
            int e0 = 0; float v0 = acc[0];
#pragma unroll
            for (int e = 1; e < 8; ++e) if (acc[e] > v0) { v0 = acc[e]; e0 = e; }
            int e1 = -1; float v1 = -3.0e38f;
#pragma unroll
            for (int e = 0; e < 8; ++e) if (e != e0 && acc[e] > v1) { v1 = acc[e]; e1 = e; }
            const float p1 = __expf(v1 - v0); const float w0 = 1.f / (1.f + p1), w1 = p1 / (1.f + p1);
            const unsigned pos0 = atomicAdd(cnt + 64 * e0, 1u), pos1 = atomicAdd(cnt + 64 * e1, 1u);
            unsigned* rr = route + (size_t)m * 8; rr[0] = (unsigned)e0; rr[1] = (unsigned)e1; rr[2] = __builtin_bit_cast(unsigned, w0); rr[3] = __builtin_bit_cast(unsigned, w1); rr[4] = pos0; rr[5] = pos1; rr[6] = __builtin_bit_cast(unsigned, rs); }
    }
}
__device__ __forceinline__ void moe_tiles(const Frame& F, int (&ts)[9]) {
    ts[0] = 0;
#pragma unroll
    for (int e = 0; e < 8; ++e) { const unsigned c = __hip_atomic_load(F.ctl + CW_CNT + 64 * e, RLX_AGENT); ts[e + 1] = ts[e] + (int)((c + 255u) >> 8); }
}
__device__ __forceinline__ void phase_gather(const Frame& F0, float* RSS) {
    const Frame F = relaunder(F0);
    constexpr int RB = F8_M1 ? D : 2 * D;
    unsigned char* ws = F.ws; const unsigned char* XH = ws + (F8_M1 ? WS_XH8 : WS_XH); unsigned char* XG = ws + WS_XG; const unsigned* route = F.ctl + CW_ROUTE;
    int ts[9]; moe_tiles(F, ts);
    for (int m = F.bid * 8 + F.wave; m < M; m += F.G * 8) { const unsigned* rr = route + (size_t)m * 8;
        const u32x4* src = (const u32x4*)(XH + (size_t)m * RB);
#pragma unroll
        for (int s = 0; s < 2; ++s) { const int e = (int)rr[s]; int base = 0;
#pragma unroll
            for (int j = 0; j < 8; ++j) base = (j == e) ? ts[j] : base;
            const int slot = base * 256 + (int)rr[4 + s]; u32x4* dst = (u32x4*)(XG + (size_t)slot * RB);
#pragma unroll
            for (int i = 0; i < RB / 1024; ++i) dst[F.lane + 64 * i] = src[F.lane + 64 * i];
            if (F.lane == 0) __hip_atomic_store((unsigned*)RSS + slot, rr[6], RLX_AGENT); } }
}
__device__ __forceinline__ void phase_combine(const Frame& F0, const bf16* X, float* out) {
    const Frame F = relaunder(F0);
    unsigned char* ws = F.ws; const bf16* YS = (const bf16*)(ws + WS_YS); const unsigned* route = F.ctl + CW_ROUTE;
    int ts[9]; moe_tiles(F, ts);
    for (int m = F.bid * 8 + F.wave; m < M; m += F.G * 8) { const unsigned* rr = route + (size_t)m * 8; int slot[2]; float w[2];
#pragma unroll
        for (int s = 0; s < 2; ++s) { const int e = (int)rr[s]; int base = 0;
#pragma unroll
            for (int j = 0; j < 8; ++j) base = (j == e) ? ts[j] : base;
            slot[s] = base * 256 + (int)rr[4 + s]; w[s] = __builtin_bit_cast(float, rr[2 + s]); }
#pragma unroll
        for (int i = 0; i < 8; ++i) { const int c = (F.lane + 64 * i) * 4; const u32x2 xr = *(const u32x2*)(X + (size_t)m * D + c); f32x4 v = (f32x4){bf2f(xr.x & 0xffffu), bf2f(xr.x >> 16), bf2f(xr.y & 0xffffu), bf2f(xr.y >> 16)};
            const u32x2 a = *(const u32x2*)(YS + (size_t)slot[0] * D + c), b2 = *(const u32x2*)(YS + (size_t)slot[1] * D + c);
            v[0] += w[0] * bf2f(a.x & 0xffffu) + w[1] * bf2f(b2.x & 0xffffu); v[1] += w[0] * bf2f(a.x >> 16) + w[1] * bf2f(b2.x >> 16);
            v[2] += w[0] * bf2f(a.y & 0xffffu) + w[1] * bf2f(b2.y & 0xffffu); v[3] += w[0] * bf2f(a.y >> 16) + w[1] * bf2f(b2.y >> 16);
            *(f32x4*)(out + (size_t)m * D + c) = v; } }
}

constexpr int PH_PER_LAYER = 14, N_PHASES = 1 + 2 * PH_PER_LAYER;
struct Args { const float* in[40]; float* out; unsigned char* ws; int ph_lo, ph_hi; };
__global__ void __launch_bounds__(512, 2) mega_fwd(Args args) {
    extern __shared__ __attribute__((aligned(16))) unsigned char lds_raw[];
    Frame F; F.lds = (LAS unsigned char*)lds_raw; F.tid = threadIdx.x; F.lane = F.tid & 63; F.wave = __builtin_amdgcn_readfirstlane(F.tid >> 6); F.G = gridDim.x; F.bid = blockIdx.x;
    F.in = args.in; F.ws = args.ws; F.ctl = (unsigned*)(args.ws + WS_CTL);
    volatile LAS unsigned* MISC = (volatile LAS unsigned*)(F.lds + MISC_OFF);
    for (int u = F.tid; u < (LDS_BYTES - RING_BYTES) / 4; u += 512) ((LAS unsigned*)(F.lds + RING_BYTES))[u] = 0u;
    __syncthreads();
    const int lo = args.ph_lo, hi = args.ph_hi;
    XcdBarrier bar; bar.bar = F.ctl + CW_BAR; bar.x = 0; bar.st = nullptr; bar.wave = F.wave;
    if (hi - lo > 1) bar = xcd_barrier_post(F.ctl + CW_BAR, MISC + 8, F.wave);
#ifndef PHMASK
#define PHMASK 0xFFFFFFFFu
#endif
#define KD(j) (((PHMASK) >> (j)) & 1u)
#define IN(k) (lo <= (k) && (k) < hi)
#define SEAM(k) do { if (IN((k) + 1)) xcd_barrier(bar); } while (0)
    unsigned char* ws = args.ws;
    u64* ssq_all = (u64*)(F.ctl + CW_SSQ);
    LAS unsigned char* lds = F.lds;

    if (KD(0) && IN(0)) { phase_prologue(F); SEAM(0); }

    auto run_layer = [&](auto LC) __attribute__((always_inline)) {
        constexpr int l = decltype(LC)::value;
        const int pb = 1 + l * PH_PER_LAYER;
        const u64* ssq_mix = ssq_all + (2 * l) * 8192; u64* ssq_ffn = ssq_all + (2 * l + 1) * 8192;
        bf16* XH = (bf16*)(ws + WS_XH);
        const float* xin = l == 0 ? args.in[0] : args.out; float* xmid = (float*)(ws + WS_XA); float* xout = args.out;
        if (KD(1) && IN(pb + 0)) {
            const int nNP = (l ? NP1 : NP0) / 256;
            { pg8::Gemm g{XH, (const bf16*)(ws + (l ? WS_WPT1 : WS_WPT0)), D, D, D, 0, 0}; pg8::GridOrder S; S.init(M / 256, nNP, 1, F.G, F.bid);
              EpiP E{(bf16*)(ws + WS_P), (bf16*)(ws + WS_G4), ssq_mix, nNP}; pg8::gemm_phase<EpiP, pg8::GridOrder>(lds, g, S, E, F.wave); }
            if (l == 0 && F.G >= 16 && F.bid >= F.G - 16) { pg8::Gemm g{(const bf16*)(ws + WS_MEMN), (const bf16*)(ws + WS_WKVT0), D, D, D, 0, 0}; pg8::GridOrder S; S.init(2, 8, 1, 16, F.bid - (F.G - 16));
              EpiF32 E{(float*)(ws + WS_KVRAW), 2048}; pg8::gemm_phase<EpiF32, pg8::GridOrder>(lds, g, S, E, F.wave); }
            SEAM(pb + 0);
        }
        if (KD(2) && IN(pb + 1)) { phase_prep(F, l); SEAM(pb + 1); }
        if (KD(3) && IN(pb + 2)) {
            if (KD(17)) { pg8::Gemm g{(const bf16*)(ws + WS_ALORA), (const bf16*)(ws + (l ? WS_WLT1 : WS_WLT0)), 512, 512, 512, 0, 0}; pg8::GridOrder S; S.init(M / 256, 8, 1, F.G, F.bid);
              EpiLora E{(float*)(ws + WS_LO), args.in[7] + l * 512, args.in[9] + l * 512, args.in[19], l}; pg8::gemm_phase<EpiLora, pg8::GridOrder>(lds, g, S, E, F.wave); }
            if (KD(18) && F.bid < 32) { const int kp = F.bid >> 3;
              pg8::Gemm g{(const bf16*)(ws + WS_ACMP) + kp * 512, (const bf16*)(ws + (l ? WS_WC1T1 : WS_WC1T0)) + kp * 512, 2048, 2048, 512, (size_t)1024 * 2048 * 2, (size_t)256 * 2048 * 2}; pg8::GridOrder S; S.init(4, 1, 2, 8, F.bid & 7);
              EpiHP E{(float*)(ws + WS_HP) + (size_t)kp * 2 * 1024 * 128}; pg8::gemm_phase<EpiHP, pg8::GridOrder>(lds, g, S, E, F.wave); }
            __syncthreads();
            if (KD(19)) phase_memattn(F);
            SEAM(pb + 2);
        }
        if (KD(4) && IN(pb + 3)) {
            if (F.bid < 8) { const CmpFin CF{(const float*)(ws + WS_HP), args.in[24] + l * 256, (const bf16*)(ws + WS_WC2T) + (size_t)l * 2 * 64 * 128, args.in[21] + l * 256 + 64, (bf16*)(ws + WS_KC), (bf16*)(ws + WS_VCT)};
                cmp_finalize(CF, F.bid >> 2, F.bid & 3, lds, F.wave, F.lane); }
            phase_scan(F, l); SEAM(pb + 3); }
        if (KD(5) && IN(pb + 4)) { unsigned* cflags = F.ctl + CW_QCTR + 256 + 64 * l; phase_carry(F, cflags); if (l == 0 && F.bid % 5 < 2) convert_late_loop(F, F.ctl + CW_QCTR + 384); phase_nsa(F, F.ctl + CW_QCTR + 64 * l); if (l == 0) convert_late_loop(F, F.ctl + CW_QCTR + 384); phase_rwkv_fin(F, l, cflags, F.ctl + CW_QCTR + 128 + 64 * l); SEAM(pb + 4); }
        if (KD(7) && IN(pb + 6)) {
            pg8::Gemm g{(const bf16*)(ws + WS_Y), (const bf16*)(ws + (l ? WS_WBT1 : WS_WBT0)), 2560, 512, 512, (size_t)512 * 2, (size_t)2048 * 512 * 2}; pg8::GridOrder S; S.init(M / 256, 8, 5, F.G, F.bid);
            EpiZ E{(bf16*)(ws + WS_ZB)}; pg8::gemm_phase<EpiZ, pg8::GridOrder>(lds, g, S, E, F.wave);
            { pg8::Gemm g4{(const bf16*)(ws + WS_XH8), (const bf16*)(ws + (l ? WS_WG4T1 : WS_WG4T0)), D / 2, D / 2, D / 2, 0, 0}; pg8::GridOrder S4; S4.init(M / 256, 8, 1, F.G, F.bid);
              EpiGate4 E4{(bf16*)(ws + WS_G4), ssq_mix}; pg8::gemm_phase<EpiGate4, pg8::GridOrder, true, true>(lds, g4, S4, E4, F.wave); }
            SEAM(pb + 6);
        }
        if (KD(8) && IN(pb + 7)) {
            constexpr int KD2 = F8_G ? D / 2 : D; pg8::Gemm g{F8_G ? (const bf16*)(ws + WS_XH8) : (const bf16*)XH, (const bf16*)(ws + (l ? WS_WGT1 : WS_WGT0)), KD2, KD2, KD2, 0, 0}; pg8::GridOrder S; S.init(M / 256, 32, 1, F.G, F.bid);
            { const int sg = (F.bid >> 3) & 3; for (int i = 0; i < sg; ++i) __builtin_amdgcn_s_sleep(127); }
            EpiG E{(const bf16*)(ws + WS_ZB), (const bf16*)(ws + WS_G4), (bf16*)(ws + WS_MG), ssq_mix, F8_G ? W8SI : 1.f}; pg8::gemm_phase<EpiG, pg8::GridOrder, true, F8_G != 0>(lds, g, S, E, F.wave);
            SEAM(pb + 7);
        }
        if (KD(9) && IN(pb + 8)) {
            pg8::Gemm g{(const bf16*)(ws + WS_MG), (const bf16*)(ws + (l ? WS_WOT1 : WS_WOT0)), D, D, D, 0, 0}; pg8::GridOrder S; S.init(M / 256, 8, 1, F.G, F.bid);
            EpiRes E{XH, ssq_ffn, ws + WS_XH8}; pg8::gemm_phase<EpiRes, pg8::GridOrder>(lds, g, S, E, F.wave);
            SEAM(pb + 8);
        }
        if (l == 0) {
            if (KD(10) && IN(pb + 9)) {
                constexpr int KD2 = F8_F1 ? D / 2 : D; pg8::Gemm g{F8_F1 ? (const bf16*)(ws + WS_XH8) : (const bf16*)XH, (const bf16*)(ws + WS_W13T), KD2, KD2, KD2, 0, 0}; pg8::GridOrder S; S.init(M / 256, 2 * FF / 256, 1, F.G, F.bid);
                EpiSwiglu<false> E{(bf16*)(ws + WS_ACT), FF, ssq_ffn, nullptr, F8_F1 ? W8SI : 1.f, 1.f}; pg8::gemm_phase<EpiSwiglu<false>, pg8::GridOrder, true, F8_F1 != 0>(lds, g, S, E, F.wave);
                SEAM(pb + 9);
            }
            if (KD(11) && IN(pb + 10)) {
                pg8::Gemm g{(const bf16*)(ws + WS_ACT), (const bf16*)(ws + WS_W2T), FF, FF, FF, 0, 0}; pg8::GridOrder S; S.init(M / 256, 8, 1, F.G, F.bid);
                EpiRes E{XH, ssq_all + 2 * 8192, ws + WS_XH8}; pg8::gemm_phase<EpiRes, pg8::GridOrder>(lds, g, S, E, F.wave);
                SEAM(pb + 13);
            }
        } else {
            float* RSS = (float*)(ws + WS_RSS);
            if (KD(12) && IN(pb + 9)) { phase_route(F, XH); SEAM(pb + 9); }
            if (KD(13) && IN(pb + 10)) { phase_gather(F, RSS); SEAM(pb + 10); }
            if (KD(14) && IN(pb + 11)) {
                pg8::MoeOrder S; moe_tiles(F, S.ts); S.nN = 2 * EFF / 256; S.G = F.G; S.c = F.bid;
                constexpr int KD2 = F8_M1 ? D / 2 : D; pg8::Gemm g{(const bf16*)(ws + WS_XG), (const bf16*)(ws + WS_MW13T), KD2, KD2, KD2, 0, (size_t)2 * EFF * 2048 * (F8_M1 ? 1 : 2)};
                EpiSwiglu<F8_M2 != 0> E{(bf16*)(ws + WS_ACTM), EFF, nullptr, RSS, F8_M1 ? W8SI : 1.f, 8.f}; pg8::gemm_phase<EpiSwiglu<F8_M2 != 0>, pg8::MoeOrder, true, F8_M1 != 0>(lds, g, S, E, F.wave);
                SEAM(pb + 11);
            }
            if (KD(15) && IN(pb + 12)) {
                pg8::MoeOrder S; moe_tiles(F, S.ts); S.nN = 8; S.G = F.G; S.c = F.bid;
                constexpr int KE2 = F8_M2 ? EFF / 2 : EFF; pg8::Gemm g{(const bf16*)(ws + WS_ACTM), (const bf16*)(ws + WS_MW2T), KE2, KE2, KE2, 0, (size_t)2048 * EFF * (F8_M2 ? 1 : 2)};
                EpiBf E{(bf16*)(ws + WS_YS), D, F8_M2 ? W8SI / 8.f : 1.f}; pg8::gemm_phase<EpiBf, pg8::MoeOrder, true, F8_M2 != 0>(lds, g, S, E, F.wave);
                SEAM(pb + 12);
            }
            if (KD(16) && IN(pb + 13)) { phase_combine(F, XH, xout); }
        }
    };
    run_layer(std::integral_constant<int, 0>{});
    run_layer(std::integral_constant<int, 1>{});
#undef IN
#undef SEAM
}

#ifdef DBG_STOP
__global__ void dbg_dump(const unsigned char* buf, size_t nelem, int is_bf16, float* out, int nout) {
    for (int i = blockIdx.x * blockDim.x + threadIdx.x; i < nout; i += gridDim.x * blockDim.x) { float s = 0.f;
        for (size_t j = (size_t)i; j < nelem; j += (size_t)nout) s += is_bf16 ? bf2f(((const bf16*)buf)[j]) : ((const float*)buf)[j];
        out[i] = s; }
}
__global__ void dbg_cols(const bf16* buf, int ld, int c0, int w, float* out) {
    for (int i = blockIdx.x * blockDim.x + threadIdx.x; i < M * D; i += gridDim.x * blockDim.x) { const int row = i >> 11, c = i & 2047; out[i] = bf2f(buf[(size_t)row * ld + c0 + (c % w)]); }
}
#endif
extern "C" void kernel_launch(void* const* d_in, const int* in_sizes, int n_in, void* d_out, int out_size, void* d_ws, size_t ws_size, hipStream_t stream) {
    static int grid = 0;
    if (grid == 0) {
        if (n_in != 40 || out_size != M * D || ws_size < WS_END) { fprintf(stderr, "kernel_launch: unexpected shapes (n_in %d out %d ws %zu need %zu)\n", n_in, out_size, ws_size, (size_t)WS_END); grid = -1; return; }
        int dev = 0, cus = 0, per_cu = 0;
        if (hipGetDevice(&dev) != hipSuccess || hipDeviceGetAttribute(&cus, hipDeviceAttributeMultiprocessorCount, dev) != hipSuccess) { grid = -1; return; }
        if (hipFuncSetAttribute((const void*)mega_fwd, hipFuncAttributeMaxDynamicSharedMemorySize, LDS_BYTES) != hipSuccess) { fprintf(stderr, "kernel_launch: hipFuncSetAttribute failed\n"); grid = -1; return; }
        if (hipOccupancyMaxActiveBlocksPerMultiprocessor(&per_cu, (const void*)mega_fwd, 512, LDS_BYTES) != hipSuccess || per_cu < 1) fprintf(stderr, "kernel_launch: occupancy query reports %d\n", per_cu);
        (void)hipGetLastError();
        grid = cus;
    }
    if (grid < 0) return;
    if (hipMemsetAsync((char*)d_ws + WS_CTL, 0, CTL_BYTES, stream) != hipSuccess) return;
    Args a{};
    for (int i = 0; i < 40; ++i) a.in[i] = (const float*)d_in[i];
    a.out = (float*)d_out; a.ws = (unsigned char*)d_ws;
#if MK_ONE_LAUNCH
    a.ph_lo = 0; a.ph_hi = N_PHASES;
    hipLaunchKernelGGL(mega_fwd, dim3(grid), dim3(512), LDS_BYTES, stream, a);
#else
    for (int p = 0; p < N_PHASES; ++p) {
        if (p >= 1 + 11 && p < 1 + PH_PER_LAYER) continue;
#ifdef DBG_STOP
        if (p > DBG_STOP) break;
#endif
        a.ph_lo = p; a.ph_hi = p + 1;
        hipLaunchKernelGGL(mega_fwd, dim3(grid), dim3(512), LDS_BYTES, stream, a);
    }
#ifdef DBG_STOP
#ifdef DBG_C0
    hipLaunchKernelGGL(dbg_cols, dim3(2048), dim3(256), 0, stream, (const bf16*)((const unsigned char*)d_ws + (size_t)(DBG_OFF)), (int)(DBG_LD), (int)(DBG_C0), (int)(DBG_W), (float*)d_out);
#else
    hipLaunchKernelGGL(dbg_dump, dim3(2048), dim3(256), 0, stream, (const unsigned char*)d_ws + (size_t)(DBG_OFF), (size_t)(DBG_NELEM), (int)(DBG_BF16), (float*)d_out, M * D);
#endif
#endif
#endif
}
```

```cpp
#include <hip/hip_runtime.h>
#include <cstdio>
#include <cstdint>
#include <type_traits>

#ifndef F8_G
#define F8_G 1
#endif
#ifndef F8_F1
#define F8_F1 0
#endif
#ifndef F8_M1
#define F8_M1 1
#endif
#ifndef F8_M2
#define F8_M2 1
#endif
#ifndef MK_ONE_LAUNCH
#define MK_ONE_LAUNCH 1
#endif

#define GAS __attribute__((address_space(1)))
#define LAS __attribute__((address_space(3)))
typedef unsigned short bf16;
typedef short bf16x8 __attribute__((ext_vector_type(8)));
typedef float f32x4 __attribute__((ext_vector_type(4)));
typedef float f32x2 __attribute__((ext_vector_type(2)));
typedef unsigned u32x4 __attribute__((ext_vector_type(4)));
typedef unsigned u32x2 __attribute__((ext_vector_type(2)));

constexpr int M = 8192, T = 4096, D = 2048;
constexpr int LDP = 6144;
constexpr int NP0 = 5888, NP1 = 6144;
constexpr int PC_R = 0, PC_K = 512, PC_V = 1024, PC_WD = 1536, PC_AD = 1632, PC_GD = 1728;
constexpr int PC_Q = 1984, PC_KC = 2496, PC_VC = 2624, PC_KS = 2752, PC_VS = 2880, PC_KW = 3008, PC_VW = 3136, PC_GL = 3264;
constexpr int PC_CB = 3288, PC_CC = 3800, PC_CX = 4312, PC_POOL = 4824, PC_MEM = 5336, PC_GATE = 5848, PC_VRES = 5848;
constexpr int NIN = 16088;
constexpr int FF = 5632, EFF = 2816, NE = 8;
constexpr float NORM_EPS = 1e-6f;
constexpr float CQ_NSA = 0.125f * 1.4426950408889634f, CQ_MEM = 0.08838834764831845f * 1.4426950408889634f;
constexpr int SLOTS = 18432;

constexpr size_t al4k(size_t x) { return (x + 4095) & ~(size_t)4095; }
constexpr size_t MiB = 1u << 20;
constexpr size_t WS_CTL = 0, CTL_BYTES = MiB;
constexpr size_t SZ_WPT0 = (size_t)NP0 * 2048 * 2, SZ_WPT1 = (size_t)NP1 * 2048 * 2;
constexpr size_t SZ_WGT = (size_t)8192 * 2048 * 2, SZ_WBT = (size_t)5 * 2048 * 512 * 2, SZ_WOT = (size_t)2048 * 2048 * 2, SZ_WLT = (size_t)2048 * 512 * 2;
constexpr size_t SZ_WKVT = (size_t)1024 * 2048 * 2, SZ_WC1T = (size_t)2 * 256 * 2048 * 2;
constexpr size_t WS_WPT0 = WS_CTL + CTL_BYTES;
constexpr size_t WS_WPT1 = WS_WPT0 + SZ_WPT0;
constexpr size_t WS_WGT0 = WS_WPT1 + SZ_WPT1, WS_WGT1 = WS_WGT0 + SZ_WGT;
constexpr size_t WS_WG4T0 = WS_WGT1 + SZ_WGT, WS_WG4T1 = WS_WG4T0 + (size_t)2048 * 2048;
constexpr size_t WS_WBT0 = WS_WG4T1 + (size_t)2048 * 2048, WS_WBT1 = WS_WBT0 + SZ_WBT;
constexpr size_t WS_WOT0 = WS_WBT1 + SZ_WBT, WS_WOT1 = WS_WOT0 + SZ_WOT;
constexpr size_t WS_WLT0 = WS_WOT1 + SZ_WOT, WS_WLT1 = WS_WLT0 + SZ_WLT;
constexpr size_t WS_WKVT0 = WS_WLT1 + SZ_WLT, WS_WKVT1 = WS_WKVT0 + SZ_WKVT;
constexpr size_t WS_WC1T0 = WS_WKVT1 + SZ_WKVT, WS_WC1T1 = WS_WC1T0 + SZ_WC1T;
constexpr size_t WS_WC2T = WS_WC1T1 + SZ_WC1T;
constexpr size_t WS_W13T = WS_WC2T + (size_t)65536;
constexpr size_t WS_W2T = WS_W13T + (size_t)2 * FF * 2048 * 2;
constexpr size_t WS_MW13T = WS_W2T + (size_t)2048 * FF * 2;
constexpr size_t WS_MW2T = WS_MW13T + (size_t)NE * 2 * EFF * 2048 * 2;
constexpr size_t WS_XA = WS_MW2T + (size_t)NE * 2048 * EFF * 2;
constexpr size_t WS_XH = WS_XA + (size_t)M * D * 4;
constexpr size_t WS_MEMN = WS_XH + (size_t)M * D * 2;
constexpr size_t WS_G4 = WS_MEMN + (size_t)512 * 2048 * 2;
constexpr size_t WS_Y = WS_G4 + (size_t)M * D * 2;
constexpr size_t WS_VFIRST = WS_Y + (size_t)M * 2560 * 2;
constexpr size_t WS_KVRAW = WS_VFIRST + (size_t)M * 512 * 4;
constexpr size_t WS_XH8 = WS_KVRAW + (size_t)512 * 2048 * 4;
constexpr size_t WS_OV = WS_XH8 + (size_t)M * D;
constexpr size_t WS_P = WS_OV;
constexpr size_t WS_ALORA = WS_P + (size_t)M * LDP * 2;
constexpr size_t WS_LO = WS_ALORA + (size_t)M * 512 * 2;
constexpr size_t WS_YL = WS_LO + (size_t)M * 2048 * 4;
constexpr size_t WS_ZL = WS_YL + (size_t)M * 512 * 4;
constexpr size_t WS_QF = WS_ZL + (size_t)M * 512 * 4;
constexpr size_t WS_PF = WS_QF + (size_t)2048 * 4096 * 4;
constexpr size_t WS_SINIT = WS_PF + (size_t)2048 * 4096 * 4;
constexpr size_t WS_VCUR = WS_SINIT + (size_t)2048 * 4096 * 4;
constexpr size_t WS_BON = WS_VCUR + (size_t)M * 512 * 4;
constexpr size_t WS_QN = WS_BON + (size_t)M * 8 * 4;
constexpr size_t WS_KS = WS_QN + (size_t)M * 512 * 2;
constexpr size_t WS_KW = WS_KS + (size_t)M * 128 * 2;
constexpr size_t WS_VST = WS_KW + (size_t)M * 128 * 2;
constexpr size_t WS_VWT = WS_VST + (size_t)M * 128 * 2;
constexpr size_t WS_ACMP = WS_VWT + (size_t)M * 128 * 2;
constexpr size_t WS_KC = WS_ACMP + (size_t)2 * 1024 * 2048 * 2;
constexpr size_t WS_VCT = WS_KC + (size_t)4 * 256 * 64 * 2;
constexpr size_t WS_QM = WS_VCT + (size_t)4 * 256 * 64 * 2;
constexpr size_t WS_KMEM = WS_QM + (size_t)M * 512 * 2;
constexpr size_t WS_VMEMT = WS_KMEM + (size_t)8 * 256 * 128 * 2;
constexpr size_t WS_HP = WS_VMEMT + (size_t)8 * 256 * 128 * 2;
constexpr size_t WS_MIX_END = WS_HP + (size_t)4 * 2 * 1024 * 128 * 4;
constexpr size_t WS_ZB = WS_OV;
constexpr size_t WS_MG = WS_ZB + (size_t)5 * M * D * 2;
constexpr size_t WS_ACT = WS_OV;
constexpr size_t WS_XG = WS_OV;
constexpr size_t WS_ACTM = WS_XG + (size_t)SLOTS * 2048 * 2;
constexpr size_t WS_YS = WS_ACTM + (size_t)SLOTS * EFF * 2;
constexpr size_t WS_RSS = WS_YS + (size_t)SLOTS * 2048 * 2;
constexpr size_t WS_MOE_END = WS_RSS + (size_t)SLOTS * 4;
constexpr size_t WS_END = WS_MIX_END > WS_MOE_END ? WS_MIX_END : WS_MOE_END;
static_assert(WS_END <= (size_t)1119977216, "workspace map exceeds the guaranteed d_ws size");
static_assert(WS_MG + (size_t)M * D * 2 <= WS_MIX_END, "Z view inside overlay");

constexpr int CW_BAR = 4096;
constexpr int CW_SSQ = 16384;
constexpr int CW_CNT = CW_SSQ + 4 * 8192 * 2;
constexpr int CW_QCTR = CW_CNT + 512;
constexpr int CW_ROUTE = CW_CNT + 1024;
static_assert((CW_ROUTE + 8 * 8192) * 4 <= (int)CTL_BYTES, "CTL map");

constexpr int RING_BYTES = 131072;
constexpr int MISC_OFF = RING_BYTES + 320;
constexpr int LDS_BYTES = 147456;

#define RLX_AGENT __ATOMIC_RELAXED, __HIP_MEMORY_SCOPE_AGENT
#define LDS_WAIT() asm volatile("s_waitcnt lgkmcnt(0)" ::: "memory")
#define VM_WAIT() asm volatile("s_waitcnt vmcnt(0)" ::: "memory")
__device__ __forceinline__ unsigned f2bf(float f) { unsigned u = __builtin_bit_cast(unsigned, f); return (u + 0x7fffu + ((u >> 16) & 1u)) >> 16; }
__device__ __forceinline__ float bf2f(unsigned b) { return __builtin_bit_cast(float, b << 16); }
typedef __bf16 bf16x2_t __attribute__((ext_vector_type(2)));
__device__ __forceinline__ unsigned pk2(float lo, float hi) { const bf16x2_t b = __builtin_convertvector((f32x2){lo, hi}, bf16x2_t); return __builtin_bit_cast(unsigned, b); }
__device__ __forceinline__ unsigned pk4_fp8(float a, float b, float c, float d) { unsigned w = 0u; w = (unsigned)__builtin_amdgcn_cvt_pk_fp8_f32(a, b, (int)w, false); w = (unsigned)__builtin_amdgcn_cvt_pk_fp8_f32(c, d, (int)w, true); return w; }
constexpr float W8S = 64.0f, W8SI = 1.0f / 64.0f;
__device__ __forceinline__ float sigmoidf_(float x) { return __builtin_amdgcn_rcpf(1.f + __builtin_amdgcn_exp2f(x * -1.4426950408889634f)); }
#define DPPF(v, ctrl) __builtin_bit_cast(float, __builtin_amdgcn_update_dpp(0, __builtin_bit_cast(int, (v)), (ctrl), 0xf, 0xf, true))
__device__ __forceinline__ float red16_max(float v) { v = fmaxf(v, DPPF(v, 0xB1)); v = fmaxf(v, DPPF(v, 0x4E)); v = fmaxf(v, DPPF(v, 0x141)); v = fmaxf(v, DPPF(v, 0x140)); return v; }
__device__ __forceinline__ float red16_sum(float v) { v += DPPF(v, 0xB1); v += DPPF(v, 0x4E); v += DPPF(v, 0x141); v += DPPF(v, 0x140); return v; }
__device__ __forceinline__ float wave_sum(float v) {
#pragma unroll
    for (int o = 1; o < 64; o <<= 1) v += __shfl_xor(v, o);
    return v;
}

#define XB_TMO      128
#define XB_XCNT(j)  (256  + 64 * (j))
#define XB_XSUB(j)  (1280 + 64 * (j))
#define XB_XGEN(j)  (2304 + 64 * (j))
#define XB_TOP      3328
#define XB_TOPGEN   3392
#define XCD_BAR_WORDS 3456
#define XB_SPIN_CAP (1u << 18)
__device__ __forceinline__ unsigned xb_ld(unsigned* p)              { return __hip_atomic_load(p, __ATOMIC_RELAXED, __HIP_MEMORY_SCOPE_AGENT); }
__device__ __forceinline__ unsigned xb_add(unsigned* p, unsigned v) { return __hip_atomic_fetch_add(p, v, __ATOMIC_RELAXED, __HIP_MEMORY_SCOPE_AGENT); }
__device__ __forceinline__ unsigned xb_xcc_id() { return (unsigned)__builtin_amdgcn_s_getreg((3 << 11) | 20) & 0xFu; }
#define XB_SPIN(cond, bar) do { unsigned _sp = 0; while (cond) { __builtin_amdgcn_s_sleep(1); \
    if ((++_sp & 255u) == 0u) { if (xb_ld(&(bar)[XB_TMO])) break; if (_sp > XB_SPIN_CAP) { atomicAdd(&(bar)[XB_TMO], 1u); break; } } } } while (0)
struct XcdBarrier { unsigned* bar; unsigned x; volatile LAS unsigned* st; int wave; };
__device__ __forceinline__ bool xb_t0(int wave) { return wave == 0 && __builtin_amdgcn_mbcnt_hi(~0u, __builtin_amdgcn_mbcnt_lo(~0u, 0u)) == 0u; }
__device__ __forceinline__ XcdBarrier xcd_barrier_post(unsigned* bar, volatile LAS unsigned* st, int wave) {
    XcdBarrier b; b.bar = bar; b.x = xb_xcc_id(); b.st = st; b.wave = wave;
    if (xb_t0(wave)) (void)xb_add(&bar[XB_XCNT(b.x)], 1u);
    return b;
}
__device__ __forceinline__ void xcd_barrier_complete(unsigned* bar, unsigned x, unsigned& nloc, unsigned& nx) {
    const unsigned G = gridDim.x * gridDim.y * gridDim.z;
    unsigned sum, cnt, mine, sp = 0u;
    for (;;) {
        sum = 0u; cnt = 0u; mine = 0u;
#pragma unroll
        for (unsigned j = 0; j < 16; ++j) { const unsigned c = xb_ld(&bar[XB_XCNT(j)]); sum += c; cnt += (c > 0u) ? 1u : 0u; mine = (j == x) ? c : mine; }
        if (sum == G) break;
        __builtin_amdgcn_s_sleep(1);
        if ((++sp & 255u) == 0u) { if (xb_ld(&bar[XB_TMO])) break; if (sp > XB_SPIN_CAP) { atomicAdd(&bar[XB_TMO], 1u); break; } }
    }
    nloc = mine > 0u ? mine : 1u; nx = cnt > 0u ? cnt : 1u;
}
__device__ __forceinline__ void xcd_barrier(const XcdBarrier& b) {
    asm volatile("s_waitcnt vmcnt(0)" ::: "memory");
    __syncthreads();
    if (xb_t0(b.wave)) {
        unsigned* bar = b.bar;
        __builtin_amdgcn_s_waitcnt(0);
        unsigned nloc = b.st[0], nx = b.st[1];
        if (nloc == 0u) { xcd_barrier_complete(bar, b.x, nloc, nx); b.st[0] = nloc; b.st[1] = nx; }
        const unsigned old = xb_add(&bar[XB_XSUB(b.x)], 1u);
        const unsigned gen = old / nloc;
        if (old + 1u == (gen + 1u) * nloc) {
            __builtin_amdgcn_fence(__ATOMIC_RELEASE, "agent");
            asm volatile("s_waitcnt vmcnt(0)" ::: "memory");
            const unsigned og = xb_add(&bar[XB_TOP], 1u);
            const unsigned tg = og / nx;
            if (og + 1u == (tg + 1u) * nx) xb_add(&bar[XB_TOPGEN], 1u);
            else XB_SPIN(xb_ld(&bar[XB_TOPGEN]) == tg, bar);
            __builtin_amdgcn_fence(__ATOMIC_ACQUIRE, "agent");
            xb_add(&bar[XB_XGEN(b.x)], 1u);
            asm volatile("s_waitcnt vmcnt(0)" ::: "memory");
        } else {
            XB_SPIN(xb_ld(&bar[XB_XGEN(b.x)]) == gen, bar);
            __builtin_amdgcn_fence(__ATOMIC_ACQUIRE, "agent");
            asm volatile("s_waitcnt vmcnt(0)" ::: "memory");
        }
    }
    __syncthreads();
}

namespace pg8 {
typedef int v4i_t __attribute__((ext_vector_type(4)));
typedef int v8i_t __attribute__((ext_vector_type(8)));
constexpr int BM = 256, BK = 64, HALF = 128, HTB = HALF * BK * 2, STAGE_BYTES = 8 * HTB, NXCD = 8, WGM = 8;
__host__ __device__ __forceinline__ int lds_byte(int r, int c) { const int st = (r >> 4) * 2 + (c >> 5), rr = r & 15, cc = c & 31, ob = rr * 64 + cc * 2; return st * 1024 + (ob ^ (((ob >> 9) & 1) << 5)); }
__host__ __device__ __forceinline__ void stage_rc(int b, int& R, int& C) { const int st = b / 1024, sb = b % 1024, swz = sb ^ (((sb >> 9) & 1) << 5); R = (st >> 1) * 16 + swz / 64; C = (st & 1) * 32 + (swz % 64) / 2; }
__host__ __device__ __forceinline__ int perm32(int rho) { const int n = rho >> 4, i = rho & 15; return 8 * (i >> 2) + 4 * n + (i & 3); }
struct Unit { int pm, pn, z; };
struct Gemm { const bf16* A; const bf16* Bt; int lda, ldb, K; size_t az, bz; };

struct GridOrder {
    int nM, nN, nZ, G, c;
    __device__ void init(int nM_, int nN_, int nZ_, int G_, int c_) { nM = nM_; nN = nN_; nZ = nZ_; G = G_; c = c_; }
    __device__ bool next(int i, Unit& u) const {
        const long L = (long)i * G + c; const int nwg = nM * nN; if (L >= (long)nwg * nZ) return false;
        u.z = (int)(L / nwg); int wgid = (int)(L % nwg);
        { const int q = nwg / NXCD, r = nwg % NXCD, xcd = wgid % NXCD, off = wgid / NXCD; wgid = (xcd < r ? xcd * (q + 1) : r * (q + 1) + (xcd - r) * q) + off; }
        const int nig = WGM * nN, gid = wgid / nig, fm = gid * WGM, gsz = (nM - fm) < WGM ? (nM - fm) : WGM;
        u.pm = fm + ((wgid % nig) % gsz); u.pn = (wgid % nig) / gsz; return true;
    }
    __device__ __forceinline__ void a_ready(const Unit&) const {}
    __device__ __forceinline__ void done(const Unit&) const {}
};
struct PBOrder {
    GridOrder base; int nP, nX;
    __device__ bool next(int i, Unit& u) const {
        const long L = (long)i * base.G + base.c;
        if (L < nP) return base.next(i, u);
        const int e = (int)(L - nP); if (e >= nX) return false;
        u.z = 1; u.pm = e & 1; u.pn = e >> 1; return true; }
    __device__ __forceinline__ void a_ready(const Unit&) const {}
    __device__ __forceinline__ void done(const Unit&) const {}
};
struct MoeOrder {
    int ts[9]; int nN, G, c;
    __device__ bool next(int i, Unit& u) const {
        const long L = (long)i * G + c; const int rt = (int)(L / nN); if (rt >= ts[8]) return false;
        u.pn = (int)(L % nN); u.pm = rt; int e = 0;
#pragma unroll
        for (int j = 1; j < 8; ++j) e += (rt >= ts[j]) ? 1 : 0;
        u.z = e; return true;
    }
    __device__ __forceinline__ void a_ready(const Unit&) const {}
    __device__ __forceinline__ void done(const Unit&) const {}
};

template <class Epi, class Sched, bool ALIGN_EPI = true, bool F8 = false>
__device__ __forceinline__ void gemm_phase(LAS unsigned char* lds, const Gemm g, const Sched& S, const Epi& E, int wave0) {
    int lane_ = (int)__builtin_amdgcn_mbcnt_hi(~0u, __builtin_amdgcn_mbcnt_lo(~0u, 0u)); asm volatile("" : "+v"(lane_));
    const int wid = wave0, lane = lane_, tid = wid * 64 + lane, wr = wid >> 2, wc = wid & 3, fr = lane & 15, fq = lane >> 4;
    const int K = g.K, nt = K / BK;
    unsigned voffA[2], voffB[2];
#pragma unroll
    for (int i = 0; i < 2; ++i) { int R, C; stage_rc(tid * 16 + i * 8192, R, C); const int Rb = Epi::PERM ? ((R & ~31) + perm32(R & 31)) : R;
        voffA[i] = (unsigned)(R * g.lda + C) * 2u; voffB[i] = (unsigned)(Rb * g.ldb + C) * 2u; }
    const size_t kstep = (size_t)(BK * 2);
    const size_t hA = (size_t)HALF * g.lda * 2, hB = (size_t)HALF * g.ldb * 2;
    const unsigned ldsw = (unsigned)wid * 1024u;
    const int aoff = lds_byte(wr * 64 + fr, fq * 8), boff = lds_byte(wc * 32 + fr, fq * 8);
#define PG8_SA(b, h) (((b) * 2 + (h)) * HTB)
#define PG8_SB(b, h) ((4 + (b) * 2 + (h)) * HTB)
#define PG8_STAGE(bufoff, gbase, voff) do { _Pragma("unroll") for (int _i = 0; _i < 2; ++_i) \
        __builtin_amdgcn_global_load_lds((const unsigned*)((const char*)(gbase) + (voff)[_i]), (LAS unsigned*)(lds + (bufoff) + ldsw + _i * 8192), 16, 0, 0); } while (0)
#define PG8_LDA(dst, b, h) do { _Pragma("unroll") for (int m = 0; m < 4; ++m) _Pragma("unroll") for (int k = 0; k < 2; ++k) dst[m][k] = *(const LAS bf16x8*)(lds + PG8_SA(b, h) + aoff + m * 2048 + k * 1024); } while (0)
#define PG8_LDB(dst, b, h) do { _Pragma("unroll") for (int n = 0; n < 2; ++n) _Pragma("unroll") for (int k = 0; k < 2; ++k) dst[n][k] = *(const LAS bf16x8*)(lds + PG8_SB(b, h) + boff + n * 2048 + k * 1024); } while (0)
#define PG8_MMA(ai, bj, At, Bt) do { __builtin_amdgcn_s_setprio(1); \
        if constexpr (F8) { _Pragma("unroll") for (int m = 0; m < 4; ++m) _Pragma("unroll") for (int n = 0; n < 2; ++n) { \
            const v4i_t b0 = __builtin_bit_cast(v4i_t, Bt[n][0]), b1 = __builtin_bit_cast(v4i_t, Bt[n][1]), a0 = __builtin_bit_cast(v4i_t, At[m][0]), a1 = __builtin_bit_cast(v4i_t, At[m][1]); \
            const v8i_t b8 = __builtin_shufflevector(b0, b1, 0, 1, 2, 3, 4, 5, 6, 7), a8 = __builtin_shufflevector(a0, a1, 0, 1, 2, 3, 4, 5, 6, 7); \
            asm volatile("v_mfma_f32_16x16x128_f8f6f4 %0, %1, %2, %0" : "+v"(acc[ai][bj][m][n]) : "v"(b8), "v"(a8)); } }     \
        else { _Pragma("unroll") for (int m = 0; m < 4; ++m) _Pragma("unroll") for (int n = 0; n < 2; ++n) _Pragma("unroll") for (int k = 0; k < 2; ++k) \
            acc[ai][bj][m][n] = __builtin_amdgcn_mfma_f32_16x16x32_bf16(Bt[n][k], At[m][k], acc[ai][bj][m][n], 0, 0, 0); } \
        __builtin_amdgcn_s_setprio(0); } while (0)
#define PG8_WAIT_V(n) asm volatile("s_waitcnt vmcnt(" #n ")" ::: "memory")
#define PG8_WAIT_L(n) asm volatile("s_waitcnt lgkmcnt(" #n ")" ::: "memory")
#define PG8_BAR __builtin_amdgcn_s_barrier()
#define PG8_SCHED __builtin_amdgcn_sched_barrier(0)
    Unit cur, nxt; int ui = 0;
    if (!S.next(0, cur)) return;
    f32x4 acc[2][2][4][2];
#pragma unroll
    for (int a = 0; a < 2; ++a)
#pragma unroll
        for (int b = 0; b < 2; ++b)
#pragma unroll
            for (int m = 0; m < 4; ++m)
#pragma unroll
                for (int n = 0; n < 2; ++n) acc[a][b][m][n] = (f32x4){0.f, 0.f, 0.f, 0.f};
    bf16x8 At[4][2], B0[2][2], B1[2][2];
    const char* cA = (const char*)g.A + (size_t)cur.z * g.az + (size_t)cur.pm * 2 * hA; const char* cB = (const char*)g.Bt + (size_t)cur.z * g.bz + (size_t)cur.pn * 2 * hB;
    S.a_ready(cur);
    PG8_STAGE(PG8_SB(0, 0), cB, voffB); PG8_STAGE(PG8_SB(0, 1), cB + hB, voffB); PG8_STAGE(PG8_SA(0, 0), cA, voffA); PG8_STAGE(PG8_SA(0, 1), cA + hA, voffA);
    if (wr == 1) PG8_BAR;
    PG8_WAIT_V(2); PG8_BAR;
    PG8_STAGE(PG8_SB(1, 0), cB + kstep, voffB); PG8_STAGE(PG8_SA(1, 0), cA + kstep, voffA); PG8_STAGE(PG8_SB(1, 1), cB + hB + kstep, voffB);
    PG8_WAIT_V(6); PG8_BAR;
    for (;;) {
        const bool has_next = S.next(ui + 1, nxt);
        const char* nA = has_next ? (const char*)g.A + (size_t)nxt.z * g.az + (size_t)nxt.pm * 2 * hA : cA; const char* nB = has_next ? (const char*)g.Bt + (size_t)nxt.z * g.bz + (size_t)nxt.pn * 2 * hB : cB;
        for (int t = 0; t < nt; t += 2) {
            const bool last = (t == nt - 2);
            const char* a1 = cA + (size_t)(t + 1) * kstep;
            const char* a2 = last ? nA : cA + (size_t)(t + 2) * kstep; const char* b2 = last ? nB : cB + (size_t)(t + 2) * kstep;
            const char* a3 = a2 + kstep; const char* b3 = b2 + kstep;
            if (last && has_next) S.a_ready(nxt);
            PG8_LDB(B0, 0, 0); PG8_LDB(B1, 0, 1); PG8_SCHED; PG8_LDA(At, 0, 0); PG8_STAGE(PG8_SA(1, 1), a1 + hA, voffA);
            PG8_WAIT_V(8); PG8_WAIT_L(0); PG8_BAR; PG8_MMA(0, 0, At, B0); PG8_MMA(0, 1, At, B1); PG8_BAR; PG8_SCHED;
            PG8_LDA(At, 0, 1); PG8_STAGE(PG8_SB(0, 0), b2, voffB); PG8_STAGE(PG8_SB(0, 1), b2 + hB, voffB); PG8_STAGE(PG8_SA(0, 0), a2, voffA);
            PG8_WAIT_V(8); PG8_WAIT_L(0); PG8_BAR; PG8_MMA(1, 0, At, B0); PG8_MMA(1, 1, At, B1); PG8_BAR; PG8_SCHED;
            PG8_LDB(B0, 1, 0); PG8_LDB(B1, 1, 1); PG8_SCHED; PG8_LDA(At, 1, 0); PG8_STAGE(PG8_SA(0, 1), a2 + hA, voffA);
            PG8_WAIT_V(8); PG8_WAIT_L(0); PG8_BAR; PG8_MMA(0, 0, At, B0); PG8_MMA(0, 1, At, B1); PG8_BAR; PG8_SCHED;
            PG8_LDA(At, 1, 1); PG8_STAGE(PG8_SB(1, 0), b3, voffB); PG8_STAGE(PG8_SB(1, 1), b3 + hB, voffB); PG8_STAGE(PG8_SA(1, 0), a3, voffA);
            PG8_WAIT_V(8); PG8_WAIT_L(0); PG8_BAR; PG8_MMA(1, 0, At, B0); PG8_MMA(1, 1, At, B1); PG8_BAR; PG8_SCHED;
        }
        if constexpr (ALIGN_EPI) { if (wr == 0) PG8_BAR; }
        if constexpr (F8) asm volatile("s_nop 15\n\ts_nop 15\n\ts_nop 15\n\ts_nop 15" ::: "memory");
        if constexpr (!Epi::AFTER_DRAIN) { E(acc, cur, wr, wc, fr, fq); S.done(cur); }
        if (!has_next) break;
#pragma unroll
        for (int a = 0; a < 2; ++a)
#pragma unroll
            for (int b = 0; b < 2; ++b)
#pragma unroll
                for (int m = 0; m < 4; ++m)
#pragma unroll
                    for (int n = 0; n < 2; ++n) acc[a][b][m][n] = (f32x4){0.f, 0.f, 0.f, 0.f};
        cur = nxt; cA = nA; cB = nB; ++ui;
        if constexpr (ALIGN_EPI) { if (wr == 1) PG8_BAR; }
    }
    PG8_WAIT_V(0);
    if constexpr (!ALIGN_EPI) { if (wr == 0) PG8_BAR; }
    PG8_BAR;
    if constexpr (Epi::AFTER_DRAIN) { E.fused(acc, cur, wr, wc, fr, fq, lds, wid, lane); S.done(cur); }
#undef PG8_SA
#undef PG8_SB
#undef PG8_STAGE
#undef PG8_LDA
#undef PG8_LDB
#undef PG8_MMA
#undef PG8_WAIT_V
#undef PG8_WAIT_L
#undef PG8_BAR
#undef PG8_SCHED
}
}
using pg8::Unit; using pg8::HALF; using pg8::BM;
typedef const f32x4 (&AccT)[2][2][4][2];

typedef unsigned long long u64;
__device__ __forceinline__ float rstd_of(const u64* ssq, int row) { return 1.0f / sqrtf((float)ssq[row] * (1.0f / 4294967296.0f) * (1.0f / D) + NORM_EPS); }
__device__ __forceinline__ size_t zblk(int row, int col) { return ((size_t)(row >> 4) * (D / 16) + (col >> 4)) * 256 + (row & 15) * 16 + (col & 15); }
__device__ __forceinline__ float rstd_raw(u64 q) { return 1.0f / sqrtf((float)q * (1.0f / 4294967296.0f) * (1.0f / D) + NORM_EPS); }
__device__ __forceinline__ u64 ssq_fix(float s) { return (u64)(s * 4294967296.0f); }

struct EpiP {
    static constexpr bool PERM = true, AFTER_DRAIN = false;
    bf16* P; bf16* G4; const u64* ssq; int nNP;
    __device__ __forceinline__ void operator()(AccT acc, const Unit& u, int wr, int wc, int fr, int fq) const {
        const int row0 = u.pm * BM + wr * 64 + fr; const bool gate = u.pn >= nNP;
        bf16* base = gate ? G4 : P; const int ld = gate ? D : LDP; const int col0 = (gate ? (u.pn - nNP) : u.pn) * BM + wc * 32 + 8 * fq;
        float rs8[2][4];
#pragma unroll
        for (int ai = 0; ai < 2; ++ai)
#pragma unroll
            for (int m = 0; m < 4; ++m) rs8[ai][m] = rstd_of(ssq, row0 + ai * HALF + m * 16);
#pragma unroll
        for (int ai = 0; ai < 2; ++ai)
#pragma unroll
            for (int m = 0; m < 4; ++m) { const int row = row0 + ai * HALF + m * 16; const float rs = rs8[ai][m]; bf16* rowp = base + (size_t)row * ld + col0;
#pragma unroll
                for (int bj = 0; bj < 2; ++bj) { f32x4 v0 = acc[ai][bj][m][0] * rs, v1 = acc[ai][bj][m][1] * rs;
                    if (gate) {
#pragma unroll
                        for (int j = 0; j < 4; ++j) { v0[j] = sigmoidf_(v0[j]); v1[j] = sigmoidf_(v1[j]); } }
                    u32x4 w; w.x = pk2(v0[0], v0[1]); w.y = pk2(v0[2], v0[3]); w.z = pk2(v1[0], v1[1]); w.w = pk2(v1[2], v1[3]);
                    *(u32x4*)(rowp + bj * HALF) = w; } }
    }
};
struct EpiGate4 {
    static constexpr bool PERM = true, AFTER_DRAIN = false;
    bf16* G4; const u64* ssq;
    __device__ __forceinline__ void operator()(AccT acc, const Unit& u, int wr, int wc, int fr, int fq) const {
        const int row0 = u.pm * BM + wr * 64 + fr, col0 = u.pn * BM + wc * 32 + 8 * fq;
        float rs8[2][4];
#pragma unroll
        for (int ai = 0; ai < 2; ++ai)
#pragma unroll
            for (int m = 0; m < 4; ++m) rs8[ai][m] = rstd_of(ssq, row0 + ai * HALF + m * 16) * W8SI;
#pragma unroll
        for (int ai = 0; ai < 2; ++ai)
#pragma unroll
            for (int m = 0; m < 4; ++m) { const int row = row0 + ai * HALF + m * 16; const float rs = rs8[ai][m];
#pragma unroll
                for (int bj = 0; bj < 2; ++bj) { f32x4 v0 = acc[ai][bj][m][0] * rs, v1 = acc[ai][bj][m][1] * rs;
#pragma unroll
                    for (int j = 0; j < 4; ++j) { v0[j] = sigmoidf_(v0[j]); v1[j] = sigmoidf_(v1[j]); }
                    u32x4 w; w.x = pk2(v0[0], v0[1]); w.y = pk2(v0[2], v0[3]); w.z = pk2(v1[0], v1[1]); w.w = pk2(v1[2], v1[3]);
                    *(u32x4*)(G4 + zblk(row, col0 + bj * HALF)) = w; } }
    }
};
struct EpiF32 {
    static constexpr bool PERM = false, AFTER_DRAIN = false;
    float* C; int ldc;
    __device__ __forceinline__ void operator()(AccT acc, const Unit& u, int wr, int wc, int fr, int fq) const {
        const int row0 = u.pm * BM + wr * 64 + fr, col0 = u.pn * BM + wc * 32 + 4 * fq;
#pragma unroll
        for (int ai = 0; ai < 2; ++ai)
#pragma unroll
            for (int m = 0; m < 4; ++m) { float* rowp = C + (size_t)(row0 + ai * HALF + m * 16) * ldc + col0;
#pragma unroll
                for (int bj = 0; bj < 2; ++bj)
#pragma unroll
                    for (int n = 0; n < 2; ++n) *(f32x4*)(rowp + bj * HALF + n * 16) = acc[ai][bj][m][n]; }
    }
};
struct EpiLora {
    static constexpr bool PERM = false, AFTER_DRAIN = false;
    float* LO; const float* w0; const float* a0; const float* v0; int has_v;
    __device__ __forceinline__ void operator()(AccT acc, const Unit& u, int wr, int wc, int fr, int fq) const {
        const int row0 = u.pm * BM + wr * 64 + fr, col0 = u.pn * BM + wc * 32 + 4 * fq; const int blk = u.pn >> 1;
        f32x4 bias4[2][2];
#pragma unroll
        for (int bj = 0; bj < 2; ++bj)
#pragma unroll
            for (int n = 0; n < 2; ++n) { const int j = (col0 + bj * HALF + n * 16) & 511; f32x4 bb = (f32x4){0.f, 0.f, 0.f, 0.f};
                if (blk == 0) bb = *(const f32x4*)(w0 + j); else if (blk == 1) bb = *(const f32x4*)(a0 + j); else if (blk == 3 && has_v) bb = *(const f32x4*)(v0 + j);
                bias4[bj][n] = bb; }
#pragma unroll
        for (int bj = 0; bj < 2; ++bj)
#pragma unroll
            for (int n = 0; n < 2; ++n) { const int col = col0 + bj * HALF + n * 16; const f32x4 bias = bias4[bj][n];
#pragma unroll
                for (int ai = 0; ai < 2; ++ai)
#pragma unroll
                    for (int m = 0; m < 4; ++m) { f32x4 v = acc[ai][bj][m][n] + bias;
                        if (blk == 0) {
#pragma unroll
                            for (int e = 0; e < 4; ++e) { const float x = v[e]; const float sp = fmaxf(-x, 0.f) + log1pf(__expf(-fabsf(x)));
                                v[e] = __expf(-__expf(-sp - 0.5f)); } }
                        else if (blk != 2) {
#pragma unroll
                            for (int e = 0; e < 4; ++e) v[e] = sigmoidf_(v[e]); }
                        *(f32x4*)(LO + (size_t)(row0 + ai * HALF + m * 16) * 2048 + col) = v; } }
    }
};
struct EpiZ {
    static constexpr bool PERM = true, AFTER_DRAIN = false;
    bf16* ZB;
    __device__ __forceinline__ void operator()(AccT acc, const Unit& u, int wr, int wc, int fr, int fq) const {
        const int row0 = u.pm * BM + wr * 64 + fr, col0 = u.pn * BM + wc * 32 + 8 * fq; bf16* base = ZB + (size_t)u.z * M * D;
#pragma unroll
        for (int ai = 0; ai < 2; ++ai)
#pragma unroll
            for (int m = 0; m < 4; ++m) { const int row = row0 + ai * HALF + m * 16;
#pragma unroll
                for (int bj = 0; bj < 2; ++bj) { const f32x4 v0 = acc[ai][bj][m][0], v1 = acc[ai][bj][m][1];
                    u32x4 w; w.x = pk2(v0[0], v0[1]); w.y = pk2(v0[2], v0[3]); w.z = pk2(v1[0], v1[1]); w.w = pk2(v1[2], v1[3]);
                    *(u32x4*)(base + zblk(row, col0 + bj * HALF)) = w; } }
    }
};
struct EpiG {
    static constexpr bool PERM = false, AFTER_DRAIN = false;
    const bf16* ZB; const bf16* G4; bf16* MG; const u64* ssq; float wsi;
    struct Bat { u64 q[2]; u32x2 g4[2], z4[2], zz[2][4]; };
    __device__ __forceinline__ void load(Bat& B, int k, int row0, int c0) const {
#pragma unroll
        for (int mm = 0; mm < 2; ++mm) { const int row = row0 + (k >> 1) * HALF + (2 * (k & 1) + mm) * 16; const size_t off = zblk(row, c0);
            B.q[mm] = ssq[row]; B.g4[mm] = *(const u32x2*)(G4 + off); B.z4[mm] = *(const u32x2*)(ZB + (size_t)4 * M * D + off);
#pragma unroll
            for (int br = 0; br < 4; ++br) B.zz[mm][br] = *(const u32x2*)(ZB + (size_t)br * M * D + off); }
    }
    __device__ __forceinline__ void operator()(AccT acc, const Unit& u, int wr, int wc, int fr, int fq) const {
        const int row0 = u.pm * BM + wr * 64 + fr, c0 = u.pn * 64 + wc * 16 + 4 * fq;
        Bat b[2]; load(b[0], 0, row0, c0);
#pragma unroll
        for (int k = 0; k < 4; ++k) { const int ai = k >> 1;
            if (k < 3) load(b[(k + 1) & 1], k + 1, row0, c0);
            const Bat& B = b[k & 1];
#pragma unroll
            for (int mm = 0; mm < 2; ++mm) { const int m = 2 * (k & 1) + mm, row = row0 + ai * HALF + m * 16; const float rs = rstd_raw(B.q[mm]) * wsi;
                f32x4 s;
                s[0] = bf2f(B.g4[mm].x & 0xffffu) * bf2f(B.z4[mm].x & 0xffffu); s[1] = bf2f(B.g4[mm].x >> 16) * bf2f(B.z4[mm].x >> 16);
                s[2] = bf2f(B.g4[mm].y & 0xffffu) * bf2f(B.z4[mm].y & 0xffffu); s[3] = bf2f(B.g4[mm].y >> 16) * bf2f(B.z4[mm].y >> 16);
#pragma unroll
                for (int bj = 0; bj < 2; ++bj)
#pragma unroll
                    for (int n = 0; n < 2; ++n) { const int br = 2 * bj + n; const u32x2 z = B.zz[mm][br]; const f32x4 a = acc[ai][bj][m][n] * rs;
                        s[0] += sigmoidf_(a[0]) * bf2f(z.x & 0xffffu); s[1] += sigmoidf_(a[1]) * bf2f(z.x >> 16);
                        s[2] += sigmoidf_(a[2]) * bf2f(z.y & 0xffffu); s[3] += sigmoidf_(a[3]) * bf2f(z.y >> 16); }
                u32x2 w; w.x = pk2(s[0], s[1]); w.y = pk2(s[2], s[3]); *(u32x2*)(MG + (size_t)row * D + c0) = w; } }
    }
};
struct EpiRes {
    static constexpr bool PERM = true, AFTER_DRAIN = false;
    bf16* XH; u64* ssq; unsigned char* XH8;
    __device__ __forceinline__ void operator()(AccT acc, const Unit& u, int wr, int wc, int fr, int fq) const {
        const int row0 = u.pm * BM + wr * 64 + fr, col0 = u.pn * BM + wc * 32 + 8 * fq;
#pragma unroll
        for (int ai = 0; ai < 2; ++ai) {
            u32x4 rv[4][2];
#pragma unroll
            for (int m = 0; m < 4; ++m) { const size_t off = (size_t)(row0 + ai * HALF + m * 16) * D + col0;
#pragma unroll
                for (int bj = 0; bj < 2; ++bj) rv[m][bj] = *(const u32x4*)(XH + off + bj * HALF); }
#pragma unroll
            for (int m = 0; m < 4; ++m) { const int row = row0 + ai * HALF + m * 16; const size_t off = (size_t)row * D + col0; float sq = 0.f;
#pragma unroll
                for (int bj = 0; bj < 2; ++bj) { const size_t o = off + bj * HALF; const u32x4 r = rv[m][bj];
                    const f32x4 v0 = (f32x4){bf2f(r.x & 0xffffu), bf2f(r.x >> 16), bf2f(r.y & 0xffffu), bf2f(r.y >> 16)} + acc[ai][bj][m][0];
                    const f32x4 v1 = (f32x4){bf2f(r.z & 0xffffu), bf2f(r.z >> 16), bf2f(r.w & 0xffffu), bf2f(r.w >> 16)} + acc[ai][bj][m][1];
                    sq += ((v0[0] * v0[0] + v0[1] * v0[1]) + (v0[2] * v0[2] + v0[3] * v0[3])) + ((v1[0] * v1[0] + v1[1] * v1[1]) + (v1[2] * v1[2] + v1[3] * v1[3]));
                    u32x4 w; w.x = pk2(v0[0], v0[1]); w.y = pk2(v0[2], v0[3]); w.z = pk2(v1[0], v1[1]); w.w = pk2(v1[2], v1[3]); *(u32x4*)(XH + o) = w;
                    u32x2 w8; w8.x = pk4_fp8(v0[0], v0[1], v0[2], v0[3]); w8.y = pk4_fp8(v1[0], v1[1], v1[2], v1[3]); *(u32x2*)(XH8 + o) = w8; }
                sq += __shfl_xor(sq, 16); sq += __shfl_xor(sq, 32);
                if (fq == 0) atomicAdd(ssq + row, ssq_fix(sq)); }
            asm volatile("" ::: "memory"); }
    }
};
template <bool OUT8> struct EpiSwiglu {
    static constexpr bool PERM = true, AFTER_DRAIN = false;
    bf16* ACT; int ldc; const u64* ssq; const float* rss; float wsi; float osc;
    __device__ __forceinline__ void operator()(AccT acc, const Unit& u, int wr, int wc, int fr, int fq) const {
        const int row0 = u.pm * BM + wr * 64 + fr, col0 = u.pn * HALF + wc * 32 + 8 * fq;
        float rs8[2][4];
#pragma unroll
        for (int ai = 0; ai < 2; ++ai)
#pragma unroll
            for (int m = 0; m < 4; ++m) { const int row = row0 + ai * HALF + m * 16; rs8[ai][m] = (rss ? rss[row] : rstd_of(ssq, row)) * wsi; }
#pragma unroll
        for (int ai = 0; ai < 2; ++ai)
#pragma unroll
            for (int m = 0; m < 4; ++m) { const int row = row0 + ai * HALF + m * 16; const float rs = rs8[ai][m];
                float o[8];
#pragma unroll
                for (int n = 0; n < 2; ++n)
#pragma unroll
                    for (int e = 0; e < 4; ++e) { const float a = acc[ai][0][m][n][e] * rs, b = acc[ai][1][m][n][e] * rs; o[4 * n + e] = a * sigmoidf_(a) * b; }
                if constexpr (OUT8) { u32x2 w; w.x = pk4_fp8(o[0] * osc, o[1] * osc, o[2] * osc, o[3] * osc); w.y = pk4_fp8(o[4] * osc, o[5] * osc, o[6] * osc, o[7] * osc);
                    *(u32x2*)((unsigned char*)ACT + (size_t)row * ldc + col0) = w; }
                else { u32x4 w; w.x = pk2(o[0], o[1]); w.y = pk2(o[2], o[3]); w.z = pk2(o[4], o[5]); w.w = pk2(o[6], o[7]);
                    *(u32x4*)(ACT + (size_t)row * ldc + col0) = w; } }
    }
};
struct EpiBf {
    static constexpr bool PERM = true, AFTER_DRAIN = false;
    bf16* O; int ldc; float sc;
    __device__ __forceinline__ void operator()(AccT acc, const Unit& u, int wr, int wc, int fr, int fq) const {
        const int row0 = u.pm * BM + wr * 64 + fr, col0 = u.pn * BM + wc * 32 + 8 * fq;
#pragma unroll
        for (int ai = 0; ai < 2; ++ai)
#pragma unroll
            for (int m = 0; m < 4; ++m) { bf16* rowp = O + (size_t)(row0 + ai * HALF + m * 16) * ldc + col0;
#pragma unroll
                for (int bj = 0; bj < 2; ++bj) { const f32x4 v0 = acc[ai][bj][m][0] * sc, v1 = acc[ai][bj][m][1] * sc;
                    u32x4 w; w.x = pk2(v0[0], v0[1]); w.y = pk2(v0[2], v0[3]); w.z = pk2(v1[0], v1[1]); w.w = pk2(v1[2], v1[3]);
                    *(u32x4*)(rowp + bj * HALF) = w; } }
    }
};
struct EpiHP {
    static constexpr bool PERM = false, AFTER_DRAIN = false;
    float* HP;
    __device__ __forceinline__ void operator()(AccT acc, const Unit& u, int wr, int wc, int fr, int fq) const {
        const int row0 = u.pm * BM + wr * 64 + fr, col0 = wc * 32 + 4 * fq; float* base = HP + (size_t)u.z * 1024 * 128;
#pragma unroll
        for (int ai = 0; ai < 2; ++ai)
#pragma unroll
            for (int m = 0; m < 4; ++m) { float* rowp = base + (size_t)(row0 + ai * HALF + m * 16) * 128 + col0;
#pragma unroll
                for (int n = 0; n < 2; ++n) *(f32x4*)(rowp + n * 16) = acc[ai][0][m][n]; }
    }
};
struct CmpFin { const float* HP; const float* b1; const bf16* w2t; const float* gain; bf16* KC; bf16* VCT; };
__device__ __forceinline__ void cmp_finalize(const CmpFin& C_, int z, int pm, LAS unsigned char* lds, int wid, int lane) {
        LAS bf16* H = (LAS bf16*)lds;
        { const int tid = wid * 64 + lane, r = tid >> 1, c0 = (tid & 1) * 64;
#pragma unroll
          for (int j = 0; j < 16; ++j) { const int c = c0 + 4 * j; f32x4 v = *(const f32x4*)(C_.b1 + z * 128 + c);
#pragma unroll
              for (int kp = 0; kp < 4; ++kp) v += *(const f32x4*)(C_.HP + ((size_t)(kp * 2 + z) * 1024 + pm * 256 + r) * 128 + c);
#pragma unroll
              for (int e = 0; e < 4; ++e) { const float x = v[e]; const float t = 0.7978845608f * (x + 0.044715f * x * x * x); const float th = 1.f - 2.f / (__expf(2.f * t) + 1.f); v[e] = 0.5f * x * (1.f + th); }
              u32x2 w; w.x = pk2(v[0], v[1]); w.y = pk2(v[2], v[3]); *(LAS u32x2*)(H + r * 136 + c) = w; } }
        LDS_WAIT(); __syncthreads();
        bf16x8 af[2][4], bfr[4][4];
#pragma unroll
        for (int mt = 0; mt < 2; ++mt)
#pragma unroll
            for (int ks = 0; ks < 4; ++ks) af[mt][ks] = *(const LAS bf16x8*)(H + (wid * 32 + mt * 16 + (lane & 15)) * 136 + ks * 32 + 8 * (lane >> 4));
#pragma unroll
        for (int n = 0; n < 4; ++n)
#pragma unroll
            for (int ks = 0; ks < 4; ++ks) bfr[n][ks] = *(const bf16x8*)(C_.w2t + (size_t)z * 64 * 128 + (16 * n + (lane & 15)) * 128 + ks * 32 + 8 * (lane >> 4));
        asm volatile("s_waitcnt vmcnt(0) lgkmcnt(0)" ::: "memory"); __builtin_amdgcn_sched_barrier(0);
        f32x4 C[2][4];
#pragma unroll
        for (int mt = 0; mt < 2; ++mt)
#pragma unroll
            for (int n = 0; n < 4; ++n) { C[mt][n] = (f32x4){0.f, 0.f, 0.f, 0.f};
#pragma unroll
                for (int ks = 0; ks < 4; ++ks) C[mt][n] = __builtin_amdgcn_mfma_f32_16x16x32_bf16(af[mt][ks], bfr[n][ks], C[mt][n], 0, 0, 0); }
        __builtin_amdgcn_sched_barrier(0);
#pragma unroll
        for (int mt = 0; mt < 2; ++mt)
#pragma unroll
            for (int r = 0; r < 4; ++r) { const int grow = pm * 256 + wid * 32 + mt * 16 + 4 * (lane >> 4) + r;
                const int hh = grow & 1, bc = grow >> 1, b = bc >> 8, c = bc & 255;
                float ss = 0.f;
#pragma unroll
                for (int n = 0; n < 4; ++n) ss += C[mt][n][r] * C[mt][n][r];
                ss = red16_sum(ss);
                if (c < 255) {
                    if (z == 0) { const float rs = 1.0f / sqrtf(ss * (1.f / 64.f) + NORM_EPS); bf16* dst = C_.KC + ((size_t)(b * 2 + hh) * 256 + c) * 64;
#pragma unroll
                        for (int n = 0; n < 4; ++n) { const int d = 16 * n + (lane & 15); dst[d] = (bf16)f2bf(C[mt][n][r] * rs * C_.gain[d]); } }
                    else { bf16* dst = C_.VCT + (size_t)(b * 2 + hh) * 64 * 256 + c;
#pragma unroll
                        for (int n = 0; n < 4; ++n) { const int d = 16 * n + (lane & 15); dst[(size_t)d * 256] = (bf16)f2bf(C[mt][n][r]); } } } }
        __syncthreads();
}

struct Frame {
    LAS unsigned char* lds; int tid, lane, wave, G, bid;
    const float* const* in; unsigned char* ws; unsigned* ctl;
};
__device__ __forceinline__ Frame relaunder(const Frame& F0) { Frame F = F0; int ln = (int)__builtin_amdgcn_mbcnt_hi(~0u, __builtin_amdgcn_mbcnt_lo(~0u, 0u)); asm volatile("" : "+v"(ln)); F.lane = ln; F.wave = F0.wave; F.tid = F0.wave * 64 + ln; return F; }
#define INP(k) (F.in[k])
__device__ __forceinline__ float ldbf(const bf16* p) { return bf2f(*p); }
__device__ __forceinline__ void ld8(const bf16* p, float (&v)[8]) { const u32x4 r = *(const u32x4*)p;
    v[0] = bf2f(r.x & 0xffffu); v[1] = bf2f(r.x >> 16); v[2] = bf2f(r.y & 0xffffu); v[3] = bf2f(r.y >> 16); v[4] = bf2f(r.z & 0xffffu); v[5] = bf2f(r.z >> 16); v[6] = bf2f(r.w & 0xffffu); v[7] = bf2f(r.w >> 16); }
__device__ __forceinline__ void st8(bf16* p, const float (&v)[8]) { u32x4 w; w.x = pk2(v[0], v[1]); w.y = pk2(v[2], v[3]); w.z = pk2(v[4], v[5]); w.w = pk2(v[6], v[7]); *(u32x4*)p = w; }
__device__ __forceinline__ void ldf8(const float* p, float (&v)[8]) { const f32x4 a = *(const f32x4*)p, b = *(const f32x4*)(p + 4); v[0] = a[0]; v[1] = a[1]; v[2] = a[2]; v[3] = a[3]; v[4] = b[0]; v[5] = b[1]; v[6] = b[2]; v[7] = b[3]; }

template <class Fsrc, bool F8 = false>
__device__ __forceinline__ void tr_matrix(const Frame& F, Fsrc f, int nrows, int K, bf16* dst) {
    LAS float* scr = (LAS float*)(F.lds + F.wave * 16384);
    const int gw = F.bid * 8 + F.wave, NGW = F.G * 8, lane = F.lane;
    const int nblk = nrows / 32, nitems = (K / 64) * nblk;
    const int kq = lane >> 3, n4 = (lane & 7) * 4;
    for (int it = gw; it < nitems; it += NGW) {
        const int kb = it / nblk, nb = it % nblk, k0 = 64 * kb, n0 = 32 * nb;
        f32x4 v[8];
#pragma unroll
        for (int i = 0; i < 8; ++i) v[i] = f(n0 + n4, k0 + 8 * i + kq);
#pragma unroll
        for (int i = 0; i < 8; ++i) { LAS float* d = scr + (8 * i + kq) * 33 + n4; d[0] = v[i][0]; d[1] = v[i][1]; d[2] = v[i][2]; d[3] = v[i][3]; }
        LDS_WAIT(); asm volatile("" ::: "memory");
        const int c = lane & 7;
#pragma unroll
        for (int j = 0; j < 4; ++j) { const int n = (lane >> 3) + 8 * j; const LAS float* sp = scr + (8 * c) * 33 + n;
            if constexpr (F8) { u32x2 o; o.x = pk4_fp8(sp[0 * 33], sp[1 * 33], sp[2 * 33], sp[3 * 33]); o.y = pk4_fp8(sp[4 * 33], sp[5 * 33], sp[6 * 33], sp[7 * 33]);
                *(u32x2*)((unsigned char*)dst + (size_t)(n0 + n) * K + k0 + 8 * c) = o; }
            else { u32x4 o; o.x = pk2(sp[0 * 33], sp[1 * 33]); o.y = pk2(sp[2 * 33], sp[3 * 33]); o.z = pk2(sp[4 * 33], sp[5 * 33]); o.w = pk2(sp[6 * 33], sp[7 * 33]);
                *(u32x4*)(dst + (size_t)(n0 + n) * K + k0 + 8 * c) = o; } }
        LDS_WAIT(); asm volatile("" ::: "memory");
    }
}
#define F4Z ((f32x4){0.f, 0.f, 0.f, 0.f})
struct SrcWP { const float* win; const float* vres; const float* gain; int l, NP;
    __device__ __forceinline__ f32x4 operator()(int n, int k) const {
        f32x4 v;
        if (n < 5848) v = *(const f32x4*)(win + (size_t)k * NIN + n);
        else if (n < NP) v = (l == 1 && n < 5912) ? *(const f32x4*)(vres + (size_t)k * 64 + (n - 5848)) : F4Z;
        else v = *(const f32x4*)(win + (size_t)k * NIN + PC_GATE + 4 * 2048 + (n - NP));
        return v * gain[k]; } };
struct SrcWG4 { const float* win; const float* gain;
    __device__ __forceinline__ f32x4 operator()(int n, int k) const { return *(const f32x4*)(win + (size_t)k * NIN + PC_GATE + 4 * 2048 + n) * (gain[k] * W8S); } };
struct SrcWG { const float* win; const float* gain; float sc;
    __device__ __forceinline__ f32x4 operator()(int n, int k) const {
        const int j = n >> 8, rho = n & 255, bj = rho >> 7, wc = (rho >> 5) & 3, nn = (rho >> 4) & 1, q = (rho >> 2) & 3;
        const int br = 2 * bj + nn, c = 64 * j + 16 * wc + 4 * q;
        return *(const f32x4*)(win + (size_t)k * NIN + PC_GATE + br * 2048 + c) * (gain[k] * sc); } };
struct SrcWB { const float* wb; const float* pw; const float* ps;
    __device__ __forceinline__ f32x4 operator()(int n, int k) const {
        if (n < 8192) { const int i = n >> 11, c = n & 2047; return *(const f32x4*)(wb + ((size_t)i * 512 + k) * 2048 + c); }
        const int c = n - 8192, g = c >> 9;
        if ((k >> 7) != g) return F4Z;
        return *(const f32x4*)(pw + ((size_t)g * 128 + (k & 127)) * 512 + (c & 511)) * *(const f32x4*)(ps + c); } };
struct SrcPlain { const float* w; int ldw;
    __device__ __forceinline__ f32x4 operator()(int n, int k) const { return *(const f32x4*)(w + (size_t)k * ldw + n); } };
struct SrcPlainS { const float* w; int ldw; float sc;
    __device__ __forceinline__ f32x4 operator()(int n, int k) const { return *(const f32x4*)(w + (size_t)k * ldw + n) * sc; } };
struct SrcPlainG { const float* w; int ldw; const float* gain;
    __device__ __forceinline__ f32x4 operator()(int n, int k) const { return *(const f32x4*)(w + (size_t)k * ldw + n) * gain[k]; } };
struct SrcLora { const float* w2; const float* a2; const float* g2; const float* vup; int l;
    __device__ __forceinline__ f32x4 operator()(int n, int k) const {
        const int blk = n >> 9, j = n & 511;
        if (blk == 0) return k < 96 ? *(const f32x4*)(w2 + (size_t)k * 512 + j) : F4Z;
        if (blk == 1) return (k >= 96 && k < 192) ? *(const f32x4*)(a2 + (size_t)(k - 96) * 512 + j) : F4Z;
        if (blk == 2) return (k >= 192 && k < 448) ? *(const f32x4*)(g2 + (size_t)(k - 192) * 512 + j) : F4Z;
        return (l == 1 && k >= 448) ? *(const f32x4*)(vup + (size_t)(k - 448) * 512 + j) : F4Z; } };
struct SrcC1 { const float* w1;
    __device__ __forceinline__ f32x4 operator()(int n, int k) const { const int i = n >> 8, c = n & 255; return c < 128 ? *(const f32x4*)(w1 + ((size_t)i * 2048 + k) * 128 + c) : F4Z; } };
struct SrcW13 { const float* w1; const float* w3; const float* gain; int ffw; float sc;
    __device__ __forceinline__ f32x4 operator()(int n, int k) const { const int t = n >> 8, which = (n >> 7) & 1, ff = 128 * t + (n & 127);
        const uintptr_t a = (uintptr_t)w1, dlt = (uintptr_t)w3 - a; const float* p = (const float*)(a + (which ? dlt : (uintptr_t)0));
        return *(const f32x4*)(p + (size_t)k * ffw + ff) * (gain[k] * sc); } };

constexpr int N_LATE_CHUNKS = 512;
template <int PART>
__device__ __forceinline__ void convert_late(const Frame& F) {
    unsigned char* ws = F.ws;
    if (PART == 0) {
    tr_matrix<SrcW13, F8_F1 != 0>(F, SrcW13{INP(33), INP(34), INP(3), FF, F8_F1 ? W8S : 1.f}, 2 * FF, 2048, (bf16*)(ws + WS_W13T));
    tr_matrix(F, SrcPlain{INP(35), D}, 2048, FF, (bf16*)(ws + WS_W2T)); }
    for (int e = PART * (NE / 2); e < (PART + 1) * (NE / 2); ++e) {
        tr_matrix<SrcW13, F8_M1 != 0>(F, SrcW13{INP(37) + (size_t)e * D * EFF, INP(38) + (size_t)e * D * EFF, INP(3) + D, EFF, F8_M1 ? W8S : 1.f}, 2 * EFF, 2048, (bf16*)(ws + WS_MW13T + (size_t)e * 2 * EFF * 2048 * (F8_M1 ? 1 : 2)));
        tr_matrix<SrcPlainS, F8_M2 != 0>(F, SrcPlainS{INP(39) + (size_t)e * EFF * D, D, F8_M2 ? W8S : 1.f}, 2048, EFF, (bf16*)(ws + WS_MW2T + (size_t)e * 2048 * EFF * (F8_M2 ? 1 : 2)));
    }
}
template <int PART>
__device__ __forceinline__ void convert_late_loop(const Frame& F0, unsigned* cq) {
    Frame F = relaunder(F0);
    LAS int* UQ = (LAS int*)(F.lds + 131072 + 64);
    for (;;) {
        __syncthreads();
        if (F.tid == 0) UQ[0] = (int)atomicAdd(cq, 1u);
        LDS_WAIT(); __syncthreads();
        const int c = UQ[0]; if (c >= N_LATE_CHUNKS) break;
        Frame Fc = F; Fc.bid = c; Fc.G = N_LATE_CHUNKS; convert_late<PART>(Fc);
    }
}
__device__ __forceinline__ void phase_prologue(const Frame& F0) {
    const Frame F = relaunder(F0);
    unsigned char* ws = F.ws;
    for (int l = 0; l < 2; ++l) {
        const float* win = INP(5) + (size_t)l * D * NIN; const float* gmix = INP(2) + l * D;
        tr_matrix(F, SrcWP{win, INP(17), gmix, l, l ? NP1 : NP0}, (l ? NP1 : NP0), 2048, (bf16*)(ws + (l ? WS_WPT1 : WS_WPT0)));
        tr_matrix<SrcWG4, true>(F, SrcWG4{win, gmix}, 2048, 2048, (bf16*)(ws + (l ? WS_WG4T1 : WS_WG4T0)));
        tr_matrix<SrcWG, F8_G != 0>(F, SrcWG{win, gmix, F8_G ? W8S : 1.f}, 8192, 2048, (bf16*)(ws + (l ? WS_WGT1 : WS_WGT0)));
        tr_matrix(F, SrcWB{INP(31) + (size_t)l * 4 * 512 * 2048, INP(27) + (size_t)l * 4 * 128 * 512, INP(28) + l * D}, 10240, 512, (bf16*)(ws + (l ? WS_WBT1 : WS_WBT0)));
        tr_matrix(F, SrcPlain{INP(32) + (size_t)l * D * D, D}, 2048, 2048, (bf16*)(ws + (l ? WS_WOT1 : WS_WOT0)));
        tr_matrix(F, SrcLora{INP(8) + (size_t)l * 96 * 512, INP(10) + (size_t)l * 96 * 512, INP(11) + (size_t)l * 256 * 512, INP(20), l}, 2048, 512, (bf16*)(ws + (l ? WS_WLT1 : WS_WLT0)));
        tr_matrix(F, SrcPlainG{INP(29) + (size_t)l * D * 1024, 1024, INP(4) + l * D}, 1024, 2048, (bf16*)(ws + (l ? WS_WKVT1 : WS_WKVT0)));
        tr_matrix(F, SrcC1{INP(23) + (size_t)l * 2 * 2048 * 128}, 512, 2048, (bf16*)(ws + (l ? WS_WC1T1 : WS_WC1T0)));
        for (int i = 0; i < 2; ++i) tr_matrix(F, SrcPlain{INP(25) + (size_t)(l * 2 + i) * 128 * 64, 64}, 64, 128, (bf16*)(ws + WS_WC2T) + (size_t)(l * 2 + i) * 64 * 128);
    }
    const int gw = F.bid * 8 + F.wave, NGW = F.G * 8;
    u64* ssq = (u64*)(F.ctl + CW_SSQ);
    for (int base = F.bid * 16; base < M + 512; base += F.G * 16) for (int q = 0; q < 2; ++q) { const int m = base + F.wave * 2 + q;
        const bool ismem = m >= M; const float* src = ismem ? INP(1) + (size_t)(m - M) * D : INP(0) + (size_t)m * D;
        const f32x4* xr = (const f32x4*)src + F.lane; f32x4 v[8]; float s = 0.f;
#pragma unroll
        for (int j = 0; j < 8; ++j) { v[j] = xr[64 * j]; s += (v[j][0] * v[j][0] + v[j][1] * v[j][1]) + (v[j][2] * v[j][2] + v[j][3] * v[j][3]); }
        s = wave_sum(s);
        float sc = 1.f;
        if (ismem) sc = 1.0f / sqrtf(s * (1.f / D) + NORM_EPS); else if (F.lane == 0) ssq[m] = ssq_fix(s);
        bf16* dst = ismem ? (bf16*)(ws + WS_MEMN) + (size_t)(m - M) * D : (bf16*)(ws + WS_XH) + (size_t)m * D;
#pragma unroll
        for (int j = 0; j < 8; ++j) { u32x2 w; w.x = pk2(v[j][0] * sc, v[j][1] * sc); w.y = pk2(v[j][2] * sc, v[j][3] * sc); *((u32x2*)dst + F.lane + 64 * j) = w;
            if (!ismem) *((unsigned*)(ws + WS_XH8 + (size_t)m * D) + F.lane + 64 * j) = pk4_fp8(v[j][0], v[j][1], v[j][2], v[j][3]); }
    }
}

__device__ __forceinline__ float shiftP(const bf16* P, int m, int t, int col, float mu) {
    const float u = ldbf(P + (size_t)m * LDP + col); const float pv = t > 0 ? ldbf(P + (size_t)(m - 1) * LDP + col) : 0.f; return u + (pv - u) * mu;
}
__device__ __forceinline__ void phase_prep(const Frame& F0, int l) {
    const Frame F = relaunder(F0);
    unsigned char* ws = F.ws; const bf16* P = (const bf16*)(ws + WS_P);
    const float* mu = INP(6) + l * 1984; const float* vmu = INP(18);
    bf16* AL = (bf16*)(ws + WS_ALORA); bf16* QN = (bf16*)(ws + WS_QN); bf16* QM = (bf16*)(ws + WS_QM); bf16* Y = (bf16*)(ws + WS_Y);
    const float* qkg = INP(21) + l * 4 * 64; const float* mqg = INP(30) + l * 2 * 128;
    const float* cpos = INP(22) + (size_t)l * 2 * 32 * 64; const float* cw = INP(26) + l * 3 * 512;
    const int tid = F.tid, lane = F.lane, wave = F.wave;
    for (int tile = F.bid; tile < M / 32; tile += F.G) {
        const int m0 = tile * 32, b = m0 / T, t0 = m0 % T;
#pragma unroll
        for (int it_ = 0; it_ < 4; ++it_) { const int it = tid + it_ * 512; const int tt = it >> 6, g = it & 63, c = g * 8, m = m0 + tt, t = t0 + tt;
            int pc, kind; const float* mup;
            if (c < 96) { pc = PC_WD + c; kind = 0; mup = mu + pc; } else if (c < 192) { pc = PC_AD + c - 96; kind = 1; mup = mu + pc; }
            else if (c < 448) { pc = PC_GD + c - 192; kind = 2; mup = mu + pc; } else { pc = PC_VRES + c - 448; kind = 3; mup = vmu + (c - 448); }
            float o[8];
            if (kind == 3 && l == 0) {
#pragma unroll
                for (int j = 0; j < 8; ++j) o[j] = 0.f; }
            else { float u[8], pv[8], mm[8]; ld8(P + (size_t)m * LDP + pc, u); ldf8(mup, mm);
                if (t > 0) ld8(P + (size_t)(m - 1) * LDP + pc, pv); else {
#pragma unroll
                    for (int j = 0; j < 8; ++j) pv[j] = 0.f; }
#pragma unroll
                for (int j = 0; j < 8; ++j) { const float x = u[j] + (pv[j] - u[j]) * mm[j]; o[j] = kind == 0 ? tanhf(x) : (kind == 2 ? sigmoidf_(x) : x); } }
            st8(AL + (size_t)m * 512 + c, o); }
        for (int tt = wave; tt < 32; tt += 8) { const int m = m0 + tt;
            { float v[8]; float s = 0.f; const u32x4 raw = *(const u32x4*)(P + (size_t)m * LDP + PC_Q + lane * 8);
              v[0] = bf2f(raw.x & 0xffffu); v[1] = bf2f(raw.x >> 16); v[2] = bf2f(raw.y & 0xffffu); v[3] = bf2f(raw.y >> 16); v[4] = bf2f(raw.z & 0xffffu); v[5] = bf2f(raw.z >> 16); v[6] = bf2f(raw.w & 0xffffu); v[7] = bf2f(raw.w >> 16);
#pragma unroll
              for (int j = 0; j < 8; ++j) s += v[j] * v[j];
              s += __shfl_xor(s, 1); s += __shfl_xor(s, 2); s += __shfl_xor(s, 4);
              const float rs = CQ_NSA / sqrtf(s * (1.f / 64.f) + NORM_EPS); const int d0 = (lane & 7) * 8;
              u32x4 w; w.x = pk2(v[0] * rs * qkg[d0 + 0], v[1] * rs * qkg[d0 + 1]); w.y = pk2(v[2] * rs * qkg[d0 + 2], v[3] * rs * qkg[d0 + 3]); w.z = pk2(v[4] * rs * qkg[d0 + 4], v[5] * rs * qkg[d0 + 5]); w.w = pk2(v[6] * rs * qkg[d0 + 6], v[7] * rs * qkg[d0 + 7]);
              *(u32x4*)(QN + (size_t)m * 512 + lane * 8) = w; }
            { float v[8]; float s = 0.f; const u32x4 raw = *(const u32x4*)(P + (size_t)m * LDP + PC_MEM + lane * 8);
              v[0] = bf2f(raw.x & 0xffffu); v[1] = bf2f(raw.x >> 16); v[2] = bf2f(raw.y & 0xffffu); v[3] = bf2f(raw.y >> 16); v[4] = bf2f(raw.z & 0xffffu); v[5] = bf2f(raw.z >> 16); v[6] = bf2f(raw.w & 0xffffu); v[7] = bf2f(raw.w >> 16);
#pragma unroll
              for (int j = 0; j < 8; ++j) s += v[j] * v[j];
              s += __shfl_xor(s, 1); s += __shfl_xor(s, 2); s += __shfl_xor(s, 4); s += __shfl_xor(s, 8);
              const float rs = CQ_MEM / sqrtf(s * (1.f / 128.f) + NORM_EPS); const int d0 = (lane & 15) * 8;
              u32x4 w; w.x = pk2(v[0] * rs * mqg[d0 + 0], v[1] * rs * mqg[d0 + 1]); w.y = pk2(v[2] * rs * mqg[d0 + 2], v[3] * rs * mqg[d0 + 3]); w.z = pk2(v[4] * rs * mqg[d0 + 4], v[5] * rs * mqg[d0 + 5]); w.w = pk2(v[6] * rs * mqg[d0 + 6], v[7] * rs * mqg[d0 + 7]);
              *(u32x4*)(QM + (size_t)m * 512 + lane * 8) = w; }
            for (int which = 0; which < 2; ++which) { const int pc = which ? PC_KW : PC_KS; const float* gn = qkg + (which ? 3 : 2) * 64;
                const unsigned raw = *(const unsigned*)(P + (size_t)m * LDP + pc + lane * 2); const float a = bf2f(raw & 0xffffu), c2 = bf2f(raw >> 16);
                float s = a * a + c2 * c2; s += __shfl_xor(s, 1); s += __shfl_xor(s, 2); s += __shfl_xor(s, 4); s += __shfl_xor(s, 8); s += __shfl_xor(s, 16);
                const float rs = 1.0f / sqrtf(s * (1.f / 64.f) + NORM_EPS); const int kvh = lane >> 5, d = (lane & 31) * 2;
                bf16* dst = (bf16*)(ws + (which ? WS_KW : WS_KS)) + ((size_t)(b * 2 + kvh) * T + (t0 + tt)) * 64 + d;
                *(unsigned*)dst = pk2(a * rs * gn[d], c2 * rs * gn[d + 1]); }
        }
        if ((tile & 1) == 0) { const int col = tid & 127, tq = tid >> 7, kvh = col >> 6, d = col & 63;
          for (int which = 0; which < 2; ++which) { const int pc = which ? PC_VW : PC_VS;
            for (int q2 = 0; q2 < 2; ++q2) { const int tg = tq + 4 * q2; unsigned short v[8];
#pragma unroll
              for (int i = 0; i < 8; ++i) v[i] = P[(size_t)(m0 + tg * 8 + i) * LDP + pc + col];
              u32x4 w; w.x = v[0] | ((unsigned)v[1] << 16); w.y = v[2] | ((unsigned)v[3] << 16); w.z = v[4] | ((unsigned)v[5] << 16); w.w = v[6] | ((unsigned)v[7] << 16);
              *(u32x4*)((bf16*)(ws + (which ? WS_VWT : WS_VST)) + ((size_t)(b * 2 + kvh) * 64 + d) * T + t0 + tg * 8) = w; } } }
#pragma unroll
        for (int it_ = 0; it_ < 2; ++it_) { const int it = tid + it_ * 512; const int tt = it >> 5, r = (it & 31) * 8, i = r >> 7, h = (r >> 6) & 1, d = r & 63, t = t0 + tt, m = m0 + tt;
            float v[8], p1[8], o[8]; ld8(P + (size_t)m * LDP + PC_KC + r, v);
            bf16* A = (bf16*)(ws + WS_ACMP) + (size_t)i * 1024 * 2048;
            const int c1 = t >> 4, l1 = t & 15;
            if (c1 <= 254) { ldf8(cpos + (i * 32 + l1) * 64 + d, p1);
#pragma unroll
                for (int j = 0; j < 8; ++j) o[j] = v[j] + p1[j];
                st8(A + ((size_t)(b * 256 + c1) * 2 + h) * 2048 + l1 * 64 + d, o); }
            if (c1 >= 1) { ldf8(cpos + (i * 32 + l1 + 16) * 64 + d, p1);
#pragma unroll
                for (int j = 0; j < 8; ++j) o[j] = v[j] + p1[j];
                st8(A + ((size_t)(b * 256 + c1 - 1) * 2 + h) * 2048 + (l1 + 16) * 64 + d, o); } }
#pragma unroll
        for (int it_ = 0; it_ < 4; ++it_) { const int it = tid + it_ * 512; const int tt = it >> 6, c = (it & 63) * 8, m = m0 + tt, t = t0 + tt;
            float acc[8], bg[8];
#pragma unroll
            for (int j = 0; j < 8; ++j) acc[j] = 0.f;
#pragma unroll
            for (int k = 0; k < 3; ++k) { const int dt = 2 - k; if (t - dt >= 0) { float cg[8], xg[8], wv[8]; const size_t o = (size_t)(m - dt) * LDP; ld8(P + o + PC_CC + c, cg); ld8(P + o + PC_CX + c, xg); ldf8(cw + k * 512 + c, wv);
#pragma unroll
                    for (int j = 0; j < 8; ++j) acc[j] += wv[j] * cg[j] * xg[j]; } }
            ld8(P + (size_t)m * LDP + PC_CB + c, bg);
#pragma unroll
            for (int j = 0; j < 8; ++j) acc[j] *= bg[j];
            st8(Y + (size_t)m * 2560 + 1024 + c, acc); }
        { const int cgp = tid & 63, tg = tid >> 6, c = cgp * 8, w = 2 << (cgp >> 4); const int ts = t0 + tg * 4, ms = m0 + tg * 4;
          float sum[8];
#pragma unroll
          for (int j = 0; j < 8; ++j) sum[j] = 0.f;
#pragma unroll
          for (int k = 1; k < 16; ++k) if (k < w && ts - k >= 0) { float u[8]; ld8(P + (size_t)(ms - k) * LDP + PC_POOL + c, u);
#pragma unroll
              for (int j = 0; j < 8; ++j) sum[j] += u[j]; }
          for (int q = 0; q < 4; ++q) { const int t = ts + q, m = ms + q; float u[8], o[8]; ld8(P + (size_t)m * LDP + PC_POOL + c, u);
#pragma unroll
              for (int j = 0; j < 8; ++j) sum[j] += u[j];
              const int cnt = (t + 1) < w ? (t + 1) : w; const float ic = 1.f / (float)cnt;
#pragma unroll
              for (int j = 0; j < 8; ++j) o[j] = sum[j] * ic - u[j];
              st8(Y + (size_t)m * 2560 + 2048 + c, o);
              if (t - w + 1 >= 0) { float ud[8]; ld8(P + (size_t)(m - w + 1) * LDP + PC_POOL + c, ud);
#pragma unroll
                  for (int j = 0; j < 8; ++j) sum[j] -= ud[j]; } } }
    }
    { const float* KV = (const float*)(ws + WS_KVRAW) + l * 1024; bf16* KM = (bf16*)(ws + WS_KMEM); bf16* VM = (bf16*)(ws + WS_VMEMT); const float* kg = mqg + 128;
      for (int r = F.bid * 8 + wave; r < 512; r += F.G * 8) { const int b = r >> 8, j = r & 255;
          for (int h = 0; h < 4; ++h) { const float a = KV[(size_t)r * 2048 + h * 128 + lane], c2 = KV[(size_t)r * 2048 + h * 128 + 64 + lane];
              const float s = wave_sum(a * a + c2 * c2); const float rs = 1.0f / sqrtf(s * (1.f / 128.f) + NORM_EPS);
              bf16* dst = KM + ((size_t)(b * 4 + h) * 256 + j) * 128; dst[lane] = (bf16)f2bf(a * rs * kg[lane]); dst[64 + lane] = (bf16)f2bf(c2 * rs * kg[64 + lane]); } }
      for (int it = F.bid * 8 + wave; it < 1024; it += F.G * 8) { const int b = it >> 9, h = (it >> 7) & 3, d = it & 127;
#pragma unroll
          for (int k = 0; k < 4; ++k) { const int j = lane + 64 * k; VM[((size_t)(b * 4 + h) * 128 + d) * 256 + j] = (bf16)f2bf(KV[(size_t)(b * 256 + j) * 2048 + 512 + h * 128 + d]); } } }
}

template <int DH> struct AttL { static constexpr int KB = 64 * (DH + 8) * 2, VB = DH * 72 * 2, BUF = KB + VB, PW = 2 * BUF, END = PW + 8 * 16 * 72 * 2; };
constexpr int AT_PT = AttL<64>::END, AT_IMP = AT_PT + 32768, AT_SEL = AT_IMP + 8192, AT_UNI = AT_SEL + 256;
static_assert(AttL<128>::END <= RING_BYTES && AT_UNI + 64 <= RING_BYTES, "attention LDS map");
template <int DH, int MODE>
__device__ __forceinline__ void attn_pass(LAS unsigned char* lds, int tid, int lane, int wave, const bf16* Kg, const bf16* VTg, int ldvt, int jlo, int jhi,
                                          const bf16x8 (&qf)[DH / 32], f32x4 (&O)[DH / 16], float (&lsum)[4], int trow, unsigned sel0, unsigned sel1, unsigned uni0, unsigned uni1) {
    typedef AttL<DH> L;
    constexpr int KS = DH + 8;
    LAS bf16* PW = (LAS bf16*)(lds + L::PW) + wave * 16 * 72;
    const unsigned long long um = MODE == 2 ? (((unsigned long long)uni1 << 32) | uni0) : ~0ull;
    auto next_tile = [&](int from) -> int {
        if (from > jhi) return jhi + 1;
        if (MODE != 2) return from;
        const unsigned long long m = um >> from; if (m == 0ull) return jhi + 1;
        const int nx = from + __builtin_ctzll(m); return nx > jhi ? jhi + 1 : nx; };
    u32x4 kreg[DH / 64], vreg[DH / 64];
#define AT_LOADREGS(jt) do { _Pragma("unroll") for (int i = 0; i < DH / 64; ++i) { const int e = tid + i * 512; const int kr = e / (DH / 8), kc = (e % (DH / 8)) * 8; const int vr = e >> 3, vc = (e & 7) * 8; \
        kreg[i] = *(const u32x4*)(Kg + (size_t)(64 * (jt) + kr) * DH + kc); vreg[i] = *(const u32x4*)(VTg + (size_t)vr * ldvt + 64 * (jt) + vc); } } while (0)
#define AT_WRITELDS(bf) do { LAS bf16* KTw = (LAS bf16*)(lds + (bf) * L::BUF); LAS bf16* VTw = (LAS bf16*)(lds + (bf) * L::BUF + L::KB); \
        _Pragma("unroll") for (int i = 0; i < DH / 64; ++i) { const int e = tid + i * 512; const int kr = e / (DH / 8), kc = (e % (DH / 8)) * 8; const int vr = e >> 3, vc = (e & 7) * 8; \
        const int krp = 16 * (2 * (kr >> 5) + (kr & 1)) + ((kr >> 1) & 15); \
        *(LAS u32x4*)(KTw + krp * KS + kc) = kreg[i]; *(LAS u32x4*)(VTw + vr * 72 + vc) = vreg[i]; } } while (0)
    int jc = next_tile(jlo);
    if (jc > jhi) return;
    AT_LOADREGS(jc);
    __syncthreads();
    AT_WRITELDS(0);
    int jn = next_tile(jc + 1);
    if (jn <= jhi) AT_LOADREGS(jn);
    LDS_WAIT(); __syncthreads();
    int cur = 0;
    for (;;) {
        int jnn = jhi + 1;
        if (jn <= jhi) { AT_WRITELDS(cur ^ 1); jnn = next_tile(jn + 1); if (jnn <= jhi) AT_LOADREGS(jnn); }
        const int j = jc;
        const LAS bf16* KT = (const LAS bf16*)(lds + cur * L::BUF); const LAS bf16* VT = (const LAS bf16*)(lds + cur * L::BUF + L::KB);
        bool doit = true;
        if (MODE == 2) { const unsigned sb = j < 32 ? (sel0 >> j) : (sel1 >> (j - 32)); doit = __builtin_amdgcn_ballot_w64((sb & 1u) != 0u) != 0ull; }
        if (doit) {
        f32x4 S[4];
        { bf16x8 kfr[4][DH / 32];
#pragma unroll
          for (int n = 0; n < 4; ++n)
#pragma unroll
              for (int ks = 0; ks < DH / 32; ++ks) kfr[n][ks] = *(const LAS bf16x8*)(KT + (16 * n + (lane & 15)) * KS + ks * 32 + 8 * (lane >> 4));
          LDS_WAIT(); __builtin_amdgcn_sched_barrier(0);
#pragma unroll
          for (int n = 0; n < 4; ++n) { S[n] = (f32x4){0.f, 0.f, 0.f, 0.f};
#pragma unroll
              for (int ks = 0; ks < DH / 32; ++ks) S[n] = __builtin_amdgcn_mfma_f32_16x16x32_bf16(qf[ks], kfr[n][ks], S[n], 0, 0, 0); }
          __builtin_amdgcn_sched_barrier(0); }
        bool valid[4];
#pragma unroll
        for (int n = 0; n < 4; ++n) { const int key = 64 * j + 32 * (n >> 1) + 2 * (lane & 15) + (n & 1);
            if (MODE == 0) valid[n] = true;
            else if (MODE == 1) valid[n] = (key <= 254) && (16 * key + 31 <= trow);
            else if (MODE == 2) { const unsigned sb = j < 32 ? (sel0 >> j) : (sel1 >> (j - 32)); valid[n] = (sb & 1u) && key <= trow; }
            else valid[n] = key <= trow && key > trow - 512; }
#pragma unroll
        for (int a2 = 0; a2 < 2; ++a2)
#pragma unroll
            for (int r = 0; r < 4; ++r) { float p0 = __builtin_amdgcn_exp2f(S[2 * a2][r]), p1 = __builtin_amdgcn_exp2f(S[2 * a2 + 1][r]);
                if (MODE != 0) { p0 = valid[2 * a2] ? p0 : 0.f; p1 = valid[2 * a2 + 1] ? p1 : 0.f; }
                lsum[r] += p0 + p1;
                *(LAS unsigned*)(PW + (4 * (lane >> 4) + r) * 72 + 32 * a2 + 2 * (lane & 15)) = pk2(p0, p1); }
        LDS_WAIT(); asm volatile("" ::: "memory");
        { bf16x8 pfr[2], vfr[2][DH / 16];
#pragma unroll
          for (int ks = 0; ks < 2; ++ks) { pfr[ks] = *(const LAS bf16x8*)(PW + (lane & 15) * 72 + ks * 32 + 8 * (lane >> 4));
#pragma unroll
              for (int nd = 0; nd < DH / 16; ++nd) vfr[ks][nd] = *(const LAS bf16x8*)(VT + (16 * nd + (lane & 15)) * 72 + ks * 32 + 8 * (lane >> 4)); }
          LDS_WAIT(); __builtin_amdgcn_sched_barrier(0);
#pragma unroll
          for (int ks = 0; ks < 2; ++ks)
#pragma unroll
              for (int nd = 0; nd < DH / 16; ++nd) O[nd] = __builtin_amdgcn_mfma_f32_16x16x32_bf16(pfr[ks], vfr[ks][nd], O[nd], 0, 0, 0);
          __builtin_amdgcn_sched_barrier(0); }
        }
        if (jn > jhi) break;
        LDS_WAIT(); __syncthreads();
        cur ^= 1; jc = jn; jn = jnn;
    }
#undef AT_LOADREGS
#undef AT_WRITELDS
}

__device__ __forceinline__ void phase_memattn(const Frame& F0) {
    const Frame F = relaunder(F0);
    unsigned char* ws = F.ws; const bf16* QM = (const bf16*)(ws + WS_QM); const bf16* KM = (const bf16*)(ws + WS_KMEM); const bf16* VM = (const bf16*)(ws + WS_VMEMT); bf16* Y = (bf16*)(ws + WS_Y);
    const int lane = F.lane, wave = F.wave; const float c = 0.08838834764831845f * 1.4426950408889634f;
    for (int u = F.bid; u < 256; u += F.G) { const int b = u >> 7, h = (u >> 5) & 3, tile = u & 31; const int m0 = b * T + tile * 128 + wave * 16;
        bf16x8 qf[4];
#pragma unroll
        for (int ks = 0; ks < 4; ++ks) qf[ks] = *(const bf16x8*)(QM + (size_t)(m0 + (lane & 15)) * 512 + h * 128 + ks * 32 + 8 * (lane >> 4));
        f32x4 O[8]; float ls[4];
#pragma unroll
        for (int i = 0; i < 8; ++i) O[i] = (f32x4){0.f, 0.f, 0.f, 0.f};
#pragma unroll
        for (int r = 0; r < 4; ++r) ls[r] = 0.f;
        attn_pass<128, 0>(F.lds, F.tid, lane, wave, KM + (size_t)(b * 4 + h) * 256 * 128, VM + (size_t)(b * 4 + h) * 128 * 256, 256, 0, 3, qf, O, ls, 0, 0u, 0u, 0u, 0u);
#pragma unroll
        for (int r = 0; r < 4; ++r) { const float lr = red16_sum(ls[r]); const float inv = lr > 0.f ? 1.f / lr : 0.f; const int m = m0 + 4 * (lane >> 4) + r;
#pragma unroll
            for (int nd = 0; nd < 8; ++nd) Y[(size_t)m * 2560 + 1536 + h * 128 + 16 * nd + (lane & 15)] = (bf16)f2bf(O[nd][r] * inv); }
        __syncthreads();
    }
}

__device__ __forceinline__ void phase_nsa(const Frame& F0, unsigned* qctr) {
    const Frame F = relaunder(F0);
    unsigned char* ws = F.ws; const bf16* P = (const bf16*)(ws + WS_P); const bf16* QN = (const bf16*)(ws + WS_QN); bf16* Y = (bf16*)(ws + WS_Y);
    const int lane = F.lane, wave = F.wave, tid = F.tid; const float c = 0.125f * 1.4426950408889634f;
    LAS float* PT = (LAS float*)(F.lds + AT_PT); LAS float* IMP = (LAS float*)(F.lds + AT_IMP); LAS unsigned* SEL = (LAS unsigned*)(F.lds + AT_SEL); LAS unsigned* UNI = (LAS unsigned*)(F.lds + AT_UNI);
    LAS int* UQ = (LAS int*)(F.lds + AT_UNI + 16);
    int nxtq = 0; if (tid == 0) nxtq = (int)atomicAdd(qctr, 1u);
    for (;;) {
        __syncthreads();
        if (tid == 0) UQ[0] = nxtq;
        LDS_WAIT(); __syncthreads();
        const int uq = UQ[0]; if (uq >= 512) break;
        if (tid == 0) nxtq = (int)atomicAdd(qctr, 1u);
        const int tile = 127 - (uq >> 2), b = (uq >> 1) & 1, kvh = uq & 1;
        const int t0 = tile * 32, m0 = b * T + t0; const int cur = t0 >> 6;
        const int tl = wave * 4 + (lane >> 4);
        const int trow = t0 + tl;
        bf16x8 qf[2];
        { const int rho = lane & 15; const int mq = m0 + wave * 4 + (rho >> 2), g = rho & 3;
#pragma unroll
          for (int ks = 0; ks < 2; ++ks) qf[ks] = *(const bf16x8*)(QN + (size_t)mq * 512 + (kvh * 4 + g) * 64 + ks * 32 + 8 * (lane >> 4)); }
        const bf16* KCg = (const bf16*)(ws + WS_KC) + (size_t)(b * 2 + kvh) * 256 * 64; const bf16* VCg = (const bf16*)(ws + WS_VCT) + (size_t)(b * 2 + kvh) * 64 * 256;
        const bf16* KSg = (const bf16*)(ws + WS_KS) + (size_t)(b * 2 + kvh) * T * 64; const bf16* VSg = (const bf16*)(ws + WS_VST) + (size_t)(b * 2 + kvh) * 64 * T;
        const bf16* KWg = (const bf16*)(ws + WS_KW) + (size_t)(b * 2 + kvh) * T * 64; const bf16* VWg = (const bf16*)(ws + WS_VWT) + (size_t)(b * 2 + kvh) * 64 * T;
        f32x4 OF[4];
#pragma unroll
        for (int i = 0; i < 4; ++i) OF[i] = (f32x4){0.f, 0.f, 0.f, 0.f};
        float gate[3][4];
#pragma unroll
        for (int r = 0; r < 4; ++r)
#pragma unroll
            for (int k = 0; k < 3; ++k) gate[k][r] = sigmoidf_(ldbf(P + (size_t)(m0 + tl) * LDP + PC_GL + (kvh * 4 + r) * 3 + k));
        f32x4 O[4]; float lr[4];
#pragma unroll
        for (int i = 0; i < 4; ++i) O[i] = (f32x4){0.f, 0.f, 0.f, 0.f};
#pragma unroll
        for (int r = 0; r < 4; ++r) lr[r] = 0.f;
        attn_pass<64, 1>(F.lds, tid, lane, wave, KCg, VCg, 256, 0, 3, qf, O, lr, trow, 0u, 0u, 0u, 0u);
#pragma unroll
        for (int r = 0; r < 4; ++r) lr[r] = red16_sum(lr[r]);
#pragma unroll
        for (int r = 0; r < 4; ++r) { const float inv = lr[r] > 0.f ? 1.f / lr[r] : 0.f;
#pragma unroll
            for (int nd = 0; nd < 4; ++nd) OF[nd][r] += gate[0][r] * O[nd][r] * inv; }
        { LAS bf16* KT = (LAS bf16*)(F.lds);
          for (int j = 0; j < 4; ++j) {
              __syncthreads();
              { const int kr = tid >> 3, kc = (tid & 7) * 8; *(LAS u32x4*)(KT + kr * 72 + kc) = *(const u32x4*)(KCg + (size_t)(64 * j + kr) * 64 + kc); }
              LDS_WAIT(); __syncthreads();
              bf16x8 kfr[4][2]; f32x4 S4[4];
#pragma unroll
              for (int n = 0; n < 4; ++n)
#pragma unroll
                  for (int ks = 0; ks < 2; ++ks) kfr[n][ks] = *(const LAS bf16x8*)(KT + (16 * n + (lane & 15)) * 72 + ks * 32 + 8 * (lane >> 4));
              LDS_WAIT(); __builtin_amdgcn_sched_barrier(0);
#pragma unroll
              for (int n = 0; n < 4; ++n) { S4[n] = (f32x4){0.f, 0.f, 0.f, 0.f};
#pragma unroll
                  for (int ks = 0; ks < 2; ++ks) S4[n] = __builtin_amdgcn_mfma_f32_16x16x32_bf16(qf[ks], kfr[n][ks], S4[n], 0, 0, 0); }
              __builtin_amdgcn_sched_barrier(0);
#pragma unroll
              for (int n = 0; n < 4; ++n) { const f32x4 S = S4[n];
                  const int key = 64 * j + 16 * n + (lane & 15); const bool valid = (key <= 254) && (16 * key + 31 <= trow); float ps = 0.f;
#pragma unroll
                  for (int r = 0; r < 4; ++r) { const float inv = lr[r] > 0.f ? 1.f / lr[r] : 0.f; ps += valid ? __builtin_amdgcn_exp2f(S[r]) * inv : 0.f; }
                  PT[tl * 256 + key] = ps; } }
          if (tid < 64) SEL[tid] = 0u; if (tid < 2) UNI[tid] = 0u;
          LDS_WAIT(); __syncthreads(); }
        { const int tk = tid >> 4, sg = (tid & 15) * 4;
#pragma unroll
          for (int i = 0; i < 4; ++i) { const int s = sg + i; const LAS float* p = PT + tk * 256 + 4 * s; float v = p[0] + p[1] + p[2] + 0.5f * p[3]; if (s > 0) v += 0.5f * p[-1];
              const bool forced = (s == 0) || (s == cur) || (s == cur - 1); IMP[tk * 64 + s] = forced ? 1e9f : (s <= cur ? v : -1e9f); }
          LDS_WAIT(); __syncthreads();
          float mine[4]; int cnt[4];
#pragma unroll
          for (int i = 0; i < 4; ++i) { mine[i] = IMP[tk * 64 + sg + i]; cnt[i] = 0; }
          for (int s2 = 0; s2 < 64; ++s2) { const float o = IMP[tk * 64 + s2];
#pragma unroll
              for (int i = 0; i < 4; ++i) cnt[i] += (o > mine[i] || (o == mine[i] && s2 < sg + i)) ? 1 : 0; }
          unsigned bits = 0u;
#pragma unroll
          for (int i = 0; i < 4; ++i) if (cnt[i] < 16 && mine[i] > -1e8f) bits |= 1u << ((sg + i) & 31);
          if (bits) { atomicOr((unsigned*)(SEL + tk * 2 + (sg >> 5)), bits); atomicOr((unsigned*)(UNI + (sg >> 5)), bits); }
          LDS_WAIT(); __syncthreads(); }
        const unsigned sel0 = SEL[tl * 2], sel1 = SEL[tl * 2 + 1], uni0 = UNI[0], uni1 = UNI[1];
#pragma unroll
        for (int i = 0; i < 4; ++i) O[i] = (f32x4){0.f, 0.f, 0.f, 0.f};
#pragma unroll
        for (int r = 0; r < 4; ++r) lr[r] = 0.f;
        attn_pass<64, 2>(F.lds, tid, lane, wave, KSg, VSg, T, 0, cur, qf, O, lr, trow, sel0, sel1, uni0, uni1);
#pragma unroll
        for (int r = 0; r < 4; ++r) lr[r] = red16_sum(lr[r]);
#pragma unroll
        for (int r = 0; r < 4; ++r) { const float inv = lr[r] > 0.f ? 1.f / lr[r] : 0.f;
#pragma unroll
            for (int nd = 0; nd < 4; ++nd) OF[nd][r] += gate[1][r] * O[nd][r] * inv; }
#pragma unroll
        for (int i = 0; i < 4; ++i) O[i] = (f32x4){0.f, 0.f, 0.f, 0.f};
#pragma unroll
        for (int r = 0; r < 4; ++r) lr[r] = 0.f;
        { const int lo = t0 - 511; attn_pass<64, 3>(F.lds, tid, lane, wave, KWg, VWg, T, lo > 0 ? (lo >> 6) : 0, cur, qf, O, lr, trow, 0u, 0u, 0u, 0u); }
#pragma unroll
        for (int r = 0; r < 4; ++r) lr[r] = red16_sum(lr[r]);
#pragma unroll
        for (int r = 0; r < 4; ++r) { const float inv = lr[r] > 0.f ? 1.f / lr[r] : 0.f;
#pragma unroll
            for (int nd = 0; nd < 4; ++nd) OF[nd][r] += gate[2][r] * O[nd][r] * inv; }
#pragma unroll
        for (int r = 0; r < 4; ++r)
#pragma unroll
            for (int nd = 0; nd < 4; ++nd) Y[(size_t)(m0 + tl) * 2560 + 512 + (kvh * 4 + r) * 64 + 16 * nd + (lane & 15)] = (bf16)f2bf(OF[nd][r]);
        __syncthreads();
    }
}

constexpr int CL = 32, NCH = T / CL;
constexpr int SC_STEPS = 8;
__device__ __forceinline__ void phase_scan(const Frame& F0, int l) {
    const Frame F = relaunder(F0);
    unsigned char* ws = F.ws; const bf16* P = (const bf16*)(ws + WS_P); const float* LO = (const float*)(ws + WS_LO);
    float* VF = (float*)(ws + WS_VFIRST); float* VC = (float*)(ws + WS_VCUR); float* BON = (float*)(ws + WS_BON);
    float* YL = (float*)(ws + WS_YL); float* ZL = (float*)(ws + WS_ZL); float* QF = (float*)(ws + WS_QF); float* PF = (float*)(ws + WS_PF);
    const float* mu = INP(6) + l * 1984; const float* kk_ = INP(12) + l * 512; const float* ka_ = INP(13) + l * 512; const float* rk_ = INP(14) + l * 512;
    const int wave = F.wave;
    LAS float* ST = (LAS float*)F.lds + wave * (SC_STEPS * 5 * 64 + 64);
    for (int u = F.bid; u < 256; u += F.G) {
        int lane = F.lane; asm volatile("" : "+v"(lane));
        const int b = u >> 7, h = (u >> 4) & 7, cq = u & 15;
        const int jc = h * 64 + lane;
        const float mu_r = mu[PC_R + jc], mu_k = mu[PC_K + jc], mu_v = mu[PC_V + jc], kkw = kk_[jc], kaw = ka_[jc], rkw = rk_[jc];
        const int chunk = cq * 8 + wave;
        f32x2 Sq[32], Sp[32];
#pragma unroll
        for (int k = 0; k < 32; ++k) { Sq[k] = (f32x2){0.f, 0.f}; Sp[k] = (f32x2){(2 * k == lane) ? 1.f : 0.f, (2 * k + 1 == lane) ? 1.f : 0.f}; }
        const int tbase = chunk * CL;
        float gam = 1.f;
        for (int sb = 0; sb < CL / SC_STEPS; ++sb) {
            LDS_WAIT(); asm volatile("" ::: "memory");
#pragma unroll 1
            for (int hb = 0; hb < 2; ++hb) { const int st0 = hb * 4; const int tf = tbase + sb * SC_STEPS + st0, mf = b * T + tf;
              float ur[5], uk[5], uv[5], wv[4], av[4], vgv[4], vfv[4];
#pragma unroll
              for (int i = 0; i < 5; ++i) { const bool ok = (tf - 1 + i) >= 0; const bf16* pr = P + (size_t)(ok ? (mf - 1 + i) : mf) * LDP + h * 64;
                  const float sc = ok ? 1.f : 0.f;
                  ur[i] = ldbf(pr + PC_R + lane) * sc; uk[i] = ldbf(pr + PC_K + lane) * sc; uv[i] = ldbf(pr + PC_V + lane) * sc; }
#pragma unroll
              for (int i = 0; i < 4; ++i) { const float* lr = LO + (size_t)(mf + i) * 2048 + h * 64; wv[i] = lr[lane]; av[i] = lr[512 + lane];
                  vgv[i] = l ? lr[1536 + lane] : 0.f; vfv[i] = l ? (VF + (size_t)(mf + i) * 512 + h * 64)[lane] : 0.f; }
              float rr[4], kv[4], vv4[4], kmod4[4], red[8];
#pragma unroll
              for (int i = 0; i < 4; ++i) { const int m = mf + i;
                  const float r = ur[i + 1] + (ur[i] - ur[i + 1]) * mu_r, k = uk[i + 1] + (uk[i] - uk[i + 1]) * mu_k; float v = uv[i + 1] + (uv[i] - uv[i + 1]) * mu_v;
                  if (l == 0) (VF + (size_t)m * 512 + h * 64)[lane] = v; else v = v + (vfv[i] - v) * vgv[i];
                  (VC + (size_t)m * 512 + h * 64)[lane] = v;
                  const float kkv = k * kkw; const float kmod = k * (1.f + (av[i] - 1.f) * kaw);
                  rr[i] = r; kv[i] = kkv; vv4[i] = v; kmod4[i] = kmod; red[2 * i] = kkv * kkv; red[2 * i + 1] = r * kmod * rkw; }
#pragma unroll
              for (int o = 1; o < 64; o <<= 1) { float t8[8];
#pragma unroll
                  for (int j = 0; j < 8; ++j) t8[j] = __shfl_xor(red[j], o);
#pragma unroll
                  for (int j = 0; j < 8; ++j) red[j] += t8[j]; }
#pragma unroll
              for (int i = 0; i < 4; ++i) { const int m = mf + i; const float w = wv[i], a = av[i];
                  const float kkn = kv[i] * (1.0f / sqrtf(fmaxf(red[2 * i], 1e-24f)));
                  if (lane == 0) __hip_atomic_store((unsigned*)BON + (size_t)m * 8 + h, __builtin_bit_cast(unsigned, red[2 * i + 1]), RLX_AGENT);
                  const float gprev = gam; gam *= w; const float ig = 1.0f / gam;
                  LAS float* dst = ST + ((st0 + i) * 5) * 64 + lane;
                  dst[0] = kkn * gprev; dst[64] = kkn * a * ig; dst[128] = kmod4[i] * ig; dst[192] = rr[i] * gam; dst[256] = vv4[i]; } }
            LDS_WAIT(); asm volatile("" ::: "memory");
            for (int st = 0; st < SC_STEPS; ++st) { const LAS float* sp = ST + (st * 5) * 64; const int t = tbase + sb * SC_STEPS + st;
                const float vv = sp[256 + lane]; const f32x2 vv2 = (f32x2){vv, vv};
                f32x2 qa = (f32x2){0.f, 0.f}, qb = qa, pa = qa, pb = qa;
                { f32x4 buf[2][2];
#pragma unroll
                  for (int i = 0; i < 2; ++i) buf[0][i] = *(const LAS f32x4*)(sp + 4 * i);
#pragma unroll
                  for (int g = 0; g < 8; ++g) {
                      if (g < 7) {
#pragma unroll
                          for (int i = 0; i < 2; ++i) buf[(g + 1) & 1][i] = *(const LAS f32x4*)(sp + 8 * (g + 1) + 4 * i); }
                      asm volatile("" ::: "memory");
#pragma unroll
                      for (int i = 0; i < 2; ++i) { const int k2 = 4 * g + 2 * i; const f32x4 kk4 = buf[g & 1][i]; const f32x2 klo = (f32x2){kk4[0], kk4[1]}, khi = (f32x2){kk4[2], kk4[3]};
                          qa += Sq[k2] * klo; qb += Sq[k2 + 1] * khi; pa += Sp[k2] * klo; pb += Sp[k2 + 1] * khi; } } }
                const f32x2 qs = qa + qb, ps = pa + pb; const float nq = -(qs.x + qs.y), np = -(ps.x + ps.y); const f32x2 nq2 = (f32x2){nq, nq}, np2 = (f32x2){np, np};
                f32x2 ya = (f32x2){0.f, 0.f}, yb = ya, za = ya, zb = ya;
                { f32x4 bb[2], bk[2], br[2];
                  bb[0] = *(const LAS f32x4*)(sp + 64); bk[0] = *(const LAS f32x4*)(sp + 128); br[0] = *(const LAS f32x4*)(sp + 192);
#pragma unroll
                  for (int g = 0; g < 16; ++g) {
                      if (g < 15) { bb[(g + 1) & 1] = *(const LAS f32x4*)(sp + 64 + 4 * (g + 1)); bk[(g + 1) & 1] = *(const LAS f32x4*)(sp + 128 + 4 * (g + 1)); br[(g + 1) & 1] = *(const LAS f32x4*)(sp + 192 + 4 * (g + 1)); }
                      asm volatile("" ::: "memory");
                      { const int k2 = 2 * g; const f32x4 b4 = bb[g & 1], k4 = bk[g & 1], r4 = br[g & 1];
                        const f32x2 blo = (f32x2){b4[0], b4[1]}, bhi = (f32x2){b4[2], b4[3]}, klo = (f32x2){k4[0], k4[1]}, khi = (f32x2){k4[2], k4[3]}, rlo = (f32x2){r4[0], r4[1]}, rhi = (f32x2){r4[2], r4[3]};
                        Sq[k2] += vv2 * klo + nq2 * blo; Sq[k2 + 1] += vv2 * khi + nq2 * bhi; Sp[k2] += np2 * blo; Sp[k2 + 1] += np2 * bhi;
                        ya += Sq[k2] * rlo; yb += Sq[k2 + 1] * rhi; za += Sp[k2] * rlo; zb += Sp[k2 + 1] * rhi; } } }
                const f32x2 ys = ya + yb, zs = za + zb;
                const size_t o = (size_t)(b * T + t) * 512 + h * 64 + lane;
                YL[o] = ys.x + ys.y; ZL[o] = zs.x + zs.y; }
        }
        { LAS float* GL = ST + SC_STEPS * 5 * 64; LDS_WAIT(); asm volatile("" ::: "memory"); GL[lane] = gam; LDS_WAIT(); asm volatile("" ::: "memory");
#pragma unroll
          for (int k = 0; k < 32; k += 2) { const f32x4 g4 = *(const LAS f32x4*)(GL + 2 * k); const f32x2 glo = (f32x2){g4[0], g4[1]}, ghi = (f32x2){g4[2], g4[3]};
              Sq[k] *= glo; Sq[k + 1] *= ghi; Sp[k] *= glo; Sp[k + 1] *= ghi; } }
        { const size_t un = ((size_t)(b * 8 + h) * NCH + chunk) * 4096;
#pragma unroll
          for (int k = 0; k < 32; k += 4) { u32x4 w; w.x = pk2(Sq[k].x, Sq[k].y); w.y = pk2(Sq[k + 1].x, Sq[k + 1].y); w.z = pk2(Sq[k + 2].x, Sq[k + 2].y); w.w = pk2(Sq[k + 3].x, Sq[k + 3].y);
              *(u32x4*)((bf16*)QF + un + lane * 64 + 2 * k) = w; }
          { unsigned short* pf = (unsigned short*)PF + un + ((lane >> 2) & 3) * 16 + (lane >> 4) * 4 + (lane & 3);
#pragma unroll
            for (int k = 0; k < 32; ++k) { const unsigned w = pk2(Sp[k].x, Sp[k].y); pf[(2 * k) * 64] = (unsigned short)w; pf[(2 * k + 1) * 64] = (unsigned short)(w >> 16); } } }
    }
}
constexpr int CPF = 8;
__device__ __forceinline__ void phase_carry(const Frame& F0, unsigned* flags) {
    const Frame F = relaunder(F0);
    unsigned char* ws = F.ws; const unsigned char* QFb = ws + WS_QF; const unsigned char* PFb = ws + WS_PF; float* SI = (float*)(ws + WS_SINIT);
    const int lane = F.lane, wave = F.wave;
    LAS unsigned char* ring = F.lds;
    for (int chain = F.bid; chain < 16; chain += F.G) {
        const size_t cb = (size_t)chain * NCH * 8192;
        if (wave >= 4) {
            const int pt = (wave - 4) * 64 + lane;
            u32x4 rt[CPF][2], rq[CPF][2];
#pragma unroll
            for (int d = 0; d < CPF; ++d) { const size_t o = cb + (size_t)d * 8192 + pt * 16;
                rt[d][0] = *(const u32x4*)(PFb + o); rt[d][1] = *(const u32x4*)(PFb + o + 4096); rq[d][0] = *(const u32x4*)(QFb + o); rq[d][1] = *(const u32x4*)(QFb + o + 4096); }
            asm volatile("s_waitcnt vmcnt(%0)" :: "n"(4 * (CPF - 1)) : "memory");
            { LAS unsigned char* sl = ring + pt * 16; *(LAS u32x4*)(sl) = rt[0][0]; *(LAS u32x4*)(sl + 4096) = rt[0][1]; *(LAS u32x4*)(sl + 8192) = rq[0][0]; *(LAS u32x4*)(sl + 12288) = rq[0][1]; }
            { const size_t o = cb + (size_t)CPF * 8192 + pt * 16;
              rt[0][0] = *(const u32x4*)(PFb + o); rt[0][1] = *(const u32x4*)(PFb + o + 4096); rq[0][0] = *(const u32x4*)(QFb + o); rq[0][1] = *(const u32x4*)(QFb + o + 4096); }
            LDS_WAIT(); __syncthreads();
            for (int c0 = 0; c0 < NCH; c0 += CPF) {
#pragma unroll
                for (int d = 0; d < CPF; ++d) { const int c = c0 + d;
                    constexpr int DUMMY = 0; (void)DUMMY;
                    const int e = (d + 1) % CPF;
                    if (c + 1 < NCH) {
                        asm volatile("s_waitcnt vmcnt(%0)" :: "n"(4 * (CPF - 1)) : "memory");
                        LAS unsigned char* sl = ring + ((c + 1) & 1) * 16384 + pt * 16;
                        *(LAS u32x4*)(sl) = rt[e][0]; *(LAS u32x4*)(sl + 4096) = rt[e][1]; *(LAS u32x4*)(sl + 8192) = rq[e][0]; *(LAS u32x4*)(sl + 12288) = rq[e][1];
                        const int cn = c + 1 + CPF < NCH ? c + 1 + CPF : NCH - 1;
                        const size_t o = cb + (size_t)cn * 8192 + pt * 16;
                        rt[e][0] = *(const u32x4*)(PFb + o); rt[e][1] = *(const u32x4*)(PFb + o + 4096); rq[e][0] = *(const u32x4*)(QFb + o); rq[e][1] = *(const u32x4*)(QFb + o + 4096);
                    }
                    LDS_WAIT(); __syncthreads();
                }
            }
            asm volatile("s_waitcnt vmcnt(0)" ::: "memory");
        } else {
            const int row = wave * 16 + (lane & 15), g = lane >> 4;
            const int aoff = ((lane & 15) * 64 + g * 16) * 2, qoff = (row * 64 + 4 * g) * 2;
            f32x4 S[4];
#pragma unroll
            for (int mt = 0; mt < 4; ++mt) S[mt] = (f32x4){0.f, 0.f, 0.f, 0.f};
            u32x4 a[4][2]; u32x2 q[4];
            __syncthreads();
#pragma unroll
            for (int mt = 0; mt < 4; ++mt) { a[mt][0] = *(const LAS u32x4*)(ring + mt * 2048 + aoff); a[mt][1] = *(const LAS u32x4*)(ring + mt * 2048 + aoff + 16); q[mt] = *(const LAS u32x2*)(ring + 8192 + qoff + 32 * mt); }
            LDS_WAIT(); __builtin_amdgcn_sched_barrier(0);
            for (int c = 0; c < NCH; ++c) { const size_t un = ((size_t)chain * NCH + c) * 4096;
#pragma unroll
                for (int mt = 0; mt < 4; ++mt) *(f32x4*)(SI + un + (qoff >> 1) + 16 * mt) = S[mt];
                bf16x8 bh[2], bl[2];
#pragma unroll
                for (int ks = 0; ks < 2; ++ks) { u32x4 wh, wl; const f32x4 s0 = S[2 * ks], s1 = S[2 * ks + 1];
                    wh.x = pk2(s0[0], s0[1]); wh.y = pk2(s0[2], s0[3]); wh.z = pk2(s1[0], s1[1]); wh.w = pk2(s1[2], s1[3]);
                    wl.x = pk2(s0[0] - bf2f(wh.x & 0xffffu), s0[1] - bf2f(wh.x >> 16)); wl.y = pk2(s0[2] - bf2f(wh.y & 0xffffu), s0[3] - bf2f(wh.y >> 16));
                    wl.z = pk2(s1[0] - bf2f(wh.z & 0xffffu), s1[1] - bf2f(wh.z >> 16)); wl.w = pk2(s1[2] - bf2f(wh.w & 0xffffu), s1[3] - bf2f(wh.w >> 16));
                    bh[ks] = __builtin_bit_cast(bf16x8, wh); bl[ks] = __builtin_bit_cast(bf16x8, wl); }
                __builtin_amdgcn_sched_barrier(0);
#pragma unroll
                for (int mt = 0; mt < 4; ++mt) { f32x4 d = (f32x4){bf2f(q[mt].x & 0xffffu), bf2f(q[mt].x >> 16), bf2f(q[mt].y & 0xffffu), bf2f(q[mt].y >> 16)};
#pragma unroll
                    for (int ks = 0; ks < 2; ++ks) { const bf16x8 af = __builtin_bit_cast(bf16x8, a[mt][ks]);
                        d = __builtin_amdgcn_mfma_f32_16x16x32_bf16(af, bh[ks], d, 0, 0, 0); d = __builtin_amdgcn_mfma_f32_16x16x32_bf16(af, bl[ks], d, 0, 0, 0); }
                    S[mt] = d; }
                asm volatile("s_nop 7\n\ts_nop 7" ::: "memory");
                __builtin_amdgcn_sched_barrier(0);
                __syncthreads();
                if (c + 1 < NCH) { LAS unsigned char* sl = ring + ((c + 1) & 1) * 16384;
#pragma unroll
                    for (int mt = 0; mt < 4; ++mt) { a[mt][0] = *(const LAS u32x4*)(sl + mt * 2048 + aoff); a[mt][1] = *(const LAS u32x4*)(sl + mt * 2048 + aoff + 16); q[mt] = *(const LAS u32x2*)(sl + 8192 + qoff + 32 * mt); } }
                LDS_WAIT(); __builtin_amdgcn_sched_barrier(0);
            }
        }
        asm volatile("s_waitcnt vmcnt(0)" ::: "memory");
        __syncthreads();
        if (xb_t0(wave)) { __builtin_amdgcn_fence(__ATOMIC_RELEASE, "agent"); asm volatile("s_waitcnt vmcnt(0)" ::: "memory"); __hip_atomic_store(flags + chain, 1u, __ATOMIC_RELAXED, __HIP_MEMORY_SCOPE_AGENT); }
    }
}
__device__ __forceinline__ void phase_rwkv_fin(const Frame& F0, int l, unsigned* flags, unsigned* qctr) {
    const Frame F = relaunder(F0);
    unsigned char* ws = F.ws; const float* SI = (const float*)(ws + WS_SINIT); const float* YL = (const float*)(ws + WS_YL); const float* ZL = (const float*)(ws + WS_ZL);
    const float* LO = (const float*)(ws + WS_LO); const float* VC = (const float*)(ws + WS_VCUR); const float* BON = (const float*)(ws + WS_BON); bf16* Y = (bf16*)(ws + WS_Y);
    const float* lnw = INP(15) + l * 512; const float* lnb = INP(16) + l * 512;
    const int lane = F.lane, wave = F.wave;
    (void)qctr;
    __syncthreads();
    if (xb_t0(wave)) {
        for (int u = F.bid; u < 16 * (NCH / 4); u += F.G) { unsigned* fl = flags + u / (NCH / 4); unsigned sp = 0u;
            while (xb_ld(fl) == 0u && ++sp < (1u << 22)) __builtin_amdgcn_s_sleep(1); }
        __builtin_amdgcn_fence(__ATOMIC_ACQUIRE, "agent"); asm volatile("s_waitcnt vmcnt(0)" ::: "memory"); }
    __syncthreads();
    for (int u = F.bid; u < 16 * (NCH / 4); u += F.G) {
        const int chain = u / (NCH / 4), c = (u % (NCH / 4)) * 4 + (wave >> 1), b = chain >> 3, h = chain & 7; const size_t un = ((size_t)chain * NCH + c) * 4096;
        const int m0 = b * T + c * CL + (wave & 1) * 16;
        bf16x8 af[2], bfr[4][2];
#pragma unroll
        for (int ks = 0; ks < 2; ++ks) { float t8[8]; ldf8(ZL + (size_t)(m0 + (lane & 15)) * 512 + h * 64 + ks * 32 + 8 * (lane >> 4), t8);
            u32x4 w; w.x = pk2(t8[0], t8[1]); w.y = pk2(t8[2], t8[3]); w.z = pk2(t8[4], t8[5]); w.w = pk2(t8[6], t8[7]); af[ks] = __builtin_bit_cast(bf16x8, w); }
#pragma unroll
        for (int n = 0; n < 4; ++n)
#pragma unroll
            for (int ks = 0; ks < 2; ++ks) { float t8[8]; ldf8(SI + un + (size_t)(16 * n + (lane & 15)) * 64 + ks * 32 + 8 * (lane >> 4), t8);
                u32x4 w; w.x = pk2(t8[0], t8[1]); w.y = pk2(t8[2], t8[3]); w.z = pk2(t8[4], t8[5]); w.w = pk2(t8[6], t8[7]); bfr[n][ks] = __builtin_bit_cast(bf16x8, w); }
        float yl[4][4], vc[4][4], gg[4][4], bn[4];
#pragma unroll
        for (int r = 0; r < 4; ++r) { const int m = m0 + 4 * (lane >> 4) + r; bn[r] = BON[(size_t)m * 8 + h];
#pragma unroll
            for (int n = 0; n < 4; ++n) { const int j = h * 64 + 16 * n + (lane & 15); yl[n][r] = YL[(size_t)m * 512 + j]; vc[n][r] = VC[(size_t)m * 512 + j]; gg[n][r] = LO[(size_t)m * 2048 + 1024 + j]; } }
        asm volatile("s_waitcnt vmcnt(0)" ::: "memory"); __builtin_amdgcn_sched_barrier(0);
        f32x4 C[4];
#pragma unroll
        for (int n = 0; n < 4; ++n) { C[n] = (f32x4){yl[n][0], yl[n][1], yl[n][2], yl[n][3]};
#pragma unroll
            for (int ks = 0; ks < 2; ++ks) C[n] = __builtin_amdgcn_mfma_f32_16x16x32_bf16(af[ks], bfr[n][ks], C[n], 0, 0, 0); }
        __builtin_amdgcn_sched_barrier(0);
#pragma unroll
        for (int r = 0; r < 4; ++r) { const int m = m0 + 4 * (lane >> 4) + r;
            float sm = (C[0][r] + C[1][r]) + (C[2][r] + C[3][r]); sm = red16_sum(sm); const float mean = sm * (1.f / 64.f);
            float d[4], sv = 0.f;
#pragma unroll
            for (int n = 0; n < 4; ++n) { d[n] = C[n][r] - mean; sv += d[n] * d[n]; }
            sv = red16_sum(sv); const float rs = 1.0f / sqrtf(sv * (1.f / 64.f) + 64e-5f);
#pragma unroll
            for (int n = 0; n < 4; ++n) { const int j = h * 64 + 16 * n + (lane & 15); const float yn = d[n] * rs * lnw[j] + lnb[j];
                Y[(size_t)m * 2560 + j] = (bf16)f2bf((yn + bn[r] * vc[n][r]) * gg[n][r]); } }
    }
}

__device__ __forceinline__ void phase_route(const Frame& F0, const bf16* X) {
    const Frame F = relaunder(F0);
    const float* R = INP(36); const float* gain = INP(3) + D; const u64* ssq = (const u64*)(F.ctl + CW_SSQ) + 3 * 8192;
    unsigned* cnt = F.ctl + CW_CNT; unsigned* route = F.ctl + CW_ROUTE;
    const int lane = F.lane;
    for (int m = F.bid * 8 + F.wave; m < M; m += F.G * 8) {
        float acc[8];
#pragma unroll
        for (int e = 0; e < 8; ++e) acc[e] = 0.f;
#pragma unroll 8
        for (int i = 0; i < 32; ++i) { const int k = lane + 64 * i; const float xv = ldbf(X + (size_t)m * D + k) * gain[k]; const f32x4 r0 = *(const f32x4*)(R + k * 8), r1 = *(const f32x4*)(R + k * 8 + 4);
            acc[0] += xv * r0[0]; acc[1] += xv * r0[1]; acc[2] += xv * r0[2]; acc[3] += xv * r0[3]; acc[4] += xv * r1[0]; acc[5] += xv * r1[1]; acc[6] += xv * r1[2]; acc[7] += xv * r1[3]; }
        const float rs = rstd_of(ssq, m);
#pragma unroll
        for (int e = 0; e < 8; ++e) acc[e] = wave_sum(acc[e]) * rs;
        if (lane == 0) {
            int e0 = 0; float v0 = acc[0];
#pragma unroll
            for (int e = 1; e < 8; ++e) if (acc[e] > v0) { v0 = acc[e]; e0 = e; }
            int e1 = -1; float v1 = -3.0e38f;
#pragma unroll
            for (int e = 0; e < 8; ++e) if (e != e0 && acc[e] > v1) { v1 = acc[e]; e1 = e; }
            const float p1 = __expf(v1 - v0); const float w0 = 1.f / (1.f + p1), w1 = p1 / (1.f + p1);
            const unsigned pos0 = atomicAdd(cnt + 64 * e0, 1u), pos1 = atomicAdd(cnt + 64 * e1, 1u);
            unsigned* rr = route + (size_t)m * 8; rr[0] = (unsigned)e0; rr[1] = (unsigned)e1; rr[2] = __builtin_bit_cast(unsigned, w0); rr[3] = __builtin_bit_cast(unsigned, w1); rr[4] = pos0; rr[5] = pos1; rr[6] = __builtin_bit_cast(unsigned, rs); }
    }
}
__device__ __forceinline__ void moe_tiles(const Frame& F, int (&ts)[9]) {
    ts[0] = 0;
#pragma unroll
    for (int e = 0; e < 8; ++e) { const unsigned c = __hip_atomic_load(F.ctl + CW_CNT + 64 * e, RLX_AGENT); ts[e + 1] = ts[e] + (int)((c + 255u) >> 8); }
}
__device__ __forceinline__ void phase_gather(const Frame& F0, float* RSS) {
    const Frame F = relaunder(F0);
    constexpr int RB = F8_M1 ? D : 2 * D;
    unsigned char* ws = F.ws; const unsigned char* XH = ws + (F8_M1 ? WS_XH8 : WS_XH); unsigned char* XG = ws + WS_XG; const unsigned* route = F.ctl + CW_ROUTE;
    int ts[9]; moe_tiles(F, ts);
    for (int m = F.bid * 8 + F.wave; m < M; m += F.G * 8) { const unsigned* rr = route + (size_t)m * 8;
        const u32x4* src = (const u32x4*)(XH + (size_t)m * RB);
#pragma unroll
        for (int s = 0; s < 2; ++s) { const int e = (int)rr[s]; int base = 0;
#pragma unroll
            for (int j = 0; j < 8; ++j) base = (j == e) ? ts[j] : base;
            const int slot = base * 256 + (int)rr[4 + s]; u32x4* dst = (u32x4*)(XG + (size_t)slot * RB);
#pragma unroll
            for (int i = 0; i < RB / 1024; ++i) dst[F.lane + 64 * i] = src[F.lane + 64 * i];
            if (F.lane == 0) __hip_atomic_store((unsigned*)RSS + slot, rr[6], RLX_AGENT); } }
}
__device__ __forceinline__ void phase_combine(const Frame& F0, const bf16* X, float* out) {
    const Frame F = relaunder(F0);
    unsigned char* ws = F.ws; const bf16* YS = (const bf16*)(ws + WS_YS); const unsigned* route = F.ctl + CW_ROUTE;
    int ts[9]; moe_tiles(F, ts);
    for (int m = F.bid * 8 + F.wave; m < M; m += F.G * 8) { const unsigned* rr = route + (size_t)m * 8; int slot[2]; float w[2];
#pragma unroll
        for (int s = 0; s < 2; ++s) { const int e = (int)rr[s]; int base = 0;
#pragma unroll
            for (int j = 0; j < 8; ++j) base = (j == e) ? ts[j] : base;
            slot[s] = base * 256 + (int)rr[4 + s]; w[s] = __builtin_bit_cast(float, rr[2 + s]); }
#pragma unroll
        for (int i = 0; i < 8; ++i) { const int c = (F.lane + 64 * i) * 4; const u32x2 xr = *(const u32x2*)(X + (size_t)m * D + c); f32x4 v = (f32x4){bf2f(xr.x & 0xffffu), bf2f(xr.x >> 16), bf2f(xr.y & 0xffffu), bf2f(xr.y >> 16)};
            const u32x2 a = *(const u32x2*)(YS + (size_t)slot[0] * D + c), b2 = *(const u32x2*)(YS + (size_t)slot[1] * D + c);
            v[0] += w[0] * bf2f(a.x & 0xffffu) + w[1] * bf2f(b2.x & 0xffffu); v[1] += w[0] * bf2f(a.x >> 16) + w[1] * bf2f(b2.x >> 16);
            v[2] += w[0] * bf2f(a.y & 0xffffu) + w[1] * bf2f(b2.y & 0xffffu); v[3] += w[0] * bf2f(a.y >> 16) + w[1] * bf2f(b2.y >> 16);
            *(f32x4*)(out + (size_t)m * D + c) = v; } }
}

constexpr int PH_PER_LAYER = 14, N_PHASES = 1 + 2 * PH_PER_LAYER;
struct Args { const float* in[40]; float* out; unsigned char* ws; int ph_lo, ph_hi; };
__global__ void __launch_bounds__(512, 2) mega_fwd(Args args) {
    extern __shared__ __attribute__((aligned(16))) unsigned char lds_raw[];
    Frame F; F.lds = (LAS unsigned char*)lds_raw; F.tid = threadIdx.x; F.lane = F.tid & 63; F.wave = __builtin_amdgcn_readfirstlane(F.tid >> 6); F.G = gridDim.x; F.bid = blockIdx.x;
    F.in = args.in; F.ws = args.ws; F.ctl = (unsigned*)(args.ws + WS_CTL);
    volatile LAS unsigned* MISC = (volatile LAS unsigned*)(F.lds + MISC_OFF);
    for (int u = F.tid; u < (LDS_BYTES - RING_BYTES) / 4; u += 512) ((LAS unsigned*)(F.lds + RING_BYTES))[u] = 0u;
    __syncthreads();
    const int lo = args.ph_lo, hi = args.ph_hi;
    XcdBarrier bar; bar.bar = F.ctl + CW_BAR; bar.x = 0; bar.st = nullptr; bar.wave = F.wave;
    if (hi - lo > 1) bar = xcd_barrier_post(F.ctl + CW_BAR, MISC + 8, F.wave);
#ifndef PHMASK
#define PHMASK 0xFFFFFFFFu
#endif
#define KD(j) (((PHMASK) >> (j)) & 1u)
#define IN(k) (lo <= (k) && (k) < hi)
#define SEAM(k) do { if (IN((k) + 1)) xcd_barrier(bar); } while (0)
    unsigned char* ws = args.ws;
    u64* ssq_all = (u64*)(F.ctl + CW_SSQ);
    LAS unsigned char* lds = F.lds;

    if (KD(0) && IN(0)) { phase_prologue(F); SEAM(0); }

    auto run_layer = [&](auto LC) __attribute__((always_inline)) {
        constexpr int l = decltype(LC)::value;
        const int pb = 1 + l * PH_PER_LAYER;
        const u64* ssq_mix = ssq_all + (2 * l) * 8192; u64* ssq_ffn = ssq_all + (2 * l + 1) * 8192;
        bf16* XH = (bf16*)(ws + WS_XH);
        const float* xin = l == 0 ? args.in[0] : args.out; float* xmid = (float*)(ws + WS_XA); float* xout = args.out;
        if (KD(1) && IN(pb + 0)) {
            const int nNP = (l ? NP1 : NP0) / 256;
            { pg8::Gemm g{XH, (const bf16*)(ws + (l ? WS_WPT1 : WS_WPT0)), D, D, D, 0, 0}; pg8::GridOrder S; S.init(M / 256, nNP, 1, F.G, F.bid);
              EpiP E{(bf16*)(ws + WS_P), (bf16*)(ws + WS_G4), ssq_mix, nNP}; pg8::gemm_phase<EpiP, pg8::GridOrder>(lds, g, S, E, F.wave); }
            if (l == 0 && F.G >= 16 && F.bid >= F.G - 16) { pg8::Gemm g{(const bf16*)(ws + WS_MEMN), (const bf16*)(ws + WS_WKVT0), D, D, D, 0, 0}; pg8::GridOrder S; S.init(2, 8, 1, 16, F.bid - (F.G - 16));
              EpiF32 E{(float*)(ws + WS_KVRAW), 2048}; pg8::gemm_phase<EpiF32, pg8::GridOrder>(lds, g, S, E, F.wave); }
            SEAM(pb + 0);
        }
        if (KD(2) && IN(pb + 1)) { phase_prep(F, l); SEAM(pb + 1); }
        if (KD(3) && IN(pb + 2)) {
            if (KD(17)) { pg8::Gemm g{(const bf16*)(ws + WS_ALORA), (const bf16*)(ws + (l ? WS_WLT1 : WS_WLT0)), 512, 512, 512, 0, 0}; pg8::GridOrder S; S.init(M / 256, 8, 1, F.G, F.bid);
              EpiLora E{(float*)(ws + WS_LO), args.in[7] + l * 512, args.in[9] + l * 512, args.in[19], l}; pg8::gemm_phase<EpiLora, pg8::GridOrder>(lds, g, S, E, F.wave); }
            if (KD(18) && F.bid < 32) { const int kp = F.bid >> 3;
              pg8::Gemm g{(const bf16*)(ws + WS_ACMP) + kp * 512, (const bf16*)(ws + (l ? WS_WC1T1 : WS_WC1T0)) + kp * 512, 2048, 2048, 512, (size_t)1024 * 2048 * 2, (size_t)256 * 2048 * 2}; pg8::GridOrder S; S.init(4, 1, 2, 8, F.bid & 7);
              EpiHP E{(float*)(ws + WS_HP) + (size_t)kp * 2 * 1024 * 128}; pg8::gemm_phase<EpiHP, pg8::GridOrder>(lds, g, S, E, F.wave); }
            __syncthreads();
            if (KD(19)) phase_memattn(F);
            SEAM(pb + 2);
        }
        if (KD(4) && IN(pb + 3)) {
            if (F.bid < 8) { const CmpFin CF{(const float*)(ws + WS_HP), args.in[24] + l * 256, (const bf16*)(ws + WS_WC2T) + (size_t)l * 2 * 64 * 128, args.in[21] + l * 256 + 64, (bf16*)(ws + WS_KC), (bf16*)(ws + WS_VCT)};
                cmp_finalize(CF, F.bid >> 2, F.bid & 3, lds, F.wave, F.lane); }
            phase_scan(F, l); SEAM(pb + 3); }
        if (KD(5) && IN(pb + 4)) { unsigned* cflags = F.ctl + CW_QCTR + 256 + 64 * l; phase_carry(F, cflags); if (F.bid % 5 < (l == 0 ? 2 : 1)) convert_late_loop<l>(F, F.ctl + CW_QCTR + 384 + 64 * l); phase_nsa(F, F.ctl + CW_QCTR + 64 * l); convert_late_loop<l>(F, F.ctl + CW_QCTR + 384 + 64 * l); phase_rwkv_fin(F, l, cflags, F.ctl + CW_QCTR + 128 + 64 * l); SEAM(pb + 4); }
        if (KD(7) && IN(pb + 6)) {
            pg8::Gemm g{(const bf16*)(ws + WS_Y), (const bf16*)(ws + (l ? WS_WBT1 : WS_WBT0)), 2560, 512, 512, (size_t)512 * 2, (size_t)2048 * 512 * 2}; pg8::GridOrder S; S.init(M / 256, 8, 5, F.G, F.bid);
            EpiZ E{(bf16*)(ws + WS_ZB)}; pg8::gemm_phase<EpiZ, pg8::GridOrder>(lds, g, S, E, F.wave);
            { pg8::Gemm g4{(const bf16*)(ws + WS_XH8), (const bf16*)(ws + (l ? WS_WG4T1 : WS_WG4T0)), D / 2, D / 2, D / 2, 0, 0}; pg8::GridOrder S4; S4.init(M / 256, 8, 1, F.G, F.bid);
              EpiGate4 E4{(bf16*)(ws + WS_G4), ssq_mix}; pg8::gemm_phase<EpiGate4, pg8::GridOrder, true, true>(lds, g4, S4, E4, F.wave); }
            SEAM(pb + 6);
        }
        if (KD(8) && IN(pb + 7)) {
            constexpr int KD2 = F8_G ? D / 2 : D; pg8::Gemm g{F8_G ? (const bf16*)(ws + WS_XH8) : (const bf16*)XH, (const bf16*)(ws + (l ? WS_WGT1 : WS_WGT0)), KD2, KD2, KD2, 0, 0}; pg8::GridOrder S; S.init(M / 256, 32, 1, F.G, F.bid);
            { const int sg = (F.bid >> 3) & 3; for (int i = 0; i < sg; ++i) __builtin_amdgcn_s_sleep(127); }
            EpiG E{(const bf16*)(ws + WS_ZB), (const bf16*)(ws + WS_G4), (bf16*)(ws + WS_MG), ssq_mix, F8_G ? W8SI : 1.f}; pg8::gemm_phase<EpiG, pg8::GridOrder, true, F8_G != 0>(lds, g, S, E, F.wave);
            SEAM(pb + 7);
        }
        if (KD(9) && IN(pb + 8)) {
            pg8::Gemm g{(const bf16*)(ws + WS_MG), (const bf16*)(ws + (l ? WS_WOT1 : WS_WOT0)), D, D, D, 0, 0}; pg8::GridOrder S; S.init(M / 256, 8, 1, F.G, F.bid);
            EpiRes E{XH, ssq_ffn, ws + WS_XH8}; pg8::gemm_phase<EpiRes, pg8::GridOrder>(lds, g, S, E, F.wave);
            SEAM(pb + 8);
        }
        if (l == 0) {
            if (KD(10) && IN(pb + 9)) {
                constexpr int KD2 = F8_F1 ? D / 2 : D; pg8::Gemm g{F8_F1 ? (const bf16*)(ws + WS_XH8) : (const bf16*)XH, (const bf16*)(ws + WS_W13T), KD2, KD2, KD2, 0, 0}; pg8::GridOrder S; S.init(M / 256, 2 * FF / 256, 1, F.G, F.bid);
                EpiSwiglu<false> E{(bf16*)(ws + WS_ACT), FF, ssq_ffn, nullptr, F8_F1 ? W8SI : 1.f, 1.f}; pg8::gemm_phase<EpiSwiglu<false>, pg8::GridOrder, true, F8_F1 != 0>(lds, g, S, E, F.wave);
                SEAM(pb + 9);
            }
            if (KD(11) && IN(pb + 10)) {
                pg8::Gemm g{(const bf16*)(ws + WS_ACT), (const bf16*)(ws + WS_W2T), FF, FF, FF, 0, 0}; pg8::GridOrder S; S.init(M / 256, 8, 1, F.G, F.bid);
                EpiRes E{XH, ssq_all + 2 * 8192, ws + WS_XH8}; pg8::gemm_phase<EpiRes, pg8::GridOrder>(lds, g, S, E, F.wave);
                SEAM(pb + 13);
            }
        } else {
            float* RSS = (float*)(ws + WS_RSS);
            if (KD(12) && IN(pb + 9)) { phase_route(F, XH); SEAM(pb + 9); }
            if (KD(13) && IN(pb + 10)) { phase_gather(F, RSS); SEAM(pb + 10); }
            if (KD(14) && IN(pb + 11)) {
                pg8::MoeOrder S; moe_tiles(F, S.ts); S.nN = 2 * EFF / 256; S.G = F.G; S.c = F.bid;
                constexpr int KD2 = F8_M1 ? D / 2 : D; pg8::Gemm g{(const bf16*)(ws + WS_XG), (const bf16*)(ws + WS_MW13T), KD2, KD2, KD2, 0, (size_t)2 * EFF * 2048 * (F8_M1 ? 1 : 2)};
                EpiSwiglu<F8_M2 != 0> E{(bf16*)(ws + WS_ACTM), EFF, nullptr, RSS, F8_M1 ? W8SI : 1.f, 8.f}; pg8::gemm_phase<EpiSwiglu<F8_M2 != 0>, pg8::MoeOrder, true, F8_M1 != 0>(lds, g, S, E, F.wave);
                SEAM(pb + 11);
            }
            if (KD(15) && IN(pb + 12)) {
                pg8::MoeOrder S; moe_tiles(F, S.ts); S.nN = 8; S.G = F.G; S.c = F.bid;
                constexpr int KE2 = F8_M2 ? EFF / 2 : EFF; pg8::Gemm g{(const bf16*)(ws + WS_ACTM), (const bf16*)(ws + WS_MW2T), KE2, KE2, KE2, 0, (size_t)2048 * EFF * (F8_M2 ? 1 : 2)};
                EpiBf E{(bf16*)(ws + WS_YS), D, F8_M2 ? W8SI / 8.f : 1.f}; pg8::gemm_phase<EpiBf, pg8::MoeOrder, true, F8_M2 != 0>(lds, g, S, E, F.wave);
                SEAM(pb + 12);
            }
            if (KD(16) && IN(pb + 13)) { phase_combine(F, XH, xout); }
        }
    };
    run_layer(std::integral_constant<int, 0>{});
    run_layer(std::integral_constant<int, 1>{});
#undef IN
#undef SEAM
}

#ifdef DBG_STOP
__global__ void dbg_dump(const unsigned char* buf, size_t nelem, int is_bf16, float* out, int nout) {
    for (int i = blockIdx.x * blockDim.x + threadIdx.x; i < nout; i += gridDim.x * blockDim.x) { float s = 0.f;
        for (size_t j = (size_t)i; j < nelem; j += (size_t)nout) s += is_bf16 ? bf2f(((const bf16*)buf)[j]) : ((const float*)buf)[j];
        out[i] = s; }
}
__global__ void dbg_cols(const bf16* buf, int ld, int c0, int w, float* out) {
    for (int i = blockIdx.x * blockDim.x + threadIdx.x; i < M * D; i += gridDim.x * blockDim.x) { const int row = i >> 11, c = i & 2047; out[i] = bf2f(buf[(size_t)row * ld + c0 + (c % w)]); }
}
#endif
extern "C" void kernel_launch(void* const* d_in, const int* in_sizes, int n_in, void* d_out, int out_size, void* d_ws, size_t ws_size, hipStream_t stream) {
    static int grid = 0;
    if (grid == 0) {
        if (n_in != 40 || out_size != M * D || ws_size < WS_END) { fprintf(stderr, "kernel_launch: unexpected shapes (n_in %d out %d ws %zu need %zu)\n", n_in, out_size, ws_size, (size_t)WS_END); grid = -1; return; }
        int dev = 0, cus = 0, per_cu = 0;
        if (hipGetDevice(&dev) != hipSuccess || hipDeviceGetAttribute(&cus, hipDeviceAttributeMultiprocessorCount, dev) != hipSuccess) { grid = -1; return; }
        if (hipFuncSetAttribute((const void*)mega_fwd, hipFuncAttributeMaxDynamicSharedMemorySize, LDS_BYTES) != hipSuccess) { fprintf(stderr, "kernel_launch: hipFuncSetAttribute failed\n"); grid = -1; return; }
        if (hipOccupancyMaxActiveBlocksPerMultiprocessor(&per_cu, (const void*)mega_fwd, 512, LDS_BYTES) != hipSuccess || per_cu < 1) fprintf(stderr, "kernel_launch: occupancy query reports %d\n", per_cu);
        (void)hipGetLastError();
        grid = cus;
    }
    if (grid < 0) return;
    if (hipMemsetAsync((char*)d_ws + WS_CTL, 0, CTL_BYTES, stream) != hipSuccess) return;
    Args a{};
    for (int i = 0; i < 40; ++i) a.in[i] = (const float*)d_in[i];
    a.out = (float*)d_out; a.ws = (unsigned char*)d_ws;
#if MK_ONE_LAUNCH
    a.ph_lo = 0; a.ph_hi = N_PHASES;
    hipLaunchKernelGGL(mega_fwd, dim3(grid), dim3(512), LDS_BYTES, stream, a);
#else
    for (int p = 0; p < N_PHASES; ++p) {
        if (p >= 1 + 11 && p < 1 + PH_PER_LAYER) continue;
#ifdef DBG_STOP
        if (p > DBG_STOP) break;
#endif
        a.ph_lo = p; a.ph_hi = p + 1;
        hipLaunchKernelGGL(mega_fwd, dim3(grid), dim3(512), LDS_BYTES, stream, a);
    }
#ifdef DBG_STOP
#ifdef DBG_C0
    hipLaunchKernelGGL(dbg_cols, dim3(2048), dim3(256), 0, stream, (const bf16*)((const unsigned char*)d_ws + (size_t)(DBG_OFF)), (int)(DBG_LD), (int)(DBG_C0), (int)(DBG_W), (float*)d_out);
#else
    hipLaunchKernelGGL(dbg_dump, dim3(2048), dim3(256), 0, stream, (const unsigned char*)d_ws + (size_t)(DBG_OFF), (size_t)(DBG_NELEM), (int)(DBG_BF16), (float*)d_out, M * D);
#endif
#endif
#endif
}
```

```cpp
#include <hip/hip_runtime.h>
#include <cstdio>
#include <cstdint>
#include <type_traits>

#ifndef F8_G
#define F8_G 1
#endif
#ifndef F8_F1
#define F8_F1 0
#endif
#ifndef F8_M1
#define F8_M1 1
#endif
#ifndef F8_M2
#define F8_M2 1
#endif
#ifndef MK_ONE_LAUNCH
#define MK_ONE_LAUNCH 1
#endif

#define GAS __attribute__((address_space(1)))
#define LAS __attribute__((address_space(3)))
typedef unsigned short bf16;
typedef short bf16x8 __attribute__((ext_vector_type(8)));
typedef float f32x4 __attribute__((ext_vector_type(4)));
typedef float f32x2 __attribute__((ext_vector_type(2)));
typedef unsigned u32x4 __attribute__((ext_vector_type(4)));
typedef unsigned u32x2 __attribute__((ext_vector_type(2)));

constexpr int M = 8192, T = 4096, D = 2048;
constexpr int LDP = 6144;
constexpr int NP0 = 5888, NP1 = 6144;
constexpr int PC_R = 0, PC_K = 512, PC_V = 1024, PC_WD = 1536, PC_AD = 1632, PC_GD = 1728;
constexpr int PC_Q = 1984, PC_KC = 2496, PC_VC = 2624, PC_KS = 2752, PC_VS = 2880, PC_KW = 3008, PC_VW = 3136, PC_GL = 3264;
constexpr int PC_CB = 3288, PC_CC = 3800, PC_CX = 4312, PC_POOL = 4824, PC_MEM = 5336, PC_GATE = 5848, PC_VRES = 5848;
constexpr int NIN = 16088;
constexpr int FF = 5632, EFF = 2816, NE = 8;
constexpr float NORM_EPS = 1e-6f;
constexpr float CQ_NSA = 0.125f * 1.4426950408889634f, CQ_MEM = 0.08838834764831845f * 1.4426950408889634f;
constexpr int SLOTS = 18432;

constexpr size_t al4k(size_t x) { return (x + 4095) & ~(size_t)4095; }
constexpr size_t MiB = 1u << 20;
constexpr size_t WS_CTL = 0, CTL_BYTES = MiB;
constexpr size_t SZ_WPT0 = (size_t)NP0 * 2048 * 2, SZ_WPT1 = (size_t)NP1 * 2048 * 2;
constexpr size_t SZ_WGT = (size_t)8192 * 2048 * 2, SZ_WBT = (size_t)5 * 2048 * 512 * 2, SZ_WOT = (size_t)2048 * 2048 * 2, SZ_WLT = (size_t)2048 * 512 * 2;
constexpr size_t SZ_WKVT = (size_t)1024 * 2048 * 2, SZ_WC1T = (size_t)2 * 256 * 2048 * 2;
constexpr size_t WS_WPT0 = WS_CTL + CTL_BYTES;
constexpr size_t WS_WPT1 = WS_WPT0 + SZ_WPT0;
constexpr size_t WS_WGT0 = WS_WPT1 + SZ_WPT1, WS_WGT1 = WS_WGT0 + SZ_WGT;
constexpr size_t WS_WG4T0 = WS_WGT1 + SZ_WGT, WS_WG4T1 = WS_WG4T0 + (size_t)2048 * 2048;
constexpr size_t WS_WBT0 = WS_WG4T1 + (size_t)2048 * 2048, WS_WBT1 = WS_WBT0 + SZ_WBT;
constexpr size_t WS_WOT0 = WS_WBT1 + SZ_WBT, WS_WOT1 = WS_WOT0 + SZ_WOT;
constexpr size_t WS_WLT0 = WS_WOT1 + SZ_WOT, WS_WLT1 = WS_WLT0 + SZ_WLT;
constexpr size_t WS_WKVT0 = WS_WLT1 + SZ_WLT, WS_WKVT1 = WS_WKVT0 + SZ_WKVT;
constexpr size_t WS_WC1T0 = WS_WKVT1 + SZ_WKVT, WS_WC1T1 = WS_WC1T0 + SZ_WC1T;
constexpr size_t WS_WC2T = WS_WC1T1 + SZ_WC1T;
constexpr size_t WS_W13T = WS_WC2T + (size_t)65536;
constexpr size_t WS_W2T = WS_W13T + (size_t)2 * FF * 2048 * 2;
constexpr size_t WS_MW13T = WS_W2T + (size_t)2048 * FF * 2;
constexpr size_t WS_MW2T = WS_MW13T + (size_t)NE * 2 * EFF * 2048 * 2;
constexpr size_t WS_XA = WS_MW2T + (size_t)NE * 2048 * EFF * 2;
constexpr size_t WS_XH = WS_XA + (size_t)M * D * 4;
constexpr size_t WS_MEMN = WS_XH + (size_t)M * D * 2;
constexpr size_t WS_G4 = WS_MEMN + (size_t)512 * 2048 * 2;
constexpr size_t WS_Y = WS_G4 + (size_t)M * D * 2;
constexpr size_t WS_VFIRST = WS_Y + (size_t)M * 2560 * 2;
constexpr size_t WS_KVRAW = WS_VFIRST + (size_t)M * 512 * 4;
constexpr size_t WS_XH8 = WS_KVRAW + (size_t)512 * 2048 * 4;
constexpr size_t WS_OV = WS_XH8 + (size_t)M * D;
constexpr size_t WS_P = WS_OV;
constexpr size_t WS_ALORA = WS_P + (size_t)M * LDP * 2;
constexpr size_t WS_LO = WS_ALORA + (size_t)M * 512 * 2;
constexpr size_t WS_YL = WS_LO + (size_t)M * 2048 * 4;
constexpr size_t WS_ZL = WS_YL + (size_t)M * 512 * 4;
constexpr size_t WS_QF = WS_ZL + (size_t)M * 512 * 4;
constexpr size_t WS_PF = WS_QF + (size_t)2048 * 4096 * 4;
constexpr size_t WS_SINIT = WS_PF + (size_t)2048 * 4096 * 4;
constexpr size_t WS_VCUR = WS_SINIT + (size_t)2048 * 4096 * 4;
constexpr size_t WS_BON = WS_VCUR + (size_t)M * 512 * 4;
constexpr size_t WS_QN = WS_BON + (size_t)M * 8 * 4;
constexpr size_t WS_KS = WS_QN + (size_t)M * 512 * 2;
constexpr size_t WS_KW = WS_KS + (size_t)M * 128 * 2;
constexpr size_t WS_VST = WS_KW + (size_t)M * 128 * 2;
constexpr size_t WS_VWT = WS_VST + (size_t)M * 128 * 2;
constexpr size_t WS_ACMP = WS_VWT + (size_t)M * 128 * 2;
constexpr size_t WS_KC = WS_ACMP + (size_t)2 * 1024 * 2048 * 2;
constexpr size_t WS_VCT = WS_KC + (size_t)4 * 256 * 64 * 2;
constexpr size_t WS_QM = WS_VCT + (size_t)4 * 256 * 64 * 2;
constexpr size_t WS_KMEM = WS_QM + (size_t)M * 512 * 2;
constexpr size_t WS_VMEMT = WS_KMEM + (size_t)8 * 256 * 128 * 2;
constexpr size_t WS_HP = WS_VMEMT + (size_t)8 * 256 * 128 * 2;
constexpr size_t WS_MIX_END = WS_HP + (size_t)4 * 2 * 1024 * 128 * 4;
constexpr size_t WS_ZB = WS_OV;
constexpr size_t WS_MG = WS_ZB + (size_t)5 * M * D * 2;
constexpr size_t WS_ACT = WS_OV;
constexpr size_t WS_XG = WS_OV;
constexpr size_t WS_ACTM = WS_XG + (size_t)SLOTS * 2048 * 2;
constexpr size_t WS_YS = WS_ACTM + (size_t)SLOTS * EFF * 2;
constexpr size_t WS_RSS = WS_YS + (size_t)SLOTS * 2048 * 2;
constexpr size_t WS_MOE_END = WS_RSS + (size_t)SLOTS * 4;
constexpr size_t WS_END = WS_MIX_END > WS_MOE_END ? WS_MIX_END : WS_MOE_END;
static_assert(WS_END <= (size_t)1119977216, "workspace map exceeds the guaranteed d_ws size");
static_assert(WS_MG + (size_t)M * D * 2 <= WS_MIX_END, "Z view inside overlay");

constexpr int CW_BAR = 4096;
constexpr int CW_SSQ = 16384;
constexpr int CW_CNT = CW_SSQ + 4 * 8192 * 2;
constexpr int CW_QCTR = CW_CNT + 512;
constexpr int CW_ROUTE = CW_CNT + 1024;
static_assert((CW_ROUTE + 8 * 8192) * 4 <= (int)CTL_BYTES, "CTL map");

constexpr int RING_BYTES = 131072;
constexpr int MISC_OFF = RING_BYTES + 320;
constexpr int LDS_BYTES = 147456;

#define RLX_AGENT __ATOMIC_RELAXED, __HIP_MEMORY_SCOPE_AGENT
#define LDS_WAIT() asm volatile("s_waitcnt lgkmcnt(0)" ::: "memory")
#define VM_WAIT() asm volatile("s_waitcnt vmcnt(0)" ::: "memory")
__device__ __forceinline__ unsigned f2bf(float f) { unsigned u = __builtin_bit_cast(unsigned, f); return (u + 0x7fffu + ((u >> 16) & 1u)) >> 16; }
__device__ __forceinline__ float bf2f(unsigned b) { return __builtin_bit_cast(float, b << 16); }
typedef __bf16 bf16x2_t __attribute__((ext_vector_type(2)));
__device__ __forceinline__ unsigned pk2(float lo, float hi) { const bf16x2_t b = __builtin_convertvector((f32x2){lo, hi}, bf16x2_t); return __builtin_bit_cast(unsigned, b); }
__device__ __forceinline__ unsigned pk4_fp8(float a, float b, float c, float d) { unsigned w = 0u; w = (unsigned)__builtin_amdgcn_cvt_pk_fp8_f32(a, b, (int)w, false); w = (unsigned)__builtin_amdgcn_cvt_pk_fp8_f32(c, d, (int)w, true); return w; }
constexpr float W8S = 64.0f, W8SI = 1.0f / 64.0f;
__device__ __forceinline__ float sigmoidf_(float x) { return __builtin_amdgcn_rcpf(1.f + __builtin_amdgcn_exp2f(x * -1.4426950408889634f)); }
#define DPPF(v, ctrl) __builtin_bit_cast(float, __builtin_amdgcn_update_dpp(0, __builtin_bit_cast(int, (v)), (ctrl), 0xf, 0xf, true))
__device__ __forceinline__ float red16_max(float v) { v = fmaxf(v, DPPF(v, 0xB1)); v = fmaxf(v, DPPF(v, 0x4E)); v = fmaxf(v, DPPF(v, 0x141)); v = fmaxf(v, DPPF(v, 0x140)); return v; }
__device__ __forceinline__ float red16_sum(float v) { v += DPPF(v, 0xB1); v += DPPF(v, 0x4E); v += DPPF(v, 0x141); v += DPPF(v, 0x140); return v; }
__device__ __forceinline__ float wave_sum(float v) {
#pragma unroll
    for (int o = 1; o < 64; o <<= 1) v += __shfl_xor(v, o);
    return v;
}

#define XB_TMO      128
#define XB_XCNT(j)  (256  + 64 * (j))
#define XB_XSUB(j)  (1280 + 64 * (j))
#define XB_XGEN(j)  (2304 + 64 * (j))
#define XB_TOP      3328
#define XB_TOPGEN   3392
#define XCD_BAR_WORDS 3456
#define XB_SPIN_CAP (1u << 18)
__device__ __forceinline__ unsigned xb_ld(unsigned* p)              { return __hip_atomic_load(p, __ATOMIC_RELAXED, __HIP_MEMORY_SCOPE_AGENT); }
__device__ __forceinline__ unsigned xb_add(unsigned* p, unsigned v) { return __hip_atomic_fetch_add(p, v, __ATOMIC_RELAXED, __HIP_MEMORY_SCOPE_AGENT); }
__device__ __forceinline__ unsigned xb_xcc_id() { return (unsigned)__builtin_amdgcn_s_getreg((3 << 11) | 20) & 0xFu; }
#define XB_SPIN(cond, bar) do { unsigned _sp = 0; while (cond) { __builtin_amdgcn_s_sleep(1); \
    if ((++_sp & 255u) == 0u) { if (xb_ld(&(bar)[XB_TMO])) break; if (_sp > XB_SPIN_CAP) { atomicAdd(&(bar)[XB_TMO], 1u); break; } } } } while (0)
struct XcdBarrier { unsigned* bar; unsigned x; volatile LAS unsigned* st; int wave; };
__device__ __forceinline__ bool xb_t0(int wave) { return wave == 0 && __builtin_amdgcn_mbcnt_hi(~0u, __builtin_amdgcn_mbcnt_lo(~0u, 0u)) == 0u; }
__device__ __forceinline__ XcdBarrier xcd_barrier_post(unsigned* bar, volatile LAS unsigned* st, int wave) {
    XcdBarrier b; b.bar = bar; b.x = xb_xcc_id(); b.st = st; b.wave = wave;
    if (xb_t0(wave)) (void)xb_add(&bar[XB_XCNT(b.x)], 1u);
    return b;
}
__device__ __forceinline__ void xcd_barrier_complete(unsigned* bar, unsigned x, unsigned& nloc, unsigned& nx) {
    const unsigned G = gridDim.x * gridDim.y * gridDim.z;
    unsigned sum, cnt, mine, sp = 0u;
    for (;;) {
        sum = 0u; cnt = 0u; mine = 0u;
#pragma unroll
        for (unsigned j = 0; j < 16; ++j) { const unsigned c = xb_ld(&bar[XB_XCNT(j)]); sum += c; cnt += (c > 0u) ? 1u : 0u; mine = (j == x) ? c : mine; }
        if (sum == G) break;
        __builtin_amdgcn_s_sleep(1);
        if ((++sp & 255u) == 0u) { if (xb_ld(&bar[XB_TMO])) break; if (sp > XB_SPIN_CAP) { atomicAdd(&bar[XB_TMO], 1u); break; } }
    }
    nloc = mine > 0u ? mine : 1u; nx = cnt > 0u ? cnt : 1u;
}
__device__ __forceinline__ void xcd_barrier(const XcdBarrier& b) {
    asm volatile("s_waitcnt vmcnt(0)" ::: "memory");
    __syncthreads();
    if (xb_t0(b.wave)) {
        unsigned* bar = b.bar;
        __builtin_amdgcn_s_waitcnt(0);
        unsigned nloc = b.st[0], nx = b.st[1];
        if (nloc == 0u) { xcd_barrier_complete(bar, b.x, nloc, nx); b.st[0] = nloc; b.st[1] = nx; }
        const unsigned old = xb_add(&bar[XB_XSUB(b.x)], 1u);
        const unsigned gen = old / nloc;
        if (old + 1u == (gen + 1u) * nloc) {
            __builtin_amdgcn_fence(__ATOMIC_RELEASE, "agent");
            asm volatile("s_waitcnt vmcnt(0)" ::: "memory");
            const unsigned og = xb_add(&bar[XB_TOP], 1u);
            const unsigned tg = og / nx;
            if (og + 1u == (tg + 1u) * nx) xb_add(&bar[XB_TOPGEN], 1u);
            else XB_SPIN(xb_ld(&bar[XB_TOPGEN]) == tg, bar);
            __builtin_amdgcn_fence(__ATOMIC_ACQUIRE, "agent");
            xb_add(&bar[XB_XGEN(b.x)], 1u);
            asm volatile("s_waitcnt vmcnt(0)" ::: "memory");
        } else {
            XB_SPIN(xb_ld(&bar[XB_XGEN(b.x)]) == gen, bar);
            __builtin_amdgcn_fence(__ATOMIC_ACQUIRE, "agent");
            asm volatile("s_waitcnt vmcnt(0)" ::: "memory");
        }
    }
    __syncthreads();
}

namespace pg8 {
typedef int v4i_t __attribute__((ext_vector_type(4)));
typedef int v8i_t __attribute__((ext_vector_type(8)));
constexpr int BM = 256, BK = 64, HALF = 128, HTB = HALF * BK * 2, STAGE_BYTES = 8 * HTB, NXCD = 8, WGM = 8;
__host__ __device__ __forceinline__ int lds_byte(int r, int c) { const int st = (r >> 4) * 2 + (c >> 5), rr = r & 15, cc = c & 31, ob = rr * 64 + cc * 2; return st * 1024 + (ob ^ (((ob >> 9) & 1) << 5)); }
__host__ __device__ __forceinline__ void stage_rc(int b, int& R, int& C) { const int st = b / 1024, sb = b % 1024, swz = sb ^ (((sb >> 9) & 1) << 5); R = (st >> 1) * 16 + swz / 64; C = (st & 1) * 32 + (swz % 64) / 2; }
__host__ __device__ __forceinline__ int perm32(int rho) { const int n = rho >> 4, i = rho & 15; return 8 * (i >> 2) + 4 * n + (i & 3); }
struct Unit { int pm, pn, z; };
struct Gemm { const bf16* A; const bf16* Bt; int lda, ldb, K; size_t az, bz; };

struct GridOrder {
    int nM, nN, nZ, G, c;
    __device__ void init(int nM_, int nN_, int nZ_, int G_, int c_) { nM = nM_; nN = nN_; nZ = nZ_; G = G_; c = c_; }
    __device__ bool next(int i, Unit& u) const {
        const long L = (long)i * G + c; const int nwg = nM * nN; if (L >= (long)nwg * nZ) return false;
        u.z = (int)(L / nwg); int wgid = (int)(L % nwg);
        { const int q = nwg / NXCD, r = nwg % NXCD, xcd = wgid % NXCD, off = wgid / NXCD; wgid = (xcd < r ? xcd * (q + 1) : r * (q + 1) + (xcd - r) * q) + off; }
        const int nig = WGM * nN, gid = wgid / nig, fm = gid * WGM, gsz = (nM - fm) < WGM ? (nM - fm) : WGM;
        u.pm = fm + ((wgid % nig) % gsz); u.pn = (wgid % nig) / gsz; return true;
    }
    __device__ __forceinline__ void a_ready(const Unit&) const {}
    __device__ __forceinline__ void done(const Unit&) const {}
};
struct PBOrder {
    GridOrder base; int nP, nX;
    __device__ bool next(int i, Unit& u) const {
        const long L = (long)i * base.G + base.c;
        if (L < nP) return base.next(i, u);
        const int e = (int)(L - nP); if (e >= nX) return false;
        u.z = 1; u.pm = e & 1; u.pn = e >> 1; return true; }
    __device__ __forceinline__ void a_ready(const Unit&) const {}
    __device__ __forceinline__ void done(const Unit&) const {}
};
struct MoeOrder {
    int ts[9]; int nN, G, c;
    __device__ bool next(int i, Unit& u) const {
        const long L = (long)i * G + c; const int rt = (int)(L / nN); if (rt >= ts[8]) return false;
        u.pn = (int)(L % nN); u.pm = rt; int e = 0;
#pragma unroll
        for (int j = 1; j < 8; ++j) e += (rt >= ts[j]) ? 1 : 0;
        u.z = e; return true;
    }
    __device__ __forceinline__ void a_ready(const Unit&) const {}
    __device__ __forceinline__ void done(const Unit&) const {}
};

template <class Epi, class Sched, bool ALIGN_EPI = true, bool F8 = false>
__device__ __forceinline__ void gemm_phase(LAS unsigned char* lds, const Gemm g, const Sched& S, const Epi& E, int wave0) {
    int lane_ = (int)__builtin_amdgcn_mbcnt_hi(~0u, __builtin_amdgcn_mbcnt_lo(~0u, 0u)); asm volatile("" : "+v"(lane_));
    const int wid = wave0, lane = lane_, tid = wid * 64 + lane, wr = wid >> 2, wc = wid & 3, fr = lane & 15, fq = lane >> 4;
    const int K = g.K, nt = K / BK;
    unsigned voffA[2], voffB[2];
#pragma unroll
    for (int i = 0; i < 2; ++i) { int R, C; stage_rc(tid * 16 + i * 8192, R, C); const int Rb = Epi::PERM ? ((R & ~31) + perm32(R & 31)) : R;
        voffA[i] = (unsigned)(R * g.lda + C) * 2u; voffB[i] = (unsigned)(Rb * g.ldb + C) * 2u; }
    const size_t kstep = (size_t)(BK * 2);
    const size_t hA = (size_t)HALF * g.lda * 2, hB = (size_t)HALF * g.ldb * 2;
    const unsigned ldsw = (unsigned)wid * 1024u;
    const int aoff = lds_byte(wr * 64 + fr, fq * 8), boff = lds_byte(wc * 32 + fr, fq * 8);
#define PG8_SA(b, h) (((b) * 2 + (h)) * HTB)
#define PG8_SB(b, h) ((4 + (b) * 2 + (h)) * HTB)
#define PG8_STAGE(bufoff, gbase, voff) do { _Pragma("unroll") for (int _i = 0; _i < 2; ++_i) \
        __builtin_amdgcn_global_load_lds((const unsigned*)((const char*)(gbase) + (voff)[_i]), (LAS unsigned*)(lds + (bufoff) + ldsw + _i * 8192), 16, 0, 0); } while (0)
#define PG8_LDA(dst, b, h) do { _Pragma("unroll") for (int m = 0; m < 4; ++m) _Pragma("unroll") for (int k = 0; k < 2; ++k) dst[m][k] = *(const LAS bf16x8*)(lds + PG8_SA(b, h) + aoff + m * 2048 + k * 1024); } while (0)
#define PG8_LDB(dst, b, h) do { _Pragma("unroll") for (int n = 0; n < 2; ++n) _Pragma("unroll") for (int k = 0; k < 2; ++k) dst[n][k] = *(const LAS bf16x8*)(lds + PG8_SB(b, h) + boff + n * 2048 + k * 1024); } while (0)
#define PG8_MMA(ai, bj, At, Bt) do { __builtin_amdgcn_s_setprio(1); \
        if constexpr (F8) { _Pragma("unroll") for (int m = 0; m < 4; ++m) _Pragma("unroll") for (int n = 0; n < 2; ++n) { \
            const v4i_t b0 = __builtin_bit_cast(v4i_t, Bt[n][0]), b1 = __builtin_bit_cast(v4i_t, Bt[n][1]), a0 = __builtin_bit_cast(v4i_t, At[m][0]), a1 = __builtin_bit_cast(v4i_t, At[m][1]); \
            const v8i_t b8 = __builtin_shufflevector(b0, b1, 0, 1, 2, 3, 4, 5, 6, 7), a8 = __builtin_shufflevector(a0, a1, 0, 1, 2, 3, 4, 5, 6, 7); \
            asm volatile("v_mfma_f32_16x16x128_f8f6f4 %0, %1, %2, %0" : "+v"(acc[ai][bj][m][n]) : "v"(b8), "v"(a8)); } }     \
        else { _Pragma("unroll") for (int m = 0; m < 4; ++m) _Pragma("unroll") for (int n = 0; n < 2; ++n) _Pragma("unroll") for (int k = 0; k < 2; ++k) \
            acc[ai][bj][m][n] = __builtin_amdgcn_mfma_f32_16x16x32_bf16(Bt[n][k], At[m][k], acc[ai][bj][m][n], 0, 0, 0); } \
        __builtin_amdgcn_s_setprio(0); } while (0)
#define PG8_WAIT_V(n) asm volatile("s_waitcnt vmcnt(" #n ")" ::: "memory")
#define PG8_WAIT_L(n) asm volatile("s_waitcnt lgkmcnt(" #n ")" ::: "memory")
#define PG8_BAR __builtin_amdgcn_s_barrier()
#define PG8_SCHED __builtin_amdgcn_sched_barrier(0)
    Unit cur, nxt; int ui = 0;
    if (!S.next(0, cur)) return;
    f32x4 acc[2][2][4][2];
#pragma unroll
    for (int a = 0; a < 2; ++a)
#pragma unroll
        for (int b = 0; b < 2; ++b)
#pragma unroll
            for (int m = 0; m < 4; ++m)
#pragma unroll
                for (int n = 0; n < 2; ++n) acc[a][b][m][n] = (f32x4){0.f, 0.f, 0.f, 0.f};
    bf16x8 At[4][2], B0[2][2], B1[2][2];
    const char* cA = (const char*)g.A + (size_t)cur.z * g.az + (size_t)cur.pm * 2 * hA; const char* cB = (const char*)g.Bt + (size_t)cur.z * g.bz + (size_t)cur.pn * 2 * hB;
    S.a_ready(cur);
    PG8_STAGE(PG8_SB(0, 0), cB, voffB); PG8_STAGE(PG8_SB(0, 1), cB + hB, voffB); PG8_STAGE(PG8_SA(0, 0), cA, voffA); PG8_STAGE(PG8_SA(0, 1), cA + hA, voffA);
    if (wr == 1) PG8_BAR;
    PG8_WAIT_V(2); PG8_BAR;
    PG8_STAGE(PG8_SB(1, 0), cB + kstep, voffB); PG8_STAGE(PG8_SA(1, 0), cA + kstep, voffA); PG8_STAGE(PG8_SB(1, 1), cB + hB + kstep, voffB);
    PG8_WAIT_V(6); PG8_BAR;
    for (;;) {
        const bool has_next = S.next(ui + 1, nxt);
        const char* nA = has_next ? (const char*)g.A + (size_t)nxt.z * g.az + (size_t)nxt.pm * 2 * hA : cA; const char* nB = has_next ? (const char*)g.Bt + (size_t)nxt.z * g.bz + (size_t)nxt.pn * 2 * hB : cB;
        for (int t = 0; t < nt; t += 2) {
            const bool last = (t == nt - 2);
            const char* a1 = cA + (size_t)(t + 1) * kstep;
            const char* a2 = last ? nA : cA + (size_t)(t + 2) * kstep; const char* b2 = last ? nB : cB + (size_t)(t + 2) * kstep;
            const char* a3 = a2 + kstep; const char* b3 = b2 + kstep;
            if (last && has_next) S.a_ready(nxt);
            PG8_LDB(B0, 0, 0); PG8_LDB(B1, 0, 1); PG8_SCHED; PG8_LDA(At, 0, 0); PG8_STAGE(PG8_SA(1, 1), a1 + hA, voffA);
            PG8_WAIT_V(8); PG8_WAIT_L(0); PG8_BAR; PG8_MMA(0, 0, At, B0); PG8_MMA(0, 1, At, B1); PG8_BAR; PG8_SCHED;
            PG8_LDA(At, 0, 1); PG8_STAGE(PG8_SB(0, 0), b2, voffB); PG8_STAGE(PG8_SB(0, 1), b2 + hB, voffB); PG8_STAGE(PG8_SA(0, 0), a2, voffA);
            PG8_WAIT_V(8); PG8_WAIT_L(0); PG8_BAR; PG8_MMA(1, 0, At, B0); PG8_MMA(1, 1, At, B1); PG8_BAR; PG8_SCHED;
            PG8_LDB(B0, 1, 0); PG8_LDB(B1, 1, 1); PG8_SCHED; PG8_LDA(At, 1, 0); PG8_STAGE(PG8_SA(0, 1), a2 + hA, voffA);
            PG8_WAIT_V(8); PG8_WAIT_L(0); PG8_BAR; PG8_MMA(0, 0, At, B0); PG8_MMA(0, 1, At, B1); PG8_BAR; PG8_SCHED;
            PG8_LDA(At, 1, 1); PG8_STAGE(PG8_SB(1, 0), b3, voffB); PG8_STAGE(PG8_SB(1, 1), b3 + hB, voffB); PG8_STAGE(PG8_SA(1, 0), a3, voffA);
            PG8_WAIT_V(8); PG8_WAIT_L(0); PG8_BAR; PG8_MMA(1, 0, At, B0); PG8_MMA(1, 1, At, B1); PG8_BAR; PG8_SCHED;
        }
        if constexpr (ALIGN_EPI) { if (wr == 0) PG8_BAR; }
        if constexpr (F8) asm volatile("s_nop 15\n\ts_nop 15\n\ts_nop 15\n\ts_nop 15" ::: "memory");
        if constexpr (!Epi::AFTER_DRAIN) { E(acc, cur, wr, wc, fr, fq); S.done(cur); }
        if (!has_next) break;
#pragma unroll
        for (int a = 0; a < 2; ++a)
#pragma unroll
            for (int b = 0; b < 2; ++b)
#pragma unroll
                for (int m = 0; m < 4; ++m)
#pragma unroll
                    for (int n = 0; n < 2; ++n) acc[a][b][m][n] = (f32x4){0.f, 0.f, 0.f, 0.f};
        cur = nxt; cA = nA; cB = nB; ++ui;
        if constexpr (ALIGN_EPI) { if (wr == 1) PG8_BAR; }
    }
    PG8_WAIT_V(0);
    if constexpr (!ALIGN_EPI) { if (wr == 0) PG8_BAR; }
    PG8_BAR;
    if constexpr (Epi::AFTER_DRAIN) { E.fused(acc, cur, wr, wc, fr, fq, lds, wid, lane); S.done(cur); }
#undef PG8_SA
#undef PG8_SB
#undef PG8_STAGE
#undef PG8_LDA
#undef PG8_LDB
#undef PG8_MMA
#undef PG8_WAIT_V
#undef PG8_WAIT_L
#undef PG8_BAR
#undef PG8_SCHED
}
}
using pg8::Unit; using pg8::HALF; using pg8::BM;
typedef const f32x4 (&AccT)[2][2][4][2];

typedef unsigned long long u64;
__device__ __forceinline__ float rstd_of(const u64* ssq, int row) { return __builtin_amdgcn_rsqf((float)ssq[row] * (1.0f / 4294967296.0f) * (1.0f / D) + NORM_EPS); }
__device__ __forceinline__ size_t zblk(int row, int col) { return ((size_t)(row >> 4) * (D / 16) + (col >> 4)) * 256 + (row & 15) * 16 + (col & 15); }
__device__ __forceinline__ float rstd_raw(u64 q) { return __builtin_amdgcn_rsqf((float)q * (1.0f / 4294967296.0f) * (1.0f / D) + NORM_EPS); }
__device__ __forceinline__ u64 ssq_fix(float s) { return (u64)(s * 4294967296.0f); }

struct EpiP {
    static constexpr bool PERM = true, AFTER_DRAIN = false;
    bf16* P; bf16* G4; const u64* ssq; int nNP;
    __device__ __forceinline__ void operator()(AccT acc, const Unit& u, int wr, int wc, int fr, int fq) const {
        const int row0 = u.pm * BM + wr * 64 + fr; const bool gate = u.pn >= nNP;
        bf16* base = gate ? G4 : P; const int ld = gate ? D : LDP; const int col0 = (gate ? (u.pn - nNP) : u.pn) * BM + wc * 32 + 8 * fq;
        float rs8[2][4];
#pragma unroll
        for (int ai = 0; ai < 2; ++ai)
#pragma unroll
            for (int m = 0; m < 4; ++m) rs8[ai][m] = rstd_of(ssq, row0 + ai * HALF + m * 16);
#pragma unroll
        for (int ai = 0; ai < 2; ++ai)
#pragma unroll
            for (int m = 0; m < 4; ++m) { const int row = row0 + ai * HALF + m * 16; const float rs = rs8[ai][m]; bf16* rowp = base + (size_t)row * ld + col0;
#pragma unroll
                for (int bj = 0; bj < 2; ++bj) { f32x4 v0 = acc[ai][bj][m][0] * rs, v1 = acc[ai][bj][m][1] * rs;
                    if (gate) {
#pragma unroll
                        for (int j = 0; j < 4; ++j) { v0[j] = sigmoidf_(v0[j]); v1[j] = sigmoidf_(v1[j]); } }
                    u32x4 w; w.x = pk2(v0[0], v0[1]); w.y = pk2(v0[2], v0[3]); w.z = pk2(v1[0], v1[1]); w.w = pk2(v1[2], v1[3]);
                    *(u32x4*)(rowp + bj * HALF) = w; } }
    }
};
struct EpiGate4 {
    static constexpr bool PERM = true, AFTER_DRAIN = false;
    bf16* G4; const u64* ssq;
    __device__ __forceinline__ void operator()(AccT acc, const Unit& u, int wr, int wc, int fr, int fq) const {
        const int row0 = u.pm * BM + wr * 64 + fr, col0 = u.pn * BM + wc * 32 + 8 * fq;
        float rs8[2][4];
#pragma unroll
        for (int ai = 0; ai < 2; ++ai)
#pragma unroll
            for (int m = 0; m < 4; ++m) rs8[ai][m] = rstd_of(ssq, row0 + ai * HALF + m * 16) * W8SI;
#pragma unroll
        for (int ai = 0; ai < 2; ++ai)
#pragma unroll
            for (int m = 0; m < 4; ++m) { const int row = row0 + ai * HALF + m * 16; const float rs = rs8[ai][m];
#pragma unroll
                for (int bj = 0; bj < 2; ++bj) { const float rsn = rs * -1.4426950408889634f; f32x4 v0 = acc[ai][bj][m][0] * rsn, v1 = acc[ai][bj][m][1] * rsn;
#pragma unroll
                    for (int j = 0; j < 4; ++j) { v0[j] = __builtin_amdgcn_rcpf(1.f + __builtin_amdgcn_exp2f(v0[j])); v1[j] = __builtin_amdgcn_rcpf(1.f + __builtin_amdgcn_exp2f(v1[j])); }
                    u32x4 w; w.x = pk2(v0[0], v0[1]); w.y = pk2(v0[2], v0[3]); w.z = pk2(v1[0], v1[1]); w.w = pk2(v1[2], v1[3]);
                    *(u32x4*)(G4 + zblk(row, col0 + bj * HALF)) = w; } }
    }
};
struct EpiF32 {
    static constexpr bool PERM = false, AFTER_DRAIN = false;
    float* C; int ldc;
    __device__ __forceinline__ void operator()(AccT acc, const Unit& u, int wr, int wc, int fr, int fq) const {
        const int row0 = u.pm * BM + wr * 64 + fr, col0 = u.pn * BM + wc * 32 + 4 * fq;
#pragma unroll
        for (int ai = 0; ai < 2; ++ai)
#pragma unroll
            for (int m = 0; m < 4; ++m) { float* rowp = C + (size_t)(row0 + ai * HALF + m * 16) * ldc + col0;
#pragma unroll
                for (int bj = 0; bj < 2; ++bj)
#pragma unroll
                    for (int n = 0; n < 2; ++n) *(f32x4*)(rowp + bj * HALF + n * 16) = acc[ai][bj][m][n]; }
    }
};
struct EpiLora {
    static constexpr bool PERM = true, AFTER_DRAIN = false;
    bf16* LO; const float* w0; const float* a0; const float* v0; int has_v;
    __device__ __forceinline__ void operator()(AccT acc, const Unit& u, int wr, int wc, int fr, int fq) const {
        const int row0 = u.pm * BM + wr * 64 + fr, col0 = u.pn * BM + wc * 32 + 8 * fq; const int blk = u.pn >> 1;
        f32x4 bias4[2][2];
#pragma unroll
        for (int bj = 0; bj < 2; ++bj)
#pragma unroll
            for (int n = 0; n < 2; ++n) { const int j = (col0 + bj * HALF + n * 4) & 511; f32x4 bb = (f32x4){0.f, 0.f, 0.f, 0.f};
                if (blk == 0) bb = *(const f32x4*)(w0 + j); else if (blk == 1) bb = *(const f32x4*)(a0 + j); else if (blk == 3 && has_v) bb = *(const f32x4*)(v0 + j);
                bias4[bj][n] = bb; }
#pragma unroll
        for (int bj = 0; bj < 2; ++bj)
#pragma unroll
            for (int n = 0; n < 2; ++n) { const int col = col0 + bj * HALF + n * 4; const f32x4 bias = bias4[bj][n];
#pragma unroll
                for (int ai = 0; ai < 2; ++ai)
#pragma unroll
                    for (int m = 0; m < 4; ++m) { f32x4 v = acc[ai][bj][m][n] + bias;
                        if (blk == 0) {
#pragma unroll
                            for (int e = 0; e < 4; ++e) v[e] = 1.0f - __builtin_amdgcn_exp2f(sigmoidf_(v[e]) * (-0.6065306597f * 1.4426950408889634f)); }
                        else if (blk != 2) {
#pragma unroll
                            for (int e = 0; e < 4; ++e) v[e] = sigmoidf_(v[e]); }
                        u32x2 w; w.x = pk2(v[0], v[1]); w.y = pk2(v[2], v[3]);
                        *(u32x2*)(LO + (size_t)(row0 + ai * HALF + m * 16) * 2048 + col) = w; } }
    }
};
struct EpiZ {
    static constexpr bool PERM = true, AFTER_DRAIN = false;
    bf16* ZB;
    __device__ __forceinline__ void operator()(AccT acc, const Unit& u, int wr, int wc, int fr, int fq) const {
        const int row0 = u.pm * BM + wr * 64 + fr, col0 = u.pn * BM + wc * 32 + 8 * fq; bf16* base = ZB + (size_t)u.z * M * D;
#pragma unroll
        for (int ai = 0; ai < 2; ++ai)
#pragma unroll
            for (int m = 0; m < 4; ++m) { const int row = row0 + ai * HALF + m * 16;
#pragma unroll
                for (int bj = 0; bj < 2; ++bj) { const f32x4 v0 = acc[ai][bj][m][0], v1 = acc[ai][bj][m][1];
                    u32x4 w; w.x = pk2(v0[0], v0[1]); w.y = pk2(v0[2], v0[3]); w.z = pk2(v1[0], v1[1]); w.w = pk2(v1[2], v1[3]);
                    *(u32x4*)(base + zblk(row, col0 + bj * HALF)) = w; } }
    }
};
struct EpiG {
    static constexpr bool PERM = false, AFTER_DRAIN = false;
    const bf16* ZB; const bf16* G4; bf16* MG; const u64* ssq; float wsi;
    struct Bat { u64 q[2]; u32x2 g4[2], z4[2], zz[2][4]; };
    __device__ __forceinline__ void load(Bat& B, int k, int row0, int c0) const {
#pragma unroll
        for (int mm = 0; mm < 2; ++mm) { const int row = row0 + (k >> 1) * HALF + (2 * (k & 1) + mm) * 16; const size_t off = zblk(row, c0);
            B.q[mm] = ssq[row]; B.g4[mm] = *(const u32x2*)(G4 + off); B.z4[mm] = *(const u32x2*)(ZB + (size_t)4 * M * D + off);
#pragma unroll
            for (int br = 0; br < 4; ++br) B.zz[mm][br] = *(const u32x2*)(ZB + (size_t)br * M * D + off); }
    }
    __device__ __forceinline__ void operator()(AccT acc, const Unit& u, int wr, int wc, int fr, int fq) const {
        const int row0 = u.pm * BM + wr * 64 + fr, c0 = u.pn * 64 + wc * 16 + 4 * fq;
        Bat b[2]; load(b[0], 0, row0, c0);
#pragma unroll
        for (int k = 0; k < 4; ++k) { const int ai = k >> 1;
            if (k < 3) load(b[(k + 1) & 1], k + 1, row0, c0);
            const Bat& B = b[k & 1];
#pragma unroll
            for (int mm = 0; mm < 2; ++mm) { const int m = 2 * (k & 1) + mm, row = row0 + ai * HALF + m * 16; const float rs = rstd_raw(B.q[mm]) * wsi;
                f32x4 s;
                s[0] = bf2f(B.g4[mm].x & 0xffffu) * bf2f(B.z4[mm].x & 0xffffu); s[1] = bf2f(B.g4[mm].x >> 16) * bf2f(B.z4[mm].x >> 16);
                s[2] = bf2f(B.g4[mm].y & 0xffffu) * bf2f(B.z4[mm].y & 0xffffu); s[3] = bf2f(B.g4[mm].y >> 16) * bf2f(B.z4[mm].y >> 16);
#pragma unroll
                for (int bj = 0; bj < 2; ++bj)
#pragma unroll
                    for (int n = 0; n < 2; ++n) { const int br = 2 * bj + n; const u32x2 z = B.zz[mm][br]; const f32x4 a = acc[ai][bj][m][n] * (rs * -1.4426950408889634f);
                        s[0] += __builtin_amdgcn_rcpf(1.f + __builtin_amdgcn_exp2f(a[0])) * bf2f(z.x & 0xffffu); s[1] += __builtin_amdgcn_rcpf(1.f + __builtin_amdgcn_exp2f(a[1])) * bf2f(z.x >> 16);
                        s[2] += __builtin_amdgcn_rcpf(1.f + __builtin_amdgcn_exp2f(a[2])) * bf2f(z.y & 0xffffu); s[3] += __builtin_amdgcn_rcpf(1.f + __builtin_amdgcn_exp2f(a[3])) * bf2f(z.y >> 16); }
                u32x2 w; w.x = pk2(s[0], s[1]); w.y = pk2(s[2], s[3]); *(u32x2*)(MG + (size_t)row * D + c0) = w; } }
    }
};
struct EpiRes {
    static constexpr bool PERM = true, AFTER_DRAIN = false;
    bf16* XH; u64* ssq; unsigned char* XH8; bool w8;
    __device__ __forceinline__ void operator()(AccT acc, const Unit& u, int wr, int wc, int fr, int fq) const {
        const int row0 = u.pm * BM + wr * 64 + fr, col0 = u.pn * BM + wc * 32 + 8 * fq;
#pragma unroll
        for (int ai = 0; ai < 2; ++ai) {
            u32x4 rv[4][2];
#pragma unroll
            for (int m = 0; m < 4; ++m) { const size_t off = (size_t)(row0 + ai * HALF + m * 16) * D + col0;
#pragma unroll
                for (int bj = 0; bj < 2; ++bj) rv[m][bj] = *(const u32x4*)(XH + off + bj * HALF); }
#pragma unroll
            for (int m = 0; m < 4; ++m) { const int row = row0 + ai * HALF + m * 16; const size_t off = (size_t)row * D + col0; float sq = 0.f;
#pragma unroll
                for (int bj = 0; bj < 2; ++bj) { const size_t o = off + bj * HALF; const u32x4 r = rv[m][bj];
                    const f32x4 v0 = (f32x4){bf2f(r.x & 0xffffu), bf2f(r.x >> 16), bf2f(r.y & 0xffffu), bf2f(r.y >> 16)} + acc[ai][bj][m][0];
                    const f32x4 v1 = (f32x4){bf2f(r.z & 0xffffu), bf2f(r.z >> 16), bf2f(r.w & 0xffffu), bf2f(r.w >> 16)} + acc[ai][bj][m][1];
                    sq += ((v0[0] * v0[0] + v0[1] * v0[1]) + (v0[2] * v0[2] + v0[3] * v0[3])) + ((v1[0] * v1[0] + v1[1] * v1[1]) + (v1[2] * v1[2] + v1[3] * v1[3]));
                    u32x4 w; w.x = pk2(v0[0], v0[1]); w.y = pk2(v0[2], v0[3]); w.z = pk2(v1[0], v1[1]); w.w = pk2(v1[2], v1[3]); *(u32x4*)(XH + o) = w;
                    if (w8) { u32x2 q8; q8.x = pk4_fp8(v0[0], v0[1], v0[2], v0[3]); q8.y = pk4_fp8(v1[0], v1[1], v1[2], v1[3]); *(u32x2*)(XH8 + o) = q8; } }
                sq += __shfl_xor(sq, 16); sq += __shfl_xor(sq, 32);
                if (fq == 0) atomicAdd(ssq + row, ssq_fix(sq)); }
            asm volatile("" ::: "memory"); }
    }
};
template <bool OUT8> struct EpiSwiglu {
    static constexpr bool PERM = true, AFTER_DRAIN = false;
    bf16* ACT; int ldc; const u64* ssq; const float* rss; float wsi; float osc;
    __device__ __forceinline__ void operator()(AccT acc, const Unit& u, int wr, int wc, int fr, int fq) const {
        const int row0 = u.pm * BM + wr * 64 + fr, col0 = u.pn * HALF + wc * 32 + 8 * fq;
        float rs8[2][4];
#pragma unroll
        for (int ai = 0; ai < 2; ++ai)
#pragma unroll
            for (int m = 0; m < 4; ++m) { const int row = row0 + ai * HALF + m * 16; rs8[ai][m] = (rss ? rss[row] : rstd_of(ssq, row)) * wsi; }
#pragma unroll
        for (int ai = 0; ai < 2; ++ai)
#pragma unroll
            for (int m = 0; m < 4; ++m) { const int row = row0 + ai * HALF + m * 16; const float rs = rs8[ai][m];
                const float rsn = rs * -1.4426950408889634f, rs2 = rs * rs * (OUT8 ? osc : 1.f);
                float o[8];
#pragma unroll
                for (int n = 0; n < 2; ++n)
#pragma unroll
                    for (int e = 0; e < 4; ++e) { const float a = acc[ai][0][m][n][e], b = acc[ai][1][m][n][e];
                        o[4 * n + e] = (a * b) * (rs2 * __builtin_amdgcn_rcpf(1.f + __builtin_amdgcn_exp2f(a * rsn))); }
                if constexpr (OUT8) { u32x2 w; w.x = pk4_fp8(o[0], o[1], o[2], o[3]); w.y = pk4_fp8(o[4], o[5], o[6], o[7]);
                    *(u32x2*)((unsigned char*)ACT + (size_t)row * ldc + col0) = w; }
                else { u32x4 w; w.x = pk2(o[0], o[1]); w.y = pk2(o[2], o[3]); w.z = pk2(o[4], o[5]); w.w = pk2(o[6], o[7]);
                    *(u32x4*)(ACT + (size_t)row * ldc + col0) = w; } }
    }
};
struct EpiBf {
    static constexpr bool PERM = true, AFTER_DRAIN = false;
    bf16* O; int ldc; float sc;
    __device__ __forceinline__ void operator()(AccT acc, const Unit& u, int wr, int wc, int fr, int fq) const {
        const int row0 = u.pm * BM + wr * 64 + fr, col0 = u.pn * BM + wc * 32 + 8 * fq;
#pragma unroll
        for (int ai = 0; ai < 2; ++ai)
#pragma unroll
            for (int m = 0; m < 4; ++m) { bf16* rowp = O + (size_t)(row0 + ai * HALF + m * 16) * ldc + col0;
#pragma unroll
                for (int bj = 0; bj < 2; ++bj) { const f32x4 v0 = acc[ai][bj][m][0] * sc, v1 = acc[ai][bj][m][1] * sc;
                    u32x4 w; w.x = pk2(v0[0], v0[1]); w.y = pk2(v0[2], v0[3]); w.z = pk2(v1[0], v1[1]); w.w = pk2(v1[2], v1[3]);
                    *(u32x4*)(rowp + bj * HALF) = w; } }
    }
};
struct EpiHP {
    static constexpr bool PERM = false, AFTER_DRAIN = false;
    float* HP;
    __device__ __forceinline__ void operator()(AccT acc, const Unit& u, int wr, int wc, int fr, int fq) const {
        const int row0 = u.pm * BM + wr * 64 + fr, col0 = wc * 32 + 4 * fq; float* base = HP + (size_t)u.z * 1024 * 128;
#pragma unroll
        for (int ai = 0; ai < 2; ++ai)
#pragma unroll
            for (int m = 0; m < 4; ++m) { float* rowp = base + (size_t)(row0 + ai * HALF + m * 16) * 128 + col0;
#pragma unroll
                for (int n = 0; n < 2; ++n) *(f32x4*)(rowp + n * 16) = acc[ai][0][m][n]; }
    }
};
struct CmpFin { const float* HP; const float* b1; const bf16* w2t; const float* gain; bf16* KC; bf16* VCT; };
__device__ __forceinline__ void cmp_finalize(const CmpFin& C_, int z, int pm, LAS unsigned char* lds, int wid, int lane) {
        LAS bf16* H = (LAS bf16*)lds;
        { const int tid = wid * 64 + lane, r = tid >> 1, c0 = (tid & 1) * 64;
#pragma unroll
          for (int j = 0; j < 16; ++j) { const int c = c0 + 4 * j; f32x4 v = *(const f32x4*)(C_.b1 + z * 128 + c);
#pragma unroll
              for (int kp = 0; kp < 4; ++kp) v += *(const f32x4*)(C_.HP + ((size_t)(kp * 2 + z) * 1024 + pm * 256 + r) * 128 + c);
#pragma unroll
              for (int e = 0; e < 4; ++e) { const float x = v[e]; const float t = 0.7978845608f * (x + 0.044715f * x * x * x); const float th = 1.f - 2.f * __builtin_amdgcn_rcpf(__expf(2.f * t) + 1.f); v[e] = 0.5f * x * (1.f + th); }
              u32x2 w; w.x = pk2(v[0], v[1]); w.y = pk2(v[2], v[3]); *(LAS u32x2*)(H + r * 136 + c) = w; } }
        LDS_WAIT(); __syncthreads();
        bf16x8 af[2][4], bfr[4][4];
#pragma unroll
        for (int mt = 0; mt < 2; ++mt)
#pragma unroll
            for (int ks = 0; ks < 4; ++ks) af[mt][ks] = *(const LAS bf16x8*)(H + (wid * 32 + mt * 16 + (lane & 15)) * 136 + ks * 32 + 8 * (lane >> 4));
#pragma unroll
        for (int n = 0; n < 4; ++n)
#pragma unroll
            for (int ks = 0; ks < 4; ++ks) bfr[n][ks] = *(const bf16x8*)(C_.w2t + (size_t)z * 64 * 128 + (16 * n + (lane & 15)) * 128 + ks * 32 + 8 * (lane >> 4));
        asm volatile("s_waitcnt vmcnt(0) lgkmcnt(0)" ::: "memory"); __builtin_amdgcn_sched_barrier(0);
        f32x4 C[2][4];
#pragma unroll
        for (int mt = 0; mt < 2; ++mt)
#pragma unroll
            for (int n = 0; n < 4; ++n) { C[mt][n] = (f32x4){0.f, 0.f, 0.f, 0.f};
#pragma unroll
                for (int ks = 0; ks < 4; ++ks) C[mt][n] = __builtin_amdgcn_mfma_f32_16x16x32_bf16(af[mt][ks], bfr[n][ks], C[mt][n], 0, 0, 0); }
        __builtin_amdgcn_sched_barrier(0);
#pragma unroll
        for (int mt = 0; mt < 2; ++mt)
#pragma unroll
            for (int r = 0; r < 4; ++r) { const int grow = pm * 256 + wid * 32 + mt * 16 + 4 * (lane >> 4) + r;
                const int hh = grow & 1, bc = grow >> 1, b = bc >> 8, c = bc & 255;
                float ss = 0.f;
#pragma unroll
                for (int n = 0; n < 4; ++n) ss += C[mt][n][r] * C[mt][n][r];
                ss = red16_sum(ss);
                if (c < 255) {
                    if (z == 0) { const float rs = __builtin_amdgcn_rsqf(ss * (1.f / 64.f) + NORM_EPS); bf16* dst = C_.KC + ((size_t)(b * 2 + hh) * 256 + c) * 64;
#pragma unroll
                        for (int n = 0; n < 4; ++n) { const int d = 16 * n + (lane & 15); dst[d] = (bf16)f2bf(C[mt][n][r] * rs * C_.gain[d]); } }
                    else { bf16* dst = C_.VCT + (size_t)(b * 2 + hh) * 64 * 256 + c;
#pragma unroll
                        for (int n = 0; n < 4; ++n) { const int d = 16 * n + (lane & 15); dst[(size_t)d * 256] = (bf16)f2bf(C[mt][n][r]); } } } }
        __syncthreads();
}

struct Frame {
    LAS unsigned char* lds; int tid, lane, wave, G, bid;
    const float* const* in; unsigned char* ws; unsigned* ctl;
};
__device__ __forceinline__ Frame relaunder(const Frame& F0) { Frame F = F0; int ln = (int)__builtin_amdgcn_mbcnt_hi(~0u, __builtin_amdgcn_mbcnt_lo(~0u, 0u)); asm volatile("" : "+v"(ln)); F.lane = ln; F.wave = F0.wave; F.tid = F0.wave * 64 + ln; return F; }
#define INP(k) (F.in[k])
__device__ __forceinline__ float ldbf(const bf16* p) { return bf2f(*p); }
__device__ __forceinline__ void ld8(const bf16* p, float (&v)[8]) { const u32x4 r = *(const u32x4*)p;
    v[0] = bf2f(r.x & 0xffffu); v[1] = bf2f(r.x >> 16); v[2] = bf2f(r.y & 0xffffu); v[3] = bf2f(r.y >> 16); v[4] = bf2f(r.z & 0xffffu); v[5] = bf2f(r.z >> 16); v[6] = bf2f(r.w & 0xffffu); v[7] = bf2f(r.w >> 16); }
__device__ __forceinline__ void st8(bf16* p, const float (&v)[8]) { u32x4 w; w.x = pk2(v[0], v[1]); w.y = pk2(v[2], v[3]); w.z = pk2(v[4], v[5]); w.w = pk2(v[6], v[7]); *(u32x4*)p = w; }
__device__ __forceinline__ void ldf8(const float* p, float (&v)[8]) { const f32x4 a = *(const f32x4*)p, b = *(const f32x4*)(p + 4); v[0] = a[0]; v[1] = a[1]; v[2] = a[2]; v[3] = a[3]; v[4] = b[0]; v[5] = b[1]; v[6] = b[2]; v[7] = b[3]; }

template <class Fsrc, bool F8 = false>
__device__ __forceinline__ void tr_matrix(const Frame& F, Fsrc f, int nrows, int K, bf16* dst) {
    LAS float* scr = (LAS float*)(F.lds + F.wave * 16384);
    const int gw = F.bid * 8 + F.wave, NGW = F.G * 8, lane = F.lane;
    const int nblk = nrows / 32, nitems = (K / 64) * nblk;
    const int kq = lane >> 3, n4 = (lane & 7) * 4;
    for (int it = gw; it < nitems; it += NGW) {
        const int kb = it / nblk, nb = it % nblk, k0 = 64 * kb, n0 = 32 * nb;
        f32x4 v[8];
#pragma unroll
        for (int i = 0; i < 8; ++i) v[i] = f(n0 + n4, k0 + 8 * i + kq);
#pragma unroll
        for (int i = 0; i < 8; ++i) { LAS float* d = scr + (8 * i + kq) * 33 + n4; d[0] = v[i][0]; d[1] = v[i][1]; d[2] = v[i][2]; d[3] = v[i][3]; }
        LDS_WAIT(); asm volatile("" ::: "memory");
        const int c = lane & 7;
#pragma unroll
        for (int j = 0; j < 4; ++j) { const int n = (lane >> 3) + 8 * j; const LAS float* sp = scr + (8 * c) * 33 + n;
            if constexpr (F8) { u32x2 o; o.x = pk4_fp8(sp[0 * 33], sp[1 * 33], sp[2 * 33], sp[3 * 33]); o.y = pk4_fp8(sp[4 * 33], sp[5 * 33], sp[6 * 33], sp[7 * 33]);
                *(u32x2*)((unsigned char*)dst + (size_t)(n0 + n) * K + k0 + 8 * c) = o; }
            else { u32x4 o; o.x = pk2(sp[0 * 33], sp[1 * 33]); o.y = pk2(sp[2 * 33], sp[3 * 33]); o.z = pk2(sp[4 * 33], sp[5 * 33]); o.w = pk2(sp[6 * 33], sp[7 * 33]);
                *(u32x4*)(dst + (size_t)(n0 + n) * K + k0 + 8 * c) = o; } }
        LDS_WAIT(); asm volatile("" ::: "memory");
    }
}
#define F4Z ((f32x4){0.f, 0.f, 0.f, 0.f})
struct SrcWP { const float* win; const float* vres; const float* gain; int l, NP;
    __device__ __forceinline__ f32x4 operator()(int n, int k) const {
        f32x4 v;
        if (n < 5848) v = *(const f32x4*)(win + (size_t)k * NIN + n);
        else if (n < NP) v = (l == 1 && n < 5912) ? *(const f32x4*)(vres + (size_t)k * 64 + (n - 5848)) : F4Z;
        else v = *(const f32x4*)(win + (size_t)k * NIN + PC_GATE + 4 * 2048 + (n - NP));
        return v * gain[k]; } };
struct SrcWG4 { const float* win; const float* gain;
    __device__ __forceinline__ f32x4 operator()(int n, int k) const { return *(const f32x4*)(win + (size_t)k * NIN + PC_GATE + 4 * 2048 + n) * (gain[k] * W8S); } };
struct SrcWG { const float* win; const float* gain; float sc;
    __device__ __forceinline__ f32x4 operator()(int n, int k) const {
        const int j = n >> 8, rho = n & 255, bj = rho >> 7, wc = (rho >> 5) & 3, nn = (rho >> 4) & 1, q = (rho >> 2) & 3;
        const int br = 2 * bj + nn, c = 64 * j + 16 * wc + 4 * q;
        return *(const f32x4*)(win + (size_t)k * NIN + PC_GATE + br * 2048 + c) * (gain[k] * sc); } };
struct SrcWB { const float* wb; const float* pw; const float* ps;
    __device__ __forceinline__ f32x4 operator()(int n, int k) const {
        if (n < 8192) { const int i = n >> 11, c = n & 2047; return *(const f32x4*)(wb + ((size_t)i * 512 + k) * 2048 + c); }
        const int c = n - 8192, g = c >> 9;
        if ((k >> 7) != g) return F4Z;
        return *(const f32x4*)(pw + ((size_t)g * 128 + (k & 127)) * 512 + (c & 511)) * *(const f32x4*)(ps + c); } };
struct SrcPlain { const float* w; int ldw;
    __device__ __forceinline__ f32x4 operator()(int n, int k) const { return *(const f32x4*)(w + (size_t)k * ldw + n); } };
struct SrcPlainS { const float* w; int ldw; float sc;
    __device__ __forceinline__ f32x4 operator()(int n, int k) const { return *(const f32x4*)(w + (size_t)k * ldw + n) * sc; } };
struct SrcPlainG { const float* w; int ldw; const float* gain;
    __device__ __forceinline__ f32x4 operator()(int n, int k) const { return *(const f32x4*)(w + (size_t)k * ldw + n) * gain[k]; } };
struct SrcLora { const float* w2; const float* a2; const float* g2; const float* vup; int l;
    __device__ __forceinline__ f32x4 operator()(int n, int k) const {
        const int blk = n >> 9, j = n & 511;
        if (blk == 0) return k < 96 ? *(const f32x4*)(w2 + (size_t)k * 512 + j) : F4Z;
        if (blk == 1) return (k >= 96 && k < 192) ? *(const f32x4*)(a2 + (size_t)(k - 96) * 512 + j) : F4Z;
        if (blk == 2) return (k >= 192 && k < 448) ? *(const f32x4*)(g2 + (size_t)(k - 192) * 512 + j) : F4Z;
        return (l == 1 && k >= 448) ? *(const f32x4*)(vup + (size_t)(k - 448) * 512 + j) : F4Z; } };
struct SrcC1 { const float* w1;
    __device__ __forceinline__ f32x4 operator()(int n, int k) const { const int i = n >> 8, c = n & 255; return c < 128 ? *(const f32x4*)(w1 + ((size_t)i * 2048 + k) * 128 + c) : F4Z; } };
struct SrcW13 { const float* w1; const float* w3; const float* gain; int ffw; float sc;
    __device__ __forceinline__ f32x4 operator()(int n, int k) const { const int t = n >> 8, which = (n >> 7) & 1, ff = 128 * t + (n & 127);
        const uintptr_t a = (uintptr_t)w1, dlt = (uintptr_t)w3 - a; const float* p = (const float*)(a + (which ? dlt : (uintptr_t)0));
        return *(const f32x4*)(p + (size_t)k * ffw + ff) * (gain[k] * sc); } };

template <bool KV, bool REST>
__device__ __forceinline__ void convert_layer(const Frame& F, int l) {
    unsigned char* ws = F.ws;
    if (REST) {
        const float* win = INP(5) + (size_t)l * D * NIN; const float* gmix = INP(2) + l * D;
        tr_matrix(F, SrcWP{win, INP(17), gmix, l, l ? NP1 : NP0}, (l ? NP1 : NP0), 2048, (bf16*)(ws + (l ? WS_WPT1 : WS_WPT0)));
        tr_matrix<SrcWG4, true>(F, SrcWG4{win, gmix}, 2048, 2048, (bf16*)(ws + (l ? WS_WG4T1 : WS_WG4T0)));
        tr_matrix<SrcWG, F8_G != 0>(F, SrcWG{win, gmix, F8_G ? W8S : 1.f}, 8192, 2048, (bf16*)(ws + (l ? WS_WGT1 : WS_WGT0)));
        tr_matrix(F, SrcWB{INP(31) + (size_t)l * 4 * 512 * 2048, INP(27) + (size_t)l * 4 * 128 * 512, INP(28) + l * D}, 10240, 512, (bf16*)(ws + (l ? WS_WBT1 : WS_WBT0)));
        tr_matrix(F, SrcPlain{INP(32) + (size_t)l * D * D, D}, 2048, 2048, (bf16*)(ws + (l ? WS_WOT1 : WS_WOT0)));
        tr_matrix(F, SrcLora{INP(8) + (size_t)l * 96 * 512, INP(10) + (size_t)l * 96 * 512, INP(11) + (size_t)l * 256 * 512, INP(20), l}, 2048, 512, (bf16*)(ws + (l ? WS_WLT1 : WS_WLT0)));
        tr_matrix(F, SrcC1{INP(23) + (size_t)l * 2 * 2048 * 128}, 512, 2048, (bf16*)(ws + (l ? WS_WC1T1 : WS_WC1T0)));
        for (int i = 0; i < 2; ++i) tr_matrix(F, SrcPlain{INP(25) + (size_t)(l * 2 + i) * 128 * 64, 64}, 64, 128, (bf16*)(ws + WS_WC2T) + (size_t)(l * 2 + i) * 64 * 128);
    }
    if (KV) {
        tr_matrix(F, SrcPlainG{INP(29) + (size_t)l * D * 1024, 1024, INP(4) + l * D}, 1024, 2048, (bf16*)(ws + (l ? WS_WKVT1 : WS_WKVT0)));
    }
}
constexpr int N_LATE_CHUNKS = 512;
template <int PART>
__device__ __forceinline__ void convert_late(const Frame& F) {
    unsigned char* ws = F.ws;
    if (PART == 2) { convert_layer<false, true>(F, 1); return; }
    if (PART == 0) {
    tr_matrix<SrcW13, F8_F1 != 0>(F, SrcW13{INP(33), INP(34), INP(3), FF, F8_F1 ? W8S : 1.f}, 2 * FF, 2048, (bf16*)(ws + WS_W13T));
    tr_matrix(F, SrcPlain{INP(35), D}, 2048, FF, (bf16*)(ws + WS_W2T)); }
    for (int e = PART * (NE / 2); e < (PART + 1) * (NE / 2); ++e) {
        tr_matrix<SrcW13, F8_M1 != 0>(F, SrcW13{INP(37) + (size_t)e * D * EFF, INP(38) + (size_t)e * D * EFF, INP(3) + D, EFF, F8_M1 ? W8S : 1.f}, 2 * EFF, 2048, (bf16*)(ws + WS_MW13T + (size_t)e * 2 * EFF * 2048 * (F8_M1 ? 1 : 2)));
        tr_matrix<SrcPlainS, F8_M2 != 0>(F, SrcPlainS{INP(39) + (size_t)e * EFF * D, D, F8_M2 ? W8S : 1.f}, 2048, EFF, (bf16*)(ws + WS_MW2T + (size_t)e * 2048 * EFF * (F8_M2 ? 1 : 2)));
    }
}
template <int PART>
__device__ __forceinline__ void convert_late_loop(const Frame& F0, unsigned* cq) {
    Frame F = relaunder(F0);
    LAS int* UQ = (LAS int*)(F.lds + 131072 + 64);
    for (;;) {
        __syncthreads();
        if (F.tid == 0) UQ[0] = (int)atomicAdd(cq, 1u);
        LDS_WAIT(); __syncthreads();
        const int c = UQ[0]; if (c >= N_LATE_CHUNKS) break;
        Frame Fc = F; Fc.bid = c; Fc.G = N_LATE_CHUNKS; convert_late<PART>(Fc);
    }
}
__device__ __forceinline__ void phase_prologue(const Frame& F0) {
    const Frame F = relaunder(F0);
    unsigned char* ws = F.ws;
    convert_layer<true, true>(F, 0); convert_layer<true, false>(F, 1);
    const int gw = F.bid * 8 + F.wave, NGW = F.G * 8;
    u64* ssq = (u64*)(F.ctl + CW_SSQ);
    for (int base = F.bid * 16; base < M + 512; base += F.G * 16) for (int q = 0; q < 2; ++q) { const int m = base + F.wave * 2 + q;
        const bool ismem = m >= M; const float* src = ismem ? INP(1) + (size_t)(m - M) * D : INP(0) + (size_t)m * D;
        const f32x4* xr = (const f32x4*)src + F.lane; f32x4 v[8]; float s = 0.f;
#pragma unroll
        for (int j = 0; j < 8; ++j) { v[j] = xr[64 * j]; s += (v[j][0] * v[j][0] + v[j][1] * v[j][1]) + (v[j][2] * v[j][2] + v[j][3] * v[j][3]); }
        s = wave_sum(s);
        float sc = 1.f;
        if (ismem) sc = __builtin_amdgcn_rsqf(s * (1.f / D) + NORM_EPS); else if (F.lane == 0) ssq[m] = ssq_fix(s);
        bf16* dst = ismem ? (bf16*)(ws + WS_MEMN) + (size_t)(m - M) * D : (bf16*)(ws + WS_XH) + (size_t)m * D;
#pragma unroll
        for (int j = 0; j < 8; ++j) { u32x2 w; w.x = pk2(v[j][0] * sc, v[j][1] * sc); w.y = pk2(v[j][2] * sc, v[j][3] * sc); *((u32x2*)dst + F.lane + 64 * j) = w;
            if (!ismem) *((unsigned*)(ws + WS_XH8 + (size_t)m * D) + F.lane + 64 * j) = pk4_fp8(v[j][0], v[j][1], v[j][2], v[j][3]); }
    }
}

__device__ __forceinline__ float shiftP(const bf16* P, int m, int t, int col, float mu) {
    const float u = ldbf(P + (size_t)m * LDP + col); const float pv = t > 0 ? ldbf(P + (size_t)(m - 1) * LDP + col) : 0.f; return u + (pv - u) * mu;
}
__device__ __forceinline__ void phase_prep(const Frame& F0, int l) {
    const Frame F = relaunder(F0);
    unsigned char* ws = F.ws; const bf16* P = (const bf16*)(ws + WS_P);
    const float* mu = INP(6) + l * 1984; const float* vmu = INP(18);
    bf16* AL = (bf16*)(ws + WS_ALORA); bf16* QN = (bf16*)(ws + WS_QN); bf16* QM = (bf16*)(ws + WS_QM); bf16* Y = (bf16*)(ws + WS_Y);
    const float* qkg = INP(21) + l * 4 * 64; const float* mqg = INP(30) + l * 2 * 128;
    const float* cpos = INP(22) + (size_t)l * 2 * 32 * 64; const float* cw = INP(26) + l * 3 * 512;
    const int tid = F.tid, lane = F.lane, wave = F.wave;
    for (int tile = F.bid; tile < M / 32; tile += F.G) {
        const int m0 = tile * 32, b = m0 / T, t0 = m0 % T;
#pragma unroll
        for (int it_ = 0; it_ < 4; ++it_) { const int it = tid + it_ * 512; const int tt = it >> 6, g = it & 63, c = g * 8, m = m0 + tt, t = t0 + tt;
            int pc, kind; const float* mup;
            if (c < 96) { pc = PC_WD + c; kind = 0; mup = mu + pc; } else if (c < 192) { pc = PC_AD + c - 96; kind = 1; mup = mu + pc; }
            else if (c < 448) { pc = PC_GD + c - 192; kind = 2; mup = mu + pc; } else { pc = PC_VRES + c - 448; kind = 3; mup = vmu + (c - 448); }
            float o[8];
            if (kind == 3 && l == 0) {
#pragma unroll
                for (int j = 0; j < 8; ++j) o[j] = 0.f; }
            else { float u[8], pv[8], mm[8]; ld8(P + (size_t)m * LDP + pc, u); ldf8(mup, mm);
                if (t > 0) ld8(P + (size_t)(m - 1) * LDP + pc, pv); else {
#pragma unroll
                    for (int j = 0; j < 8; ++j) pv[j] = 0.f; }
#pragma unroll
                for (int j = 0; j < 8; ++j) { const float x = u[j] + (pv[j] - u[j]) * mm[j]; o[j] = kind == 0 ? (2.f * sigmoidf_(2.f * x) - 1.f) : (kind == 2 ? sigmoidf_(x) : x); } }
            st8(AL + (size_t)m * 512 + c, o); }
        for (int tt = wave; tt < 32; tt += 8) { const int m = m0 + tt;
            { float v[8]; float s = 0.f; const u32x4 raw = *(const u32x4*)(P + (size_t)m * LDP + PC_Q + lane * 8);
              v[0] = bf2f(raw.x & 0xffffu); v[1] = bf2f(raw.x >> 16); v[2] = bf2f(raw.y & 0xffffu); v[3] = bf2f(raw.y >> 16); v[4] = bf2f(raw.z & 0xffffu); v[5] = bf2f(raw.z >> 16); v[6] = bf2f(raw.w & 0xffffu); v[7] = bf2f(raw.w >> 16);
#pragma unroll
              for (int j = 0; j < 8; ++j) s += v[j] * v[j];
              s += __shfl_xor(s, 1); s += __shfl_xor(s, 2); s += __shfl_xor(s, 4);
              const float rs = CQ_NSA * __builtin_amdgcn_rsqf(s * (1.f / 64.f) + NORM_EPS); const int d0 = (lane & 7) * 8;
              u32x4 w; w.x = pk2(v[0] * rs * qkg[d0 + 0], v[1] * rs * qkg[d0 + 1]); w.y = pk2(v[2] * rs * qkg[d0 + 2], v[3] * rs * qkg[d0 + 3]); w.z = pk2(v[4] * rs * qkg[d0 + 4], v[5] * rs * qkg[d0 + 5]); w.w = pk2(v[6] * rs * qkg[d0 + 6], v[7] * rs * qkg[d0 + 7]);
              *(u32x4*)(QN + (size_t)m * 512 + lane * 8) = w; }
            { float v[8]; float s = 0.f; const u32x4 raw = *(const u32x4*)(P + (size_t)m * LDP + PC_MEM + lane * 8);
              v[0] = bf2f(raw.x & 0xffffu); v[1] = bf2f(raw.x >> 16); v[2] = bf2f(raw.y & 0xffffu); v[3] = bf2f(raw.y >> 16); v[4] = bf2f(raw.z & 0xffffu); v[5] = bf2f(raw.z >> 16); v[6] = bf2f(raw.w & 0xffffu); v[7] = bf2f(raw.w >> 16);
#pragma unroll
              for (int j = 0; j < 8; ++j) s += v[j] * v[j];
              s += __shfl_xor(s, 1); s += __shfl_xor(s, 2); s += __shfl_xor(s, 4); s += __shfl_xor(s, 8);
              const float rs = CQ_MEM * __builtin_amdgcn_rsqf(s * (1.f / 128.f) + NORM_EPS); const int d0 = (lane & 15) * 8;
              u32x4 w; w.x = pk2(v[0] * rs * mqg[d0 + 0], v[1] * rs * mqg[d0 + 1]); w.y = pk2(v[2] * rs * mqg[d0 + 2], v[3] * rs * mqg[d0 + 3]); w.z = pk2(v[4] * rs * mqg[d0 + 4], v[5] * rs * mqg[d0 + 5]); w.w = pk2(v[6] * rs * mqg[d0 + 6], v[7] * rs * mqg[d0 + 7]);
              *(u32x4*)(QM + (size_t)m * 512 + lane * 8) = w; }
            for (int which = 0; which < 2; ++which) { const int pc = which ? PC_KW : PC_KS; const float* gn = qkg + (which ? 3 : 2) * 64;
                const unsigned raw = *(const unsigned*)(P + (size_t)m * LDP + pc + lane * 2); const float a = bf2f(raw & 0xffffu), c2 = bf2f(raw >> 16);
                float s = a * a + c2 * c2; s += __shfl_xor(s, 1); s += __shfl_xor(s, 2); s += __shfl_xor(s, 4); s += __shfl_xor(s, 8); s += __shfl_xor(s, 16);
                const float rs = __builtin_amdgcn_rsqf(s * (1.f / 64.f) + NORM_EPS); const int kvh = lane >> 5, d = (lane & 31) * 2;
                bf16* dst = (bf16*)(ws + (which ? WS_KW : WS_KS)) + ((size_t)(b * 2 + kvh) * T + (t0 + tt)) * 64 + d;
                *(unsigned*)dst = pk2(a * rs * gn[d], c2 * rs * gn[d + 1]); }
        }
        if ((tile & 1) == 0) { const int col = tid & 127, tq = tid >> 7, kvh = col >> 6, d = col & 63;
          for (int which = 0; which < 2; ++which) { const int pc = which ? PC_VW : PC_VS;
            for (int q2 = 0; q2 < 2; ++q2) { const int tg = tq + 4 * q2; unsigned short v[8];
#pragma unroll
              for (int i = 0; i < 8; ++i) v[i] = P[(size_t)(m0 + tg * 8 + i) * LDP + pc + col];
              u32x4 w; w.x = v[0] | ((unsigned)v[1] << 16); w.y = v[2] | ((unsigned)v[3] << 16); w.z = v[4] | ((unsigned)v[5] << 16); w.w = v[6] | ((unsigned)v[7] << 16);
              *(u32x4*)((bf16*)(ws + (which ? WS_VWT : WS_VST)) + ((size_t)(b * 2 + kvh) * 64 + d) * T + t0 + tg * 8) = w; } } }
#pragma unroll
        for (int it_ = 0; it_ < 2; ++it_) { const int it = tid + it_ * 512; const int tt = it >> 5, r = (it & 31) * 8, i = r >> 7, h = (r >> 6) & 1, d = r & 63, t = t0 + tt, m = m0 + tt;
            float v[8], p1[8], o[8]; ld8(P + (size_t)m * LDP + PC_KC + r, v);
            bf16* A = (bf16*)(ws + WS_ACMP) + (size_t)i * 1024 * 2048;
            const int c1 = t >> 4, l1 = t & 15;
            if (c1 <= 254) { ldf8(cpos + (i * 32 + l1) * 64 + d, p1);
#pragma unroll
                for (int j = 0; j < 8; ++j) o[j] = v[j] + p1[j];
                st8(A + ((size_t)(b * 256 + c1) * 2 + h) * 2048 + l1 * 64 + d, o); }
            if (c1 >= 1) { ldf8(cpos + (i * 32 + l1 + 16) * 64 + d, p1);
#pragma unroll
                for (int j = 0; j < 8; ++j) o[j] = v[j] + p1[j];
                st8(A + ((size_t)(b * 256 + c1 - 1) * 2 + h) * 2048 + (l1 + 16) * 64 + d, o); } }
#pragma unroll
        for (int it_ = 0; it_ < 4; ++it_) { const int it = tid + it_ * 512; const int tt = it >> 6, c = (it & 63) * 8, m = m0 + tt, t = t0 + tt;
            float acc[8], bg[8];
#pragma unroll
            for (int j = 0; j < 8; ++j) acc[j] = 0.f;
#pragma unroll
            for (int k = 0; k < 3; ++k) { const int dt = 2 - k; if (t - dt >= 0) { float cg[8], xg[8], wv[8]; const size_t o = (size_t)(m - dt) * LDP; ld8(P + o + PC_CC + c, cg); ld8(P + o + PC_CX + c, xg); ldf8(cw + k * 512 + c, wv);
#pragma unroll
                    for (int j = 0; j < 8; ++j) acc[j] += wv[j] * cg[j] * xg[j]; } }
            ld8(P + (size_t)m * LDP + PC_CB + c, bg);
#pragma unroll
            for (int j = 0; j < 8; ++j) acc[j] *= bg[j];
            st8(Y + (size_t)m * 2560 + 1024 + c, acc); }
        { const int cgp = tid & 63, tg = tid >> 6, c = cgp * 8, w = 2 << (cgp >> 4); const int ts = t0 + tg * 4, ms = m0 + tg * 4;
          float sum[8];
#pragma unroll
          for (int j = 0; j < 8; ++j) sum[j] = 0.f;
#pragma unroll
          for (int k = 1; k < 16; ++k) if (k < w && ts - k >= 0) { float u[8]; ld8(P + (size_t)(ms - k) * LDP + PC_POOL + c, u);
#pragma unroll
              for (int j = 0; j < 8; ++j) sum[j] += u[j]; }
          for (int q = 0; q < 4; ++q) { const int t = ts + q, m = ms + q; float u[8], o[8]; ld8(P + (size_t)m * LDP + PC_POOL + c, u);
#pragma unroll
              for (int j = 0; j < 8; ++j) sum[j] += u[j];
              const int cnt = (t + 1) < w ? (t + 1) : w; const float ic = 1.f / (float)cnt;
#pragma unroll
              for (int j = 0; j < 8; ++j) o[j] = sum[j] * ic - u[j];
              st8(Y + (size_t)m * 2560 + 2048 + c, o);
              if (t - w + 1 >= 0) { float ud[8]; ld8(P + (size_t)(m - w + 1) * LDP + PC_POOL + c, ud);
#pragma unroll
                  for (int j = 0; j < 8; ++j) sum[j] -= ud[j]; } } }
    }
    { const float* KV = (const float*)(ws + WS_KVRAW) + l * 1024; bf16* KM = (bf16*)(ws + WS_KMEM); bf16* VM = (bf16*)(ws + WS_VMEMT); const float* kg = mqg + 128;
      for (int r = F.bid * 8 + wave; r < 512; r += F.G * 8) { const int b = r >> 8, j = r & 255;
          for (int h = 0; h < 4; ++h) { const float a = KV[(size_t)r * 2048 + h * 128 + lane], c2 = KV[(size_t)r * 2048 + h * 128 + 64 + lane];
              const float s = wave_sum(a * a + c2 * c2); const float rs = __builtin_amdgcn_rsqf(s * (1.f / 128.f) + NORM_EPS);
              bf16* dst = KM + ((size_t)(b * 4 + h) * 256 + j) * 128; dst[lane] = (bf16)f2bf(a * rs * kg[lane]); dst[64 + lane] = (bf16)f2bf(c2 * rs * kg[64 + lane]); } }
      for (int it = F.bid * 8 + wave; it < 1024; it += F.G * 8) { const int b = it >> 9, h = (it >> 7) & 3, d = it & 127;
#pragma unroll
          for (int k = 0; k < 4; ++k) { const int j = lane + 64 * k; VM[((size_t)(b * 4 + h) * 128 + d) * 256 + j] = (bf16)f2bf(KV[(size_t)(b * 256 + j) * 2048 + 512 + h * 128 + d]); } } }
}

template <int DH> struct AttL { static constexpr int KB = 64 * (DH + 8) * 2, VB = DH * 72 * 2, BUF = KB + VB, PW = 2 * BUF, END = PW + 8 * 16 * 72 * 2; };
constexpr int AT_PT = AttL<64>::END, AT_IMP = AT_PT + 32768, AT_SEL = AT_IMP + 8192, AT_UNI = AT_SEL + 256;
static_assert(AttL<128>::END <= RING_BYTES && AT_UNI + 64 <= RING_BYTES, "attention LDS map");
template <int DH, int MODE>
__device__ __forceinline__ void attn_pass(LAS unsigned char* lds, int tid, int lane, int wave, const bf16* Kg, const bf16* VTg, int ldvt, int jlo, int jhi,
                                          const bf16x8 (&qf)[DH / 32], f32x4 (&O)[DH / 16], float (&lsum)[4], int trow, unsigned sel0, unsigned sel1, unsigned uni0, unsigned uni1) {
    typedef AttL<DH> L;
    constexpr int KS = DH + 8;
    LAS bf16* PW = (LAS bf16*)(lds + L::PW) + wave * 16 * 72;
    const unsigned long long um = MODE == 2 ? (((unsigned long long)uni1 << 32) | uni0) : ~0ull;
    auto next_tile = [&](int from) -> int {
        if (from > jhi) return jhi + 1;
        if (MODE != 2) return from;
        const unsigned long long m = um >> from; if (m == 0ull) return jhi + 1;
        const int nx = from + __builtin_ctzll(m); return nx > jhi ? jhi + 1 : nx; };
    u32x4 kreg[DH / 64], vreg[DH / 64];
#define AT_LOADREGS(jt) do { _Pragma("unroll") for (int i = 0; i < DH / 64; ++i) { const int e = tid + i * 512; const int kr = e / (DH / 8), kc = (e % (DH / 8)) * 8; const int vr = e >> 3, vc = (e & 7) * 8; \
        kreg[i] = *(const u32x4*)(Kg + (size_t)(64 * (jt) + kr) * DH + kc); vreg[i] = *(const u32x4*)(VTg + (size_t)vr * ldvt + 64 * (jt) + vc); } } while (0)
#define AT_WRITELDS(bf) do { LAS bf16* KTw = (LAS bf16*)(lds + (bf) * L::BUF); LAS bf16* VTw = (LAS bf16*)(lds + (bf) * L::BUF + L::KB); \
        _Pragma("unroll") for (int i = 0; i < DH / 64; ++i) { const int e = tid + i * 512; const int kr = e / (DH / 8), kc = (e % (DH / 8)) * 8; const int vr = e >> 3, vc = (e & 7) * 8; \
        const int krp = 16 * (2 * (kr >> 5) + (kr & 1)) + ((kr >> 1) & 15); \
        *(LAS u32x4*)(KTw + krp * KS + kc) = kreg[i]; *(LAS u32x4*)(VTw + vr * 72 + vc) = vreg[i]; } } while (0)
    int jc = next_tile(jlo);
    if (jc > jhi) return;
    AT_LOADREGS(jc);
    __syncthreads();
    AT_WRITELDS(0);
    int jn = next_tile(jc + 1);
    if (jn <= jhi) AT_LOADREGS(jn);
    LDS_WAIT(); __syncthreads();
    int cur = 0;
    for (;;) {
        int jnn = jhi + 1;
        if (jn <= jhi) { AT_WRITELDS(cur ^ 1); jnn = next_tile(jn + 1); if (jnn <= jhi) AT_LOADREGS(jnn); }
        const int j = jc;
        const LAS bf16* KT = (const LAS bf16*)(lds + cur * L::BUF); const LAS bf16* VT = (const LAS bf16*)(lds + cur * L::BUF + L::KB);
        bool doit = true;
        if (MODE == 2) { const unsigned sb = j < 32 ? (sel0 >> j) : (sel1 >> (j - 32)); doit = __builtin_amdgcn_ballot_w64((sb & 1u) != 0u) != 0ull; }
        if (doit) {
        f32x4 S[4];
        { bf16x8 kfr[4][DH / 32];
#pragma unroll
          for (int n = 0; n < 4; ++n)
#pragma unroll
              for (int ks = 0; ks < DH / 32; ++ks) kfr[n][ks] = *(const LAS bf16x8*)(KT + (16 * n + (lane & 15)) * KS + ks * 32 + 8 * (lane >> 4));
          LDS_WAIT(); __builtin_amdgcn_sched_barrier(0);
#pragma unroll
          for (int n = 0; n < 4; ++n) { S[n] = (f32x4){0.f, 0.f, 0.f, 0.f};
#pragma unroll
              for (int ks = 0; ks < DH / 32; ++ks) S[n] = __builtin_amdgcn_mfma_f32_16x16x32_bf16(qf[ks], kfr[n][ks], S[n], 0, 0, 0); }
          __builtin_amdgcn_sched_barrier(0); }
        bool valid[4];
#pragma unroll
        for (int n = 0; n < 4; ++n) { const int key = 64 * j + 32 * (n >> 1) + 2 * (lane & 15) + (n & 1);
            if (MODE == 0) valid[n] = true;
            else if (MODE == 1) valid[n] = (key <= 254) && (16 * key + 31 <= trow);
            else if (MODE == 2) { const unsigned sb = j < 32 ? (sel0 >> j) : (sel1 >> (j - 32)); valid[n] = (sb & 1u) && key <= trow; }
            else valid[n] = key <= trow && key > trow - 512; }
#pragma unroll
        for (int a2 = 0; a2 < 2; ++a2)
#pragma unroll
            for (int r = 0; r < 4; ++r) { float p0 = __builtin_amdgcn_exp2f(S[2 * a2][r]), p1 = __builtin_amdgcn_exp2f(S[2 * a2 + 1][r]);
                if (MODE != 0) { p0 = valid[2 * a2] ? p0 : 0.f; p1 = valid[2 * a2 + 1] ? p1 : 0.f; }
                lsum[r] += p0 + p1;
                *(LAS unsigned*)(PW + (4 * (lane >> 4) + r) * 72 + 32 * a2 + 2 * (lane & 15)) = pk2(p0, p1); }
        LDS_WAIT(); asm volatile("" ::: "memory");
        { bf16x8 pfr[2], vfr[2][DH / 16];
#pragma unroll
          for (int ks = 0; ks < 2; ++ks) { pfr[ks] = *(const LAS bf16x8*)(PW + (lane & 15) * 72 + ks * 32 + 8 * (lane >> 4));
#pragma unroll
              for (int nd = 0; nd < DH / 16; ++nd) vfr[ks][nd] = *(const LAS bf16x8*)(VT + (16 * nd + (lane & 15)) * 72 + ks * 32 + 8 * (lane >> 4)); }
          LDS_WAIT(); __builtin_amdgcn_sched_barrier(0);
#pragma unroll
          for (int ks = 0; ks < 2; ++ks)
#pragma unroll
              for (int nd = 0; nd < DH / 16; ++nd) O[nd] = __builtin_amdgcn_mfma_f32_16x16x32_bf16(pfr[ks], vfr[ks][nd], O[nd], 0, 0, 0);
          __builtin_amdgcn_sched_barrier(0); }
        }
        if (jn > jhi) break;
        LDS_WAIT(); __syncthreads();
        cur ^= 1; jc = jn; jn = jnn;
    }
#undef AT_LOADREGS
#undef AT_WRITELDS
}

__device__ __forceinline__ void phase_memattn(const Frame& F0) {
    const Frame F = relaunder(F0);
    unsigned char* ws = F.ws; const bf16* QM = (const bf16*)(ws + WS_QM); const bf16* KM = (const bf16*)(ws + WS_KMEM); const bf16* VM = (const bf16*)(ws + WS_VMEMT); bf16* Y = (bf16*)(ws + WS_Y);
    const int lane = F.lane, wave = F.wave; const float c = 0.08838834764831845f * 1.4426950408889634f;
    for (int u = F.bid; u < 256; u += F.G) { const int b = u >> 7, h = (u >> 5) & 3, tile = u & 31; const int m0 = b * T + tile * 128 + wave * 16;
        bf16x8 qf[4];
#pragma unroll
        for (int ks = 0; ks < 4; ++ks) qf[ks] = *(const bf16x8*)(QM + (size_t)(m0 + (lane & 15)) * 512 + h * 128 + ks * 32 + 8 * (lane >> 4));
        f32x4 O[8]; float ls[4];
#pragma unroll
        for (int i = 0; i < 8; ++i) O[i] = (f32x4){0.f, 0.f, 0.f, 0.f};
#pragma unroll
        for (int r = 0; r < 4; ++r) ls[r] = 0.f;
        attn_pass<128, 0>(F.lds, F.tid, lane, wave, KM + (size_t)(b * 4 + h) * 256 * 128, VM + (size_t)(b * 4 + h) * 128 * 256, 256, 0, 3, qf, O, ls, 0, 0u, 0u, 0u, 0u);
#pragma unroll
        for (int r = 0; r < 4; ++r) { const float lr = red16_sum(ls[r]); const float inv = lr > 0.f ? 1.f / lr : 0.f; const int m = m0 + 4 * (lane >> 4) + r;
#pragma unroll
            for (int nd = 0; nd < 8; ++nd) Y[(size_t)m * 2560 + 1536 + h * 128 + 16 * nd + (lane & 15)] = (bf16)f2bf(O[nd][r] * inv); }
        __syncthreads();
    }
}

__device__ __forceinline__ void phase_nsa(const Frame& F0, unsigned* qctr) {
    const Frame F = relaunder(F0);
    unsigned char* ws = F.ws; const bf16* P = (const bf16*)(ws + WS_P); const bf16* QN = (const bf16*)(ws + WS_QN); bf16* Y = (bf16*)(ws + WS_Y);
    const int lane = F.lane, wave = F.wave, tid = F.tid; const float c = 0.125f * 1.4426950408889634f;
    LAS float* PT = (LAS float*)(F.lds + AT_PT); LAS float* IMP = (LAS float*)(F.lds + AT_IMP); LAS unsigned* SEL = (LAS unsigned*)(F.lds + AT_SEL); LAS unsigned* UNI = (LAS unsigned*)(F.lds + AT_UNI);
    LAS int* UQ = (LAS int*)(F.lds + AT_UNI + 16);
    int nxtq = 0; if (tid == 0) nxtq = (int)atomicAdd(qctr, 1u);
    for (;;) {
        __syncthreads();
        if (tid == 0) UQ[0] = nxtq;
        LDS_WAIT(); __syncthreads();
        const int uq = UQ[0]; if (uq >= 512) break;
        if (tid == 0) nxtq = (int)atomicAdd(qctr, 1u);
        const int tile = 127 - (uq >> 2), b = (uq >> 1) & 1, kvh = uq & 1;
        const int t0 = tile * 32, m0 = b * T + t0; const int cur = t0 >> 6;
        const int tl = wave * 4 + (lane >> 4);
        const int trow = t0 + tl;
        bf16x8 qf[2];
        { const int rho = lane & 15; const int mq = m0 + wave * 4 + (rho >> 2), g = rho & 3;
#pragma unroll
          for (int ks = 0; ks < 2; ++ks) qf[ks] = *(const bf16x8*)(QN + (size_t)mq * 512 + (kvh * 4 + g) * 64 + ks * 32 + 8 * (lane >> 4)); }
        const bf16* KCg = (const bf16*)(ws + WS_KC) + (size_t)(b * 2 + kvh) * 256 * 64; const bf16* VCg = (const bf16*)(ws + WS_VCT) + (size_t)(b * 2 + kvh) * 64 * 256;
        const bf16* KSg = (const bf16*)(ws + WS_KS) + (size_t)(b * 2 + kvh) * T * 64; const bf16* VSg = (const bf16*)(ws + WS_VST) + (size_t)(b * 2 + kvh) * 64 * T;
        const bf16* KWg = (const bf16*)(ws + WS_KW) + (size_t)(b * 2 + kvh) * T * 64; const bf16* VWg = (const bf16*)(ws + WS_VWT) + (size_t)(b * 2 + kvh) * 64 * T;
        f32x4 OF[4];
#pragma unroll
        for (int i = 0; i < 4; ++i) OF[i] = (f32x4){0.f, 0.f, 0.f, 0.f};
        float gate[3][4];
#pragma unroll
        for (int r = 0; r < 4; ++r)
#pragma unroll
            for (int k = 0; k < 3; ++k) gate[k][r] = sigmoidf_(ldbf(P + (size_t)(m0 + tl) * LDP + PC_GL + (kvh * 4 + r) * 3 + k));
        f32x4 O[4]; float lr[4];
#pragma unroll
        for (int i = 0; i < 4; ++i) O[i] = (f32x4){0.f, 0.f, 0.f, 0.f};
#pragma unroll
        for (int r = 0; r < 4; ++r) lr[r] = 0.f;
        attn_pass<64, 1>(F.lds, tid, lane, wave, KCg, VCg, 256, 0, 3, qf, O, lr, trow, 0u, 0u, 0u, 0u);
#pragma unroll
        for (int r = 0; r < 4; ++r) lr[r] = red16_sum(lr[r]);
#pragma unroll
        for (int r = 0; r < 4; ++r) { const float inv = lr[r] > 0.f ? 1.f / lr[r] : 0.f;
#pragma unroll
            for (int nd = 0; nd < 4; ++nd) OF[nd][r] += gate[0][r] * O[nd][r] * inv; }
        { LAS bf16* KT = (LAS bf16*)(F.lds);
          for (int j = 0; j < 4; ++j) {
              __syncthreads();
              { const int kr = tid >> 3, kc = (tid & 7) * 8; *(LAS u32x4*)(KT + kr * 72 + kc) = *(const u32x4*)(KCg + (size_t)(64 * j + kr) * 64 + kc); }
              LDS_WAIT(); __syncthreads();
              bf16x8 kfr[4][2]; f32x4 S4[4];
#pragma unroll
              for (int n = 0; n < 4; ++n)
#pragma unroll
                  for (int ks = 0; ks < 2; ++ks) kfr[n][ks] = *(const LAS bf16x8*)(KT + (16 * n + (lane & 15)) * 72 + ks * 32 + 8 * (lane >> 4));
              LDS_WAIT(); __builtin_amdgcn_sched_barrier(0);
#pragma unroll
              for (int n = 0; n < 4; ++n) { S4[n] = (f32x4){0.f, 0.f, 0.f, 0.f};
#pragma unroll
                  for (int ks = 0; ks < 2; ++ks) S4[n] = __builtin_amdgcn_mfma_f32_16x16x32_bf16(qf[ks], kfr[n][ks], S4[n], 0, 0, 0); }
              __builtin_amdgcn_sched_barrier(0);
#pragma unroll
              for (int n = 0; n < 4; ++n) { const f32x4 S = S4[n];
                  const int key = 64 * j + 16 * n + (lane & 15); const bool valid = (key <= 254) && (16 * key + 31 <= trow); float ps = 0.f;
#pragma unroll
                  for (int r = 0; r < 4; ++r) { const float inv = lr[r] > 0.f ? 1.f / lr[r] : 0.f; ps += valid ? __builtin_amdgcn_exp2f(S[r]) * inv : 0.f; }
                  PT[tl * 256 + key] = ps; } }
          if (tid < 64) SEL[tid] = 0u; if (tid < 2) UNI[tid] = 0u;
          LDS_WAIT(); __syncthreads(); }
        { const int tk = tid >> 4, sg = (tid & 15) * 4;
#pragma unroll
          for (int i = 0; i < 4; ++i) { const int s = sg + i; const LAS float* p = PT + tk * 256 + 4 * s; float v = p[0] + p[1] + p[2] + 0.5f * p[3]; if (s > 0) v += 0.5f * p[-1];
              const bool forced = (s == 0) || (s == cur) || (s == cur - 1); IMP[tk * 64 + s] = forced ? 1e9f : (s <= cur ? v : -1e9f); }
          LDS_WAIT(); __syncthreads();
          float mine[4]; int cnt[4];
#pragma unroll
          for (int i = 0; i < 4; ++i) { mine[i] = IMP[tk * 64 + sg + i]; cnt[i] = 0; }
          for (int s2 = 0; s2 < 64; ++s2) { const float o = IMP[tk * 64 + s2];
#pragma unroll
              for (int i = 0; i < 4; ++i) cnt[i] += (o > mine[i] || (o == mine[i] && s2 < sg + i)) ? 1 : 0; }
          unsigned bits = 0u;
#pragma unroll
          for (int i = 0; i < 4; ++i) if (cnt[i] < 16 && mine[i] > -1e8f) bits |= 1u << ((sg + i) & 31);
          if (bits) { atomicOr((unsigned*)(SEL + tk * 2 + (sg >> 5)), bits); atomicOr((unsigned*)(UNI + (sg >> 5)), bits); }
          LDS_WAIT(); __syncthreads(); }
        const unsigned sel0 = SEL[tl * 2], sel1 = SEL[tl * 2 + 1], uni0 = UNI[0], uni1 = UNI[1];
#pragma unroll
        for (int i = 0; i < 4; ++i) O[i] = (f32x4){0.f, 0.f, 0.f, 0.f};
#pragma unroll
        for (int r = 0; r < 4; ++r) lr[r] = 0.f;
        attn_pass<64, 2>(F.lds, tid, lane, wave, KSg, VSg, T, 0, cur, qf, O, lr, trow, sel0, sel1, uni0, uni1);
#pragma unroll
        for (int r = 0; r < 4; ++r) lr[r] = red16_sum(lr[r]);
#pragma unroll
        for (int r = 0; r < 4; ++r) { const float inv = lr[r] > 0.f ? 1.f / lr[r] : 0.f;
#pragma unroll
            for (int nd = 0; nd < 4; ++nd) OF[nd][r] += gate[1][r] * O[nd][r] * inv; }
#pragma unroll
        for (int i = 0; i < 4; ++i) O[i] = (f32x4){0.f, 0.f, 0.f, 0.f};
#pragma unroll
        for (int r = 0; r < 4; ++r) lr[r] = 0.f;
        { const int lo = t0 - 511; attn_pass<64, 3>(F.lds, tid, lane, wave, KWg, VWg, T, lo > 0 ? (lo >> 6) : 0, cur, qf, O, lr, trow, 0u, 0u, 0u, 0u); }
#pragma unroll
        for (int r = 0; r < 4; ++r) lr[r] = red16_sum(lr[r]);
#pragma unroll
        for (int r = 0; r < 4; ++r) { const float inv = lr[r] > 0.f ? 1.f / lr[r] : 0.f;
#pragma unroll
            for (int nd = 0; nd < 4; ++nd) OF[nd][r] += gate[2][r] * O[nd][r] * inv; }
#pragma unroll
        for (int r = 0; r < 4; ++r)
#pragma unroll
            for (int nd = 0; nd < 4; ++nd) Y[(size_t)(m0 + tl) * 2560 + 512 + (kvh * 4 + r) * 64 + 16 * nd + (lane & 15)] = (bf16)f2bf(OF[nd][r]);
        __syncthreads();
    }
}

constexpr int CL = 32, NCH = T / CL;
constexpr int SC_STEPS = 8;
__device__ __forceinline__ void phase_scan(const Frame& F0, int l) {
    const Frame F = relaunder(F0);
    unsigned char* ws = F.ws; const bf16* P = (const bf16*)(ws + WS_P); const bf16* LO = (const bf16*)(ws + WS_LO);
    float* VF = (float*)(ws + WS_VFIRST); bf16* VC = (bf16*)(ws + WS_VCUR); float* BON = (float*)(ws + WS_BON);
    bf16* YL = (bf16*)(ws + WS_YL); bf16* ZL = (bf16*)(ws + WS_ZL); float* QF = (float*)(ws + WS_QF); float* PF = (float*)(ws + WS_PF);
    const float* mu = INP(6) + l * 1984; const float* kk_ = INP(12) + l * 512; const float* ka_ = INP(13) + l * 512; const float* rk_ = INP(14) + l * 512;
    const int wave = F.wave;
    LAS float* ST = (LAS float*)F.lds + wave * (SC_STEPS * 5 * 64 + 64);
    for (int u = F.bid; u < 256; u += F.G) {
        int lane = F.lane; asm volatile("" : "+v"(lane));
        const int b = u >> 7, h = (u >> 4) & 7, cq = u & 15;
        const int jc = h * 64 + lane;
        const float mu_r = mu[PC_R + jc], mu_k = mu[PC_K + jc], mu_v = mu[PC_V + jc], kkw = kk_[jc], kaw = ka_[jc], rkw = rk_[jc];
        const int chunk = cq * 8 + wave;
        f32x2 Sq[32], Sp[32];
#pragma unroll
        for (int k = 0; k < 32; ++k) { Sq[k] = (f32x2){0.f, 0.f}; Sp[k] = (f32x2){(2 * k == lane) ? 1.f : 0.f, (2 * k + 1 == lane) ? 1.f : 0.f}; }
        const int tbase = chunk * CL;
        float gam = 1.f;
        for (int sb = 0; sb < CL / SC_STEPS; ++sb) {
            LDS_WAIT(); asm volatile("" ::: "memory");
#pragma unroll 1
            for (int hb = 0; hb < 2; ++hb) { const int st0 = hb * 4; const int tf = tbase + sb * SC_STEPS + st0, mf = b * T + tf;
              float ur[5], uk[5], uv[5], wv[4], av[4], vgv[4], vfv[4];
#pragma unroll
              for (int i = 0; i < 5; ++i) { const bool ok = (tf - 1 + i) >= 0; const bf16* pr = P + (size_t)(ok ? (mf - 1 + i) : mf) * LDP + h * 64;
                  const float sc = ok ? 1.f : 0.f;
                  ur[i] = ldbf(pr + PC_R + lane) * sc; uk[i] = ldbf(pr + PC_K + lane) * sc; uv[i] = ldbf(pr + PC_V + lane) * sc; }
#pragma unroll
              for (int i = 0; i < 4; ++i) { const bf16* lr = LO + (size_t)(mf + i) * 2048 + h * 64; wv[i] = 1.0f - ldbf(lr + lane); av[i] = ldbf(lr + 512 + lane);
                  vgv[i] = l ? ldbf(lr + 1536 + lane) : 0.f; vfv[i] = l ? (VF + (size_t)(mf + i) * 512 + h * 64)[lane] : 0.f; }
              float rr[4], kv[4], vv4[4], kmod4[4], red[8];
#pragma unroll
              for (int i = 0; i < 4; ++i) { const int m = mf + i;
                  const float r = ur[i + 1] + (ur[i] - ur[i + 1]) * mu_r, k = uk[i + 1] + (uk[i] - uk[i + 1]) * mu_k; float v = uv[i + 1] + (uv[i] - uv[i + 1]) * mu_v;
                  if (l == 0) (VF + (size_t)m * 512 + h * 64)[lane] = v; else v = v + (vfv[i] - v) * vgv[i];
                  (VC + (size_t)m * 512 + h * 64)[lane] = (bf16)f2bf(v);
                  const float kkv = k * kkw; const float kmod = k * (1.f + (av[i] - 1.f) * kaw);
                  rr[i] = r; kv[i] = kkv; vv4[i] = v; kmod4[i] = kmod; red[2 * i] = kkv * kkv; red[2 * i + 1] = r * kmod * rkw; }
#pragma unroll
              for (int o = 1; o < 64; o <<= 1) { float t8[8];
#pragma unroll
                  for (int j = 0; j < 8; ++j) t8[j] = __shfl_xor(red[j], o);
#pragma unroll
                  for (int j = 0; j < 8; ++j) red[j] += t8[j]; }
#pragma unroll
              for (int i = 0; i < 4; ++i) { const int m = mf + i; const float w = wv[i], a = av[i];
                  const float kkn = kv[i] * __builtin_amdgcn_rsqf(fmaxf(red[2 * i], 1e-24f));
                  if (lane == 0) __hip_atomic_store((unsigned*)BON + (size_t)m * 8 + h, __builtin_bit_cast(unsigned, red[2 * i + 1]), RLX_AGENT);
                  const float gprev = gam; gam *= w; const float ig = __builtin_amdgcn_rcpf(gam);
                  LAS float* dst = ST + ((st0 + i) * 5) * 64 + lane;
                  dst[0] = kkn * gprev; dst[64] = kkn * a * ig; dst[128] = kmod4[i] * ig; dst[192] = rr[i] * gam; dst[256] = vv4[i]; } }
            LDS_WAIT(); asm volatile("" ::: "memory");
            for (int st = 0; st < SC_STEPS; ++st) { const LAS float* sp = ST + (st * 5) * 64; const int t = tbase + sb * SC_STEPS + st;
                const float vv = sp[256 + lane]; const f32x2 vv2 = (f32x2){vv, vv};
                f32x2 qa = (f32x2){0.f, 0.f}, qb = qa, pa = qa, pb = qa;
                { f32x4 buf[2][2];
#pragma unroll
                  for (int i = 0; i < 2; ++i) buf[0][i] = *(const LAS f32x4*)(sp + 4 * i);
#pragma unroll
                  for (int g = 0; g < 8; ++g) {
                      if (g < 7) {
#pragma unroll
                          for (int i = 0; i < 2; ++i) buf[(g + 1) & 1][i] = *(const LAS f32x4*)(sp + 8 * (g + 1) + 4 * i); }
                      asm volatile("" ::: "memory");
#pragma unroll
                      for (int i = 0; i < 2; ++i) { const int k2 = 4 * g + 2 * i; const f32x4 kk4 = buf[g & 1][i]; const f32x2 klo = (f32x2){kk4[0], kk4[1]}, khi = (f32x2){kk4[2], kk4[3]};
                          qa += Sq[k2] * klo; qb += Sq[k2 + 1] * khi; pa += Sp[k2] * klo; pb += Sp[k2 + 1] * khi; } } }
                const f32x2 qs = qa + qb, ps = pa + pb; const float nq = -(qs.x + qs.y), np = -(ps.x + ps.y); const f32x2 nq2 = (f32x2){nq, nq}, np2 = (f32x2){np, np};
                f32x2 ya = (f32x2){0.f, 0.f}, yb = ya, za = ya, zb = ya;
                { f32x4 bb[2], bk[2], br[2];
                  bb[0] = *(const LAS f32x4*)(sp + 64); bk[0] = *(const LAS f32x4*)(sp + 128); br[0] = *(const LAS f32x4*)(sp + 192);
#pragma unroll
                  for (int g = 0; g < 16; ++g) {
                      if (g < 15) { bb[(g + 1) & 1] = *(const LAS f32x4*)(sp + 64 + 4 * (g + 1)); bk[(g + 1) & 1] = *(const LAS f32x4*)(sp + 128 + 4 * (g + 1)); br[(g + 1) & 1] = *(const LAS f32x4*)(sp + 192 + 4 * (g + 1)); }
                      asm volatile("" ::: "memory");
                      { const int k2 = 2 * g; const f32x4 b4 = bb[g & 1], k4 = bk[g & 1], r4 = br[g & 1];
                        const f32x2 blo = (f32x2){b4[0], b4[1]}, bhi = (f32x2){b4[2], b4[3]}, klo = (f32x2){k4[0], k4[1]}, khi = (f32x2){k4[2], k4[3]}, rlo = (f32x2){r4[0], r4[1]}, rhi = (f32x2){r4[2], r4[3]};
                        Sq[k2] += vv2 * klo + nq2 * blo; Sq[k2 + 1] += vv2 * khi + nq2 * bhi; Sp[k2] += np2 * blo; Sp[k2 + 1] += np2 * bhi;
                        ya += Sq[k2] * rlo; yb += Sq[k2 + 1] * rhi; za += Sp[k2] * rlo; zb += Sp[k2 + 1] * rhi; } } }
                const f32x2 ys = ya + yb, zs = za + zb;
                const size_t o = (size_t)(b * T + t) * 512 + h * 64 + lane;
                YL[o] = (bf16)f2bf(ys.x + ys.y); ZL[o] = (bf16)f2bf(zs.x + zs.y); }
        }
        { LAS float* GL = ST + SC_STEPS * 5 * 64; LDS_WAIT(); asm volatile("" ::: "memory"); GL[lane] = gam; LDS_WAIT(); asm volatile("" ::: "memory");
#pragma unroll
          for (int k = 0; k < 32; k += 2) { const f32x4 g4 = *(const LAS f32x4*)(GL + 2 * k); const f32x2 glo = (f32x2){g4[0], g4[1]}, ghi = (f32x2){g4[2], g4[3]};
              Sq[k] *= glo; Sq[k + 1] *= ghi; Sp[k] *= glo; Sp[k + 1] *= ghi; } }
        { const size_t un = ((size_t)(b * 8 + h) * NCH + chunk) * 4096;
#pragma unroll
          for (int k = 0; k < 32; k += 4) { u32x4 w; w.x = pk2(Sq[k].x, Sq[k].y); w.y = pk2(Sq[k + 1].x, Sq[k + 1].y); w.z = pk2(Sq[k + 2].x, Sq[k + 2].y); w.w = pk2(Sq[k + 3].x, Sq[k + 3].y);
              *(u32x4*)((bf16*)QF + un + lane * 64 + 2 * k) = w; }
          { unsigned short* pf = (unsigned short*)PF + un + ((lane >> 2) & 3) * 16 + (lane >> 4) * 4 + (lane & 3);
#pragma unroll
            for (int k = 0; k < 32; ++k) { const unsigned w = pk2(Sp[k].x, Sp[k].y); pf[(2 * k) * 64] = (unsigned short)w; pf[(2 * k + 1) * 64] = (unsigned short)(w >> 16); } } }
    }
}
constexpr int CPF = 8;
__device__ __forceinline__ void phase_carry(const Frame& F0, unsigned* flags) {
    const Frame F = relaunder(F0);
    unsigned char* ws = F.ws; const unsigned char* QFb = ws + WS_QF; const unsigned char* PFb = ws + WS_PF; float* SI = (float*)(ws + WS_SINIT);
    const int lane = F.lane, wave = F.wave;
    LAS unsigned char* ring = F.lds;
    for (int chain = F.bid; chain < 16; chain += F.G) {
        const size_t cb = (size_t)chain * NCH * 8192;
        if (wave >= 4) {
            const int pt = (wave - 4) * 64 + lane;
            u32x4 rt[CPF][2], rq[CPF][2];
#pragma unroll
            for (int d = 0; d < CPF; ++d) { const size_t o = cb + (size_t)d * 8192 + pt * 16;
                rt[d][0] = *(const u32x4*)(PFb + o); rt[d][1] = *(const u32x4*)(PFb + o + 4096); rq[d][0] = *(const u32x4*)(QFb + o); rq[d][1] = *(const u32x4*)(QFb + o + 4096); }
            asm volatile("s_waitcnt vmcnt(%0)" :: "n"(4 * (CPF - 1)) : "memory");
            { LAS unsigned char* sl = ring + pt * 16; *(LAS u32x4*)(sl) = rt[0][0]; *(LAS u32x4*)(sl + 4096) = rt[0][1]; *(LAS u32x4*)(sl + 8192) = rq[0][0]; *(LAS u32x4*)(sl + 12288) = rq[0][1]; }
            { const size_t o = cb + (size_t)CPF * 8192 + pt * 16;
              rt[0][0] = *(const u32x4*)(PFb + o); rt[0][1] = *(const u32x4*)(PFb + o + 4096); rq[0][0] = *(const u32x4*)(QFb + o); rq[0][1] = *(const u32x4*)(QFb + o + 4096); }
            LDS_WAIT(); __syncthreads();
            for (int c0 = 0; c0 < NCH; c0 += CPF) {
#pragma unroll
                for (int d = 0; d < CPF; ++d) { const int c = c0 + d;
                    constexpr int DUMMY = 0; (void)DUMMY;
                    const int e = (d + 1) % CPF;
                    if (c + 1 < NCH) {
                        asm volatile("s_waitcnt vmcnt(%0)" :: "n"(4 * (CPF - 1)) : "memory");
                        LAS unsigned char* sl = ring + ((c + 1) & 1) * 16384 + pt * 16;
                        *(LAS u32x4*)(sl) = rt[e][0]; *(LAS u32x4*)(sl + 4096) = rt[e][1]; *(LAS u32x4*)(sl + 8192) = rq[e][0]; *(LAS u32x4*)(sl + 12288) = rq[e][1];
                        const int cn = c + 1 + CPF < NCH ? c + 1 + CPF : NCH - 1;
                        const size_t o = cb + (size_t)cn * 8192 + pt * 16;
                        rt[e][0] = *(const u32x4*)(PFb + o); rt[e][1] = *(const u32x4*)(PFb + o + 4096); rq[e][0] = *(const u32x4*)(QFb + o); rq[e][1] = *(const u32x4*)(QFb + o + 4096);
                    }
                    LDS_WAIT(); __syncthreads();
                }
            }
            asm volatile("s_waitcnt vmcnt(0)" ::: "memory");
        } else {
            const int row = wave * 16 + (lane & 15), g = lane >> 4;
            const int aoff = ((lane & 15) * 64 + g * 16) * 2, qoff = (row * 64 + 4 * g) * 2;
            f32x4 S[4];
#pragma unroll
            for (int mt = 0; mt < 4; ++mt) S[mt] = (f32x4){0.f, 0.f, 0.f, 0.f};
            u32x4 a[4][2]; u32x2 q[4];
            __syncthreads();
#pragma unroll
            for (int mt = 0; mt < 4; ++mt) { a[mt][0] = *(const LAS u32x4*)(ring + mt * 2048 + aoff); a[mt][1] = *(const LAS u32x4*)(ring + mt * 2048 + aoff + 16); q[mt] = *(const LAS u32x2*)(ring + 8192 + qoff + 32 * mt); }
            LDS_WAIT(); __builtin_amdgcn_sched_barrier(0);
            for (int c = 0; c < NCH; ++c) { const size_t un = ((size_t)chain * NCH + c) * 4096;
#pragma unroll
                for (int mt = 0; mt < 4; ++mt) *(f32x4*)(SI + un + (qoff >> 1) + 16 * mt) = S[mt];
                bf16x8 bh[2], bl[2];
#pragma unroll
                for (int ks = 0; ks < 2; ++ks) { u32x4 wh, wl; const f32x4 s0 = S[2 * ks], s1 = S[2 * ks + 1];
                    wh.x = pk2(s0[0], s0[1]); wh.y = pk2(s0[2], s0[3]); wh.z = pk2(s1[0], s1[1]); wh.w = pk2(s1[2], s1[3]);
                    wl.x = pk2(s0[0] - bf2f(wh.x & 0xffffu), s0[1] - bf2f(wh.x >> 16)); wl.y = pk2(s0[2] - bf2f(wh.y & 0xffffu), s0[3] - bf2f(wh.y >> 16));
                    wl.z = pk2(s1[0] - bf2f(wh.z & 0xffffu), s1[1] - bf2f(wh.z >> 16)); wl.w = pk2(s1[2] - bf2f(wh.w & 0xffffu), s1[3] - bf2f(wh.w >> 16));
                    bh[ks] = __builtin_bit_cast(bf16x8, wh); bl[ks] = __builtin_bit_cast(bf16x8, wl); }
                __builtin_amdgcn_sched_barrier(0);
#pragma unroll
                for (int mt = 0; mt < 4; ++mt) { f32x4 d = (f32x4){bf2f(q[mt].x & 0xffffu), bf2f(q[mt].x >> 16), bf2f(q[mt].y & 0xffffu), bf2f(q[mt].y >> 16)};
#pragma unroll
                    for (int ks = 0; ks < 2; ++ks) { const bf16x8 af = __builtin_bit_cast(bf16x8, a[mt][ks]);
                        d = __builtin_amdgcn_mfma_f32_16x16x32_bf16(af, bh[ks], d, 0, 0, 0); d = __builtin_amdgcn_mfma_f32_16x16x32_bf16(af, bl[ks], d, 0, 0, 0); }
                    S[mt] = d; }
                asm volatile("s_nop 7\n\ts_nop 7" ::: "memory");
                __builtin_amdgcn_sched_barrier(0);
                __syncthreads();
                if (c + 1 < NCH) { LAS unsigned char* sl = ring + ((c + 1) & 1) * 16384;
#pragma unroll
                    for (int mt = 0; mt < 4; ++mt) { a[mt][0] = *(const LAS u32x4*)(sl + mt * 2048 + aoff); a[mt][1] = *(const LAS u32x4*)(sl + mt * 2048 + aoff + 16); q[mt] = *(const LAS u32x2*)(sl + 8192 + qoff + 32 * mt); } }
                LDS_WAIT(); __builtin_amdgcn_sched_barrier(0);
            }
        }
        asm volatile("s_waitcnt vmcnt(0)" ::: "memory");
        __syncthreads();
        if (xb_t0(wave)) { __builtin_amdgcn_fence(__ATOMIC_RELEASE, "agent"); asm volatile("s_waitcnt vmcnt(0)" ::: "memory"); __hip_atomic_store(flags + chain, 1u, __ATOMIC_RELAXED, __HIP_MEMORY_SCOPE_AGENT); }
    }
}
__device__ __forceinline__ void phase_rwkv_fin(const Frame& F0, int l, unsigned* flags, unsigned* qctr) {
    const Frame F = relaunder(F0);
    unsigned char* ws = F.ws; const float* SI = (const float*)(ws + WS_SINIT); const bf16* YL = (const bf16*)(ws + WS_YL); const bf16* ZL = (const bf16*)(ws + WS_ZL);
    const bf16* LO = (const bf16*)(ws + WS_LO); const bf16* VC = (const bf16*)(ws + WS_VCUR); const float* BON = (const float*)(ws + WS_BON); bf16* Y = (bf16*)(ws + WS_Y);
    const float* lnw = INP(15) + l * 512; const float* lnb = INP(16) + l * 512;
    const int lane = F.lane, wave = F.wave;
    (void)qctr;
    __syncthreads();
    if (xb_t0(wave)) {
        for (int u = F.bid; u < 16 * (NCH / 4); u += F.G) { unsigned* fl = flags + u / (NCH / 4); unsigned sp = 0u;
            while (xb_ld(fl) == 0u && ++sp < (1u << 22)) __builtin_amdgcn_s_sleep(1); }
        __builtin_amdgcn_fence(__ATOMIC_ACQUIRE, "agent"); asm volatile("s_waitcnt vmcnt(0)" ::: "memory"); }
    __syncthreads();
    for (int u = F.bid; u < 16 * (NCH / 4); u += F.G) {
        const int chain = u / (NCH / 4), c = (u % (NCH / 4)) * 4 + (wave >> 1), b = chain >> 3, h = chain & 7; const size_t un = ((size_t)chain * NCH + c) * 4096;
        const int m0 = b * T + c * CL + (wave & 1) * 16;
        bf16x8 af[2], bfr[4][2];
#pragma unroll
        for (int ks = 0; ks < 2; ++ks) af[ks] = __builtin_bit_cast(bf16x8, *(const u32x4*)(ZL + (size_t)(m0 + (lane & 15)) * 512 + h * 64 + ks * 32 + 8 * (lane >> 4)));
#pragma unroll
        for (int n = 0; n < 4; ++n)
#pragma unroll
            for (int ks = 0; ks < 2; ++ks) { float t8[8]; ldf8(SI + un + (size_t)(16 * n + (lane & 15)) * 64 + ks * 32 + 8 * (lane >> 4), t8);
                u32x4 w; w.x = pk2(t8[0], t8[1]); w.y = pk2(t8[2], t8[3]); w.z = pk2(t8[4], t8[5]); w.w = pk2(t8[6], t8[7]); bfr[n][ks] = __builtin_bit_cast(bf16x8, w); }
        float yl[4][4], vc[4][4], gg[4][4], bn[4];
#pragma unroll
        for (int r = 0; r < 4; ++r) { const int m = m0 + 4 * (lane >> 4) + r; bn[r] = BON[(size_t)m * 8 + h];
#pragma unroll
            for (int n = 0; n < 4; ++n) { const int j = h * 64 + 16 * n + (lane & 15); yl[n][r] = ldbf(YL + (size_t)m * 512 + j); vc[n][r] = ldbf(VC + (size_t)m * 512 + j); gg[n][r] = ldbf(LO + (size_t)m * 2048 + 1024 + j); } }
        asm volatile("s_waitcnt vmcnt(0)" ::: "memory"); __builtin_amdgcn_sched_barrier(0);
        f32x4 C[4];
#pragma unroll
        for (int n = 0; n < 4; ++n) { C[n] = (f32x4){yl[n][0], yl[n][1], yl[n][2], yl[n][3]};
#pragma unroll
            for (int ks = 0; ks < 2; ++ks) C[n] = __builtin_amdgcn_mfma_f32_16x16x32_bf16(af[ks], bfr[n][ks], C[n], 0, 0, 0); }
        __builtin_amdgcn_sched_barrier(0);
#pragma unroll
        for (int r = 0; r < 4; ++r) { const int m = m0 + 4 * (lane >> 4) + r;
            float sm = (C[0][r] + C[1][r]) + (C[2][r] + C[3][r]); sm = red16_sum(sm); const float mean = sm * (1.f / 64.f);
            float d[4], sv = 0.f;
#pragma unroll
            for (int n = 0; n < 4; ++n) { d[n] = C[n][r] - mean; sv += d[n] * d[n]; }
            sv = red16_sum(sv); const float rs = __builtin_amdgcn_rsqf(sv * (1.f / 64.f) + 64e-5f);
#pragma unroll
            for (int n = 0; n < 4; ++n) { const int j = h * 64 + 16 * n + (lane & 15); const float yn = d[n] * rs * lnw[j] + lnb[j];
                Y[(size_t)m * 2560 + j] = (bf16)f2bf((yn + bn[r] * vc[n][r]) * gg[n][r]); } }
    }
}

__device__ __forceinline__ void phase_route(const Frame& F0, const bf16* X) {
    const Frame F = relaunder(F0);
    const float* R = INP(36); const float* gain = INP(3) + D; const u64* ssq = (const u64*)(F.ctl + CW_SSQ) + 3 * 8192;
    unsigned* cnt = F.ctl + CW_CNT; unsigned* route = F.ctl + CW_ROUTE;
    const int lane = F.lane;
    for (int m = F.bid * 8 + F.wave; m < M; m += F.G * 8) {
        float acc[8];
#pragma unroll
        for (int e = 0; e < 8; ++e) acc[e] = 0.f;
#pragma unroll 8
        for (int i = 0; i < 32; ++i) { const int k = lane + 64 * i; const float xv = ldbf(X + (size_t)m * D + k) * gain[k]; const f32x4 r0 = *(const f32x4*)(R + k * 8), r1 = *(const f32x4*)(R + k * 8 + 4);
            acc[0] += xv * r0[0]; acc[1] += xv * r0[1]; acc[2] += xv * r0[2]; acc[3] += xv * r0[3]; acc[4] += xv * r1[0]; acc[5] += xv * r1[1]; acc[6] += xv * r1[2]; acc[7] += xv * r1[3]; }
        const float rs = rstd_of(ssq, m);
#pragma unroll
        for (int e = 0; e < 8; ++e) acc[e] = wave_sum(acc[e]) * rs;
        if (lane == 0) {
            int e0 = 0; float v0 = acc[0];
#pragma unroll
            for (int e = 1; e < 8; ++e) if (acc[e] > v0) { v0 = acc[e]; e0 = e; }
            int e1 = -1; float v1 = -3.0e38f;
#pragma unroll
            for (int e = 0; e < 8; ++e) if (e != e0 && acc[e] > v1) { v1 = acc[e]; e1 = e; }
            const float p1 = __expf(v1 - v0); const float w0 = 1.f / (1.f + p1), w1 = p1 / (1.f + p1);
            const unsigned pos0 = atomicAdd(cnt + 64 * e0, 1u), pos1 = atomicAdd(cnt + 64 * e1, 1u);
            unsigned* rr = route + (size_t)m * 8; rr[0] = (unsigned)e0; rr[1] = (unsigned)e1; rr[2] = __builtin_bit_cast(unsigned, w0); rr[3] = __builtin_bit_cast(unsigned, w1); rr[4] = pos0; rr[5] = pos1; rr[6] = __builtin_bit_cast(unsigned, rs); }
    }
}
__device__ __forceinline__ void moe_tiles(const Frame& F, int (&ts)[9]) {
    ts[0] = 0;
#pragma unroll
    for (int e = 0; e < 8; ++e) { const unsigned c = __hip_atomic_load(F.ctl + CW_CNT + 64 * e, RLX_AGENT); ts[e + 1] = ts[e] + (int)((c + 255u) >> 8); }
}
__device__ __forceinline__ void phase_gather(const Frame& F0, float* RSS) {
    const Frame F = relaunder(F0);
    constexpr int RB = F8_M1 ? D : 2 * D;
    unsigned char* ws = F.ws; const unsigned char* XH = ws + (F8_M1 ? WS_XH8 : WS_XH); unsigned char* XG = ws + WS_XG; const unsigned* route = F.ctl + CW_ROUTE;
    int ts[9]; moe_tiles(F, ts);
    for (int m = F.bid * 8 + F.wave; m < M; m += F.G * 8) { const unsigned* rr = route + (size_t)m * 8;
        const u32x4* src = (const u32x4*)(XH + (size_t)m * RB);
#pragma unroll
        for (int s = 0; s < 2; ++s) { const int e = (int)rr[s]; int base = 0;
#pragma unroll
            for (int j = 0; j < 8; ++j) base = (j == e) ? ts[j] : base;
            const int slot = base * 256 + (int)rr[4 + s]; u32x4* dst = (u32x4*)(XG + (size_t)slot * RB);
#pragma unroll
            for (int i = 0; i < RB / 1024; ++i) dst[F.lane + 64 * i] = src[F.lane + 64 * i];
            if (F.lane == 0) __hip_atomic_store((unsigned*)RSS + slot, rr[6], RLX_AGENT); } }
}
__device__ __forceinline__ void phase_combine(const Frame& F0, const bf16* X, float* out) {
    const Frame F = relaunder(F0);
    unsigned char* ws = F.ws; const bf16* YS = (const bf16*)(ws + WS_YS); const unsigned* route = F.ctl + CW_ROUTE;
    int ts[9]; moe_tiles(F, ts);
    for (int m = F.bid * 8 + F.wave; m < M; m += F.G * 8) { const unsigned* rr = route + (size_t)m * 8; int slot[2]; float w[2];
#pragma unroll
        for (int s = 0; s < 2; ++s) { const int e = (int)rr[s]; int base = 0;
#pragma unroll
            for (int j = 0; j < 8; ++j) base = (j == e) ? ts[j] : base;
            slot[s] = base * 256 + (int)rr[4 + s]; w[s] = __builtin_bit_cast(float, rr[2 + s]); }
#pragma unroll
        for (int i = 0; i < 8; ++i) { const int c = (F.lane + 64 * i) * 4; const u32x2 xr = *(const u32x2*)(X + (size_t)m * D + c); f32x4 v = (f32x4){bf2f(xr.x & 0xffffu), bf2f(xr.x >> 16), bf2f(xr.y & 0xffffu), bf2f(xr.y >> 16)};
            const u32x2 a = *(const u32x2*)(YS + (size_t)slot[0] * D + c), b2 = *(const u32x2*)(YS + (size_t)slot[1] * D + c);
            v[0] += w[0] * bf2f(a.x & 0xffffu) + w[1] * bf2f(b2.x & 0xffffu); v[1] += w[0] * bf2f(a.x >> 16) + w[1] * bf2f(b2.x >> 16);
            v[2] += w[0] * bf2f(a.y & 0xffffu) + w[1] * bf2f(b2.y & 0xffffu); v[3] += w[0] * bf2f(a.y >> 16) + w[1] * bf2f(b2.y >> 16);
            *(f32x4*)(out + (size_t)m * D + c) = v; } }
}

constexpr int PH_PER_LAYER = 14, N_PHASES = 1 + 2 * PH_PER_LAYER;
struct Args { const float* in[40]; float* out; unsigned char* ws; int ph_lo, ph_hi; };
__global__ void __launch_bounds__(512, 2) mega_fwd(Args args) {
    extern __shared__ __attribute__((aligned(16))) unsigned char lds_raw[];
    Frame F; F.lds = (LAS unsigned char*)lds_raw; F.tid = threadIdx.x; F.lane = F.tid & 63; F.wave = __builtin_amdgcn_readfirstlane(F.tid >> 6); F.G = gridDim.x; F.bid = blockIdx.x;
    F.in = args.in; F.ws = args.ws; F.ctl = (unsigned*)(args.ws + WS_CTL);
    volatile LAS unsigned* MISC = (volatile LAS unsigned*)(F.lds + MISC_OFF);
    for (int u = F.tid; u < (LDS_BYTES - RING_BYTES) / 4; u += 512) ((LAS unsigned*)(F.lds + RING_BYTES))[u] = 0u;
    __syncthreads();
    const int lo = args.ph_lo, hi = args.ph_hi;
    XcdBarrier bar; bar.bar = F.ctl + CW_BAR; bar.x = 0; bar.st = nullptr; bar.wave = F.wave;
    if (hi - lo > 1) bar = xcd_barrier_post(F.ctl + CW_BAR, MISC + 8, F.wave);
#ifndef PHMASK
#define PHMASK 0xFFFFFFFFu
#endif
#define KD(j) (((PHMASK) >> (j)) & 1u)
#define IN(k) (lo <= (k) && (k) < hi)
#define SEAM(k) do { if (IN((k) + 1)) xcd_barrier(bar); } while (0)
    unsigned char* ws = args.ws;
    u64* ssq_all = (u64*)(F.ctl + CW_SSQ);
    LAS unsigned char* lds = F.lds;

    if (KD(0) && IN(0)) { phase_prologue(F); SEAM(0); }

    auto run_layer = [&](auto LC) __attribute__((always_inline)) {
        constexpr int l = decltype(LC)::value;
        const int pb = 1 + l * PH_PER_LAYER;
        const u64* ssq_mix = ssq_all + (2 * l) * 8192; u64* ssq_ffn = ssq_all + (2 * l + 1) * 8192;
        bf16* XH = (bf16*)(ws + WS_XH);
        const float* xin = l == 0 ? args.in[0] : args.out; float* xmid = (float*)(ws + WS_XA); float* xout = args.out;
        if (KD(1) && IN(pb + 0)) {
            const int nNP = (l ? NP1 : NP0) / 256;
            { pg8::Gemm g{XH, (const bf16*)(ws + (l ? WS_WPT1 : WS_WPT0)), D, D, D, 0, 0}; pg8::GridOrder S; S.init(M / 256, nNP, 1, F.G, F.bid);
              EpiP E{(bf16*)(ws + WS_P), (bf16*)(ws + WS_G4), ssq_mix, nNP}; pg8::gemm_phase<EpiP, pg8::GridOrder>(lds, g, S, E, F.wave); }
            if (l == 0 && F.G >= 16 && F.bid >= F.G - 16) { pg8::Gemm g{(const bf16*)(ws + WS_MEMN), (const bf16*)(ws + WS_WKVT0), D, D, D, 0, 0}; pg8::GridOrder S; S.init(2, 8, 1, 16, F.bid - (F.G - 16));
              EpiF32 E{(float*)(ws + WS_KVRAW), 2048}; pg8::gemm_phase<EpiF32, pg8::GridOrder>(lds, g, S, E, F.wave); }
            SEAM(pb + 0);
        }
        if (KD(2) && IN(pb + 1)) { phase_prep(F, l); SEAM(pb + 1); }
        if (KD(3) && IN(pb + 2)) {
            if (KD(17)) { pg8::Gemm g{(const bf16*)(ws + WS_ALORA), (const bf16*)(ws + (l ? WS_WLT1 : WS_WLT0)), 512, 512, 512, 0, 0}; pg8::GridOrder S; S.init(M / 256, 8, 1, F.G, F.bid);
              EpiLora E{(bf16*)(ws + WS_LO), args.in[7] + l * 512, args.in[9] + l * 512, args.in[19], l}; pg8::gemm_phase<EpiLora, pg8::GridOrder>(lds, g, S, E, F.wave); }
            if (KD(18) && F.bid < 32) { const int kp = F.bid >> 3;
              pg8::Gemm g{(const bf16*)(ws + WS_ACMP) + kp * 512, (const bf16*)(ws + (l ? WS_WC1T1 : WS_WC1T0)) + kp * 512, 2048, 2048, 512, (size_t)1024 * 2048 * 2, (size_t)256 * 2048 * 2}; pg8::GridOrder S; S.init(4, 1, 2, 8, F.bid & 7);
              EpiHP E{(float*)(ws + WS_HP) + (size_t)kp * 2 * 1024 * 128}; pg8::gemm_phase<EpiHP, pg8::GridOrder>(lds, g, S, E, F.wave); }
            __syncthreads();
            if (KD(19)) phase_memattn(F);
            SEAM(pb + 2);
        }
        if (KD(4) && IN(pb + 3)) {
            if (F.bid < 8) { const CmpFin CF{(const float*)(ws + WS_HP), args.in[24] + l * 256, (const bf16*)(ws + WS_WC2T) + (size_t)l * 2 * 64 * 128, args.in[21] + l * 256 + 64, (bf16*)(ws + WS_KC), (bf16*)(ws + WS_VCT)};
                cmp_finalize(CF, F.bid >> 2, F.bid & 3, lds, F.wave, F.lane); }
            phase_scan(F, l); SEAM(pb + 3); }
        if (KD(5) && IN(pb + 4)) { unsigned* cflags = F.ctl + CW_QCTR + 256 + 64 * l; phase_carry(F, cflags); if (F.bid % 5 < (l == 0 ? 2 : 1)) convert_late_loop<l>(F, F.ctl + CW_QCTR + 384 + 64 * l); phase_nsa(F, F.ctl + CW_QCTR + 64 * l); convert_late_loop<l>(F, F.ctl + CW_QCTR + 384 + 64 * l); phase_rwkv_fin(F, l, cflags, F.ctl + CW_QCTR + 128 + 64 * l); SEAM(pb + 4); }
        if (KD(7) && IN(pb + 6)) {
            pg8::Gemm g{(const bf16*)(ws + WS_Y), (const bf16*)(ws + (l ? WS_WBT1 : WS_WBT0)), 2560, 512, 512, (size_t)512 * 2, (size_t)2048 * 512 * 2}; pg8::GridOrder S; S.init(M / 256, 8, 5, F.G, F.bid);
            EpiZ E{(bf16*)(ws + WS_ZB)}; pg8::gemm_phase<EpiZ, pg8::GridOrder>(lds, g, S, E, F.wave);
            { pg8::Gemm g4{(const bf16*)(ws + WS_XH8), (const bf16*)(ws + (l ? WS_WG4T1 : WS_WG4T0)), D / 2, D / 2, D / 2, 0, 0}; pg8::GridOrder S4; S4.init(M / 256, 8, 1, F.G, F.bid);
              EpiGate4 E4{(bf16*)(ws + WS_G4), ssq_mix}; pg8::gemm_phase<EpiGate4, pg8::GridOrder, true, true>(lds, g4, S4, E4, F.wave); }
            SEAM(pb + 6);
        }
        if (KD(8) && IN(pb + 7)) {
            constexpr int KD2 = F8_G ? D / 2 : D; pg8::Gemm g{F8_G ? (const bf16*)(ws + WS_XH8) : (const bf16*)XH, (const bf16*)(ws + (l ? WS_WGT1 : WS_WGT0)), KD2, KD2, KD2, 0, 0}; pg8::GridOrder S; S.init(M / 256, 32, 1, F.G, F.bid);
            { const int sg = (F.bid >> 3) & 3; for (int i = 0; i < sg; ++i) __builtin_amdgcn_s_sleep(127); }
            EpiG E{(const bf16*)(ws + WS_ZB), (const bf16*)(ws + WS_G4), (bf16*)(ws + WS_MG), ssq_mix, F8_G ? W8SI : 1.f}; pg8::gemm_phase<EpiG, pg8::GridOrder, true, F8_G != 0>(lds, g, S, E, F.wave);
            SEAM(pb + 7);
        }
        if (KD(9) && IN(pb + 8)) {
            pg8::Gemm g{(const bf16*)(ws + WS_MG), (const bf16*)(ws + (l ? WS_WOT1 : WS_WOT0)), D, D, D, 0, 0}; pg8::GridOrder S; S.init(M / 256, 8, 1, F.G, F.bid);
            EpiRes E{XH, ssq_ffn, ws + WS_XH8, l == 1 || F8_F1 != 0}; pg8::gemm_phase<EpiRes, pg8::GridOrder>(lds, g, S, E, F.wave);
            SEAM(pb + 8);
        }
        if (l == 0) {
            if (KD(10) && IN(pb + 9)) {
                constexpr int KD2 = F8_F1 ? D / 2 : D; pg8::Gemm g{F8_F1 ? (const bf16*)(ws + WS_XH8) : (const bf16*)XH, (const bf16*)(ws + WS_W13T), KD2, KD2, KD2, 0, 0}; pg8::GridOrder S; S.init(M / 256, 2 * FF / 256, 1, F.G, F.bid);
                EpiSwiglu<false> E{(bf16*)(ws + WS_ACT), FF, ssq_ffn, nullptr, F8_F1 ? W8SI : 1.f, 1.f}; pg8::gemm_phase<EpiSwiglu<false>, pg8::GridOrder, true, F8_F1 != 0>(lds, g, S, E, F.wave);
                convert_late_loop<2>(F, F.ctl + CW_QCTR + 160);
                SEAM(pb + 9);
            }
            if (KD(11) && IN(pb + 10)) {
                pg8::Gemm g{(const bf16*)(ws + WS_ACT), (const bf16*)(ws + WS_W2T), FF, FF, FF, 0, 0}; pg8::GridOrder S; S.init(M / 256, 8, 1, F.G, F.bid);
                EpiRes E{XH, ssq_all + 2 * 8192, ws + WS_XH8, true}; pg8::gemm_phase<EpiRes, pg8::GridOrder>(lds, g, S, E, F.wave);
                SEAM(pb + 13);
            }
        } else {
            float* RSS = (float*)(ws + WS_RSS);
            if (KD(12) && IN(pb + 9)) { phase_route(F, XH); SEAM(pb + 9); }
            if (KD(13) && IN(pb + 10)) { phase_gather(F, RSS); SEAM(pb + 10); }
            if (KD(14) && IN(pb + 11)) {
                pg8::MoeOrder S; moe_tiles(F, S.ts); S.nN = 2 * EFF / 256; S.G = F.G; S.c = F.bid;
                constexpr int KD2 = F8_M1 ? D / 2 : D; pg8::Gemm g{(const bf16*)(ws + WS_XG), (const bf16*)(ws + WS_MW13T), KD2, KD2, KD2, 0, (size_t)2 * EFF * 2048 * (F8_M1 ? 1 : 2)};
                EpiSwiglu<F8_M2 != 0> E{(bf16*)(ws + WS_ACTM), EFF, nullptr, RSS, F8_M1 ? W8SI : 1.f, 8.f}; pg8::gemm_phase<EpiSwiglu<F8_M2 != 0>, pg8::MoeOrder, true, F8_M1 != 0>(lds, g, S, E, F.wave);
                SEAM(pb + 11);
            }
            if (KD(15) && IN(pb + 12)) {
                pg8::MoeOrder S; moe_tiles(F, S.ts); S.nN = 8; S.G = F.G; S.c = F.bid;
                constexpr int KE2 = F8_M2 ? EFF / 2 : EFF; pg8::Gemm g{(const bf16*)(ws + WS_ACTM), (const bf16*)(ws + WS_MW2T), KE2, KE2, KE2, 0, (size_t)2048 * EFF * (F8_M2 ? 1 : 2)};
                EpiBf E{(bf16*)(ws + WS_YS), D, F8_M2 ? W8SI / 8.f : 1.f}; pg8::gemm_phase<EpiBf, pg8::MoeOrder, true, F8_M2 != 0>(lds, g, S, E, F.wave);
                SEAM(pb + 12);
            }
            if (KD(16) && IN(pb + 13)) { phase_combine(F, XH, xout); }
        }
    };
    run_layer(std::integral_constant<int, 0>{});
    run_layer(std::integral_constant<int, 1>{});
#undef IN
#undef SEAM
}

#ifdef DBG_STOP
__global__ void dbg_dump(const unsigned char* buf, size_t nelem, int is_bf16, float* out, int nout) {
    for (int i = blockIdx.x * blockDim.x + threadIdx.x; i < nout; i += gridDim.x * blockDim.x) { float s = 0.f;
        for (size_t j = (size_t)i; j < nelem; j += (size_t)nout) s += is_bf16 ? bf2f(((const bf16*)buf)[j]) : ((const float*)buf)[j];
        out[i] = s; }
}
__global__ void dbg_cols(const bf16* buf, int ld, int c0, int w, float* out) {
    for (int i = blockIdx.x * blockDim.x + threadIdx.x; i < M * D; i += gridDim.x * blockDim.x) { const int row = i >> 11, c = i & 2047; out[i] = bf2f(buf[(size_t)row * ld + c0 + (c % w)]); }
}
#endif
extern "C" void kernel_launch(void* const* d_in, const int* in_sizes, int n_in, void* d_out, int out_size, void* d_ws, size_t ws_size, hipStream_t stream) {
    static int grid = 0;
    if (grid == 0) {
        if (n_in != 40 || out_size != M * D || ws_size < WS_END) { fprintf(stderr, "kernel_launch: unexpected shapes (n_in %d out %d ws %zu need %zu)\n", n_in, out_size, ws_size, (size_t)WS_END); grid = -1; return; }
        int dev = 0, cus = 0, per_cu = 0;
        if (hipGetDevice(&dev) != hipSuccess || hipDeviceGetAttribute(&cus, hipDeviceAttributeMultiprocessorCount, dev) != hipSuccess) { grid = -1; return; }
        if (hipFuncSetAttribute((const void*)mega_fwd, hipFuncAttributeMaxDynamicSharedMemorySize, LDS_BYTES) != hipSuccess) { fprintf(stderr, "kernel_launch: hipFuncSetAttribute failed\n"); grid = -1; return; }
        if (hipOccupancyMaxActiveBlocksPerMultiprocessor(&per_cu, (const void*)mega_fwd, 512, LDS_BYTES) != hipSuccess || per_cu < 1) fprintf(stderr, "kernel_launch: occupancy query reports %d\n", per_cu);
        (void)hipGetLastError();
        grid = cus;
    }
    if (grid < 0) return;
    if (hipMemsetAsync((char*)d_ws + WS_CTL, 0, CTL_BYTES, stream) != hipSuccess) return;
    Args a{};
    for (int i = 0; i < 40; ++i) a.in[i] = (const float*)d_in[i];
    a.out = (float*)d_out; a.ws = (unsigned char*)d_ws;
#if MK_ONE_LAUNCH
    a.ph_lo = 0; a.ph_hi = N_PHASES;
    hipLaunchKernelGGL(mega_fwd, dim3(grid), dim3(512), LDS_BYTES, stream, a);
#else
    for (int p = 0; p < N_PHASES; ++p) {
        if (p >= 1 + 11 && p < 1 + PH_PER_LAYER) continue;
#ifdef DBG_STOP
        if (p > DBG_STOP) break;
#endif
        a.ph_lo = p; a.ph_hi = p + 1;
        hipLaunchKernelGGL(mega_fwd, dim3(grid), dim3(512), LDS_BYTES, stream, a);
    }
#ifdef DBG_STOP
#ifdef DBG_C0
    hipLaunchKernelGGL(dbg_cols, dim3(2048), dim3(256), 0, stream, (const bf16*)((const unsigned char*)d_ws + (size_t)(DBG_OFF)), (int)(DBG_LD), (int)(DBG_C0), (int)(DBG_W), (float*)d_out);
#else
    hipLaunchKernelGGL(dbg_dump, dim3(2048), dim3(256), 0, stream, (const unsigned char*)d_ws + (size_t)(DBG_OFF), (size_t)(DBG_NELEM), (int)(DBG_BF16), (float*)d_out, M * D);
#endif
#endif
#endif
}
```
